# Optimizing an MI355X kernel written in HIP

```python
import math
import jax, jax.numpy as jnp
from jax import lax
import numpy as np

D_MODEL = 1024
BATCH = 8
SEQ = 2048
DEPTH = 2

GRID_W = 64
CTX_LEN = 256
N_MIXERS = 2
DIFF_HEAD_DIM = 64
DIFF_HEADS = D_MODEL // (2 * DIFF_HEAD_DIM)
GQA_HEAD_DIM = 128
GQA_Q_HEADS = D_MODEL // GQA_HEAD_DIM
GQA_KV_HEADS = 2
GQA_GROUP = GQA_Q_HEADS // GQA_KV_HEADS
Q_BLOCK = 128
ROPE_THETA = 10000.0
N_GROUPS = 4
EXPERTS_PER_GROUP = 8
N_EXPERTS = N_GROUPS * EXPERTS_PER_GROUP
EXPERT_TOP_K = 2
EXPERT_HIDDEN = D_MODEL // 4
N_MOD = 6
LN_EPS = 1e-5
RMS_EPS = 1e-6
DEEPNORM_ALPHA = (2 * DEPTH) ** 0.25
DEEPNORM_BETA = (8 * DEPTH) ** -0.25
N_DIFF_LAYERS = (DEPTH + 1) // 2
N_GQA_LAYERS = DEPTH // 2

kernel_name = "hybrid_diffattn_gqa_hmoe_prefix_dit"


def layer_norm(x, g, b):
    xf = x.astype(jnp.float32)
    mu = jnp.mean(xf, axis=-1, keepdims=True)
    var = jnp.mean(jnp.square(xf - mu), axis=-1, keepdims=True)
    return ((xf - mu) * lax.rsqrt(var + LN_EPS) * g + b).astype(x.dtype)


def rms_norm(x, g):
    xf = x.astype(jnp.float32)
    return (xf * lax.rsqrt(jnp.mean(xf * xf, axis=-1, keepdims=True) + RMS_EPS) * g).astype(x.dtype)


def modulation(cond, w_mod, b_mod):
    return jnp.split(jax.nn.silu(cond) @ w_mod + b_mod, N_MOD, axis=-1)


def axial_rope_tables(n, head_dim):
    rows = n // GRID_W
    row = jnp.broadcast_to(jnp.arange(rows, dtype=jnp.float32)[:, None], (rows, GRID_W)).reshape(-1)
    col = jnp.broadcast_to(jnp.arange(GRID_W, dtype=jnp.float32)[None, :], (rows, GRID_W)).reshape(-1)
    axis_dim = head_dim // 2
    inv_freq = ROPE_THETA ** (-jnp.arange(0, axis_dim, 2, dtype=jnp.float32) / axis_dim)
    ang = jnp.stack([row, col], axis=-1)[:, :, None] * inv_freq
    return jnp.cos(ang), jnp.sin(ang)


def apply_rope(x, cos, sin):
    d = x.shape[-1]
    xs = x.reshape(*x.shape[:-1], 2, 2, d // 4)
    x1, x2 = xs[..., 0, :], xs[..., 1, :]
    cos = cos.astype(x.dtype)
    sin = sin.astype(x.dtype)
    out = jnp.stack([x1 * cos - x2 * sin, x2 * cos + x1 * sin], axis=-2)
    return out.reshape(x.shape)


def sweep_queries(attend, q):
    n, dq = q.shape[-2], q.shape[-1]
    nb = n // Q_BLOCK
    qb = jnp.moveaxis(q.reshape(*q.shape[:-2], nb, Q_BLOCK, dq), -3, 0)
    ob = jnp.moveaxis(lax.map(attend, qb), 0, -3)
    return ob.reshape(*ob.shape[:-3], n, ob.shape[-1])


def diff_attention(hc, hx, w_qkv, w_o, lq1, lk1, lq2, lk2, subln_g, lambda_init, need_ctx):
    B, L, _ = hc.shape
    N = hx.shape[1]
    H, d = DIFF_HEADS, DIFF_HEAD_DIM
    T = L + N
    qkv = jnp.concatenate([hc, hx], axis=1) @ w_qkv
    q, k, v = jnp.split(qkv, 3, axis=-1)
    q = q.reshape(B, T, 2 * H, d).transpose(0, 2, 1, 3)
    k = k.reshape(B, T, 2 * H, d).transpose(0, 2, 1, 3)
    v = v.reshape(B, T, H, 2 * d).transpose(0, 2, 1, 3)
    cos, sin = axial_rope_tables(N, d)
    qx = apply_rope(q[:, :, L:], cos, sin)
    kx = apply_rope(k[:, :, L:], cos, sin)
    kc, vc = k[:, :, :L], v[:, :, :L]
    k_all = jnp.concatenate([kc, kx], axis=2)
    lam = (jnp.exp(jnp.sum(lq1.astype(jnp.float32) * lk1.astype(jnp.float32)))
           - jnp.exp(jnp.sum(lq2.astype(jnp.float32) * lk2.astype(jnp.float32))) + lambda_init)
    scale = d ** -0.5

    def diff_map(qb, keys, vals):
        s = jnp.einsum('bhqd,bhkd->bhqk', qb, keys).astype(jnp.float32) * scale
        p = jax.nn.softmax(s, axis=-1)
        p = p.reshape(B, H, 2, *p.shape[2:])
        a = p[:, :, 0] - lam * p[:, :, 1]
        return jnp.einsum('bhqk,bhkd->bhqd', a.astype(vals.dtype), vals)

    def finish(o):
        o = rms_norm(o, subln_g) * (1.0 - lambda_init)
        return o.transpose(0, 2, 1, 3).reshape(B, o.shape[2], H * 2 * d) @ w_o

    ox = finish(sweep_queries(lambda qb: diff_map(qb, k_all, v), qx))
    oc = finish(sweep_queries(lambda qb: diff_map(qb, kc, vc), q[:, :, :L])) if need_ctx else None
    return ox, oc


def gqa_attention(hc, hx, w_qkv, w_o, q_norm_g, k_norm_g, need_ctx):
    B, L, _ = hc.shape
    N = hx.shape[1]
    Hk, G, d = GQA_KV_HEADS, GQA_GROUP, GQA_HEAD_DIM
    T = L + N
    qkv = jnp.concatenate([hc, hx], axis=1) @ w_qkv
    q, k, v = jnp.split(qkv, [GQA_Q_HEADS * d, GQA_Q_HEADS * d + Hk * d], axis=-1)
    q = rms_norm(q.reshape(B, T, Hk, G, d), q_norm_g).transpose(0, 2, 3, 1, 4)
    k = rms_norm(k.reshape(B, T, Hk, d), k_norm_g).transpose(0, 2, 1, 3)
    v = v.reshape(B, T, Hk, d).transpose(0, 2, 1, 3)
    cos, sin = axial_rope_tables(N, d)
    qx = apply_rope(q[:, :, :, L:], cos, sin)
    kx = apply_rope(k[:, :, L:], cos, sin)
    kc, vc = k[:, :, :L], v[:, :, :L]
    k_all = jnp.concatenate([kc, kx], axis=2)
    scale = d ** -0.5

    def gqa_map(qb, keys, vals):
        s = jnp.einsum('bhgqd,bhkd->bhgqk', qb, keys).astype(jnp.float32) * scale
        p = jax.nn.softmax(s, axis=-1)
        return jnp.einsum('bhgqk,bhkd->bhgqd', p.astype(vals.dtype), vals)

    def finish(o):
        return o.transpose(0, 3, 1, 2, 4).reshape(B, o.shape[3], GQA_Q_HEADS * d) @ w_o

    ox = finish(sweep_queries(lambda qb: gqa_map(qb, k_all, v), qx))
    oc = finish(sweep_queries(lambda qb: gqa_map(qb, kc, vc), q[:, :, :, :L])) if need_ctx else None
    return ox, oc


def hier_moe(h, w_group, b_group, w_router, b_router, w_gate, w_up, w_down):
    shp = h.shape
    hf = h.reshape(-1, shp[-1])
    g_prob = jax.nn.softmax((hf @ w_group + b_group).astype(jnp.float32), axis=-1)
    g_top, g_idx = lax.top_k(g_prob, 1)
    g_onehot = jax.nn.one_hot(g_idx[:, 0], N_GROUPS, dtype=jnp.float32)
    e_logits = (hf @ w_router + b_router).astype(jnp.float32).reshape(-1, N_GROUPS, EXPERTS_PER_GROUP)
    e_sel = jnp.einsum('mg,mge->me', g_onehot, e_logits)
    e_prob = jax.nn.softmax(e_sel, axis=-1)
    e_top, e_idx = lax.top_k(e_prob, EXPERT_TOP_K)
    e_top = e_top / jnp.sum(e_top, axis=-1, keepdims=True)
    w_within = jnp.einsum('mk,mke->me', e_top, jax.nn.one_hot(e_idx, EXPERTS_PER_GROUP, dtype=jnp.float32))
    gate = g_onehot[:, :, None] * (g_top * w_within)[:, None, :]
    y = jnp.zeros_like(hf)
    for g in range(N_GROUPS):
        a = jnp.einsum('md,edf->mef', hf, w_gate[g])
        u = jnp.einsum('md,edf->mef', hf, w_up[g])
        act = jax.nn.silu(a) * u * gate[:, g, :, None].astype(hf.dtype)
        y = y + jnp.einsum('mef,efd->md', act, w_down[g])
    return y.reshape(shp)


def setup_inputs(seed: int = 0) -> dict:
    key = jax.random.key(seed)
    ks = jax.random.split(key, 32)
    D, F = D_MODEL, EXPERT_HIDDEN

    def nrm(k, shape, scale):
        return jax.random.normal(k, shape, jnp.float32) * scale

    gqa_qkv_width = GQA_Q_HEADS * GQA_HEAD_DIM + 2 * GQA_KV_HEADS * GQA_HEAD_DIM
    return {
        "x": nrm(ks[0], (BATCH, SEQ, D), 1.0),
        "c": nrm(ks[1], (BATCH, D), 1.0),
        "ctx": nrm(ks[2], (BATCH, CTX_LEN, D), 1.0),
        "c_ctx": nrm(ks[3], (D,), 1.0),
        "w_mod": nrm(ks[4], (DEPTH, D, N_MOD * D), 0.5 * D ** -0.5),
        "b_mod": nrm(ks[5], (DEPTH, N_MOD * D), 0.02),
        "ln_mix_g": 1.0 + nrm(ks[6], (DEPTH, D), 0.02),
        "ln_mix_b": nrm(ks[7], (DEPTH, D), 0.02),
        "ln_ffn_g": 1.0 + nrm(ks[8], (DEPTH, D), 0.02),
        "ln_ffn_b": nrm(ks[9], (DEPTH, D), 0.02),
        "diff_w_qkv": nrm(ks[10], (N_DIFF_LAYERS, D, 3 * D), D ** -0.5),
        "diff_w_o": nrm(ks[11], (N_DIFF_LAYERS, D, D), D ** -0.5 * DEEPNORM_BETA),
        "diff_lambda_q1": nrm(ks[12], (N_DIFF_LAYERS, DIFF_HEAD_DIM), 0.1),
        "diff_lambda_k1": nrm(ks[13], (N_DIFF_LAYERS, DIFF_HEAD_DIM), 0.1),
        "diff_lambda_q2": nrm(ks[14], (N_DIFF_LAYERS, DIFF_HEAD_DIM), 0.1),
        "diff_lambda_k2": nrm(ks[15], (N_DIFF_LAYERS, DIFF_HEAD_DIM), 0.1),
        "diff_subln_g": 1.0 + nrm(ks[16], (N_DIFF_LAYERS, 2 * DIFF_HEAD_DIM), 0.02),
        "gqa_w_qkv": nrm(ks[17], (N_GQA_LAYERS, D, gqa_qkv_width), D ** -0.5),
        "gqa_w_o": nrm(ks[18], (N_GQA_LAYERS, D, D), D ** -0.5 * DEEPNORM_BETA),
        "gqa_q_norm_g": 1.0 + nrm(ks[19], (N_GQA_LAYERS, GQA_HEAD_DIM), 0.02),
        "gqa_k_norm_g": 1.0 + nrm(ks[20], (N_GQA_LAYERS, GQA_HEAD_DIM), 0.02),
        "moe_w_group": nrm(ks[21], (DEPTH, D, N_GROUPS), D ** -0.5),
        "moe_b_group": nrm(ks[22], (DEPTH, N_GROUPS), 0.01),
        "moe_w_router": nrm(ks[23], (DEPTH, D, N_EXPERTS), D ** -0.5),
        "moe_b_router": nrm(ks[24], (DEPTH, N_EXPERTS), 0.01),
        "moe_w_gate": nrm(ks[25], (DEPTH, N_GROUPS, EXPERTS_PER_GROUP, D, F), D ** -0.5),
        "moe_w_up": nrm(ks[26], (DEPTH, N_GROUPS, EXPERTS_PER_GROUP, D, F), D ** -0.5),
        "moe_w_down": nrm(ks[27], (DEPTH, N_GROUPS, EXPERTS_PER_GROUP, F, D), F ** -0.5 * DEEPNORM_BETA),
    }


def reference(x, c, ctx, c_ctx, w_mod, b_mod, ln_mix_g, ln_mix_b, ln_ffn_g, ln_ffn_b,
              diff_w_qkv, diff_w_o, diff_lambda_q1, diff_lambda_k1, diff_lambda_q2, diff_lambda_k2,
              diff_subln_g, gqa_w_qkv, gqa_w_o, gqa_q_norm_g, gqa_k_norm_g,
              moe_w_group, moe_b_group, moe_w_router, moe_b_router, moe_w_gate, moe_w_up, moe_w_down):
    L = ctx.shape[1]
    for i in range(DEPTH):
        need_ctx = i < DEPTH - 1
        sx_m, ax_m, gx_m, sx_f, ax_f, gx_f = modulation(c[:, None, :], w_mod[i], b_mod[i])
        sc_m, ac_m, gc_m, sc_f, ac_f, gc_f = modulation(c_ctx, w_mod[i], b_mod[i])

        hx = x * (1.0 + ax_m) + sx_m
        hc = ctx * (1.0 + ac_m) + sc_m
        j = i // N_MIXERS
        if i % N_MIXERS == 0:
            lambda_init = 0.8 - 0.6 * math.exp(-0.3 * i)
            ox, oc = diff_attention(hc, hx, diff_w_qkv[j], diff_w_o[j], diff_lambda_q1[j], diff_lambda_k1[j],
                                    diff_lambda_q2[j], diff_lambda_k2[j], diff_subln_g[j], lambda_init, need_ctx)
        else:
            ox, oc = gqa_attention(hc, hx, gqa_w_qkv[j], gqa_w_o[j], gqa_q_norm_g[j], gqa_k_norm_g[j], need_ctx)
        x = layer_norm(DEEPNORM_ALPHA * x + gx_m * ox, ln_mix_g[i], ln_mix_b[i])

        hx = x * (1.0 + ax_f) + sx_f
        moe_args = (moe_w_group[i], moe_b_group[i], moe_w_router[i], moe_b_router[i],
                    moe_w_gate[i], moe_w_up[i], moe_w_down[i])
        if need_ctx:
            ctx = layer_norm(DEEPNORM_ALPHA * ctx + gc_m * oc, ln_mix_g[i], ln_mix_b[i])
            hc = ctx * (1.0 + ac_f) + sc_f
            f = hier_moe(jnp.concatenate([hc, hx], axis=1), *moe_args)
            fc, fx = f[:, :L], f[:, L:]
            ctx = layer_norm(DEEPNORM_ALPHA * ctx + gc_f * fc, ln_ffn_g[i], ln_ffn_b[i])
        else:
            fx = hier_moe(hx, *moe_args)
        x = layer_norm(DEEPNORM_ALPHA * x + gx_f * fx, ln_ffn_g[i], ln_ffn_b[i])
    return x
```

```cpp
#include <hip/hip_runtime.h>
#include <hip/hip_bf16.h>
#include <cstdio>
#include <cstdint>
__device__ __forceinline__ int ltid(int wv) { int l; asm volatile("v_mbcnt_lo_u32_b32 %0, -1, 0\n\tv_mbcnt_hi_u32_b32 %0, -1, %0" : "=v"(l)); return wv * 64 + l; }
namespace pg8 {
#define PG8_LAS __attribute__((address_space(3)))
typedef unsigned short bf16_t;
typedef short bf16x8 __attribute__((ext_vector_type(8)));
typedef float f32x4 __attribute__((ext_vector_type(4)));
typedef unsigned u32x4 __attribute__((ext_vector_type(4)));
constexpr int BM = 256, BK = 64, HALF = 128, HTB = HALF * BK * 2  , STAGE_BYTES = 8 * HTB, NXCD = 8, WGM = 8;

__host__ __device__ __forceinline__ int lds_byte(int r, int c) { const int st = (r >> 4) * 2 + (c >> 5), rr = r & 15, cc = c & 31, ob = rr * 64 + cc * 2; return st * 1024 + (ob ^ (((ob >> 9) & 1) << 5)); }
__host__ __device__ __forceinline__ void stage_rc(int b, int& R, int& C) { const int st = b / 1024, sb = b % 1024, swz = sb ^ (((sb >> 9) & 1) << 5); R = (st >> 1) * 16 + swz / 64; C = (st & 1) * 32 + (swz % 64) / 2; }
__host__ __device__ __forceinline__ int perm32(int rho) { const int n = rho >> 4, i = rho & 15; return 8 * (i >> 2) + 4 * n + (i & 3); }

struct Unit { int pm, pn, hm; };
struct Gemm { const bf16_t* A; const bf16_t* Bt; int M, N, K; };

struct StaticOrder {
    int nM, nN, nwg, G, c;
    __host__ __device__ void init(int M, int N, int G_, int c_) { nM = M / BM; nN = N / BM; nwg = nM * nN; G = G_; c = c_; }
    __host__ __device__ bool next(int i, Unit& u) const { return at((long)i * G + c, u); }
    __host__ __device__ bool at(const long L, Unit& u) const {
        if (L >= nwg) return false; u.hm = 0;
        int wgid = (int)L; { const int q = nwg / NXCD, r = nwg % NXCD, xcd = wgid % NXCD, off = wgid / NXCD; wgid = (xcd < r ? xcd * (q + 1) : r * (q + 1) + (xcd - r) * q) + off; }
        const int nig = WGM * nN, gid = wgid / nig, fm = gid * WGM, gsz = (nM - fm) < WGM ? (nM - fm) : WGM;
        u.pm = fm + ((wgid % nig) % gsz); u.pn = (wgid % nig) / gsz; return true;
    }
    __device__ __forceinline__ void a_ready(const Unit&) const {}
    __device__ __forceinline__ void done(const Unit&) const {}
};

__device__ __forceinline__ unsigned cvt_pk_bf16(float lo, float hi) { unsigned r; asm volatile("v_cvt_pk_bf16_f32 %0, %1, %2" : "=v"(r) : "v"(lo), "v"(hi)); return r; }
typedef float f32x2 __attribute__((ext_vector_type(2)));
struct NoGather {};
struct GatherA { const int* tok; const PG8_LAS int* tbase; const PG8_LAS int* cnt; int NP, cap; };
template <class Epi, class Sched, bool ALIGN_EPI = false, bool SP2 = false, bool GATHER = false, class GAT = NoGather>
__device__ __forceinline__ void gemm_phase(PG8_LAS unsigned char* lds, const Gemm g, const Sched& S, const Epi& E, const int wv, const GAT& GA = GAT()) {
    static_assert(!GATHER || SP2, "gather staging is written for the SP2 loop");
    const int tid = ltid(wv), wid = wv, lane = tid & 63, wr = wid >> 2, wc = wid & 3, fr = lane & 15, fq = lane >> 4;
    const int K = g.K, nt = K / BK;
    unsigned voffA[2], voffB[2];
#pragma unroll
    for (int i = 0; i < 2; ++i) { int R, C; stage_rc(tid * 16 + i * 8192, R, C); const int Rb = Epi::PERM ? ((R & ~31) + perm32(R & 31)) : R;
        voffA[i] = (unsigned)(R * K + C) * 2u; voffB[i] = (unsigned)(Rb * K + C) * 2u; }
    const size_t kstep = (size_t)(BK * 2);
    const size_t hstep = (size_t)HALF * K * 2;
    const size_t tstep = 2 * hstep;
    const unsigned ldsw = (unsigned)wid * 1024u;
    const int aoff = lds_byte(wr * 64 + fr, fq * 8), boff = lds_byte(wc * 32 + fr, fq * 8);
#define PG8_SA(b, h) (((b) * 2 + (h)) * HTB)
#define PG8_SB(b, h) ((4 + (b) * 2 + (h)) * HTB)
#define PG8_STAGE(bufoff, gbase, voff) do { _Pragma("unroll") for (int _i = 0; _i < 2; ++_i) \
        __builtin_amdgcn_global_load_lds((const unsigned*)((const char*)(gbase) + (voff)[_i]), (PG8_LAS unsigned*)(lds + (bufoff) + ldsw + _i * 8192), 16, 0, 0); } while (0)
#define PG8_STAGE_A(bufoff, ngptr, h, kofs, GV) do { if constexpr (GATHER) { PG8_STAGE(bufoff, (const char*)g.A + (kofs), GV[h]); } else { PG8_STAGE(bufoff, ngptr, voffA); } } while (0)
#define PG8_GOFS(dst, U) do { if constexpr (GATHER) { const int e_ = (U).pn / GA.NP; const int rk0_ = ((U).pm - GA.tbase[e_]) * 256; const int c_ = GA.cnt[e_]; \
        _Pragma("unroll") for (int h_ = 0; h_ < 2; ++h_) _Pragma("unroll") for (int i_ = 0; i_ < 2; ++i_) { int R_, C_; stage_rc(tid * 16 + i_ * 8192, R_, C_); const int rk_ = rk0_ + h_ * 128 + R_; \
            const int tk_ = rk_ < c_ ? GA.tok[(size_t)e_ * GA.cap + rk_] : 0; dst[h_][i_] = (unsigned)(tk_ * K + C_) * 2u; } } } while (0)
#define PG8_LDA(dst, b, h) do { _Pragma("unroll") for (int m = 0; m < 4; ++m) _Pragma("unroll") for (int k = 0; k < 2; ++k) dst[m][k] = *(const PG8_LAS bf16x8*)(lds + PG8_SA(b, h) + aoff + m * 2048 + k * 1024); } while (0)
#define PG8_LDB(dst, b, h) do { _Pragma("unroll") for (int n = 0; n < 2; ++n) _Pragma("unroll") for (int k = 0; k < 2; ++k) dst[n][k] = *(const PG8_LAS bf16x8*)(lds + PG8_SB(b, h) + boff + n * 2048 + k * 1024); } while (0)
#define PG8_MMA(ai, bj, At, Bt) do { if (cur.hm != 0 && cur.hm != (ai) + 1) break; __builtin_amdgcn_s_setprio(1); _Pragma("unroll") for (int m = 0; m < 4; ++m) _Pragma("unroll") for (int n = 0; n < 2; ++n) _Pragma("unroll") for (int k = 0; k < 2; ++k) \
        acc[ai][bj][m][n] = __builtin_amdgcn_mfma_f32_16x16x32_bf16(Bt[n][k], At[m][k], acc[ai][bj][m][n], 0, 0, 0); __builtin_amdgcn_s_setprio(0); } while (0)
#define PG8_WAIT_V(n) asm volatile("s_waitcnt vmcnt(" #n ")" ::: "memory")
#define PG8_WAIT_L(n) asm volatile("s_waitcnt lgkmcnt(" #n ")" ::: "memory")
#define PG8_BAR __builtin_amdgcn_s_barrier()
#define PG8_SCHED __builtin_amdgcn_sched_barrier(0)
    Unit cur, nxt; int ui = 0;
    if (!S.next(0, cur)) return;
    f32x4 acc[2][2][4][2];
#pragma unroll
    for (int a = 0; a < 2; ++a)
#pragma unroll
        for (int b = 0; b < 2; ++b)
#pragma unroll
            for (int m = 0; m < 4; ++m)
#pragma unroll
                for (int n = 0; n < 2; ++n) acc[a][b][m][n] = (f32x4){0.f, 0.f, 0.f, 0.f};
    bf16x8 At[4][2], B0[2][2], B1[2][2];
    const char* cA = (const char*)g.A + (size_t)cur.pm * tstep; const char* cB = (const char*)g.Bt + (size_t)cur.pn * tstep;
    S.a_ready(cur);
    unsigned curG[2][2] = {{0u, 0u}, {0u, 0u}}, nxtG[2][2] = {{0u, 0u}, {0u, 0u}};
    PG8_GOFS(curG, cur); { Unit n0_; if (S.next(1, n0_)) PG8_GOFS(nxtG, n0_); }
    if constexpr (SP2) {
        PG8_STAGE(PG8_SB(0, 0), cB, voffB); PG8_STAGE(PG8_SB(0, 1), cB + hstep, voffB); PG8_STAGE_A(PG8_SA(0, 0), cA, 0, (size_t)0, curG); PG8_STAGE_A(PG8_SA(0, 1), cA + hstep, 1, (size_t)0, curG);
        if (wr == 1) PG8_BAR;
        PG8_WAIT_V(2); PG8_BAR;
        PG8_STAGE(PG8_SB(1, 0), cB + kstep, voffB); PG8_STAGE_A(PG8_SA(1, 0), cA + kstep, 0, kstep, curG); PG8_STAGE(PG8_SB(1, 1), cB + hstep + kstep, voffB);
        PG8_WAIT_V(6); PG8_BAR;
    } else {
        PG8_STAGE(PG8_SB(0, 0), cB, voffB); PG8_STAGE(PG8_SA(0, 0), cA, voffA); PG8_STAGE(PG8_SB(0, 1), cB + hstep, voffB); PG8_STAGE(PG8_SA(0, 1), cA + hstep, voffA);
        if (wr == 1) PG8_BAR;
        PG8_WAIT_V(4); PG8_BAR;
        PG8_STAGE(PG8_SB(1, 0), cB + kstep, voffB); PG8_STAGE(PG8_SA(1, 0), cA + kstep, voffA); PG8_STAGE(PG8_SB(1, 1), cB + hstep + kstep, voffB);
        PG8_WAIT_V(6); PG8_BAR;
    }
    for (;;) {
        const bool has_next = S.next(ui + 1, nxt);
        if (GATHER && has_next && ui >= 1) PG8_GOFS(nxtG, nxt);
        const char* nA = has_next ? (const char*)g.A + (size_t)nxt.pm * tstep : cA; const char* nB = has_next ? (const char*)g.Bt + (size_t)nxt.pn * tstep : cB;
        for (int t = 0; t < nt; t += 2) {
            const bool last = (t == nt - 2);
            const char* a1 = cA + (size_t)(t + 1) * kstep;
            const char* a2 = last ? nA : cA + (size_t)(t + 2) * kstep; const char* b2 = last ? nB : cB + (size_t)(t + 2) * kstep;
            const char* a3 = a2 + kstep; const char* b3 = b2 + kstep;
            if (last && has_next) S.a_ready(nxt);
            const size_t k1o = (size_t)(t + 1) * kstep, k2o = last ? (size_t)0 : (size_t)(t + 2) * kstep; unsigned selG[2][2];
            _Pragma("unroll") for (int h_ = 0; h_ < 2; ++h_) _Pragma("unroll") for (int i_ = 0; i_ < 2; ++i_) selG[h_][i_] = (last && has_next) ? nxtG[h_][i_] : curG[h_][i_];
            if constexpr (SP2) {
            PG8_LDB(B0, 0, 0); PG8_LDB(B1, 0, 1); PG8_SCHED; PG8_LDA(At, 0, 0); PG8_STAGE_A(PG8_SA(1, 1), a1 + hstep, 1, k1o, curG);
            PG8_WAIT_V(8); PG8_WAIT_L(0); PG8_BAR; PG8_MMA(0, 0, At, B0); PG8_MMA(0, 1, At, B1); PG8_BAR; PG8_SCHED;
            PG8_LDA(At, 0, 1); PG8_STAGE(PG8_SB(0, 0), b2, voffB); PG8_STAGE(PG8_SB(0, 1), b2 + hstep, voffB); PG8_STAGE_A(PG8_SA(0, 0), a2, 0, k2o, selG);
            PG8_WAIT_V(8); PG8_WAIT_L(0); PG8_BAR; PG8_MMA(1, 0, At, B0); PG8_MMA(1, 1, At, B1); PG8_BAR; PG8_SCHED;
            PG8_LDB(B0, 1, 0); PG8_LDB(B1, 1, 1); PG8_SCHED; PG8_LDA(At, 1, 0); PG8_STAGE_A(PG8_SA(0, 1), a2 + hstep, 1, k2o, selG);
            PG8_WAIT_V(8); PG8_WAIT_L(0); PG8_BAR; PG8_MMA(0, 0, At, B0); PG8_MMA(0, 1, At, B1); PG8_BAR; PG8_SCHED;
            PG8_LDA(At, 1, 1); PG8_STAGE(PG8_SB(1, 0), b3, voffB); PG8_STAGE(PG8_SB(1, 1), b3 + hstep, voffB); PG8_STAGE_A(PG8_SA(1, 0), a3, 0, k2o + kstep, selG);
            PG8_WAIT_V(8); PG8_WAIT_L(0); PG8_BAR; PG8_MMA(1, 0, At, B0); PG8_MMA(1, 1, At, B1); PG8_BAR; PG8_SCHED;
            } else {
            PG8_LDB(B0, 0, 0); PG8_SCHED; PG8_LDA(At, 0, 0); PG8_STAGE(PG8_SA(1, 1), a1 + hstep, voffA);
            PG8_WAIT_L(8); PG8_BAR; PG8_WAIT_L(0); PG8_MMA(0, 0, At, B0); PG8_BAR; PG8_SCHED;
            PG8_LDB(B1, 0, 1); PG8_STAGE(PG8_SB(0, 0), b2, voffB);
            PG8_BAR; PG8_WAIT_L(0); PG8_MMA(0, 1, At, B1); PG8_BAR;
            PG8_LDA(At, 0, 1); PG8_STAGE(PG8_SA(0, 0), a2, voffA);
            PG8_BAR; PG8_WAIT_L(0); PG8_MMA(1, 0, At, B0); PG8_BAR; PG8_SCHED;
            PG8_STAGE(PG8_SB(0, 1), b2 + hstep, voffB);
            PG8_WAIT_V(6); PG8_BAR; PG8_MMA(1, 1, At, B1); PG8_BAR;
            PG8_LDB(B0, 1, 0); PG8_SCHED; PG8_LDA(At, 1, 0); PG8_STAGE(PG8_SA(0, 1), a2 + hstep, voffA);
            PG8_WAIT_L(8); PG8_BAR; PG8_WAIT_L(0); PG8_MMA(0, 0, At, B0); PG8_BAR; PG8_SCHED;
            PG8_LDB(B1, 1, 1); PG8_STAGE(PG8_SB(1, 0), b3, voffB);
            PG8_BAR; PG8_WAIT_L(0); PG8_MMA(0, 1, At, B1); PG8_BAR;
            PG8_LDA(At, 1, 1); PG8_STAGE(PG8_SA(1, 0), a3, voffA);
            PG8_BAR; PG8_WAIT_L(0); PG8_MMA(1, 0, At, B0); PG8_BAR; PG8_SCHED;
            PG8_STAGE(PG8_SB(1, 1), b3 + hstep, voffB);
            PG8_WAIT_V(6); PG8_BAR; PG8_MMA(1, 1, At, B1); PG8_BAR;
            }
        }
        if constexpr (ALIGN_EPI) { if (wr == 0) PG8_BAR; }
        if constexpr (!Epi::AFTER_DRAIN) { E(acc, cur, wr, wc, fr, fq); S.done(cur); }
        if (!has_next) break;
#pragma unroll
        for (int a = 0; a < 2; ++a)
#pragma unroll
            for (int b = 0; b < 2; ++b)
#pragma unroll
                for (int m = 0; m < 4; ++m)
#pragma unroll
                    for (int n = 0; n < 2; ++n) acc[a][b][m][n] = (f32x4){0.f, 0.f, 0.f, 0.f};
        cur = nxt; cA = nA; cB = nB; ++ui;
        _Pragma("unroll") for (int h_ = 0; h_ < 2; ++h_) _Pragma("unroll") for (int i_ = 0; i_ < 2; ++i_) curG[h_][i_] = nxtG[h_][i_];
        if constexpr (ALIGN_EPI) { if (wr == 1) PG8_BAR; }
    }
    PG8_WAIT_V(0);
    if constexpr (!ALIGN_EPI) { if (wr == 0) PG8_BAR; }
    PG8_BAR;
    if constexpr (Epi::AFTER_DRAIN) { E.fused(acc, cur, wr, wc, fr, fq, lds, wid, lane); S.done(cur); }
#undef PG8_SA
#undef PG8_SB
#undef PG8_STAGE
#undef PG8_LDA
#undef PG8_STAGE_A
#undef PG8_GOFS
#undef PG8_LDB
#undef PG8_MMA
#undef PG8_WAIT_V
#undef PG8_WAIT_L
#undef PG8_BAR
#undef PG8_SCHED
}
}

constexpr int NB = 8, NXT = 2048, LCT = 256, TT = 2304, DM = 1024;
constexpr int MALL = NB * TT;
constexpr int MXR = NB * NXT;
constexpr int NQKV0 = 3072, NQKV1 = 1536;
constexpr int NEXP = 32, FH = 256, NMOD = 6144;
constexpr float ALPHA = 1.41421356237309515f;
constexpr float LAMBDA_INIT0 = 0.2f;
constexpr float LN_EPS = 1e-5f, RMS_EPS = 1e-6f;
constexpr int SORT_ROWS = 45056;

#define GAS __attribute__((address_space(1)))
#define LAS __attribute__((address_space(3)))
typedef unsigned short bf16_t;
typedef unsigned v4u __attribute__((ext_vector_type(4)));
typedef unsigned v2u __attribute__((ext_vector_type(2)));
typedef float f32x4 __attribute__((ext_vector_type(4)));
typedef float f32x2 __attribute__((ext_vector_type(2)));
typedef short bf16x8 __attribute__((ext_vector_type(8)));
typedef short s16x4 __attribute__((ext_vector_type(4)));
typedef float f32x16 __attribute__((ext_vector_type(16)));
typedef GAS unsigned gu32;
#define RLX_AGENT __ATOMIC_RELAXED, __HIP_MEMORY_SCOPE_AGENT
#define LDS_WAIT() asm volatile("s_waitcnt lgkmcnt(0)" ::: "memory")
#define VM_WAIT() asm volatile("s_waitcnt vmcnt(0)" ::: "memory")

constexpr size_t MiB = 1u << 20;
constexpr size_t WS_CTL = 0, CTL_ZERO_BYTES = 1 * MiB;
constexpr size_t WS_MOD = 1 * MiB;
constexpr size_t WS_TAB64 = 1 * MiB + 512 * 1024;
constexpr size_t WS_TAB128 = WS_TAB64 + 8192;
constexpr size_t WS_WRT = WS_TAB64 + 65536;
constexpr size_t WS_TOKINFO = 2 * MiB;
constexpr size_t WS_TOKW = WS_TOKINFO + (size_t)MALL * 16;
constexpr size_t WS_TOKPOS = WS_TOKW + (size_t)MALL * 8;
constexpr size_t WS_GW = 3 * MiB;
constexpr size_t WS_XRC = 4 * MiB;
constexpr size_t WS_WQKV0 = 12 * MiB, WS_WO0 = 18 * MiB, WS_WQKV1 = 20 * MiB, WS_WO1 = 23 * MiB;
constexpr size_t WS_WGU = 26 * MiB;
constexpr size_t WS_WD = 58 * MiB;
constexpr size_t WS_HBUF = 74 * MiB;
constexpr size_t WS_QKV = 110 * MiB;
constexpr size_t WS_R1 = WS_QKV + 66 * MiB;
constexpr size_t WS_Y = 218 * MiB;
constexpr size_t WS_TOKOF = 306 * MiB;
constexpr size_t WS_GWOF = 309 * MiB;
constexpr int ECAP = 18432;
constexpr size_t WS_STATS = 312 * MiB;
constexpr size_t WS_ROWST = 315 * MiB;
constexpr size_t WS_YOFF = WS_QKV + 24 * MiB;
constexpr size_t WS_WRS = 316 * MiB;
constexpr size_t WS_END = 317 * MiB;
static_assert(WS_TOKPOS + (size_t)MALL * 8 <= WS_GW && WS_GW + SORT_ROWS * 4 <= WS_XRC && WS_XRC + 2048 * 4096 <= WS_WQKV0, "ws map");
static_assert(WS_YOFF + (size_t)MALL * DM * 4 <= WS_Y && (size_t)SORT_ROWS * FH * 2 <= 24 * MiB && WS_QKV + (size_t)MALL * 3072 * 2 <= WS_Y && WS_Y + (size_t)SORT_ROWS * 2048 <= WS_END && WS_HBUF + (size_t)MALL * 2048 <= WS_QKV, "ws map");
constexpr int CW_BAR = 4096;
constexpr int CW_CNT = 8192;

constexpr int RING_BYTES = 131072;
constexpr int MISC_OFF = 139264;
constexpr int TILEE_OFF = MISC_OFF + 256;
constexpr int ROWB_OFF = MISC_OFF + 512;
constexpr int LDS_BYTES = 147456;

__device__ __forceinline__ unsigned cvtpk(float lo, float hi) { unsigned r; asm volatile("v_cvt_pk_bf16_f32 %0, %1, %2" : "=v"(r) : "v"(lo), "v"(hi)); return r; }
__device__ __forceinline__ float bf_lo(unsigned u) { return __uint_as_float(u << 16); }
__device__ __forceinline__ float bf_hi(unsigned u) { return __uint_as_float(u & 0xffff0000u); }
template <int M> __device__ __forceinline__ float xsum(float v) {
    if constexpr (M < 32) return v + __int_as_float(__builtin_amdgcn_ds_swizzle(__float_as_int(v), (M << 10) | 0x1f));
    else { auto rr = __builtin_amdgcn_permlane32_swap(__float_as_uint(v), __float_as_uint(v), false, false); return __uint_as_float(rr[0]) + __uint_as_float(rr[1]); }
}
__device__ __forceinline__ float sum32(float v) { v = xsum<1>(v); v = xsum<2>(v); v = xsum<4>(v); v = xsum<8>(v); v = xsum<16>(v); return v; }
__device__ __forceinline__ float wave_sum(float v) { return xsum<32>(sum32(v)); }
__device__ __forceinline__ int row_b(int r) { return r / TT; }
__device__ __forceinline__ float* xr_ptr(float* out, float* xrc, int r) {
    const int b = r / TT, t = r - b * TT;
    return t < LCT ? xrc + ((size_t)b * LCT + t) * DM : out + ((size_t)b * NXT + (t - LCT)) * DM;
}
__device__ __forceinline__ const float* in0_ptr(const float* x, const float* ctx, int r) {
    const int b = r / TT, t = r - b * TT;
    return t < LCT ? ctx + ((size_t)b * LCT + t) * DM : x + ((size_t)b * NXT + (t - LCT)) * DM;
}

#define XB_TMO      128
#define XB_XCNT(j)  (256  + 64 * (j))
#define XB_XSUB(j)  (1280 + 64 * (j))
#define XB_XGEN(j)  (2304 + 64 * (j))
#define XB_TOP      3328
#define XB_TOPGEN   3392
#define XCD_BAR_WORDS 3456
#define XB_SPIN_CAP (1u << 18)
__device__ __forceinline__ unsigned xb_ld(unsigned* p)              { return __hip_atomic_load(p, __ATOMIC_RELAXED, __HIP_MEMORY_SCOPE_AGENT); }
__device__ __forceinline__ unsigned xb_add(unsigned* p, unsigned v) { return __hip_atomic_fetch_add(p, v, __ATOMIC_RELAXED, __HIP_MEMORY_SCOPE_AGENT); }
__device__ __forceinline__ unsigned xb_xcc_id() { return (unsigned)__builtin_amdgcn_s_getreg((3 << 11) | 20) & 0xFu; }
#define XB_SPIN(cond, bar) do { unsigned _sp = 0; while (cond) { __builtin_amdgcn_s_sleep(1); \
    if ((++_sp & 255u) == 0u) { if (xb_ld(&(bar)[XB_TMO])) break; if (_sp > XB_SPIN_CAP) { atomicAdd(&(bar)[XB_TMO], 1u); break; } } } } while (0)
__device__ __forceinline__ void xcd_barrier_post(unsigned* bar) {
    const unsigned x = xb_xcc_id();
    if (threadIdx.x == 0) (void)xb_add(&bar[XB_XCNT(x)], 1u);
}
__device__ __forceinline__ void xcd_barrier_complete(unsigned* bar, unsigned x, unsigned& nloc, unsigned& nx) {
    const unsigned G = gridDim.x * gridDim.y * gridDim.z;
    unsigned sum, cnt, mine, sp = 0u;
    for (;;) {
        sum = 0u; cnt = 0u; mine = 0u;
#pragma unroll
        for (unsigned j = 0; j < 16; ++j) { const unsigned c = xb_ld(&bar[XB_XCNT(j)]); sum += c; cnt += (c > 0u) ? 1u : 0u; mine = (j == x) ? c : mine; }
        if (sum == G) break;
        __builtin_amdgcn_s_sleep(1);
        if ((++sp & 255u) == 0u) { if (xb_ld(&bar[XB_TMO])) break; if (sp > XB_SPIN_CAP) { atomicAdd(&bar[XB_TMO], 1u); break; } }
    }
    nloc = mine > 0u ? mine : 1u; nx = cnt > 0u ? cnt : 1u;
}
__device__ __forceinline__ void xcd_barrier(unsigned* bar_in, volatile LAS unsigned* st, bool leader) {
    asm volatile("s_waitcnt vmcnt(0)" ::: "memory");
    __syncthreads();
    if (leader) {
        unsigned* bar = bar_in;
        unsigned bx_ = xb_xcc_id(); asm volatile("" : "+s"(bx_));
        __builtin_amdgcn_s_waitcnt(0);
        unsigned nloc = st[0], nx = st[1];
        if (nloc == 0u) { xcd_barrier_complete(bar, bx_, nloc, nx); st[0] = nloc; st[1] = nx; }
        const unsigned old = xb_add(&bar[XB_XSUB(bx_)], 1u);
        const unsigned gen = old / nloc;
        if (old + 1u == (gen + 1u) * nloc) {
            __builtin_amdgcn_fence(__ATOMIC_RELEASE, "agent");
            asm volatile("s_waitcnt vmcnt(0)" ::: "memory");
            const unsigned og = xb_add(&bar[XB_TOP], 1u);
            const unsigned tg = og / nx;
            if (og + 1u == (tg + 1u) * nx) xb_add(&bar[XB_TOPGEN], 1u);
            else XB_SPIN(xb_ld(&bar[XB_TOPGEN]) == tg, bar);
            __builtin_amdgcn_fence(__ATOMIC_ACQUIRE, "agent");
            asm volatile("s_waitcnt vmcnt(0)" ::: "memory");
        } else {
            XB_SPIN(xb_ld(&bar[XB_TOPGEN]) == gen, bar);
            __builtin_amdgcn_fence(__ATOMIC_ACQUIRE, "agent");
            asm volatile("s_waitcnt vmcnt(0)" ::: "memory");
        }
    }
    __syncthreads();
}

struct SchedRect {
    pg8::StaticOrder so; int xonly, n_extra, G, c, full, rsplit;
    __device__ void init(int nMt, int N, int G_, int c_, int xonly_, int n_extra_) { so.init(nMt * 256, N, G_, c_); xonly = xonly_; n_extra = n_extra_; G = G_; c = c_;
        const int r = so.nwg % G; full = so.nwg - r; rsplit = (n_extra == 0 && r > 0 && 2 * r <= G) ? r : 0; }
    __device__ bool next(int i, pg8::Unit& u) const {
        const long L = (long)i * G + c;
        if (rsplit && L >= full) { const int j = (int)(L - full); if (j >= 2 * rsplit) return false;
            so.at(full + (j >> 1), u); u.hm = 1 + (j & 1); if (xonly) u.pm = (u.pm >> 3) * 9 + 1 + (u.pm & 7); return true; }
        if (L < so.nwg) { so.at(L, u); if (xonly) u.pm = (u.pm >> 3) * 9 + 1 + (u.pm & 7); return true; }
        const int j = (int)(L - so.nwg); if (j >= n_extra) return false;
        u.pm = (j >> 1) * 9; u.pn = 4 + (j & 1); u.hm = 0; return true;
    }
    __device__ __forceinline__ void a_ready(const pg8::Unit&) const {}
    __device__ __forceinline__ void done(const pg8::Unit&) const {}
};
struct SchedExp {
    const LAS unsigned char* tile_e; int NP, nunits, G, c;
    __device__ bool next(int i, pg8::Unit& u) const {
        long L = (long)i * G + c; int hm = 0;
        const int rr = nunits % G, full = nunits - rr;
        if (rr > 0 && 2 * rr <= G && L >= full) { const int j = (int)(L - full); if (j >= 2 * rr) return false; L = full + (j >> 1); hm = 1 + (j & 1); }
        if (L >= nunits) return false;
        const int q = nunits / 8, r = nunits % 8, xcd = (int)(L % 8), off = (int)(L / 8);
        const int Lr = (xcd < r ? xcd * (q + 1) : r * (q + 1) + (xcd - r) * q) + off;
        const int tm = Lr / NP, pl = Lr % NP;
        u.pm = tm; u.pn = (int)tile_e[tm] * NP + pl; u.hm = hm; return true;
    }
    __device__ __forceinline__ void a_ready(const pg8::Unit&) const {}
    __device__ __forceinline__ void done(const pg8::Unit&) const {}
};

struct EpiStoreBf16 {
    static constexpr bool PERM = true, AFTER_DRAIN = false;
    bf16_t* O; int ldc; int pn_mask; const f32x2* tab; const float* kg; LAS float* xch;
    __device__ __forceinline__ void operator()(const pg8::f32x4 (&acc)[2][2][4][2], const pg8::Unit& u, int wr, int wc, int fr_in, int fq_in) const {
        int fr = fr_in, fq = fq_in; asm volatile("" : "+v"(fr), "+v"(fq));
        const int row0 = u.pm * 256 + wr * 64 + fr;
        if (kg == nullptr && tab != nullptr && u.pn >= 4 && u.pn < 8) {
            const int tj = u.pm % 9; const bool lat = tj != 0; const int nbase = (tj - 1) * 256 + wr * 64 + fr;
            const int ax = fq >> 1, f0 = (fq & 1) * 8; const int col0 = u.pn * 256 + wc * 64 + ax * 32 + f0;
#pragma unroll
            for (int ai = 0; ai < 2; ++ai) { if (u.hm != 0 && u.hm != ai + 1) continue;
#pragma unroll
                for (int m = 0; m < 4; ++m) { bf16_t* rowp = O + (size_t)(row0 + ai * 128 + m * 16) * ldc + col0;
                    float x1[8], x2[8];
#pragma unroll
                    for (int n = 0; n < 2; ++n)
#pragma unroll
                        for (int q = 0; q < 4; ++q) { x1[n * 4 + q] = acc[ai][0][m][n][q]; x2[n * 4 + q] = acc[ai][1][m][n][q]; }
                    if (lat) { const int nr = nbase + ai * 128 + m * 16; const int pos = ax ? (nr & 63) : (nr >> 6);
                        const pg8::f32x4* tp = (const pg8::f32x4*)(tab + pos * 16 + f0);
#pragma unroll
                        for (int q = 0; q < 4; ++q) { const pg8::f32x4 cs = tp[q];
                            const float a0 = x1[2 * q], b0 = x2[2 * q], a1 = x1[2 * q + 1], b1 = x2[2 * q + 1];
                            x1[2 * q] = a0 * cs[0] - b0 * cs[1]; x2[2 * q] = b0 * cs[0] + a0 * cs[1];
                            x1[2 * q + 1] = a1 * cs[2] - b1 * cs[3]; x2[2 * q + 1] = b1 * cs[2] + a1 * cs[3]; } }
                    v4u w; w.x = cvtpk(x1[0], x1[1]); w.y = cvtpk(x1[2], x1[3]); w.z = cvtpk(x1[4], x1[5]); w.w = cvtpk(x1[6], x1[7]);
                    *(v4u*)rowp = w;
                    w.x = cvtpk(x2[0], x2[1]); w.y = cvtpk(x2[2], x2[3]); w.z = cvtpk(x2[4], x2[5]); w.w = cvtpk(x2[6], x2[7]);
                    *(v4u*)(rowp + 16) = w; } }
            return;
        }
        if (kg != nullptr && u.pn == 4) {
            const int tj = u.pm % 9; const bool lat = tj != 0; const int nbase = (tj - 1) * 256 + wr * 64 + fr;
            const int hl = wc >> 1, ax = wc & 1, f0 = 8 * fq; const int col0k = 1024 + hl * 128 + ax * 64 + f0; const int wid = wr * 4 + wc;
            float ssq[2][4];
#pragma unroll
            for (int ai = 0; ai < 2; ++ai)
#pragma unroll
                for (int m = 0; m < 4; ++m) { float s = 0.f;
#pragma unroll
                    for (int bj = 0; bj < 2; ++bj)
#pragma unroll
                        for (int n = 0; n < 2; ++n)
#pragma unroll
                            for (int q = 0; q < 4; ++q) s += acc[ai][bj][m][n][q] * acc[ai][bj][m][n][q];
                    s = xsum<16>(s); s = xsum<32>(s);
                    ssq[ai][m] = s; if (fq == 0) xch[wid * 128 + ai * 64 + m * 16 + fr] = s; }
            asm volatile("s_waitcnt lgkmcnt(0)" ::: "memory"); __builtin_amdgcn_s_barrier(); asm volatile("" ::: "memory");
            const float g00 = 0.f; (void)g00;
            pg8::f32x4 gA[2][2];
#pragma unroll
            for (int bj = 0; bj < 2; ++bj)
#pragma unroll
                for (int n = 0; n < 2; ++n) gA[bj][n] = *(const pg8::f32x4*)(kg + ax * 64 + bj * 32 + f0 + 4 * n);
#pragma unroll
            for (int ai = 0; ai < 2; ++ai) { if (u.hm != 0 && u.hm != ai + 1) continue;
#pragma unroll
                for (int m = 0; m < 4; ++m) { bf16_t* rowp = O + (size_t)(row0 + ai * 128 + m * 16) * ldc + col0k;
                    const float tot = ssq[ai][m] + xch[(wid ^ 1) * 128 + ai * 64 + m * 16 + fr];
                    const float rs = 1.0f / sqrtf(tot * (1.f / 128.f) + RMS_EPS);
                    float x1[8], x2[8];
#pragma unroll
                    for (int n = 0; n < 2; ++n)
#pragma unroll
                        for (int q = 0; q < 4; ++q) { x1[n * 4 + q] = acc[ai][0][m][n][q] * rs * gA[0][n][q]; x2[n * 4 + q] = acc[ai][1][m][n][q] * rs * gA[1][n][q]; }
                    if (lat) { const int nr = nbase + ai * 128 + m * 16; const int pos = ax ? (nr & 63) : (nr >> 6);
                        const pg8::f32x4* tp = (const pg8::f32x4*)(tab + pos * 32 + f0);
#pragma unroll
                        for (int q = 0; q < 4; ++q) { const pg8::f32x4 cs = tp[q];
                            const float a0 = x1[2 * q], b0 = x2[2 * q], a1 = x1[2 * q + 1], b1 = x2[2 * q + 1];
                            x1[2 * q] = a0 * cs[0] - b0 * cs[1]; x2[2 * q] = b0 * cs[0] + a0 * cs[1];
                            x1[2 * q + 1] = a1 * cs[2] - b1 * cs[3]; x2[2 * q + 1] = b1 * cs[2] + a1 * cs[3]; } }
                    v4u w; w.x = cvtpk(x1[0], x1[1]); w.y = cvtpk(x1[2], x1[3]); w.z = cvtpk(x1[4], x1[5]); w.w = cvtpk(x1[6], x1[7]);
                    *(v4u*)rowp = w;
                    w.x = cvtpk(x2[0], x2[1]); w.y = cvtpk(x2[2], x2[3]); w.z = cvtpk(x2[4], x2[5]); w.w = cvtpk(x2[6], x2[7]);
                    *(v4u*)(rowp + 32) = w; } }
            asm volatile("s_waitcnt lgkmcnt(0)" ::: "memory"); __builtin_amdgcn_s_barrier(); asm volatile("" ::: "memory");
            return;
        }
        const int col0 = (u.pn & pn_mask) * 256 + wc * 32 + 8 * fq;
#pragma unroll
        for (int ai = 0; ai < 2; ++ai) { if (u.hm != 0 && u.hm != ai + 1) continue;
#pragma unroll
            for (int m = 0; m < 4; ++m) { bf16_t* rowp = O + (size_t)(row0 + ai * 128 + m * 16) * ldc + col0;
#pragma unroll
                for (int bj = 0; bj < 2; ++bj) { const pg8::f32x4 v0 = acc[ai][bj][m][0], v1 = acc[ai][bj][m][1];
                    v4u w; w.x = cvtpk(v0[0], v0[1]); w.y = cvtpk(v0[2], v0[3]); w.z = cvtpk(v1[0], v1[1]); w.w = cvtpk(v1[2], v1[3]);
                    *(v4u*)(rowp + bj * 128) = w; } } }
    }
};
typedef _Float16 hf_t;
typedef _Float16 hf2_t __attribute__((ext_vector_type(2)));
__device__ __forceinline__ unsigned pkh(float a, float b_) { const hf2_t v = {(hf_t)a, (hf_t)b_}; return __builtin_bit_cast(unsigned, v); }
__device__ __forceinline__ float hf_lo(unsigned u) { const hf2_t v = __builtin_bit_cast(hf2_t, u); return (float)v[0]; }
__device__ __forceinline__ float hf_hi(unsigned u) { const hf2_t v = __builtin_bit_cast(hf2_t, u); return (float)v[1]; }
template <int RH>
struct EpiResid {
    static constexpr bool PERM = true, AFTER_DRAIN = false;
    hf_t* Y; const float* xbase; const float* cbase; const float* modl; f32x2* stats;
    __device__ __forceinline__ void operator()(const pg8::f32x4 (&acc)[2][2][4][2], const pg8::Unit& u, int wr, int wc, int fr_in, int fq_in) const {
        int fr = fr_in, fq = fq_in; asm volatile("" : "+v"(fr), "+v"(fq));
        const int b = u.pm / 9, j = u.pm - b * 9;
        const size_t roff0 = (j == 0) ? (size_t)b * LCT * DM : ((size_t)b * NXT + (size_t)(j - 1) * 256) * DM;
        const float* rb = ((j == 0) ? cbase : xbase) + roff0; const hf_t* rbh = (const hf_t*)xbase + (RH == 2 ? (size_t)u.pm * 256 * DM : roff0);
        const float* g = modl + (size_t)(j == 0 ? 8 : b) * NMOD + 2048;
        const int col0 = u.pn * 256 + wc * 32 + 8 * fq;
        pg8::f32x4 gv[2][2];
#pragma unroll
        for (int bj = 0; bj < 2; ++bj)
#pragma unroll
            for (int n = 0; n < 2; ++n) gv[bj][n] = *(const pg8::f32x4*)(g + col0 + bj * 128 + n * 4);
#pragma unroll
        for (int ai = 0; ai < 2; ++ai) { if (u.hm != 0 && u.hm != ai + 1) continue;
#pragma unroll
            for (int mh = 0; mh < 2; ++mh) {
            pg8::f32x4 rva[2][2][2]; v4u rvh[2][2];
#pragma unroll
            for (int mm = 0; mm < 2; ++mm) { const size_t ro = (size_t)(ai * 128 + wr * 64 + (2 * mh + mm) * 16 + fr) * DM + col0;
#pragma unroll
                for (int bj = 0; bj < 2; ++bj) {
                    if constexpr (RH != 0) rvh[mm][bj] = *(const v4u*)(rbh + ro + bj * 128);
                    else {
#pragma unroll
                        for (int n = 0; n < 2; ++n) rva[mm][bj][n] = *(const pg8::f32x4*)(rb + ro + bj * 128 + n * 4); } } }
#pragma unroll
            for (int mm = 0; mm < 2; ++mm) { const int m = 2 * mh + mm; const int lr = ai * 128 + wr * 64 + m * 16 + fr;
                hf_t* yrow = Y + ((size_t)u.pm * 256 + lr) * DM + col0;
                float s = 0.f, q = 0.f;
#pragma unroll
                for (int bj = 0; bj < 2; ++bj) {
                    if constexpr (RH != 0) { const v4u h = rvh[mm][bj]; rva[mm][bj][0] = (pg8::f32x4){hf_lo(h.x), hf_hi(h.x), hf_lo(h.y), hf_hi(h.y)}; rva[mm][bj][1] = (pg8::f32x4){hf_lo(h.z), hf_hi(h.z), hf_lo(h.w), hf_hi(h.w)}; }
                    const pg8::f32x4 o0 = rva[mm][bj][0] * ALPHA + gv[bj][0] * acc[ai][bj][m][0], o1 = rva[mm][bj][1] * ALPHA + gv[bj][1] * acc[ai][bj][m][1];
                    s += ((o0[0] + o0[1]) + (o0[2] + o0[3])) + ((o1[0] + o1[1]) + (o1[2] + o1[3]));
                    q += ((o0[0] * o0[0] + o0[1] * o0[1]) + (o0[2] * o0[2] + o0[3] * o0[3])) + ((o1[0] * o1[0] + o1[1] * o1[1]) + (o1[2] * o1[2] + o1[3] * o1[3]));
                    v4u w; w.x = pkh(o0[0], o0[1]); w.y = pkh(o0[2], o0[3]); w.z = pkh(o1[0], o1[1]); w.w = pkh(o1[2], o1[3]);
                    *(v4u*)(yrow + bj * 128) = w; }
                s = xsum<16>(s); q = xsum<16>(q); s = xsum<32>(s); q = xsum<32>(q);
                if (fq == 0) stats[((size_t)u.pm * 256 + lr) * 16 + u.pn * 4 + wc] = (f32x2){s, q}; } } }
    }
};
struct EpiGateUp {
    static constexpr bool PERM = true, AFTER_DRAIN = false;
    bf16_t* ACT; const float* gwof; const LAS int* tbase;
    __device__ __forceinline__ void operator()(const pg8::f32x4 (&acc)[2][2][4][2], const pg8::Unit& u, int wr, int wc, int fr_in, int fq_in) const {
        int fr = fr_in, fq = fq_in; asm volatile("" : "+v"(fr), "+v"(fq));
        const int e = u.pn >> 1; const float* gwe = gwof + (size_t)e * ECAP + (u.pm - tbase[e]) * 256;
        const int lr0 = wr * 64 + fr; const int f0 = (u.pn & 1) * 128 + wc * 32 + 8 * fq;
#pragma unroll
        for (int ai = 0; ai < 2; ++ai) { if (u.hm != 0 && u.hm != ai + 1) continue;
#pragma unroll
            for (int m = 0; m < 4; ++m) { const int lr = lr0 + ai * 128 + m * 16; const float gw = gwe[lr];
                float o[8];
#pragma unroll
                for (int n = 0; n < 2; ++n)
#pragma unroll
                    for (int q = 0; q < 4; ++q) { const float a = acc[ai][0][m][n][q], up = acc[ai][1][m][n][q];
                        o[n * 4 + q] = a * __builtin_amdgcn_rcpf(1.f + __expf(-a)) * up * gw; }
                v4u w; w.x = cvtpk(o[0], o[1]); w.y = cvtpk(o[2], o[3]); w.z = cvtpk(o[4], o[5]); w.w = cvtpk(o[6], o[7]);
                *(v4u*)(ACT + ((size_t)u.pm * 256 + lr) * FH + f0) = w; } }
    }
};

namespace att {
constexpr int KVBLK = 64;
constexpr int SHM_V = KVBLK * 128 * 2, SHM_K = KVBLK * 128 * 2;
constexpr int OFF_WS = 2 * SHM_V + 2 * SHM_K;
constexpr int OFF_XCH = OFF_WS + 8 * 256;
constexpr int LDS_NEED = OFF_XCH + 4 * 16384;
static_assert(LDS_NEED <= MISC_OFF, "attention LDS");
constexpr float THR = 8.f;
#define KSWZ(row, colB) ((row) * 256 + ((colB) ^ (((row) & 7) << 4)))
#define SBAR() __builtin_amdgcn_sched_barrier(0)
__device__ __forceinline__ int crow(int r, int hi) { return (r & 3) + 8 * (r >> 2) + 4 * hi; }

template <bool DIFF> struct Cst { static constexpr float SCALE = DIFF ? 0.125f : 0.088388347648318440f; static constexpr float C = SCALE * 1.4426950408889634f; };

template <bool DIFF>
__device__ __forceinline__ void partialSM(f32x16& p0, f32x16& p1, float& m_reg, float& mn, float& alpha) {
  constexpr float C = Cst<DIFF>::C, SCALE = Cst<DIFF>::SCALE;
  float pmax = p0[0];
#pragma unroll
  for (int r = 1; r < 16; ++r) pmax = fmaxf(pmax, p0[r]);
#pragma unroll
  for (int r = 0; r < 16; ++r) pmax = fmaxf(pmax, p1[r]);
  { auto rr = __builtin_amdgcn_permlane32_swap(__float_as_uint(pmax), __float_as_uint(pmax), false, false);
    pmax = fmaxf(__uint_as_float(rr[0]), __uint_as_float(rr[1])); }
  if (__builtin_expect(__all(pmax - m_reg <= THR / SCALE), 1)) { mn = m_reg; alpha = 1.f; }
  else { mn = fmaxf(m_reg, pmax); alpha = __builtin_amdgcn_exp2f((m_reg - mn) * C); m_reg = mn; }
  float mnC = -mn * C;
#pragma unroll
  for (int r = 0; r < 16; ++r) p0[r] = fmaf(p0[r], C, mnC);
#pragma unroll
  for (int r = 0; r < 16; ++r) p1[r] = fmaf(p1[r], C, mnC);
#pragma unroll
  for (int r = 0; r < 16; ++r) p0[r] = __builtin_amdgcn_exp2f(p0[r]);
}
__device__ __forceinline__ void finishSM(f32x16& p0, f32x16& p1, float alpha, float& l_reg, bf16x8& pa0, bf16x8& pa1, bf16x8& pa2, bf16x8& pa3) {
#pragma unroll
  for (int r = 0; r < 16; ++r) p1[r] = __builtin_amdgcn_exp2f(p1[r]);
  float ps = 0;
#pragma unroll
  for (int r = 0; r < 16; ++r) ps += p0[r];
#pragma unroll
  for (int r = 0; r < 16; ++r) ps += p1[r];
  { auto rr = __builtin_amdgcn_permlane32_swap(__float_as_uint(ps), __float_as_uint(ps), false, false);
    ps = __uint_as_float(rr[0]) + __uint_as_float(rr[1]); }
  l_reg = l_reg * alpha + ps;
#define PK4(P, BASE, OUT) do { unsigned a0 = cvtpk(P[BASE + 0], P[BASE + 1]), a1 = cvtpk(P[BASE + 2], P[BASE + 3]);   \
    unsigned b0 = cvtpk(P[BASE + 4], P[BASE + 5]), b1 = cvtpk(P[BASE + 6], P[BASE + 7]);                              \
    auto r0 = __builtin_amdgcn_permlane32_swap(a0, b0, false, false); auto r1 = __builtin_amdgcn_permlane32_swap(a1, b1, false, false); \
    v4u w = {r0[0], r1[0], r0[1], r1[1]}; OUT = *reinterpret_cast<bf16x8*>(&w); } while (0)
  PK4(p0, 0, pa0); PK4(p0, 8, pa1); PK4(p1, 0, pa2); PK4(p1, 8, pa3);
#undef PK4
}
template <int NQ>
__device__ __forceinline__ void qkt(f32x16& p0, f32x16& p1, const char* Ks, const bf16x8* qr, int r32, int hi, int d0base) {
  p0 = f32x16{}; p1 = f32x16{};
#pragma unroll
  for (int d0 = 0; d0 < NQ; ++d0) { const int cb = ((d0base + d0) * 16 + hi * 8) * 2;
    bf16x8 b0 = *reinterpret_cast<const bf16x8*>(Ks + KSWZ(r32, cb));
    bf16x8 b1 = *reinterpret_cast<const bf16x8*>(Ks + KSWZ(32 + r32, cb));
    p0 = __builtin_amdgcn_mfma_f32_32x32x16_bf16(b0, qr[d0], p0, 0, 0, 0);
    p1 = __builtin_amdgcn_mfma_f32_32x32x16_bf16(b1, qr[d0], p1, 0, 0, 0); }
}
__device__ __forceinline__ int v_st(int k, int c) { const int kk = (k & ~0xC) | ((k & 4) << 1) | ((k & 8) >> 1); return ((kk >> 3) * 4 + (c >> 5)) * 512 + ((kk & 7) * 32 + (c & 31)) * 2; }
__device__ __forceinline__ int v_rd_base(int lane) { return ((lane & 3) << 3) | (((lane >> 2) & 3) << 6) | (((lane >> 4) & 1) << 5) | (((lane >> 5) & 1) << 8); }
constexpr int v_rd_off(int d0, int ks, int half) { return d0 * 512 + ks * 4096 + half * 2048; }
template <int OFF> __device__ __forceinline__ s16x4 tr_read(int vb) {
  s16x4 r; asm volatile("ds_read_b64_tr_b16 %0, %1 offset:%2" : "=&v"(r) : "v"(vb), "i"(OFF) : "memory"); return r;
}
template <int D0> __device__ __forceinline__ void pv_one(f32x16& od, int vb, bf16x8 pa0, bf16x8 pa1, bf16x8 pa2, bf16x8 pa3) {
  const s16x4 l0 = tr_read<v_rd_off(D0, 0, 0)>(vb), h0 = tr_read<v_rd_off(D0, 0, 1)>(vb), l1 = tr_read<v_rd_off(D0, 1, 0)>(vb), h1 = tr_read<v_rd_off(D0, 1, 1)>(vb);
  const s16x4 l2 = tr_read<v_rd_off(D0, 2, 0)>(vb), h2 = tr_read<v_rd_off(D0, 2, 1)>(vb), l3 = tr_read<v_rd_off(D0, 3, 0)>(vb), h3 = tr_read<v_rd_off(D0, 3, 1)>(vb);
  asm volatile("s_waitcnt lgkmcnt(0)" ::: "memory"); SBAR();
#define PK(L, H) (bf16x8){L[0], L[1], L[2], L[3], H[0], H[1], H[2], H[3]}
  od = __builtin_amdgcn_mfma_f32_32x32x16_bf16(pa0, PK(l0, h0), od, 0, 0, 0);
  od = __builtin_amdgcn_mfma_f32_32x32x16_bf16(pa1, PK(l1, h1), od, 0, 0, 0);
  od = __builtin_amdgcn_mfma_f32_32x32x16_bf16(pa2, PK(l2, h2), od, 0, 0, 0);
  od = __builtin_amdgcn_mfma_f32_32x32x16_bf16(pa3, PK(l3, h3), od, 0, 0, 0);
#undef PK
}
__device__ __forceinline__ void pv_d0(f32x16* o, int vb, bf16x8 pa0, bf16x8 pa1, bf16x8 pa2, bf16x8 pa3) {
  pv_one<0>(o[0], vb, pa0, pa1, pa2, pa3); pv_one<1>(o[1], vb, pa0, pa1, pa2, pa3); pv_one<2>(o[2], vb, pa0, pa1, pa2, pa3); pv_one<3>(o[3], vb, pa0, pa1, pa2, pa3);
}

constexpr float THRL = THR * 1.4426950408889634f;
__device__ __forceinline__ void qkt_negm(f32x16& p0, f32x16& p1, const char* Ks, const bf16x8* qr, const f32x16& negm, int r32, int hi, int d0base) {
#pragma unroll
  for (int d0 = 0; d0 < 4; ++d0) { const int cb = ((d0base + d0) * 16 + hi * 8) * 2;
    bf16x8 b0 = *reinterpret_cast<const bf16x8*>(Ks + KSWZ(r32, cb));
    bf16x8 b1 = *reinterpret_cast<const bf16x8*>(Ks + KSWZ(32 + r32, cb));
    if (d0 == 0) { p0 = __builtin_amdgcn_mfma_f32_32x32x16_bf16(b0, qr[0], negm, 0, 0, 0); p1 = __builtin_amdgcn_mfma_f32_32x32x16_bf16(b1, qr[0], negm, 0, 0, 0); }
    else { p0 = __builtin_amdgcn_mfma_f32_32x32x16_bf16(b0, qr[d0], p0, 0, 0, 0); p1 = __builtin_amdgcn_mfma_f32_32x32x16_bf16(b1, qr[d0], p1, 0, 0, 0); } }
}
__device__ __forceinline__ void splat16(f32x16& v, float x) {
#pragma unroll
  for (int r = 0; r < 16; ++r) v[r] = x;
}
__device__ __forceinline__ void partial_first_negm(f32x16& p0, f32x16& p1, float& m_reg, f32x16& negm) {
  float pmax = p0[0];
#pragma unroll
  for (int r = 1; r < 16; ++r) pmax = fmaxf(pmax, p0[r]);
#pragma unroll
  for (int r = 0; r < 16; ++r) pmax = fmaxf(pmax, p1[r]);
  { auto rr = __builtin_amdgcn_permlane32_swap(__float_as_uint(pmax), __float_as_uint(pmax), false, false);
    pmax = fmaxf(__uint_as_float(rr[0]), __uint_as_float(rr[1])); }
  m_reg = pmax; splat16(negm, -pmax);
#pragma unroll
  for (int r = 0; r < 16; ++r) { p0[r] -= pmax; p1[r] -= pmax; }
#pragma unroll
  for (int r = 0; r < 16; ++r) p0[r] = __builtin_amdgcn_exp2f(p0[r]);
}
__device__ __forceinline__ void pv_partial_negm(f32x16* o, int vb, bf16x8 pa0, bf16x8 pa1, bf16x8 pa2, bf16x8 pa3, f32x16& p0, f32x16& p1, float& m_reg, f32x16& negm, float& alpha) {
  pv_one<0>(o[0], vb, pa0, pa1, pa2, pa3);
  float pmax = p0[0];
#pragma unroll
  for (int r = 1; r < 16; ++r) pmax = fmaxf(pmax, p0[r]);
  pv_one<1>(o[1], vb, pa0, pa1, pa2, pa3);
#pragma unroll
  for (int r = 0; r < 16; ++r) pmax = fmaxf(pmax, p1[r]);
  { auto rr = __builtin_amdgcn_permlane32_swap(__float_as_uint(pmax), __float_as_uint(pmax), false, false);
    pmax = fmaxf(__uint_as_float(rr[0]), __uint_as_float(rr[1])); }
  if (__builtin_expect(__all(pmax <= THRL), 1)) { alpha = 1.f; }
  else { const float d = fmaxf(pmax, 0.f); alpha = __builtin_amdgcn_exp2f(-d); m_reg += d; splat16(negm, -m_reg);
#pragma unroll
    for (int r = 0; r < 16; ++r) { p0[r] -= d; p1[r] -= d; } }
  pv_one<2>(o[2], vb, pa0, pa1, pa2, pa3);
  pv_one<3>(o[3], vb, pa0, pa1, pa2, pa3);
#pragma unroll
  for (int r = 0; r < 16; ++r) p0[r] = __builtin_amdgcn_exp2f(p0[r]);
  asm volatile("" : "+v"(p0), "+v"(p1));
  SBAR();
}

template <bool DIFF>
__device__ __forceinline__ void pv_partial(f32x16* o, int vb, bf16x8 pa0, bf16x8 pa1, bf16x8 pa2, bf16x8 pa3, f32x16& p0, f32x16& p1, float& m_reg, float& mn, float& alpha) {
  constexpr float C = Cst<DIFF>::C, SCALE = Cst<DIFF>::SCALE;
  pv_one<0>(o[0], vb, pa0, pa1, pa2, pa3);
  float pmax = p0[0];
#pragma unroll
  for (int r = 1; r < 16; ++r) pmax = fmaxf(pmax, p0[r]);
  pv_one<1>(o[1], vb, pa0, pa1, pa2, pa3);
#pragma unroll
  for (int r = 0; r < 16; ++r) pmax = fmaxf(pmax, p1[r]);
  { auto rr = __builtin_amdgcn_permlane32_swap(__float_as_uint(pmax), __float_as_uint(pmax), false, false);
    pmax = fmaxf(__uint_as_float(rr[0]), __uint_as_float(rr[1])); }
  if (__builtin_expect(__all(pmax - m_reg <= THR / SCALE), 1)) { mn = m_reg; alpha = 1.f; }
  else { mn = fmaxf(m_reg, pmax); alpha = __builtin_amdgcn_exp2f((m_reg - mn) * C); m_reg = mn; }
  pv_one<2>(o[2], vb, pa0, pa1, pa2, pa3);
  const float mnC = -mn * C;
#pragma unroll
  for (int r = 0; r < 16; ++r) p0[r] = fmaf(p0[r], C, mnC);
#pragma unroll
  for (int r = 0; r < 16; ++r) p1[r] = fmaf(p1[r], C, mnC);
  pv_one<3>(o[3], vb, pa0, pa1, pa2, pa3);
#pragma unroll
  for (int r = 0; r < 16; ++r) p0[r] = __builtin_amdgcn_exp2f(p0[r]);
  asm volatile("" : "+v"(p0), "+v"(p1));
  SBAR();
}

template <bool DIFF>
__device__ __forceinline__ void attn_unit(const bf16_t* __restrict__ Qb, int ldq, const bf16_t* __restrict__ Kh, const bf16_t* __restrict__ Vh, int ldk, int seq,
                                          bf16_t* __restrict__ Ob, int ldo, bool rope, int n0, const f32x2* __restrict__ tab,
                                          const float* __restrict__ qg  , const float* __restrict__ subg  , float lam, char* lds, const int wv) {
  constexpr int NQ = DIFF ? 4 : 8;
  const int tid = ltid(wv), wid = wv, lane = tid & 63, r32 = lane & 31, hi = lane >> 5;
  const int qblk = DIFF ? (wid & 3) : wid, map = DIFF ? (wid >> 2) : 0;
  char* V_lds = lds; char* K_lds = lds + 2 * SHM_V;
  float* wsf = (float*)(lds + OFF_WS) + wid * 64; float* li_l = wsf; float* al_l = wsf + 32;
  float m_reg = -1e30f, l_reg = 0; f32x16 o[4] = {}; bf16x8 qr[NQ];
  const int sr = tid >> 4, sc = (tid & 15) * 8, vst0 = v_st(sr, sc), vst1 = v_st(32 + sr, sc);
  const int vb0 = (int)(uintptr_t)V_lds + v_rd_base(lane);
  struct { bf16x8 vs0, vs1, ks0, ks1; } sr_[2] = {};
#define LD8(p) (*reinterpret_cast<const bf16x8*>(p))
#define SLOAD(i, k0) do { sr_[i].vs0 = LD8(&Vh[(size_t)((k0) + sr) * ldk + sc]); sr_[i].vs1 = LD8(&Vh[(size_t)((k0) + 32 + sr) * ldk + sc]); \
    sr_[i].ks0 = LD8(&Kh[(size_t)((k0) + sr) * ldk + sc]); sr_[i].ks1 = LD8(&Kh[(size_t)((k0) + 32 + sr) * ldk + sc]); } while (0)
#define SWRITE(b, i) do { *(bf16x8*)(V_lds + (b) * SHM_V + vst0) = sr_[i].vs0;          \
    *(bf16x8*)(V_lds + (b) * SHM_V + vst1) = sr_[i].vs1; int kc = sc * 2;               \
    *(bf16x8*)(K_lds + (b) * SHM_K + KSWZ(sr, kc)) = sr_[i].ks0;                       \
    *(bf16x8*)(K_lds + (b) * SHM_K + KSWZ(32 + sr, kc)) = sr_[i].ks1; } while (0)
  constexpr int SE = 0, SO = 1;
  SLOAD(SE, 0); SLOAD(SO, KVBLK);
  {
    const bf16_t* Qw = Qb + (size_t)(qblk * 32 + r32) * ldq + map * 64 + hi * 8;
    const int n = n0 + qblk * 32 + r32;
    float qf[NQ][8];
#pragma unroll
    for (int d0 = 0; d0 < NQ; ++d0) { const v4u w = *reinterpret_cast<const v4u*>(Qw + d0 * 16);
      qf[d0][0] = bf_lo(w.x); qf[d0][1] = bf_hi(w.x); qf[d0][2] = bf_lo(w.y); qf[d0][3] = bf_hi(w.y);
      qf[d0][4] = bf_lo(w.z); qf[d0][5] = bf_hi(w.z); qf[d0][6] = bf_lo(w.w); qf[d0][7] = bf_hi(w.w); }
    if constexpr (!DIFF) {
      float ss = 0.f;
#pragma unroll
      for (int d0 = 0; d0 < NQ; ++d0)
#pragma unroll
        for (int j = 0; j < 8; ++j) ss += qf[d0][j] * qf[d0][j];
      ss = xsum<32>(ss);
      const float rs = 1.0f / sqrtf(ss * (1.f / 128.f) + RMS_EPS);
#pragma unroll
      for (int d0 = 0; d0 < NQ; ++d0) { const f32x4 g0 = *(const f32x4*)(qg + d0 * 16 + hi * 8), g1 = *(const f32x4*)(qg + d0 * 16 + hi * 8 + 4);
#pragma unroll
        for (int j = 0; j < 4; ++j) { qf[d0][j] *= rs * g0[j]; qf[d0][4 + j] *= rs * g1[j]; } }
    }
    if (rope) {
      constexpr int NF = DIFF ? 16 : 32;
      constexpr int HB = DIFF ? 1 : 2;
#pragma unroll
      for (int ax = 0; ax < 2; ++ax) { const int pos = ax ? (n & 63) : (n >> 6);
#pragma unroll
        for (int hb = 0; hb < HB; ++hb) { const int dA = ax * 2 * HB + hb, dB = dA + HB;
          const f32x2* tp = tab + pos * NF + hb * 16 + hi * 8;
#pragma unroll
          for (int j = 0; j < 8; ++j) { const f32x2 cs = tp[j]; const float x1 = qf[dA][j], x2 = qf[dB][j];
            qf[dA][j] = x1 * cs.x - x2 * cs.y; qf[dB][j] = x2 * cs.x + x1 * cs.y; } } }
    }
    if constexpr (DIFF) {
#pragma unroll
      for (int d0 = 0; d0 < NQ; ++d0)
#pragma unroll
        for (int j = 0; j < 8; ++j) qf[d0][j] *= Cst<true>::C; }
#pragma unroll
    for (int d0 = 0; d0 < NQ; ++d0) { v4u w = {cvtpk(qf[d0][0], qf[d0][1]), cvtpk(qf[d0][2], qf[d0][3]), cvtpk(qf[d0][4], qf[d0][5]), cvtpk(qf[d0][6], qf[d0][7])};
      qr[d0] = *reinterpret_cast<bf16x8*>(&w); }
  }
#define SWAIT() asm volatile("s_waitcnt vmcnt(4)" ::: "memory")
#define RESC(a) do { if (__any((a) < 1.f)) { if (hi == 0) al_l[r32] = (a); asm volatile("s_waitcnt lgkmcnt(0)" ::: "memory"); \
    _Pragma("unroll") for (int d = 0; d < 4; ++d) _Pragma("unroll") for (int r = 0; r < 16; ++r) o[d][r] *= al_l[crow(r, hi)]; } } while (0)
  f32x16 pA0, pA1, pB0, pB1; float mnA, mnB, alA, alB; bf16x8 pa0, pa1, pa2, pa3; const int NT = seq / KVBLK;
  const int dbase = map * 4;
  f32x16 negm = {};
  if constexpr (DIFF) m_reg = 0.f;
#define QKT(P0, P1, KS) do { if constexpr (DIFF) qkt_negm(P0, P1, KS, qr, negm, r32, hi, dbase); else qkt<NQ>(P0, P1, KS, qr, r32, hi, dbase); } while (0)
#define PVP(VB, P0, P1, MN, AL) do { if constexpr (DIFF) pv_partial_negm(o, VB, pa0, pa1, pa2, pa3, P0, P1, m_reg, negm, AL); else pv_partial<DIFF>(o, VB, pa0, pa1, pa2, pa3, P0, P1, m_reg, MN, AL); } while (0)
  SWAIT(); SWRITE(0, SE); __syncthreads();
  QKT(pA0, pA1, K_lds); if constexpr (DIFF) { partial_first_negm(pA0, pA1, m_reg, negm); alA = 1.f; } else partialSM<DIFF>(pA0, pA1, m_reg, mnA, alA);
  if (2 < NT) SLOAD(SE, 2 * KVBLK);
  SWAIT(); SWRITE(1, SO); __syncthreads();
  for (int j = 1; j + 1 < NT; j += 2) {
    SBAR(); QKT(pB0, pB1, K_lds + SHM_K);
    finishSM(pA0, pA1, alA, l_reg, pa0, pa1, pa2, pa3); SBAR();
    SLOAD(SO, (j + 2) * KVBLK); SBAR();
    PVP(vb0, pB0, pB1, mnB, alB);
    __syncthreads(); SWAIT(); SWRITE(0, SE);
    RESC(alB); __syncthreads();
    SBAR(); QKT(pA0, pA1, K_lds);
    finishSM(pB0, pB1, alB, l_reg, pa0, pa1, pa2, pa3); SBAR();
    if (j + 3 < NT) SLOAD(SE, (j + 3) * KVBLK); SBAR();
    PVP(vb0 + (int)SHM_V, pA0, pA1, mnA, alA);
    __syncthreads(); SWAIT(); SWRITE(1, SO);
    RESC(alA); __syncthreads();
  }
  SBAR(); QKT(pB0, pB1, K_lds + SHM_K);
  finishSM(pA0, pA1, alA, l_reg, pa0, pa1, pa2, pa3); SBAR();
  PVP(vb0, pB0, pB1, mnB, alB);
  __syncthreads(); RESC(alB);
  finishSM(pB0, pB1, alB, l_reg, pa0, pa1, pa2, pa3); SBAR();
  pv_d0(o, vb0 + (int)SHM_V, pa0, pa1, pa2, pa3);
  if (hi == 0) li_l[r32] = l_reg; asm volatile("s_waitcnt lgkmcnt(0)" ::: "memory");
#pragma unroll
  for (int r = 0; r < 16; ++r) { const float rl = __builtin_amdgcn_rcpf(li_l[crow(r, hi)]);
#pragma unroll
    for (int d0 = 0; d0 < 4; ++d0) o[d0][r] *= rl; }
  if constexpr (!DIFF) {
    bf16_t* ost = (bf16_t*)(lds + OFF_XCH) + wid * (32 * 136);
#pragma unroll
    for (int r = 0; r < 16; ++r) { const int orow = crow(r, hi);
#pragma unroll
      for (int d0 = 0; d0 < 4; ++d0) ost[orow * 136 + d0 * 32 + r32] = (bf16_t)(cvtpk(o[d0][r], 0.f) & 0xffffu); }
    asm volatile("s_waitcnt lgkmcnt(0)" ::: "memory");
    bf16_t* Ow = Ob + (size_t)(wid * 32) * ldo;
#pragma unroll
    for (int i = 0; i < 8; ++i) { const int c = i * 64 + lane, orow = c >> 4, ch = c & 15;
      *(v4u*)(Ow + (size_t)orow * ldo + ch * 8) = *(const v4u*)(ost + orow * 136 + ch * 8); }
  } else {
    float* xch = (float*)(lds + OFF_XCH) + qblk * 4096;
    if (map == 1) {
#pragma unroll
      for (int d0 = 0; d0 < 4; ++d0)
#pragma unroll
        for (int r = 0; r < 16; ++r) xch[(d0 * 16 + r) * 64 + lane] = o[d0][r];
    }
    __syncthreads();
    if (map == 0) {
      float ssr[16];
#pragma unroll
      for (int r = 0; r < 16; ++r) { float s = 0.f;
#pragma unroll
        for (int d0 = 0; d0 < 4; ++d0) { const float d = o[d0][r] - lam * xch[(d0 * 16 + r) * 64 + lane]; o[d0][r] = d; s += d * d; }
        ssr[r] = s; }
#pragma unroll
      for (int r = 0; r < 16; ++r) { float s = ssr[r];
        s = sum32(s);
        ssr[r] = (1.0f / sqrtf(s * (1.f / 128.f) + RMS_EPS)) * (1.f - LAMBDA_INIT0); }
      asm volatile("s_waitcnt lgkmcnt(0)" ::: "memory");
      bf16_t* ost = (bf16_t*)xch;
#pragma unroll
      for (int d0 = 0; d0 < 4; ++d0) { const float g = subg[d0 * 32 + r32];
#pragma unroll
        for (int r = 0; r < 16; ++r) ost[crow(r, hi) * 136 + d0 * 32 + r32] = (bf16_t)(cvtpk(o[d0][r] * ssr[r] * g, 0.f) & 0xffffu); }
      asm volatile("s_waitcnt lgkmcnt(0)" ::: "memory");
      bf16_t* Ow = Ob + (size_t)(qblk * 32) * ldo;
#pragma unroll
      for (int i = 0; i < 8; ++i) { const int c = i * 64 + lane, orow = c >> 4, ch = c & 15;
        *(v4u*)(Ow + (size_t)orow * ldo + ch * 8) = *(const v4u*)(ost + orow * 136 + ch * 8); }
    }
  }
#undef QKT
#undef PVP
#undef LD8
#undef SLOAD
#undef SWRITE
#undef SWAIT
#undef RESC
}
#undef KSWZ
#undef SBAR
}

#ifndef REPMASK
#define REPMASK 0
#endif
#ifndef REPN
#define REPN 1
#endif
#ifndef PHMASK
#define PHMASK 0x3ffff
#endif
struct Args { const float* in[28]; float* o_; unsigned char* w_; };
enum { I_X = 0, I_C, I_CTX, I_CCTX, I_WMOD, I_BMOD, I_LNMG, I_LNMB, I_LNFG, I_LNFB, I_DWQKV, I_DWO, I_LQ1, I_LK1, I_LQ2, I_LK2, I_SUBG,
       I_GWQKV, I_GWO, I_GQN, I_GKN, I_WGRP, I_BGRP, I_WRT, I_BRT, I_WGATE, I_WUP, I_WDOWN };

constexpr int PTR_OFF = MISC_OFF + 1024;
__device__ __forceinline__ const float* ldptr(LAS unsigned char* ldsl, int i) {
    int off = PTR_OFF + 8 * i; asm volatile("" : "+v"(off));
    const LAS unsigned* p = (const LAS unsigned*)(ldsl + off);
    const unsigned lo = __builtin_amdgcn_readfirstlane(p[0]), hi = __builtin_amdgcn_readfirstlane(p[1]);
    return (const float*)(GAS const float*)(((unsigned long long)hi << 32) | lo);
}
struct TrItem { const float* W; int N; bf16_t* WT; int KT; int dstrow0; int k0; int n0; int hi_stride; };
__device__ __forceinline__ void transpose_load(const TrItem& I, float (&wv_)[32], int lane) {
    const unsigned vo_ = (unsigned)((lane >> 3) * I.N + (lane & 7) * 4) * 4u;
#pragma unroll
    for (int i = 0; i < 8; ++i) { const f32x4 w = __builtin_nontemporal_load((const f32x4*)((const char*)(I.W + (size_t)(I.k0 + 8 * i) * I.N + I.n0) + vo_));
        wv_[4 * i] = w[0]; wv_[4 * i + 1] = w[1]; wv_[4 * i + 2] = w[2]; wv_[4 * i + 3] = w[3]; }
}
__device__ __forceinline__ void transpose_finish(const TrItem& I, const float (&wv_)[32], LAS float* scr, int lane) {
#pragma unroll
    for (int i = 0; i < 8; ++i)
#pragma unroll
        for (int j = 0; j < 4; ++j) scr[(8 * i + (lane >> 3)) * 33 + (lane & 7) * 4 + j] = wv_[4 * i + j];
    LDS_WAIT(); asm volatile("" ::: "memory");
    const int c = lane & 7;
#pragma unroll
    for (int j = 0; j < 4; ++j) { const int n = (lane >> 3) + 8 * j; const LAS float* s = scr + (8 * c) * 33 + n;
        v4u o; o.x = cvtpk(s[0 * 33], s[1 * 33]); o.y = cvtpk(s[2 * 33], s[3 * 33]); o.z = cvtpk(s[4 * 33], s[5 * 33]); o.w = cvtpk(s[6 * 33], s[7 * 33]);
        *(v4u*)(I.WT + (size_t)(I.dstrow0 + (n & 15) + (n >> 4) * I.hi_stride) * I.KT + I.k0 + 8 * c) = o; }
    LDS_WAIT(); asm volatile("" ::: "memory");
}
__device__ __forceinline__ void transpose_item(const float* __restrict__ W, int N, bf16_t* __restrict__ WT, int KT, int dstrow0, int k0, int n0, LAS float* scr, int lane, int hi_stride = 16) {
    const TrItem I{W, N, WT, KT, dstrow0, k0, n0, hi_stride}; float wv_[32];
    transpose_load(I, wv_, lane); transpose_finish(I, wv_, scr, lane);
}
__device__ __forceinline__ TrItem moe_item_desc(LAS unsigned char* ldsl, int layer, int it, bf16_t* wgu_, bf16_t* wd_) {
    const int e = it / 384, r = it - e * 384;
    const size_t eoff = ((size_t)layer * NEXP + e) * (size_t)DM * FH;
    if (r < 256) {
        const int isup = r >> 7, rr = r & 127, kb = rr >> 3, nb = rr & 7, n0 = nb * 32;
        const float* W = (isup ? ldptr(ldsl, I_WUP) : ldptr(ldsl, I_WGATE)) + eoff;
        return TrItem{W, FH, wgu_, DM, e * 512 + (n0 >> 7) * 256 + isup * 128 + (n0 & 127), kb * 64, n0, 16};
    }
    const int rr = r - 256, kb = rr >> 5, nb = rr & 31;
    return TrItem{ldptr(ldsl, I_WDOWN) + eoff, DM, wd_, FH, e * 1024 + nb * 32, kb * 64, nb * 32, 16};
}
__device__ __forceinline__ void moe_weight_item(LAS unsigned char* ldsl, int layer, int it, bf16_t* wgu_, bf16_t* wd_, LAS float* scr, int lane) {
    const TrItem I = moe_item_desc(ldsl, layer, it, wgu_, wd_); float wv_[32];
    transpose_load(I, wv_, lane); transpose_finish(I, wv_, scr, lane);
}
__device__ __forceinline__ void moe_weight_pair(LAS unsigned char* ldsl, int layer, int ita, int itb, bf16_t* wgu_, bf16_t* wd_, LAS float* scr, int lane) {
    const TrItem A = moe_item_desc(ldsl, layer, ita, wgu_, wd_), B = moe_item_desc(ldsl, layer, itb, wgu_, wd_); float wa_[32], wb_[32];
    transpose_load(A, wa_, lane); transpose_load(B, wb_, lane);
    transpose_finish(A, wa_, scr, lane); transpose_finish(B, wb_, scr, lane);
}
__device__ __forceinline__ int pcol(int lane, int c) { return 8 * lane + 512 * (c >> 1) + 4 * (c & 1); }
__device__ __forceinline__ void store_h_row(const f32x4 (&v)[4], const float* __restrict__ sv, const float* __restrict__ av, bf16_t* __restrict__ hrow, int lane) {
#pragma unroll
    for (int j = 0; j < 2; ++j) { const int col = 8 * lane + 512 * j;
        const f32x4 s0 = *(const f32x4*)(sv + col), s1 = *(const f32x4*)(sv + col + 4), a0 = *(const f32x4*)(av + col), a1 = *(const f32x4*)(av + col + 4);
        const f32x4 h0 = v[2 * j] * (a0 + 1.0f) + s0, h1 = v[2 * j + 1] * (a1 + 1.0f) + s1;
        v4u w; w.x = cvtpk(h0[0], h0[1]); w.y = cvtpk(h0[2], h0[3]); w.z = cvtpk(h1[0], h1[1]); w.w = cvtpk(h1[2], h1[3]); *(v4u*)(hrow + col) = w; }
}
__device__ __forceinline__ void ln_row(f32x4 (&v)[4], const float* __restrict__ g, const float* __restrict__ bb, int lane, float& mean_o, float& rstd_o) {
    float s = 0.f;
#pragma unroll
    for (int j = 0; j < 4; ++j) s += (v[j][0] + v[j][1]) + (v[j][2] + v[j][3]);
    const float mean = wave_sum(s) * (1.f / DM); float s2 = 0.f;
#pragma unroll
    for (int j = 0; j < 4; ++j) { v[j] = v[j] - mean; s2 += (v[j][0] * v[j][0] + v[j][1] * v[j][1]) + (v[j][2] * v[j][2] + v[j][3] * v[j][3]); }
    const float rstd = 1.0f / sqrtf(wave_sum(s2) * (1.f / DM) + LN_EPS);
#pragma unroll
    for (int j = 0; j < 4; ++j) { const int col = pcol(lane, j); const f32x4 gg = *(const f32x4*)(g + col), b4 = *(const f32x4*)(bb + col); v[j] = v[j] * rstd * gg + b4; }
    mean_o = mean; rstd_o = rstd;
}

__device__ __forceinline__ int row_of(int layer, int idx, int per_item, int it, int j) { (void)idx;
    if (layer == 0) return it * per_item + j; const int xi = it * per_item + j; return (xi >> 11) * TT + LCT + (xi & 2047); }
template <int RB>
__device__ __forceinline__ void p8_rows(int idx0, int layer, const int4* __restrict__ tinfo, const LAS int* rowb, const bf16_t* __restrict__ fo, const hf_t* __restrict__ Yp, const f32x2* __restrict__ rst, const float* __restrict__ mg, const float* __restrict__ mb, float* outp, float* xrcp,
                                        const float* __restrict__ modlp, const float* __restrict__ modn, const float* __restrict__ fg, const float* __restrict__ fb, bf16_t* hbp, hf_t* r1p, int lane) {
    f32x4 v[RB][4]; v4u yh[RB][2], fa[RB][2], fc[RB][2]; int rr[RB]; int4 ti[RB];
#pragma unroll
    for (int q = 0; q < RB; ++q) { const int idx = idx0 + q; rr[q] = layer == 0 ? idx : (idx >> 11) * TT + LCT + (idx & 2047); ti[q] = tinfo[rr[q]]; }
    f32x2 st[RB];
#pragma unroll
    for (int q = 0; q < RB; ++q) { const hf_t* xr = Yp + (size_t)rr[q] * DM; st[q] = rst[rr[q]];
        const bf16_t* f1 = fo + (size_t)(rowb[ti[q].x] + ti[q].y) * DM; const bf16_t* f2 = fo + (size_t)(rowb[ti[q].z] + ti[q].w) * DM;
#pragma unroll
        for (int j = 0; j < 2; ++j) yh[q][j] = *(const v4u*)(xr + 8 * lane + 512 * j);
#pragma unroll
        for (int j = 0; j < 2; ++j) { fa[q][j] = *(const v4u*)(f1 + 8 * lane + 512 * j); fc[q][j] = *(const v4u*)(f2 + 8 * lane + 512 * j); } }
#pragma unroll
    for (int q = 0; q < RB; ++q) { const int r = rr[q]; const int b = r / TT, t = r - b * TT; const int cond = t < LCT ? 8 : b;
        const float* gf = modlp + (size_t)cond * NMOD + 5120;
#pragma unroll
        for (int c = 0; c < 4; ++c) { const int col = pcol(lane, c); const v4u a4 = fa[q][c >> 1], c4 = fc[q][c >> 1];
            const unsigned ax = (c & 1) ? a4.z : a4.x, ay = (c & 1) ? a4.w : a4.y, cx = (c & 1) ? c4.z : c4.x, cy = (c & 1) ? c4.w : c4.y;
            const f32x4 f = {bf_lo(ax) + bf_lo(cx), bf_hi(ax) + bf_hi(cx), bf_lo(ay) + bf_lo(cy), bf_hi(ay) + bf_hi(cy)};
            const v4u y4 = yh[q][c >> 1]; const unsigned yx = (c & 1) ? y4.z : y4.x, yy = (c & 1) ? y4.w : y4.y;
            const f32x4 yv = {hf_lo(yx), hf_hi(yx), hf_lo(yy), hf_hi(yy)};
            const f32x4 x1 = (yv - st[q].x) * st[q].y * *(const f32x4*)(mg + col) + *(const f32x4*)(mb + col);
            v[q][c] = x1 * ALPHA + *(const f32x4*)(gf + col) * f; }
        float mean, rstd; ln_row(v[q], fg, fb, lane, mean, rstd); }
#pragma unroll
    for (int q = 0; q < RB; ++q) { const int r = rr[q]; const int b = r / TT, t = r - b * TT; const int cond = t < LCT ? 8 : b;
        if (layer == 0) { if (t >= LCT) { hf_t* xh = r1p + ((size_t)b * NXT + (t - LCT)) * DM;
#pragma unroll
                for (int j = 0; j < 2; ++j) { const f32x4 a = v[q][2 * j], c4 = v[q][2 * j + 1]; v4u w; w.x = pkh(a[0], a[1]); w.y = pkh(a[2], a[3]); w.z = pkh(c4[0], c4[1]); w.w = pkh(c4[2], c4[3]);
                    *(v4u*)(xh + 8 * lane + 512 * j) = w; } } }
        else { float* xr = xr_ptr(outp, xrcp, r);
#pragma unroll
            for (int c = 0; c < 4; ++c) *(f32x4*)(xr + pcol(lane, c)) = v[q][c]; }
        if (layer == 0) { const float* mv = modn + (size_t)cond * NMOD; store_h_row(v[q], mv, mv + 1024, hbp + (size_t)r * DM, lane); } }
}

template <int RB>
__device__ __forceinline__ void h0_rows(int r0, const float* __restrict__ xin, const float* __restrict__ cin, const float* __restrict__ mv0, bf16_t* hb, hf_t* xh, int lane) {
    f32x4 v[RB][4];
#pragma unroll
    for (int q = 0; q < RB; ++q) { const float* src = in0_ptr(xin, cin, r0 + q);
#pragma unroll
        for (int j = 0; j < 2; ++j) { v[q][2 * j] = *(const f32x4*)(src + 8 * lane + 512 * j); v[q][2 * j + 1] = *(const f32x4*)(src + 8 * lane + 512 * j + 4); } }
#pragma unroll
    for (int q = 0; q < RB; ++q) { const int r = r0 + q; const int b = r / TT, t = r - b * TT; const int cond = t < LCT ? 8 : b;
        const float* sv = mv0 + (size_t)cond * NMOD; const float* av = sv + 1024; bf16_t* hrow = hb + (size_t)r * DM;
#pragma unroll
        for (int j = 0; j < 2; ++j) { const int col = 8 * lane + 512 * j;
            const f32x4 s0 = *(const f32x4*)(sv + col), s1 = *(const f32x4*)(sv + col + 4), a0 = *(const f32x4*)(av + col), a1 = *(const f32x4*)(av + col + 4);
            const f32x4 h0 = v[q][2 * j] * (a0 + 1.0f) + s0, h1 = v[q][2 * j + 1] * (a1 + 1.0f) + s1;
            v4u w; w.x = cvtpk(h0[0], h0[1]); w.y = cvtpk(h0[2], h0[3]); w.z = cvtpk(h1[0], h1[1]); w.w = cvtpk(h1[2], h1[3]); *(v4u*)(hrow + col) = w;
            const f32x4 x0 = v[q][2 * j], x1 = v[q][2 * j + 1];
            v4u xw; xw.x = pkh(x0[0], x0[1]); xw.y = pkh(x0[2], x0[3]); xw.z = pkh(x1[0], x1[1]); xw.w = pkh(x1[2], x1[3]); *(v4u*)(xh + (size_t)r * DM + col) = xw; } }
}

__global__ void __launch_bounds__(512, 2) fwd_megakernel(Args args) {
    extern __shared__ __attribute__((aligned(16))) unsigned char lds[];
    LAS unsigned char* ldsl = (LAS unsigned char*)lds;
    volatile LAS unsigned* MISC = (volatile LAS unsigned*)(ldsl + MISC_OFF);
    const int G0 = gridDim.x; const int bx0 = blockIdx.x;
    const int vcu0 = (G0 % 8 == 0) ? (bx0 % 8) * (G0 / 8) + bx0 / 8 : bx0;
    const int wv = __builtin_amdgcn_readfirstlane(threadIdx.x >> 6);
#define PHASE_IDS() int G = G0, bx = bx0, vcu = vcu0; asm volatile("" : "+s"(G), "+s"(bx), "+s"(vcu)); const int NGW = G * 8; (void)NGW; (void)bx; int wave = wv; asm volatile("" : "+s"(wave)); const int tid = ltid(wave); (void)tid; const int lane = tid & 63; const int gw = vcu * 8 + wave; (void)gw; (void)lane
#define AIN(i) ldptr(ldsl, (i))
#define WSB ((unsigned char*)ldptr(ldsl, 29))
#define ctl ((gu32*)(WSB + WS_CTL))
#define modv ((float*)(WSB + WS_MOD))
#define tab64 ((f32x2*)(WSB + WS_TAB64))
#define tab128 ((f32x2*)(WSB + WS_TAB128))
#define wrt ((float*)(WSB + WS_WRT))
#define wrs ((bf16_t*)(WSB + WS_WRS))
#define tokinfo ((int4*)(WSB + WS_TOKINFO))
#define tokof ((int*)(WSB + WS_TOKOF))
#define rstats ((f32x2*)(WSB + WS_STATS))
#define gwof ((float*)(WSB + WS_GWOF))
#define ACTB ((bf16_t*)(WSB + WS_QKV))
#define XRC ((float*)(WSB + WS_XRC))
#define wqkv0 ((bf16_t*)(WSB + WS_WQKV0))
#define wo0 ((bf16_t*)(WSB + WS_WO0))
#define wqkv1 ((bf16_t*)(WSB + WS_WQKV1))
#define wo1 ((bf16_t*)(WSB + WS_WO1))
#define wgu ((bf16_t*)(WSB + WS_WGU))
#define wd ((bf16_t*)(WSB + WS_WD))
#define HB ((bf16_t*)(WSB + WS_HBUF))
#define QKV ((bf16_t*)(WSB + WS_QKV))
#define HS QKV
#define Y ((hf_t*)(WSB + WS_YOFF))
#define rowst ((f32x2*)(WSB + WS_ROWST))
#define FO ((bf16_t*)(WSB + WS_Y))
#define out ((float*)ldptr(ldsl, 28))
    for (int u = threadIdx.x; u < (LDS_BYTES - MISC_OFF) / 4; u += 512) ((LAS unsigned*)(ldsl + MISC_OFF))[u] = 0u;
    __syncthreads();
    if (threadIdx.x == 0) { LAS unsigned long long* pt = (LAS unsigned long long*)(ldsl + PTR_OFF);
#pragma unroll
        for (int i = 0; i < 28; ++i) pt[i] = (unsigned long long)args.in[i];
        pt[28] = (unsigned long long)args.o_; pt[29] = (unsigned long long)args.w_; }
    __syncthreads();
    xcd_barrier_post((unsigned*)(ctl + CW_BAR));
#define GRID_BAR() xcd_barrier((unsigned*)(ctl + CW_BAR), MISC + 8, ltid(wv) == 0)

        for (int rep_ = 0; rep_ < ((REPMASK >> 0) & 1) * REPN + 1; ++rep_) {
    if (PHMASK & (1 << 0)) {
        PHASE_IDS();
        for (int it = bx; it < 192; it += G) {
            const int layer = it / 96, col0 = (it % 96) * 64;
            const float* Wm = AIN(I_WMOD) + (size_t)layer * DM * NMOD;
            LAS float* sl = (LAS float*)(ldsl + wave * 8192);
            const int k0 = wave * 128;
            for (int idx = lane; idx < 9 * 128; idx += 64) { const int cond = idx >> 7, kk = idx & 127;
                const float v = cond < 8 ? AIN(I_C)[cond * DM + k0 + kk] : AIN(I_CCTX)[k0 + kk];
                sl[idx] = v / (1.f + expf(-v)); }
            LDS_WAIT(); asm volatile("" ::: "memory");
            const int rg = lane >> 4, c4 = (lane & 15) * 4;
            f32x4 acc[9];
#pragma unroll
            for (int c = 0; c < 9; ++c) acc[c] = (f32x4){0.f, 0.f, 0.f, 0.f};
            const unsigned lofs = (unsigned)(rg * NMOD + c4) * 4u;
#pragma unroll 1
            for (int kb = 0; kb < 128; kb += 64) { f32x4 wv_[16];
#pragma unroll
                for (int i = 0; i < 16; ++i) wv_[i] = __builtin_nontemporal_load((const f32x4*)((const char*)(Wm + (size_t)(k0 + kb + 4 * i) * NMOD + col0) + lofs));
#pragma unroll
                for (int i = 0; i < 16; ++i) {
#pragma unroll
                    for (int c = 0; c < 9; ++c) acc[c] += wv_[i] * sl[c * 128 + kb + 4 * i + rg]; } }
            LAS float* part = (LAS float*)(ldsl + 65536);
#pragma unroll
            for (int c = 0; c < 9; ++c) *(LAS f32x4*)(part + (wave * 4 + rg) * 576 + c * 64 + c4) = acc[c];
            __syncthreads();
            for (int idx = tid; idx < 576; idx += 512) { float s = 0.f;
#pragma unroll
                for (int w = 0; w < 32; ++w) s += part[w * 576 + idx];
                const int cond = idx >> 6, col = col0 + (idx & 63);
                modv[((size_t)layer * 9 + cond) * NMOD + col] = s + AIN(I_BMOD)[layer * NMOD + col]; }
            __syncthreads();
        }
        for (int idx = bx * 512 + tid; idx < 3072 + 2 * 8 * 4 * 3 * 64; idx += G * 512) {
            if (idx < 1024) { const int pos = idx >> 4, f = idx & 15; const float inv = powf(10000.f, -(float)(2 * f) / 32.f); float s, c; sincosf((float)pos * inv, &s, &c); tab64[idx] = (f32x2){c, s}; }
            else if (idx < 3072) { const int i2 = idx - 1024, pos = i2 >> 5, f = i2 & 31; const float inv = powf(10000.f, -(float)(2 * f) / 64.f); float s, c; sincosf((float)pos * inv, &s, &c); tab128[i2] = (f32x2){c, s}; }
            else { const int i2 = idx - 3072, ln = i2 & 63, nb = (i2 >> 6) % 3, s = ((i2 >> 6) / 3) & 3, w = ((i2 >> 6) / 12) & 7, l = (i2 >> 6) / 96;
                const int k0 = 128 * w + 32 * s + 8 * (ln >> 4), o = nb * 16 + (ln & 15); float wv_[8];
#pragma unroll
                for (int j = 0; j < 8; ++j) wv_[j] = o < 4 ? AIN(I_WGRP)[(size_t)l * DM * 4 + (k0 + j) * 4 + o] : (o < 36 ? AIN(I_WRT)[(size_t)l * DM * 32 + (k0 + j) * 32 + (o - 4)] : 0.f);
                unsigned hi_[4], lo_[4];
#pragma unroll
                for (int j = 0; j < 4; ++j) { hi_[j] = cvtpk(wv_[2 * j], wv_[2 * j + 1]); lo_[j] = cvtpk(wv_[2 * j] - bf_lo(hi_[j]), wv_[2 * j + 1] - bf_hi(hi_[j])); }
                bf16_t* dst = wrs + ((size_t)(((l * 8 + w) * 4 + s) * 3 + nb) * 2) * 512 + ln * 8;
                *(v4u*)dst = (v4u){hi_[0], hi_[1], hi_[2], hi_[3]}; *(v4u*)(dst + 512) = (v4u){lo_[0], lo_[1], lo_[2], lo_[3]}; }
        }
        LAS float* scr = (LAS float*)(ldsl + wave * 16384);
        constexpr int S0 = 16 * 96, S1 = 16 * 32, S2 = 16 * 48, S3 = 16 * 32, S4 = NEXP * 384;
        for (int it = gw; it < S0 + S1 + S2 + S3; it += NGW) {
            int r = it;
            if (r < S0) { const int n0 = (r % 96) * 32; const bool kcol = (n0 >= 1024 && n0 < 2048);
                transpose_item(AIN(I_DWQKV), NQKV0, wqkv0, DM, kcol ? (n0 & ~255) + ((n0 >> 6) & 3) * 32 + ((n0 >> 5) & 1) * 16 : n0, (r / 96) * 64, n0, scr, lane, kcol ? 128 : 16); continue; } r -= S0;
            if (r < S1) { transpose_item(AIN(I_DWO), DM, wo0, DM, (r % 32) * 32, (r / 32) * 64, (r % 32) * 32, scr, lane); continue; } r -= S1;
            if (r < S2) { const int n0 = (r % 48) * 32; const bool kcol = (n0 >= 1024 && n0 < 1280);
                transpose_item(AIN(I_GWQKV), NQKV1, wqkv1, DM, kcol ? 1024 + ((n0 >> 5) & 1) * 128 + ((n0 >> 7) & 1) * 64 + ((n0 >> 6) & 1) * 32 : n0, (r / 48) * 64, n0, scr, lane); continue; } r -= S2;
            if (r < S3) { transpose_item(AIN(I_GWO), DM, wo1, DM, (r % 32) * 32, (r / 32) * 64, (r % 32) * 32, scr, lane); continue; }
        }
        { int it = gw; for (; it + NGW < S4; it += 2 * NGW) moe_weight_pair(ldsl, 0, it, it + NGW, wgu, wd, scr, lane);
          if (it < S4) moe_weight_item(ldsl, 0, it, wgu, wd, scr, lane); }
    }
    GRID_BAR(); }
        for (int rep_ = 0; rep_ < ((REPMASK >> 1) & 1) * REPN + 1; ++rep_) {
    if (PHMASK & (1 << 1)) { PHASE_IDS();
    { const float* xin = AIN(I_X); const float* cin = AIN(I_CTX); const float* mv0 = modv; bf16_t* hb = HB;
    const int per = (MALL + NGW - 1) / NGW; int r0 = gw * per; const int r1 = min((int)MALL, r0 + per);
    hf_t* xh = (hf_t*)(WSB + WS_Y);
    for (; r0 + 5 <= r1; r0 += 5) h0_rows<5>(r0, xin, cin, mv0, hb, xh, lane);
    for (; r0 + 4 <= r1; r0 += 4) h0_rows<4>(r0, xin, cin, mv0, hb, xh, lane);
    for (; r0 < r1; ++r0) h0_rows<1>(r0, xin, cin, mv0, hb, xh, lane);
    } }
    GRID_BAR(); }

#pragma unroll
    for (int layer = 0; layer < 2; ++layer) {
#define modl (modv + (size_t)layer * 9 * NMOD)
        const int NQ = layer == 0 ? NQKV0 : NQKV1;
        for (int rep_ = 0; rep_ < ((REPMASK >> 2) & 1) * REPN + 1; ++rep_) {
        if (PHMASK & (1 << 2))
        { PHASE_IDS();
            pg8::Gemm g{HB, layer == 0 ? wqkv0 : wqkv1, MALL, NQ, DM};
            SchedRect S; if (layer == 0) S.init(72, NQKV0, G, bx, 0, 0); else S.init(64, NQKV1, G, bx, 1, 16);
            EpiStoreBf16 E{QKV, NQ, 0xffff, layer == 0 ? tab64 : tab128, layer == 0 ? (const float*)nullptr : AIN(I_GKN), (LAS float*)(ldsl + MISC_OFF + 4096)};
            pg8::gemm_phase<EpiStoreBf16, SchedRect, true, true>(ldsl, g, S, E, wave);
        }
        GRID_BAR(); }
        for (int rep_ = 0; rep_ < ((REPMASK >> 4) & 1) * REPN + 1; ++rep_) {
        if (PHMASK & (1 << 4)) {
        if (layer == 0 && (PHMASK & (1 << 16))) { PHASE_IDS();
            float lam;
            { const float s1 = wave_sum(AIN(I_LQ1)[lane] * AIN(I_LK1)[lane]), s2 = wave_sum(AIN(I_LQ2)[lane] * AIN(I_LK2)[lane]);
              lam = expf(s1) - expf(s2) + LAMBDA_INIT0; }
            const int nH = 1024, base = nH / G, rem = nH % G;
            const int u0 = vcu * base + (vcu < rem ? vcu : rem), cnt = base + (vcu < rem ? 1 : 0);
            for (int i = 0; i < cnt; ++i) {
                const int u = u0 + i, bh = u >> 4, qb = u & 15, b = bh >> 3, h = bh & 7;
                const size_t row0 = (size_t)b * TT + LCT + qb * 128;
                const bf16_t* kb = QKV + (size_t)b * TT * NQKV0 + h * 128;
                att::attn_unit<true>(QKV + row0 * NQKV0 + h * 128, NQKV0, kb + 1024, kb + 2048, NQKV0, TT, HB + row0 * DM + h * 128, DM,
                                     true, qb * 128, tab64, nullptr, AIN(I_SUBG), lam, (char*)lds, wave);
            }
            for (int l = vcu; l < 128; l += G) {
                const int bh = l >> 1, qb = l & 1, b = bh >> 3, h = bh & 7;
                const size_t row0 = (size_t)b * TT + qb * 128;
                const bf16_t* kb = QKV + (size_t)b * TT * NQKV0 + h * 128;
                att::attn_unit<true>(QKV + row0 * NQKV0 + h * 128, NQKV0, kb + 1024, kb + 2048, NQKV0, LCT, HB + row0 * DM + h * 128, DM,
                                     false, 0, tab64, nullptr, AIN(I_SUBG), lam, (char*)lds, wave);
            }
        } else if (PHMASK & (1 << 17)) { PHASE_IDS();
            const int nU = 512, base = nU / G, rem = nU % G;
            const int u0 = vcu * base + (vcu < rem ? vcu : rem), cnt = base + (vcu < rem ? 1 : 0);
            for (int i = 0; i < cnt; ++i) {
                const int u = u0 + i, bh = u >> 3, qb = u & 7, b = bh >> 3, h = bh & 7;
                const size_t row0 = (size_t)b * TT + LCT + qb * 256;
                const bf16_t* kb = QKV + (size_t)b * TT * NQKV1 + (h >> 2) * 128;
                att::attn_unit<false>(QKV + row0 * NQKV1 + h * 128, NQKV1, kb + 1024, kb + 1280, NQKV1, TT, HB + row0 * DM + h * 128, DM,
                                      true, qb * 256, tab128, AIN(I_GQN), nullptr, 0.f, (char*)lds, wave);
            }
        } }
        GRID_BAR(); }
        for (int rep_ = 0; rep_ < ((REPMASK >> 5) & 1) * REPN + 1; ++rep_) {
        if (PHMASK & (1 << 5))
        { PHASE_IDS();
            pg8::Gemm g{HB, layer == 0 ? wo0 : wo1, MALL, DM, DM};
            SchedRect S; if (layer == 0) S.init(72, DM, G, bx, 0, 0); else S.init(64, DM, G, bx, 1, 0);
            if (layer == 0) { EpiResid<2> E{Y, (const float*)(WSB + WS_Y), (const float*)nullptr, modl, rstats}; pg8::gemm_phase<EpiResid<2>, SchedRect, true, true>(ldsl, g, S, E, wave); }
            else { EpiResid<1> E{Y, (const float*)(WSB + WS_R1), (const float*)nullptr, modl, rstats}; pg8::gemm_phase<EpiResid<1>, SchedRect, true, true>(ldsl, g, S, E, wave); }
        }
        GRID_BAR(); }
        if (PHMASK & (1 << 6))
        { PHASE_IDS();
            const int TR = layer == 0 ? 72 : 64;
            const f32x2* stq = rstats; const hf_t* Yq = Y; float* outq = out; float* xrcq = XRC; const float* modq = modl; bf16_t* hbq = HB;
            const float* lg = AIN(I_LNMG) + layer * DM; const float* lb = AIN(I_LNMB) + layer * DM;
            const bf16_t* wrs_l = wrs + (size_t)layer * 8 * 4 * 3 * 2 * 512;
            LAS float* red = (LAS float*)ldsl;
            LAS float* logits = (LAS float*)(ldsl + 116736);
            LAS float* stats = (LAS float*)(ldsl + 127232);
            LAS int* lcnt = (LAS int*)(ldsl + 127232 + 576);
            LAS int* lbase = lcnt + 32;
            for (int it = bx; it < 256; it += G) {
                if (tid < 32) lcnt[tid] = 0;
                if (tid < TR) { const int r = row_of(layer, 0, TR, it, tid); const f32x2* sp = stq + (size_t)r * 16; float S = 0.f, Q = 0.f;
#pragma unroll
                    for (int p = 0; p < 16; ++p) { const f32x2 v = sp[p]; S += v.x; Q += v.y; }
                    const float mean = S * (1.f / DM); const float var = fmaxf(Q * (1.f / DM) - mean * mean, 0.f);
                    const float rstd = 1.0f / sqrtf(var + LN_EPS); stats[2 * tid] = mean; stats[2 * tid + 1] = rstd; rowst[r] = (f32x2){mean, rstd}; }
                __syncthreads();
                {
                    const int l15 = lane & 15, kg = lane >> 4;
                    pg8::f32x4 acc[5][3];
#pragma unroll
                    for (int mt = 0; mt < 5; ++mt)
#pragma unroll
                        for (int nb = 0; nb < 3; ++nb) acc[mt][nb] = (pg8::f32x4){0.f, 0.f, 0.f, 0.f};
                    int rrow[5]; float rmean[5], rrstd[5]; int rcond[5];
#pragma unroll
                    for (int mt = 0; mt < 5; ++mt) { const int j = mt * 16 + l15; const bool ok = j < TR; const int r = ok ? row_of(layer, 0, TR, it, j) : row_of(layer, 0, TR, it, 0);
                        const int bb = r / TT, tt = r - bb * TT; rrow[mt] = ok ? r : -1; rmean[mt] = stats[2 * (ok ? j : 0)]; rrstd[mt] = stats[2 * (ok ? j : 0) + 1];
                        rcond[mt] = tt < LCT ? 8 : bb; }
#pragma unroll 1
                    for (int s = 0; s < 4; ++s) { const int k0 = 128 * wave + 32 * s + 8 * kg;
                        const f32x4 g0 = *(const f32x4*)(lg + k0), g1 = *(const f32x4*)(lg + k0 + 4), b0 = *(const f32x4*)(lb + k0), b1 = *(const f32x4*)(lb + k0 + 4);
                        bf16x8 bh[3], bl[3];
#pragma unroll
                        for (int nb = 0; nb < 3; ++nb) { const bf16_t* bp = wrs_l + ((size_t)((wave * 4 + s) * 3 + nb) * 2) * 512 + lane * 8; bh[nb] = *(const bf16x8*)bp; bl[nb] = *(const bf16x8*)(bp + 512); }
                        f32x4 y0[5], y1[5];
#pragma unroll
                        for (int mt = 0; mt < 5; ++mt) { y0[mt] = (f32x4){0.f, 0.f, 0.f, 0.f}; y1[mt] = y0[mt];
                            if (rrow[mt] >= 0) { const v4u yh = *(const v4u*)(Yq + (size_t)rrow[mt] * DM + k0);
                                y0[mt] = (f32x4){hf_lo(yh.x), hf_hi(yh.x), hf_lo(yh.y), hf_hi(yh.y)}; y1[mt] = (f32x4){hf_lo(yh.z), hf_hi(yh.z), hf_lo(yh.w), hf_hi(yh.w)}; } }
#pragma unroll
                        for (int mt = 0; mt < 5; ++mt) {
                            int co_ = rcond[mt] * NMOD + k0; asm volatile("" : "+v"(co_));
                            const float* mv = modq + co_ - k0;
                            const f32x4 a0 = *(const f32x4*)(mv + 4096 + k0), a1 = *(const f32x4*)(mv + 4096 + k0 + 4), s0 = *(const f32x4*)(mv + 3072 + k0), s1 = *(const f32x4*)(mv + 3072 + k0 + 4);
                            const f32x4 x0 = (y0[mt] - rmean[mt]) * rrstd[mt] * g0 + b0, x1 = (y1[mt] - rmean[mt]) * rrstd[mt] * g1 + b1;
                            f32x4 h0 = x0 * (a0 + 1.0f) + s0, h1 = x1 * (a1 + 1.0f) + s1;
                            if (rrow[mt] < 0) { h0 = (f32x4){0.f, 0.f, 0.f, 0.f}; h1 = h0; }
                            v4u hh; hh.x = cvtpk(h0[0], h0[1]); hh.y = cvtpk(h0[2], h0[3]); hh.z = cvtpk(h1[0], h1[1]); hh.w = cvtpk(h1[2], h1[3]);
                            v4u hl; hl.x = cvtpk(h0[0] - bf_lo(hh.x), h0[1] - bf_hi(hh.x)); hl.y = cvtpk(h0[2] - bf_lo(hh.y), h0[3] - bf_hi(hh.y));
                            hl.z = cvtpk(h1[0] - bf_lo(hh.z), h1[1] - bf_hi(hh.z)); hl.w = cvtpk(h1[2] - bf_lo(hh.w), h1[3] - bf_hi(hh.w));
                            if (rrow[mt] >= 0) *(v4u*)(hbq + (size_t)rrow[mt] * DM + k0) = hh;
                            const bf16x8 ah = *reinterpret_cast<const bf16x8*>(&hh), al = *reinterpret_cast<const bf16x8*>(&hl);
#pragma unroll
                            for (int nb = 0; nb < 3; ++nb) {
                                acc[mt][nb] = __builtin_amdgcn_mfma_f32_16x16x32_bf16(ah, bh[nb], acc[mt][nb], 0, 0, 0);
                                acc[mt][nb] = __builtin_amdgcn_mfma_f32_16x16x32_bf16(ah, bl[nb], acc[mt][nb], 0, 0, 0);
                                acc[mt][nb] = __builtin_amdgcn_mfma_f32_16x16x32_bf16(al, bh[nb], acc[mt][nb], 0, 0, 0); }
                        }
                    }
                    const int ln2 = ltid(wave) & 63; const int l15b = ln2 & 15, kgb = ln2 >> 4;
#pragma unroll
                    for (int mt = 0; mt < 5; ++mt)
#pragma unroll
                        for (int nb = 0; nb < 3; ++nb)
#pragma unroll
                            for (int q = 0; q < 4; ++q) { const int row = mt * 16 + kgb * 4 + q, col = nb * 16 + l15b; if (row < 72 && col < 36) red[wave * 2592 + row * 36 + col] = acc[mt][nb][q]; }
                }
                const int tidc = ltid(wave);
                __syncthreads();
                for (int idx = tidc; idx < 2592; idx += 512) { const int o = idx % 36;
                    float s = o < 4 ? AIN(I_BGRP)[layer * 4 + o] : AIN(I_BRT)[layer * 32 + o - 4];
#pragma unroll
                    for (int w = 0; w < 8; ++w) s += red[w * 2592 + idx];
                    logits[idx] = s; }
                __syncthreads();
                int e1 = 0, e2 = 0, rk1 = 0, rk2 = 0; float G1 = 0.f, G2 = 0.f; int rme = 0;
                if (tidc < TR) {
                    const LAS float* lgt = logits + tidc * 36;
                    int gi = 0; float gm = lgt[0];
#pragma unroll
                    for (int g = 1; g < 4; ++g) { const float v = lgt[g]; if (v > gm) { gm = v; gi = g; } }
                    float gs = 0.f;
#pragma unroll
                    for (int g = 0; g < 4; ++g) gs += expf(lgt[g] - gm);
                    const float gtop = 1.0f / gs;
                    const LAS float* el = lgt + 4 + gi * 8;
                    int i1 = 0; float v1 = el[0];
#pragma unroll
                    for (int e = 1; e < 8; ++e) { const float v = el[e]; if (v > v1) { v1 = v; i1 = e; } }
                    int i2 = -1; float v2 = -3.0e38f;
#pragma unroll
                    for (int e = 0; e < 8; ++e) { const float v = el[e]; if (e != i1 && v > v2) { v2 = v; i2 = e; } }
                    const float ex = expf(v2 - v1); const float w1 = 1.0f / (1.0f + ex), w2 = ex / (1.0f + ex);
                    e1 = gi * 8 + i1; e2 = gi * 8 + i2; G1 = gtop * w1; G2 = gtop * w2;
                    rk1 = atomicAdd((int*)(lcnt + e1), 1); rk2 = atomicAdd((int*)(lcnt + e2), 1);
                    if (layer == 0) rme = it * 72 + tidc; else { const int xi = it * 64 + tidc; rme = (xi >> 11) * TT + LCT + (xi & 2047); }
                }
                __syncthreads();
                if (tidc < 32) { const int n = lcnt[tidc]; lbase[tidc] = n ? (int)__hip_atomic_fetch_add((unsigned*)(ctl + CW_CNT + layer * 32 + tidc), (unsigned)n, RLX_AGENT) : 0; }
                __syncthreads();
                if (tidc < TR) { const int q1 = lbase[e1] + rk1, q2 = lbase[e2] + rk2; tokinfo[rme] = make_int4(e1, q1, e2, q2);
                    int* tkf = tokof; float* gwf = gwof; tkf[(size_t)e1 * ECAP + q1] = rme; tkf[(size_t)e2 * ECAP + q2] = rme; gwf[(size_t)e1 * ECAP + q1] = G1; gwf[(size_t)e2 * ECAP + q2] = G2; }
                __syncthreads();
            }
        }
        GRID_BAR();
        for (int rep_ = 0; rep_ < ((REPMASK >> 8) & 1) * REPN + 1; ++rep_) {
        if (PHMASK & (1 << 8))
        {
            PHASE_IDS();
            LAS unsigned char* tile_e = ldsl + TILEE_OFF; LAS int* rowb = (LAS int*)(ldsl + ROWB_OFF); LAS int* cntl = (LAS int*)(ldsl + ROWB_OFF + 128); LAS int* tbase = (LAS int*)(ldsl + ROWB_OFF + 256);
            if (tid == 0) { int tt = 0;
#pragma unroll 1
                for (int e = 0; e < NEXP; ++e) { const int cnt = (int)__hip_atomic_load((unsigned*)(ctl + CW_CNT + layer * 32 + e), RLX_AGENT); rowb[e] = tt * 256; tbase[e] = tt; cntl[e] = cnt; tt += (cnt + 255) >> 8; }
                tbase[NEXP] = tt; MISC[16] = (unsigned)tt; }
            __syncthreads();
            if (tid < 176) { int e = 0;
#pragma unroll 1
                for (int q = 1; q < NEXP; ++q) e += (tbase[q] <= tid) ? 1 : 0;
                tile_e[tid] = (unsigned char)e; }
            __syncthreads();
            const int ntile = (int)MISC[16];
            pg8::Gemm g{HB, wgu, SORT_ROWS, NEXP * 512, DM};
            SchedExp S{ldsl + TILEE_OFF, 2, ntile * 2, G, bx};
            EpiGateUp E{ACTB, gwof, tbase};
            pg8::GatherA GA{tokof, tbase, cntl, 2, ECAP};
            pg8::gemm_phase<EpiGateUp, SchedExp, true, true, true, pg8::GatherA>(ldsl, g, S, E, wave, GA);
        }
        GRID_BAR(); }
        for (int rep_ = 0; rep_ < ((REPMASK >> 9) & 1) * REPN + 1; ++rep_) {
        if (PHMASK & (1 << 9))
        { PHASE_IDS();
            const int ntile = (int)MISC[16];
            int kdn = FH; asm volatile("" : "+s"(kdn));
            pg8::Gemm g{ACTB, wd, SORT_ROWS, NEXP * 1024, kdn};
            SchedExp S{ldsl + TILEE_OFF, 4, ntile * 4, G, bx};
            EpiStoreBf16 E{FO, DM, 3, (const f32x2*)nullptr, (const float*)nullptr, (LAS float*)nullptr};
            pg8::gemm_phase<EpiStoreBf16, SchedExp, true, true>(ldsl, g, S, E, wave);
        }
        GRID_BAR(); }
        if (PHMASK & (1 << 10))
        { PHASE_IDS();
            const float* fg = AIN(I_LNFG) + layer * DM; const float* fb = AIN(I_LNFB) + layer * DM;
            const int nrows = layer == 0 ? MALL : MXR;
            { const hf_t* Yq = Y; const f32x2* rsq = rowst; const float* mg = AIN(I_LNMG) + layer * DM; const float* mb = AIN(I_LNMB) + layer * DM; const int4* tinfo = tokinfo; const LAS int* rowb = (const LAS int*)(ldsl + ROWB_OFF); const bf16_t* fo = FO; float* outq = out; float* xrcq = XRC; const float* modq = modl; const float* modn = modv + (size_t)9 * NMOD; bf16_t* hbq = HB;
              if (layer == 0) {
                  const int per = (nrows + NGW - 1) / NGW; int idx0 = gw * per; const int i1 = min(nrows, idx0 + per);
                  for (; idx0 + 3 <= i1; idx0 += 3) p8_rows<3>(idx0, layer, tinfo, rowb, fo, Yq, rsq, mg, mb, outq, xrcq, modq, modn, fg, fb, hbq, (hf_t*)(WSB + WS_R1), lane);
                  for (; idx0 < i1; ++idx0) p8_rows<1>(idx0, layer, tinfo, rowb, fo, Yq, rsq, mg, mb, outq, xrcq, modq, modn, fg, fb, hbq, (hf_t*)(WSB + WS_R1), lane);
              } else
              for (int idx0 = gw * 4; idx0 < nrows; idx0 += NGW * 4) p8_rows<4>(idx0, layer, tinfo, rowb, fo, Yq, rsq, mg, mb, outq, xrcq, modq, modn, fg, fb, hbq, (hf_t*)(WSB + WS_R1), lane); }
            if (layer == 0) {
                LAS float* scr = (LAS float*)(ldsl + wave * 16384);
                { int it = gw; for (; it + NGW < NEXP * 384; it += 2 * NGW) moe_weight_pair(ldsl, 1, it, it + NGW, wgu, wd, scr, lane);
                  if (it < NEXP * 384) moe_weight_item(ldsl, 1, it, wgu, wd, scr, lane); }
                GRID_BAR();
            }
        }
    }
}

#undef out
#undef Y
#undef HS
#undef QKV
#undef HB
#undef ctl
extern "C" void kernel_launch(void* const* d_in, const int* in_sizes, int n_in, void* d_out, int out_size, void* d_ws, size_t ws_size, hipStream_t stream) {
    static int grid = 0;
    if (grid == 0) {
        if (n_in != 28 || in_sizes[0] != MXR * DM || out_size != MXR * DM || ws_size < WS_END) {
            fprintf(stderr, "kernel_launch: unexpected shapes: n_in %d in0 %d out %d ws %zu (need %zu)\n", n_in, n_in > 0 ? in_sizes[0] : -1, out_size, ws_size, (size_t)WS_END); grid = -1; return; }
        int dev = 0, cus = 0, per_cu = 0;
        if (hipGetDevice(&dev) != hipSuccess || hipDeviceGetAttribute(&cus, hipDeviceAttributeMultiprocessorCount, dev) != hipSuccess) { grid = -1; return; }
        if (hipFuncSetAttribute((const void*)fwd_megakernel, hipFuncAttributeMaxDynamicSharedMemorySize, LDS_BYTES) != hipSuccess) { fprintf(stderr, "kernel_launch: hipFuncSetAttribute failed\n"); grid = -1; return; }
        if (hipOccupancyMaxActiveBlocksPerMultiprocessor(&per_cu, (const void*)fwd_megakernel, 512, LDS_BYTES) != hipSuccess || per_cu < 1) { fprintf(stderr, "kernel_launch: occupancy query reports %d\n", per_cu); (void)hipGetLastError(); per_cu = 1; }
        grid = cus;
        if (grid > 256) grid = 256;
    }
    if (grid < 0) return;
    if (hipMemsetAsync((char*)d_ws + WS_CTL, 0, CTL_ZERO_BYTES, stream) != hipSuccess) { fprintf(stderr, "kernel_launch: memset failed\n"); return; }
    Args a{};
    for (int i = 0; i < 28; ++i) a.in[i] = (const float*)d_in[i];
    a.o_ = (float*)d_out; a.w_ = (unsigned char*)d_ws;
    hipLaunchKernelGGL(fwd_megakernel, dim3(grid), dim3(512), LDS_BYTES, stream, a);
    const hipError_t le = hipPeekAtLastError();
    if (le != hipSuccess) fprintf(stderr, "kernel_launch: launch failed: %s\n", hipGetErrorName(le));
}
```

```cpp
#include <hip/hip_runtime.h>
#include <hip/hip_bf16.h>
#include <cstdio>
#include <cstdint>
__device__ __forceinline__ int ltid(int wv) { int l; asm volatile("v_mbcnt_lo_u32_b32 %0, -1, 0\n\tv_mbcnt_hi_u32_b32 %0, -1, %0" : "=v"(l)); return wv * 64 + l; }
namespace pg8 {
#define PG8_LAS __attribute__((address_space(3)))
typedef unsigned short bf16_t;
typedef short bf16x8 __attribute__((ext_vector_type(8)));
typedef float f32x4 __attribute__((ext_vector_type(4)));
typedef unsigned u32x4 __attribute__((ext_vector_type(4)));
constexpr int BM = 256, BK = 64, HALF = 128, HTB = HALF * BK * 2  , STAGE_BYTES = 8 * HTB, NXCD = 8, WGM = 8;

__host__ __device__ __forceinline__ int lds_byte(int r, int c) { const int st = (r >> 4) * 2 + (c >> 5), rr = r & 15, cc = c & 31, ob = rr * 64 + cc * 2; return st * 1024 + (ob ^ (((ob >> 9) & 1) << 5)); }
__host__ __device__ __forceinline__ void stage_rc(int b, int& R, int& C) { const int st = b / 1024, sb = b % 1024, swz = sb ^ (((sb >> 9) & 1) << 5); R = (st >> 1) * 16 + swz / 64; C = (st & 1) * 32 + (swz % 64) / 2; }
__host__ __device__ __forceinline__ int perm32(int rho) { const int n = rho >> 4, i = rho & 15; return 8 * (i >> 2) + 4 * n + (i & 3); }

struct Unit { int pm, pn, hm; };
struct Gemm { const bf16_t* A; const bf16_t* Bt; int M, N, K; };

struct StaticOrder {
    int nM, nN, nwg, G, c;
    __host__ __device__ void init(int M, int N, int G_, int c_) { nM = M / BM; nN = N / BM; nwg = nM * nN; G = G_; c = c_; }
    __host__ __device__ bool next(int i, Unit& u) const { return at((long)i * G + c, u); }
    __host__ __device__ bool at(const long L, Unit& u) const {
        if (L >= nwg) return false; u.hm = 0;
        int wgid = (int)L; { const int q = nwg / NXCD, r = nwg % NXCD, xcd = wgid % NXCD, off = wgid / NXCD; wgid = (xcd < r ? xcd * (q + 1) : r * (q + 1) + (xcd - r) * q) + off; }
        const int nig = WGM * nN, gid = wgid / nig, fm = gid * WGM, gsz = (nM - fm) < WGM ? (nM - fm) : WGM;
        u.pm = fm + ((wgid % nig) % gsz); u.pn = (wgid % nig) / gsz; return true;
    }
    __device__ __forceinline__ void a_ready(const Unit&) const {}
    __device__ __forceinline__ void done(const Unit&) const {}
};

__device__ __forceinline__ unsigned cvt_pk_bf16(float lo, float hi) { unsigned r; asm volatile("v_cvt_pk_bf16_f32 %0, %1, %2" : "=v"(r) : "v"(lo), "v"(hi)); return r; }
typedef float f32x2 __attribute__((ext_vector_type(2)));
struct NoGather {};
struct GatherA { const int* tok; const PG8_LAS int* tbase; const PG8_LAS int* cnt; int NP, cap; };
template <class Epi, class Sched, bool ALIGN_EPI = false, bool SP2 = false, bool GATHER = false, class GAT = NoGather>
__device__ __forceinline__ void gemm_phase(PG8_LAS unsigned char* lds, const Gemm g, const Sched& S, const Epi& E, const int wv, const GAT& GA = GAT()) {
    static_assert(!GATHER || SP2, "gather staging is written for the SP2 loop");
    const int tid = ltid(wv), wid = wv, lane = tid & 63, wr = wid >> 2, wc = wid & 3, fr = lane & 15, fq = lane >> 4;
    const int K = g.K, nt = K / BK;
    unsigned voffA[2], voffB[2];
#pragma unroll
    for (int i = 0; i < 2; ++i) { int R, C; stage_rc(tid * 16 + i * 8192, R, C); const int Rb = Epi::PERM ? ((R & ~31) + perm32(R & 31)) : R;
        voffA[i] = (unsigned)(R * K + C) * 2u; voffB[i] = (unsigned)(Rb * K + C) * 2u; }
    const size_t kstep = (size_t)(BK * 2);
    const size_t hstep = (size_t)HALF * K * 2;
    const size_t tstep = 2 * hstep;
    const unsigned ldsw = (unsigned)wid * 1024u;
    const int aoff = lds_byte(wr * 64 + fr, fq * 8), boff = lds_byte(wc * 32 + fr, fq * 8);
#define PG8_SA(b, h) (((b) * 2 + (h)) * HTB)
#define PG8_SB(b, h) ((4 + (b) * 2 + (h)) * HTB)
#define PG8_STAGE(bufoff, gbase, voff) do { _Pragma("unroll") for (int _i = 0; _i < 2; ++_i) \
        __builtin_amdgcn_global_load_lds((const unsigned*)((const char*)(gbase) + (voff)[_i]), (PG8_LAS unsigned*)(lds + (bufoff) + ldsw + _i * 8192), 16, 0, 0); } while (0)
#define PG8_STAGE_A(bufoff, ngptr, h, kofs, GV) do { if constexpr (GATHER) { PG8_STAGE(bufoff, (const char*)g.A + (kofs), GV[h]); } else { PG8_STAGE(bufoff, ngptr, voffA); } } while (0)
#define PG8_GOFS(dst, U) do { if constexpr (GATHER) { const int e_ = (U).pn / GA.NP; const int rk0_ = ((U).pm - GA.tbase[e_]) * 256; const int c_ = GA.cnt[e_]; \
        _Pragma("unroll") for (int h_ = 0; h_ < 2; ++h_) _Pragma("unroll") for (int i_ = 0; i_ < 2; ++i_) { int R_, C_; stage_rc(tid * 16 + i_ * 8192, R_, C_); const int rk_ = rk0_ + h_ * 128 + R_; \
            const int tk_ = rk_ < c_ ? GA.tok[(size_t)e_ * GA.cap + rk_] : 0; dst[h_][i_] = (unsigned)(tk_ * K + C_) * 2u; } } } while (0)
#define PG8_LDA(dst, b, h) do { _Pragma("unroll") for (int m = 0; m < 4; ++m) _Pragma("unroll") for (int k = 0; k < 2; ++k) dst[m][k] = *(const PG8_LAS bf16x8*)(lds + PG8_SA(b, h) + aoff + m * 2048 + k * 1024); } while (0)
#define PG8_LDB(dst, b, h) do { _Pragma("unroll") for (int n = 0; n < 2; ++n) _Pragma("unroll") for (int k = 0; k < 2; ++k) dst[n][k] = *(const PG8_LAS bf16x8*)(lds + PG8_SB(b, h) + boff + n * 2048 + k * 1024); } while (0)
#define PG8_MMA(ai, bj, At, Bt) do { if (cur.hm != 0 && cur.hm != (ai) + 1) break; __builtin_amdgcn_s_setprio(1); _Pragma("unroll") for (int m = 0; m < 4; ++m) _Pragma("unroll") for (int n = 0; n < 2; ++n) _Pragma("unroll") for (int k = 0; k < 2; ++k) \
        acc[ai][bj][m][n] = __builtin_amdgcn_mfma_f32_16x16x32_bf16(Bt[n][k], At[m][k], acc[ai][bj][m][n], 0, 0, 0); __builtin_amdgcn_s_setprio(0); } while (0)
#define PG8_WAIT_V(n) asm volatile("s_waitcnt vmcnt(" #n ")" ::: "memory")
#define PG8_WAIT_L(n) asm volatile("s_waitcnt lgkmcnt(" #n ")" ::: "memory")
#define PG8_BAR __builtin_amdgcn_s_barrier()
#define PG8_SCHED __builtin_amdgcn_sched_barrier(0)
    Unit cur, nxt; int ui = 0;
    if (!S.next(0, cur)) return;
    f32x4 acc[2][2][4][2];
#pragma unroll
    for (int a = 0; a < 2; ++a)
#pragma unroll
        for (int b = 0; b < 2; ++b)
#pragma unroll
            for (int m = 0; m < 4; ++m)
#pragma unroll
                for (int n = 0; n < 2; ++n) acc[a][b][m][n] = (f32x4){0.f, 0.f, 0.f, 0.f};
    bf16x8 At[4][2], B0[2][2], B1[2][2];
    const char* cA = (const char*)g.A + (size_t)cur.pm * tstep; const char* cB = (const char*)g.Bt + (size_t)cur.pn * tstep;
    S.a_ready(cur);
    unsigned curG[2][2] = {{0u, 0u}, {0u, 0u}}, nxtG[2][2] = {{0u, 0u}, {0u, 0u}};
    PG8_GOFS(curG, cur); { Unit n0_; if (S.next(1, n0_)) PG8_GOFS(nxtG, n0_); }
    if constexpr (SP2) {
        PG8_STAGE(PG8_SB(0, 0), cB, voffB); PG8_STAGE(PG8_SB(0, 1), cB + hstep, voffB); PG8_STAGE_A(PG8_SA(0, 0), cA, 0, (size_t)0, curG); PG8_STAGE_A(PG8_SA(0, 1), cA + hstep, 1, (size_t)0, curG);
        if (wr == 1) PG8_BAR;
        PG8_WAIT_V(2); PG8_BAR;
        PG8_STAGE(PG8_SB(1, 0), cB + kstep, voffB); PG8_STAGE_A(PG8_SA(1, 0), cA + kstep, 0, kstep, curG); PG8_STAGE(PG8_SB(1, 1), cB + hstep + kstep, voffB);
        PG8_WAIT_V(6); PG8_BAR;
    } else {
        PG8_STAGE(PG8_SB(0, 0), cB, voffB); PG8_STAGE(PG8_SA(0, 0), cA, voffA); PG8_STAGE(PG8_SB(0, 1), cB + hstep, voffB); PG8_STAGE(PG8_SA(0, 1), cA + hstep, voffA);
        if (wr == 1) PG8_BAR;
        PG8_WAIT_V(4); PG8_BAR;
        PG8_STAGE(PG8_SB(1, 0), cB + kstep, voffB); PG8_STAGE(PG8_SA(1, 0), cA + kstep, voffA); PG8_STAGE(PG8_SB(1, 1), cB + hstep + kstep, voffB);
        PG8_WAIT_V(6); PG8_BAR;
    }
    for (;;) {
        const bool has_next = S.next(ui + 1, nxt);
        if (GATHER && has_next && ui >= 1) PG8_GOFS(nxtG, nxt);
        const char* nA = has_next ? (const char*)g.A + (size_t)nxt.pm * tstep : cA; const char* nB = has_next ? (const char*)g.Bt + (size_t)nxt.pn * tstep : cB;
        for (int t = 0; t < nt; t += 2) {
            const bool last = (t == nt - 2);
            const char* a1 = cA + (size_t)(t + 1) * kstep;
            const char* a2 = last ? nA : cA + (size_t)(t + 2) * kstep; const char* b2 = last ? nB : cB + (size_t)(t + 2) * kstep;
            const char* a3 = a2 + kstep; const char* b3 = b2 + kstep;
            if (last && has_next) S.a_ready(nxt);
            const size_t k1o = (size_t)(t + 1) * kstep, k2o = last ? (size_t)0 : (size_t)(t + 2) * kstep; unsigned selG[2][2];
            _Pragma("unroll") for (int h_ = 0; h_ < 2; ++h_) _Pragma("unroll") for (int i_ = 0; i_ < 2; ++i_) selG[h_][i_] = (last && has_next) ? nxtG[h_][i_] : curG[h_][i_];
            if constexpr (SP2) {
            PG8_LDB(B0, 0, 0); PG8_LDB(B1, 0, 1); PG8_SCHED; PG8_LDA(At, 0, 0); PG8_STAGE_A(PG8_SA(1, 1), a1 + hstep, 1, k1o, curG);
            PG8_WAIT_V(8); PG8_WAIT_L(0); PG8_BAR; PG8_MMA(0, 0, At, B0); PG8_MMA(0, 1, At, B1); PG8_BAR; PG8_SCHED;
            PG8_LDA(At, 0, 1); PG8_STAGE(PG8_SB(0, 0), b2, voffB); PG8_STAGE(PG8_SB(0, 1), b2 + hstep, voffB); PG8_STAGE_A(PG8_SA(0, 0), a2, 0, k2o, selG);
            PG8_WAIT_V(8); PG8_WAIT_L(0); PG8_BAR; PG8_MMA(1, 0, At, B0); PG8_MMA(1, 1, At, B1); PG8_BAR; PG8_SCHED;
            PG8_LDB(B0, 1, 0); PG8_LDB(B1, 1, 1); PG8_SCHED; PG8_LDA(At, 1, 0); PG8_STAGE_A(PG8_SA(0, 1), a2 + hstep, 1, k2o, selG);
            PG8_WAIT_V(8); PG8_WAIT_L(0); PG8_BAR; PG8_MMA(0, 0, At, B0); PG8_MMA(0, 1, At, B1); PG8_BAR; PG8_SCHED;
            PG8_LDA(At, 1, 1); PG8_STAGE(PG8_SB(1, 0), b3, voffB); PG8_STAGE(PG8_SB(1, 1), b3 + hstep, voffB); PG8_STAGE_A(PG8_SA(1, 0), a3, 0, k2o + kstep, selG);
            PG8_WAIT_V(8); PG8_WAIT_L(0); PG8_BAR; PG8_MMA(1, 0, At, B0); PG8_MMA(1, 1, At, B1); PG8_BAR; PG8_SCHED;
            } else {
            PG8_LDB(B0, 0, 0); PG8_SCHED; PG8_LDA(At, 0, 0); PG8_STAGE(PG8_SA(1, 1), a1 + hstep, voffA);
            PG8_WAIT_L(8); PG8_BAR; PG8_WAIT_L(0); PG8_MMA(0, 0, At, B0); PG8_BAR; PG8_SCHED;
            PG8_LDB(B1, 0, 1); PG8_STAGE(PG8_SB(0, 0), b2, voffB);
            PG8_BAR; PG8_WAIT_L(0); PG8_MMA(0, 1, At, B1); PG8_BAR;
            PG8_LDA(At, 0, 1); PG8_STAGE(PG8_SA(0, 0), a2, voffA);
            PG8_BAR; PG8_WAIT_L(0); PG8_MMA(1, 0, At, B0); PG8_BAR; PG8_SCHED;
            PG8_STAGE(PG8_SB(0, 1), b2 + hstep, voffB);
            PG8_WAIT_V(6); PG8_BAR; PG8_MMA(1, 1, At, B1); PG8_BAR;
            PG8_LDB(B0, 1, 0); PG8_SCHED; PG8_LDA(At, 1, 0); PG8_STAGE(PG8_SA(0, 1), a2 + hstep, voffA);
            PG8_WAIT_L(8); PG8_BAR; PG8_WAIT_L(0); PG8_MMA(0, 0, At, B0); PG8_BAR; PG8_SCHED;
            PG8_LDB(B1, 1, 1); PG8_STAGE(PG8_SB(1, 0), b3, voffB);
            PG8_BAR; PG8_WAIT_L(0); PG8_MMA(0, 1, At, B1); PG8_BAR;
            PG8_LDA(At, 1, 1); PG8_STAGE(PG8_SA(1, 0), a3, voffA);
            PG8_BAR; PG8_WAIT_L(0); PG8_MMA(1, 0, At, B0); PG8_BAR; PG8_SCHED;
            PG8_STAGE(PG8_SB(1, 1), b3 + hstep, voffB);
            PG8_WAIT_V(6); PG8_BAR; PG8_MMA(1, 1, At, B1); PG8_BAR;
            }
        }
        if constexpr (ALIGN_EPI) { if (wr == 0) PG8_BAR; }
        if constexpr (!Epi::AFTER_DRAIN) { E(acc, cur, wr, wc, fr, fq); S.done(cur); }
        if (!has_next) break;
#pragma unroll
        for (int a = 0; a < 2; ++a)
#pragma unroll
            for (int b = 0; b < 2; ++b)
#pragma unroll
                for (int m = 0; m < 4; ++m)
#pragma unroll
                    for (int n = 0; n < 2; ++n) acc[a][b][m][n] = (f32x4){0.f, 0.f, 0.f, 0.f};
        cur = nxt; cA = nA; cB = nB; ++ui;
        _Pragma("unroll") for (int h_ = 0; h_ < 2; ++h_) _Pragma("unroll") for (int i_ = 0; i_ < 2; ++i_) curG[h_][i_] = nxtG[h_][i_];
        if constexpr (ALIGN_EPI) { if (wr == 1) PG8_BAR; }
    }
    PG8_WAIT_V(0);
    if constexpr (!ALIGN_EPI) { if (wr == 0) PG8_BAR; }
    PG8_BAR;
    if constexpr (Epi::AFTER_DRAIN) { E.fused(acc, cur, wr, wc, fr, fq, lds, wid, lane); S.done(cur); }
#undef PG8_SA
#undef PG8_SB
#undef PG8_STAGE
#undef PG8_LDA
#undef PG8_STAGE_A
#undef PG8_GOFS
#undef PG8_LDB
#undef PG8_MMA
#undef PG8_WAIT_V
#undef PG8_WAIT_L
#undef PG8_BAR
#undef PG8_SCHED
}
}

constexpr int NB = 8, NXT = 2048, LCT = 256, TT = 2304, DM = 1024;
constexpr int MALL = NB * TT;
constexpr int MXR = NB * NXT;
constexpr int NQKV0 = 3072, NQKV1 = 1536;
constexpr int NEXP = 32, FH = 256, NMOD = 6144;
constexpr float ALPHA = 1.41421356237309515f;
constexpr float LAMBDA_INIT0 = 0.2f;
constexpr float LN_EPS = 1e-5f, RMS_EPS = 1e-6f;
constexpr int SORT_ROWS = 45056;

#define GAS __attribute__((address_space(1)))
#define LAS __attribute__((address_space(3)))
typedef unsigned short bf16_t;
typedef unsigned v4u __attribute__((ext_vector_type(4)));
typedef unsigned v2u __attribute__((ext_vector_type(2)));
typedef float f32x4 __attribute__((ext_vector_type(4)));
typedef float f32x2 __attribute__((ext_vector_type(2)));
typedef short bf16x8 __attribute__((ext_vector_type(8)));
typedef short s16x4 __attribute__((ext_vector_type(4)));
typedef float f32x16 __attribute__((ext_vector_type(16)));
typedef GAS unsigned gu32;
#define RLX_AGENT __ATOMIC_RELAXED, __HIP_MEMORY_SCOPE_AGENT
#define LDS_WAIT() asm volatile("s_waitcnt lgkmcnt(0)" ::: "memory")
#define VM_WAIT() asm volatile("s_waitcnt vmcnt(0)" ::: "memory")

constexpr size_t MiB = 1u << 20;
constexpr size_t WS_CTL = 0, CTL_ZERO_BYTES = 1 * MiB;
constexpr size_t WS_MOD = 1 * MiB;
constexpr size_t WS_TAB64 = 1 * MiB + 512 * 1024;
constexpr size_t WS_TAB128 = WS_TAB64 + 8192;
constexpr size_t WS_WRT = WS_TAB64 + 65536;
constexpr size_t WS_TOKINFO = 2 * MiB;
constexpr size_t WS_TOKW = WS_TOKINFO + (size_t)MALL * 16;
constexpr size_t WS_TOKPOS = WS_TOKW + (size_t)MALL * 8;
constexpr size_t WS_GW = 3 * MiB;
constexpr size_t WS_XRC = 4 * MiB;
constexpr size_t WS_WQKV0 = 12 * MiB, WS_WO0 = 18 * MiB, WS_WQKV1 = 20 * MiB, WS_WO1 = 23 * MiB;
constexpr size_t WS_WGU = 26 * MiB;
constexpr size_t WS_WD = 58 * MiB;
constexpr size_t WS_HBUF = 74 * MiB;
constexpr size_t WS_QKV = 110 * MiB;
constexpr size_t WS_Y = 218 * MiB;
constexpr size_t WS_TOKOF = 306 * MiB;
constexpr size_t WS_GWOF = 309 * MiB;
constexpr int ECAP = 18432;
constexpr size_t WS_STATS = 312 * MiB;
constexpr size_t WS_ROWST = 315 * MiB;
constexpr size_t WS_YOFF = WS_QKV + 24 * MiB;
constexpr size_t WS_WRS = 316 * MiB;
constexpr size_t WS_END = 317 * MiB;
static_assert(WS_TOKPOS + (size_t)MALL * 8 <= WS_GW && WS_GW + SORT_ROWS * 4 <= WS_XRC && WS_XRC + 2048 * 4096 <= WS_WQKV0, "ws map");
static_assert(WS_YOFF + (size_t)MALL * DM * 4 <= WS_Y && (size_t)SORT_ROWS * FH * 2 <= 24 * MiB && WS_QKV + (size_t)MALL * 3072 * 2 <= WS_Y && WS_Y + (size_t)SORT_ROWS * 2048 <= WS_END && WS_HBUF + (size_t)MALL * 2048 <= WS_QKV, "ws map");
constexpr int CW_BAR = 4096;
constexpr int CW_CNT = 8192;

constexpr int RING_BYTES = 131072;
constexpr int MISC_OFF = 139264;
constexpr int TILEE_OFF = MISC_OFF + 256;
constexpr int ROWB_OFF = MISC_OFF + 512;
constexpr int LDS_BYTES = 147456;

__device__ __forceinline__ unsigned cvtpk(float lo, float hi) { unsigned r; asm volatile("v_cvt_pk_bf16_f32 %0, %1, %2" : "=v"(r) : "v"(lo), "v"(hi)); return r; }
__device__ __forceinline__ float bf_lo(unsigned u) { return __uint_as_float(u << 16); }
__device__ __forceinline__ float bf_hi(unsigned u) { return __uint_as_float(u & 0xffff0000u); }
template <int M> __device__ __forceinline__ float xsum(float v) {
    if constexpr (M < 32) return v + __int_as_float(__builtin_amdgcn_ds_swizzle(__float_as_int(v), (M << 10) | 0x1f));
    else { auto rr = __builtin_amdgcn_permlane32_swap(__float_as_uint(v), __float_as_uint(v), false, false); return __uint_as_float(rr[0]) + __uint_as_float(rr[1]); }
}
__device__ __forceinline__ float sum32(float v) { v = xsum<1>(v); v = xsum<2>(v); v = xsum<4>(v); v = xsum<8>(v); v = xsum<16>(v); return v; }
__device__ __forceinline__ float wave_sum(float v) { return xsum<32>(sum32(v)); }
__device__ __forceinline__ int row_b(int r) { return r / TT; }
__device__ __forceinline__ float* xr_ptr(float* out, float* xrc, int r) {
    const int b = r / TT, t = r - b * TT;
    return t < LCT ? xrc + ((size_t)b * LCT + t) * DM : out + ((size_t)b * NXT + (t - LCT)) * DM;
}
__device__ __forceinline__ const float* in0_ptr(const float* x, const float* ctx, int r) {
    const int b = r / TT, t = r - b * TT;
    return t < LCT ? ctx + ((size_t)b * LCT + t) * DM : x + ((size_t)b * NXT + (t - LCT)) * DM;
}

#define XB_TMO      128
#define XB_XCNT(j)  (256  + 64 * (j))
#define XB_XSUB(j)  (1280 + 64 * (j))
#define XB_XGEN(j)  (2304 + 64 * (j))
#define XB_TOP      3328
#define XB_TOPGEN   3392
#define XCD_BAR_WORDS 3456
#define XB_SPIN_CAP (1u << 18)
__device__ __forceinline__ unsigned xb_ld(unsigned* p)              { return __hip_atomic_load(p, __ATOMIC_RELAXED, __HIP_MEMORY_SCOPE_AGENT); }
__device__ __forceinline__ unsigned xb_add(unsigned* p, unsigned v) { return __hip_atomic_fetch_add(p, v, __ATOMIC_RELAXED, __HIP_MEMORY_SCOPE_AGENT); }
__device__ __forceinline__ unsigned xb_xcc_id() { return (unsigned)__builtin_amdgcn_s_getreg((3 << 11) | 20) & 0xFu; }
#define XB_SPIN(cond, bar) do { unsigned _sp = 0; while (cond) { __builtin_amdgcn_s_sleep(1); \
    if ((++_sp & 255u) == 0u) { if (xb_ld(&(bar)[XB_TMO])) break; if (_sp > XB_SPIN_CAP) { atomicAdd(&(bar)[XB_TMO], 1u); break; } } } } while (0)
__device__ __forceinline__ void xcd_barrier_post(unsigned* bar) {
    const unsigned x = xb_xcc_id();
    if (threadIdx.x == 0) (void)xb_add(&bar[XB_XCNT(x)], 1u);
}
__device__ __forceinline__ void xcd_barrier_complete(unsigned* bar, unsigned x, unsigned& nloc, unsigned& nx) {
    const unsigned G = gridDim.x * gridDim.y * gridDim.z;
    unsigned sum, cnt, mine, sp = 0u;
    for (;;) {
        sum = 0u; cnt = 0u; mine = 0u;
#pragma unroll
        for (unsigned j = 0; j < 16; ++j) { const unsigned c = xb_ld(&bar[XB_XCNT(j)]); sum += c; cnt += (c > 0u) ? 1u : 0u; mine = (j == x) ? c : mine; }
        if (sum == G) break;
        __builtin_amdgcn_s_sleep(1);
        if ((++sp & 255u) == 0u) { if (xb_ld(&bar[XB_TMO])) break; if (sp > XB_SPIN_CAP) { atomicAdd(&bar[XB_TMO], 1u); break; } }
    }
    nloc = mine > 0u ? mine : 1u; nx = cnt > 0u ? cnt : 1u;
}
__device__ __forceinline__ void xcd_barrier(unsigned* bar_in, volatile LAS unsigned* st, bool leader) {
    asm volatile("s_waitcnt vmcnt(0)" ::: "memory");
    __syncthreads();
    if (leader) {
        unsigned* bar = bar_in;
        unsigned bx_ = xb_xcc_id(); asm volatile("" : "+s"(bx_));
        __builtin_amdgcn_s_waitcnt(0);
        unsigned nloc = st[0], nx = st[1];
        if (nloc == 0u) { xcd_barrier_complete(bar, bx_, nloc, nx); st[0] = nloc; st[1] = nx; }
        const unsigned old = xb_add(&bar[XB_XSUB(bx_)], 1u);
        const unsigned gen = old / nloc;
        if (old + 1u == (gen + 1u) * nloc) {
            __builtin_amdgcn_fence(__ATOMIC_RELEASE, "agent");
            asm volatile("s_waitcnt vmcnt(0)" ::: "memory");
            const unsigned og = xb_add(&bar[XB_TOP], 1u);
            const unsigned tg = og / nx;
            if (og + 1u == (tg + 1u) * nx) xb_add(&bar[XB_TOPGEN], 1u);
            else XB_SPIN(xb_ld(&bar[XB_TOPGEN]) == tg, bar);
            __builtin_amdgcn_fence(__ATOMIC_ACQUIRE, "agent");
            asm volatile("s_waitcnt vmcnt(0)" ::: "memory");
        } else {
            XB_SPIN(xb_ld(&bar[XB_TOPGEN]) == gen, bar);
            __builtin_amdgcn_fence(__ATOMIC_ACQUIRE, "agent");
            asm volatile("s_waitcnt vmcnt(0)" ::: "memory");
        }
    }
    __syncthreads();
}

struct SchedRect {
    pg8::StaticOrder so; int xonly, n_extra, G, c, full, rsplit;
    __device__ void init(int nMt, int N, int G_, int c_, int xonly_, int n_extra_) { so.init(nMt * 256, N, G_, c_); xonly = xonly_; n_extra = n_extra_; G = G_; c = c_;
        const int r = so.nwg % G; full = so.nwg - r; rsplit = (n_extra == 0 && r > 0 && 2 * r <= G) ? r : 0; }
    __device__ bool next(int i, pg8::Unit& u) const {
        const long L = (long)i * G + c;
        if (rsplit && L >= full) { const int j = (int)(L - full); if (j >= 2 * rsplit) return false;
            so.at(full + (j >> 1), u); u.hm = 1 + (j & 1); if (xonly) u.pm = (u.pm >> 3) * 9 + 1 + (u.pm & 7); return true; }
        if (L < so.nwg) { so.at(L, u); if (xonly) u.pm = (u.pm >> 3) * 9 + 1 + (u.pm & 7); return true; }
        const int j = (int)(L - so.nwg); if (j >= n_extra) return false;
        u.pm = (j >> 1) * 9; u.pn = 4 + (j & 1); u.hm = 0; return true;
    }
    __device__ __forceinline__ void a_ready(const pg8::Unit&) const {}
    __device__ __forceinline__ void done(const pg8::Unit&) const {}
};
struct SchedExp {
    const LAS unsigned char* tile_e; int NP, nunits, G, c;
    __device__ bool next(int i, pg8::Unit& u) const {
        long L = (long)i * G + c; int hm = 0;
        const int rr = nunits % G, full = nunits - rr;
        if (rr > 0 && 2 * rr <= G && L >= full) { const int j = (int)(L - full); if (j >= 2 * rr) return false; L = full + (j >> 1); hm = 1 + (j & 1); }
        if (L >= nunits) return false;
        const int q = nunits / 8, r = nunits % 8, xcd = (int)(L % 8), off = (int)(L / 8);
        const int Lr = (xcd < r ? xcd * (q + 1) : r * (q + 1) + (xcd - r) * q) + off;
        const int tm = Lr / NP, pl = Lr % NP;
        u.pm = tm; u.pn = (int)tile_e[tm] * NP + pl; u.hm = hm; return true;
    }
    __device__ __forceinline__ void a_ready(const pg8::Unit&) const {}
    __device__ __forceinline__ void done(const pg8::Unit&) const {}
};

struct EpiStoreBf16 {
    static constexpr bool PERM = true, AFTER_DRAIN = false;
    bf16_t* O; int ldc; int pn_mask; const f32x2* tab; const float* kg; LAS float* xch;
    __device__ __forceinline__ void operator()(const pg8::f32x4 (&acc)[2][2][4][2], const pg8::Unit& u, int wr, int wc, int fr_in, int fq_in) const {
        int fr = fr_in, fq = fq_in; asm volatile("" : "+v"(fr), "+v"(fq));
        const int row0 = u.pm * 256 + wr * 64 + fr;
        if (kg == nullptr && tab != nullptr && u.pn >= 4 && u.pn < 8) {
            const int tj = u.pm % 9; const bool lat = tj != 0; const int nbase = (tj - 1) * 256 + wr * 64 + fr;
            const int ax = fq >> 1, f0 = (fq & 1) * 8; const int col0 = u.pn * 256 + wc * 64 + ax * 32 + f0;
#pragma unroll
            for (int ai = 0; ai < 2; ++ai) { if (u.hm != 0 && u.hm != ai + 1) continue;
#pragma unroll
                for (int m = 0; m < 4; ++m) { bf16_t* rowp = O + (size_t)(row0 + ai * 128 + m * 16) * ldc + col0;
                    float x1[8], x2[8];
#pragma unroll
                    for (int n = 0; n < 2; ++n)
#pragma unroll
                        for (int q = 0; q < 4; ++q) { x1[n * 4 + q] = acc[ai][0][m][n][q]; x2[n * 4 + q] = acc[ai][1][m][n][q]; }
                    if (lat) { const int nr = nbase + ai * 128 + m * 16; const int pos = ax ? (nr & 63) : (nr >> 6);
                        const pg8::f32x4* tp = (const pg8::f32x4*)(tab + pos * 16 + f0);
#pragma unroll
                        for (int q = 0; q < 4; ++q) { const pg8::f32x4 cs = tp[q];
                            const float a0 = x1[2 * q], b0 = x2[2 * q], a1 = x1[2 * q + 1], b1 = x2[2 * q + 1];
                            x1[2 * q] = a0 * cs[0] - b0 * cs[1]; x2[2 * q] = b0 * cs[0] + a0 * cs[1];
                            x1[2 * q + 1] = a1 * cs[2] - b1 * cs[3]; x2[2 * q + 1] = b1 * cs[2] + a1 * cs[3]; } }
                    v4u w; w.x = cvtpk(x1[0], x1[1]); w.y = cvtpk(x1[2], x1[3]); w.z = cvtpk(x1[4], x1[5]); w.w = cvtpk(x1[6], x1[7]);
                    *(v4u*)rowp = w;
                    w.x = cvtpk(x2[0], x2[1]); w.y = cvtpk(x2[2], x2[3]); w.z = cvtpk(x2[4], x2[5]); w.w = cvtpk(x2[6], x2[7]);
                    *(v4u*)(rowp + 16) = w; } }
            return;
        }
        if (kg != nullptr && u.pn == 4) {
            const int tj = u.pm % 9; const bool lat = tj != 0; const int nbase = (tj - 1) * 256 + wr * 64 + fr;
            const int hl = wc >> 1, ax = wc & 1, f0 = 8 * fq; const int col0k = 1024 + hl * 128 + ax * 64 + f0; const int wid = wr * 4 + wc;
            float ssq[2][4];
#pragma unroll
            for (int ai = 0; ai < 2; ++ai)
#pragma unroll
                for (int m = 0; m < 4; ++m) { float s = 0.f;
#pragma unroll
                    for (int bj = 0; bj < 2; ++bj)
#pragma unroll
                        for (int n = 0; n < 2; ++n)
#pragma unroll
                            for (int q = 0; q < 4; ++q) s += acc[ai][bj][m][n][q] * acc[ai][bj][m][n][q];
                    s = xsum<16>(s); s = xsum<32>(s);
                    ssq[ai][m] = s; if (fq == 0) xch[wid * 128 + ai * 64 + m * 16 + fr] = s; }
            asm volatile("s_waitcnt lgkmcnt(0)" ::: "memory"); __builtin_amdgcn_s_barrier(); asm volatile("" ::: "memory");
            const float g00 = 0.f; (void)g00;
            pg8::f32x4 gA[2][2];
#pragma unroll
            for (int bj = 0; bj < 2; ++bj)
#pragma unroll
                for (int n = 0; n < 2; ++n) gA[bj][n] = *(const pg8::f32x4*)(kg + ax * 64 + bj * 32 + f0 + 4 * n);
#pragma unroll
            for (int ai = 0; ai < 2; ++ai) { if (u.hm != 0 && u.hm != ai + 1) continue;
#pragma unroll
                for (int m = 0; m < 4; ++m) { bf16_t* rowp = O + (size_t)(row0 + ai * 128 + m * 16) * ldc + col0k;
                    const float tot = ssq[ai][m] + xch[(wid ^ 1) * 128 + ai * 64 + m * 16 + fr];
                    const float rs = 1.0f / sqrtf(tot * (1.f / 128.f) + RMS_EPS);
                    float x1[8], x2[8];
#pragma unroll
                    for (int n = 0; n < 2; ++n)
#pragma unroll
                        for (int q = 0; q < 4; ++q) { x1[n * 4 + q] = acc[ai][0][m][n][q] * rs * gA[0][n][q]; x2[n * 4 + q] = acc[ai][1][m][n][q] * rs * gA[1][n][q]; }
                    if (lat) { const int nr = nbase + ai * 128 + m * 16; const int pos = ax ? (nr & 63) : (nr >> 6);
                        const pg8::f32x4* tp = (const pg8::f32x4*)(tab + pos * 32 + f0);
#pragma unroll
                        for (int q = 0; q < 4; ++q) { const pg8::f32x4 cs = tp[q];
                            const float a0 = x1[2 * q], b0 = x2[2 * q], a1 = x1[2 * q + 1], b1 = x2[2 * q + 1];
                            x1[2 * q] = a0 * cs[0] - b0 * cs[1]; x2[2 * q] = b0 * cs[0] + a0 * cs[1];
                            x1[2 * q + 1] = a1 * cs[2] - b1 * cs[3]; x2[2 * q + 1] = b1 * cs[2] + a1 * cs[3]; } }
                    v4u w; w.x = cvtpk(x1[0], x1[1]); w.y = cvtpk(x1[2], x1[3]); w.z = cvtpk(x1[4], x1[5]); w.w = cvtpk(x1[6], x1[7]);
                    *(v4u*)rowp = w;
                    w.x = cvtpk(x2[0], x2[1]); w.y = cvtpk(x2[2], x2[3]); w.z = cvtpk(x2[4], x2[5]); w.w = cvtpk(x2[6], x2[7]);
                    *(v4u*)(rowp + 32) = w; } }
            asm volatile("s_waitcnt lgkmcnt(0)" ::: "memory"); __builtin_amdgcn_s_barrier(); asm volatile("" ::: "memory");
            return;
        }
        const int col0 = (u.pn & pn_mask) * 256 + wc * 32 + 8 * fq;
#pragma unroll
        for (int ai = 0; ai < 2; ++ai) { if (u.hm != 0 && u.hm != ai + 1) continue;
#pragma unroll
            for (int m = 0; m < 4; ++m) { bf16_t* rowp = O + (size_t)(row0 + ai * 128 + m * 16) * ldc + col0;
#pragma unroll
                for (int bj = 0; bj < 2; ++bj) { const pg8::f32x4 v0 = acc[ai][bj][m][0], v1 = acc[ai][bj][m][1];
                    v4u w; w.x = cvtpk(v0[0], v0[1]); w.y = cvtpk(v0[2], v0[3]); w.z = cvtpk(v1[0], v1[1]); w.w = cvtpk(v1[2], v1[3]);
                    *(v4u*)(rowp + bj * 128) = w; } } }
    }
};
typedef _Float16 hf_t;
typedef _Float16 hf2_t __attribute__((ext_vector_type(2)));
__device__ __forceinline__ unsigned pkh(float a, float b_) { const hf2_t v = {(hf_t)a, (hf_t)b_}; return __builtin_bit_cast(unsigned, v); }
__device__ __forceinline__ float hf_lo(unsigned u) { const hf2_t v = __builtin_bit_cast(hf2_t, u); return (float)v[0]; }
__device__ __forceinline__ float hf_hi(unsigned u) { const hf2_t v = __builtin_bit_cast(hf2_t, u); return (float)v[1]; }
template <bool RH>
struct EpiResid {
    static constexpr bool PERM = true, AFTER_DRAIN = false;
    hf_t* Y; const float* xbase; const float* cbase; const float* modl; f32x2* stats;
    __device__ __forceinline__ void operator()(const pg8::f32x4 (&acc)[2][2][4][2], const pg8::Unit& u, int wr, int wc, int fr_in, int fq_in) const {
        int fr = fr_in, fq = fq_in; asm volatile("" : "+v"(fr), "+v"(fq));
        const int b = u.pm / 9, j = u.pm - b * 9;
        const size_t roff0 = (j == 0) ? (size_t)b * LCT * DM : ((size_t)b * NXT + (size_t)(j - 1) * 256) * DM;
        const float* rb = ((j == 0) ? cbase : xbase) + roff0; const hf_t* rbh = (const hf_t*)xbase + roff0;
        const float* g = modl + (size_t)(j == 0 ? 8 : b) * NMOD + 2048;
        const int col0 = u.pn * 256 + wc * 32 + 8 * fq;
        pg8::f32x4 gv[2][2];
#pragma unroll
        for (int bj = 0; bj < 2; ++bj)
#pragma unroll
            for (int n = 0; n < 2; ++n) gv[bj][n] = *(const pg8::f32x4*)(g + col0 + bj * 128 + n * 4);
#pragma unroll
        for (int ai = 0; ai < 2; ++ai) { if (u.hm != 0 && u.hm != ai + 1) continue;
#pragma unroll
            for (int mh = 0; mh < 2; ++mh) {
            pg8::f32x4 rva[2][2][2]; v4u rvh[2][2];
#pragma unroll
            for (int mm = 0; mm < 2; ++mm) { const size_t ro = (size_t)(ai * 128 + wr * 64 + (2 * mh + mm) * 16 + fr) * DM + col0;
#pragma unroll
                for (int bj = 0; bj < 2; ++bj) {
                    if constexpr (RH) rvh[mm][bj] = *(const v4u*)(rbh + ro + bj * 128);
                    else {
#pragma unroll
                        for (int n = 0; n < 2; ++n) rva[mm][bj][n] = *(const pg8::f32x4*)(rb + ro + bj * 128 + n * 4); } } }
#pragma unroll
            for (int mm = 0; mm < 2; ++mm) { const int m = 2 * mh + mm; const int lr = ai * 128 + wr * 64 + m * 16 + fr;
                hf_t* yrow = Y + ((size_t)u.pm * 256 + lr) * DM + col0;
                float s = 0.f, q = 0.f;
#pragma unroll
                for (int bj = 0; bj < 2; ++bj) {
                    if constexpr (RH) { const v4u h = rvh[mm][bj]; rva[mm][bj][0] = (pg8::f32x4){hf_lo(h.x), hf_hi(h.x), hf_lo(h.y), hf_hi(h.y)}; rva[mm][bj][1] = (pg8::f32x4){hf_lo(h.z), hf_hi(h.z), hf_lo(h.w), hf_hi(h.w)}; }
                    const pg8::f32x4 o0 = rva[mm][bj][0] * ALPHA + gv[bj][0] * acc[ai][bj][m][0], o1 = rva[mm][bj][1] * ALPHA + gv[bj][1] * acc[ai][bj][m][1];
                    s += ((o0[0] + o0[1]) + (o0[2] + o0[3])) + ((o1[0] + o1[1]) + (o1[2] + o1[3]));
                    q += ((o0[0] * o0[0] + o0[1] * o0[1]) + (o0[2] * o0[2] + o0[3] * o0[3])) + ((o1[0] * o1[0] + o1[1] * o1[1]) + (o1[2] * o1[2] + o1[3] * o1[3]));
                    v4u w; w.x = pkh(o0[0], o0[1]); w.y = pkh(o0[2], o0[3]); w.z = pkh(o1[0], o1[1]); w.w = pkh(o1[2], o1[3]);
                    *(v4u*)(yrow + bj * 128) = w; }
                s = xsum<16>(s); q = xsum<16>(q); s = xsum<32>(s); q = xsum<32>(q);
                if (fq == 0) stats[((size_t)u.pm * 256 + lr) * 16 + u.pn * 4 + wc] = (f32x2){s, q}; } } }
    }
};
struct EpiGateUp {
    static constexpr bool PERM = true, AFTER_DRAIN = false;
    bf16_t* ACT; const float* gwof; const LAS int* tbase;
    __device__ __forceinline__ void operator()(const pg8::f32x4 (&acc)[2][2][4][2], const pg8::Unit& u, int wr, int wc, int fr_in, int fq_in) const {
        int fr = fr_in, fq = fq_in; asm volatile("" : "+v"(fr), "+v"(fq));
        const int e = u.pn >> 1; const float* gwe = gwof + (size_t)e * ECAP + (u.pm - tbase[e]) * 256;
        const int lr0 = wr * 64 + fr; const int f0 = (u.pn & 1) * 128 + wc * 32 + 8 * fq;
#pragma unroll
        for (int ai = 0; ai < 2; ++ai) { if (u.hm != 0 && u.hm != ai + 1) continue;
#pragma unroll
            for (int m = 0; m < 4; ++m) { const int lr = lr0 + ai * 128 + m * 16; const float gw = gwe[lr];
                float o[8];
#pragma unroll
                for (int n = 0; n < 2; ++n)
#pragma unroll
                    for (int q = 0; q < 4; ++q) { const float a = acc[ai][0][m][n][q], up = acc[ai][1][m][n][q];
                        o[n * 4 + q] = a * __builtin_amdgcn_rcpf(1.f + __expf(-a)) * up * gw; }
                v4u w; w.x = cvtpk(o[0], o[1]); w.y = cvtpk(o[2], o[3]); w.z = cvtpk(o[4], o[5]); w.w = cvtpk(o[6], o[7]);
                *(v4u*)(ACT + ((size_t)u.pm * 256 + lr) * FH + f0) = w; } }
    }
};

namespace att {
constexpr int KVBLK = 64;
constexpr int SHM_V = KVBLK * 128 * 2, SHM_K = KVBLK * 128 * 2;
constexpr int OFF_WS = 2 * SHM_V + 2 * SHM_K;
constexpr int OFF_XCH = OFF_WS + 8 * 256;
constexpr int LDS_NEED = OFF_XCH + 4 * 16384;
static_assert(LDS_NEED <= MISC_OFF, "attention LDS");
constexpr float THR = 8.f;
#define KSWZ(row, colB) ((row) * 256 + ((colB) ^ (((row) & 7) << 4)))
#define SBAR() __builtin_amdgcn_sched_barrier(0)
__device__ __forceinline__ int crow(int r, int hi) { return (r & 3) + 8 * (r >> 2) + 4 * hi; }

template <bool DIFF> struct Cst { static constexpr float SCALE = DIFF ? 0.125f : 0.088388347648318440f; static constexpr float C = SCALE * 1.4426950408889634f; };

template <bool DIFF>
__device__ __forceinline__ void partialSM(f32x16& p0, f32x16& p1, float& m_reg, float& mn, float& alpha) {
  constexpr float C = Cst<DIFF>::C, SCALE = Cst<DIFF>::SCALE;
  float pmax = p0[0];
#pragma unroll
  for (int r = 1; r < 16; ++r) pmax = fmaxf(pmax, p0[r]);
#pragma unroll
  for (int r = 0; r < 16; ++r) pmax = fmaxf(pmax, p1[r]);
  { auto rr = __builtin_amdgcn_permlane32_swap(__float_as_uint(pmax), __float_as_uint(pmax), false, false);
    pmax = fmaxf(__uint_as_float(rr[0]), __uint_as_float(rr[1])); }
  if (__builtin_expect(__all(pmax - m_reg <= THR / SCALE), 1)) { mn = m_reg; alpha = 1.f; }
  else { mn = fmaxf(m_reg, pmax); alpha = __builtin_amdgcn_exp2f((m_reg - mn) * C); m_reg = mn; }
  float mnC = -mn * C;
#pragma unroll
  for (int r = 0; r < 16; ++r) p0[r] = fmaf(p0[r], C, mnC);
#pragma unroll
  for (int r = 0; r < 16; ++r) p1[r] = fmaf(p1[r], C, mnC);
#pragma unroll
  for (int r = 0; r < 16; ++r) p0[r] = __builtin_amdgcn_exp2f(p0[r]);
}
__device__ __forceinline__ void finishSM(f32x16& p0, f32x16& p1, float alpha, float& l_reg, bf16x8& pa0, bf16x8& pa1, bf16x8& pa2, bf16x8& pa3) {
#pragma unroll
  for (int r = 0; r < 16; ++r) p1[r] = __builtin_amdgcn_exp2f(p1[r]);
  float ps = 0;
#pragma unroll
  for (int r = 0; r < 16; ++r) ps += p0[r];
#pragma unroll
  for (int r = 0; r < 16; ++r) ps += p1[r];
  { auto rr = __builtin_amdgcn_permlane32_swap(__float_as_uint(ps), __float_as_uint(ps), false, false);
    ps = __uint_as_float(rr[0]) + __uint_as_float(rr[1]); }
  l_reg = l_reg * alpha + ps;
#define PK4(P, BASE, OUT) do { unsigned a0 = cvtpk(P[BASE + 0], P[BASE + 1]), a1 = cvtpk(P[BASE + 2], P[BASE + 3]);   \
    unsigned b0 = cvtpk(P[BASE + 4], P[BASE + 5]), b1 = cvtpk(P[BASE + 6], P[BASE + 7]);                              \
    auto r0 = __builtin_amdgcn_permlane32_swap(a0, b0, false, false); auto r1 = __builtin_amdgcn_permlane32_swap(a1, b1, false, false); \
    v4u w = {r0[0], r1[0], r0[1], r1[1]}; OUT = *reinterpret_cast<bf16x8*>(&w); } while (0)
  PK4(p0, 0, pa0); PK4(p0, 8, pa1); PK4(p1, 0, pa2); PK4(p1, 8, pa3);
#undef PK4
}
template <int NQ>
__device__ __forceinline__ void qkt(f32x16& p0, f32x16& p1, const char* Ks, const bf16x8* qr, int r32, int hi, int d0base) {
  p0 = f32x16{}; p1 = f32x16{};
#pragma unroll
  for (int d0 = 0; d0 < NQ; ++d0) { const int cb = ((d0base + d0) * 16 + hi * 8) * 2;
    bf16x8 b0 = *reinterpret_cast<const bf16x8*>(Ks + KSWZ(r32, cb));
    bf16x8 b1 = *reinterpret_cast<const bf16x8*>(Ks + KSWZ(32 + r32, cb));
    p0 = __builtin_amdgcn_mfma_f32_32x32x16_bf16(b0, qr[d0], p0, 0, 0, 0);
    p1 = __builtin_amdgcn_mfma_f32_32x32x16_bf16(b1, qr[d0], p1, 0, 0, 0); }
}
__device__ __forceinline__ int v_st(int k, int c) { const int kk = (k & ~0xC) | ((k & 4) << 1) | ((k & 8) >> 1); return ((kk >> 3) * 4 + (c >> 5)) * 512 + ((kk & 7) * 32 + (c & 31)) * 2; }
__device__ __forceinline__ int v_rd_base(int lane) { return ((lane & 3) << 3) | (((lane >> 2) & 3) << 6) | (((lane >> 4) & 1) << 5) | (((lane >> 5) & 1) << 8); }
constexpr int v_rd_off(int d0, int ks, int half) { return d0 * 512 + ks * 4096 + half * 2048; }
template <int OFF> __device__ __forceinline__ s16x4 tr_read(int vb) {
  s16x4 r; asm volatile("ds_read_b64_tr_b16 %0, %1 offset:%2" : "=&v"(r) : "v"(vb), "i"(OFF) : "memory"); return r;
}
template <int D0> __device__ __forceinline__ void pv_one(f32x16& od, int vb, bf16x8 pa0, bf16x8 pa1, bf16x8 pa2, bf16x8 pa3) {
  const s16x4 l0 = tr_read<v_rd_off(D0, 0, 0)>(vb), h0 = tr_read<v_rd_off(D0, 0, 1)>(vb), l1 = tr_read<v_rd_off(D0, 1, 0)>(vb), h1 = tr_read<v_rd_off(D0, 1, 1)>(vb);
  const s16x4 l2 = tr_read<v_rd_off(D0, 2, 0)>(vb), h2 = tr_read<v_rd_off(D0, 2, 1)>(vb), l3 = tr_read<v_rd_off(D0, 3, 0)>(vb), h3 = tr_read<v_rd_off(D0, 3, 1)>(vb);
  asm volatile("s_waitcnt lgkmcnt(0)" ::: "memory"); SBAR();
#define PK(L, H) (bf16x8){L[0], L[1], L[2], L[3], H[0], H[1], H[2], H[3]}
  od = __builtin_amdgcn_mfma_f32_32x32x16_bf16(pa0, PK(l0, h0), od, 0, 0, 0);
  od = __builtin_amdgcn_mfma_f32_32x32x16_bf16(pa1, PK(l1, h1), od, 0, 0, 0);
  od = __builtin_amdgcn_mfma_f32_32x32x16_bf16(pa2, PK(l2, h2), od, 0, 0, 0);
  od = __builtin_amdgcn_mfma_f32_32x32x16_bf16(pa3, PK(l3, h3), od, 0, 0, 0);
#undef PK
}
__device__ __forceinline__ void pv_d0(f32x16* o, int vb, bf16x8 pa0, bf16x8 pa1, bf16x8 pa2, bf16x8 pa3) {
  pv_one<0>(o[0], vb, pa0, pa1, pa2, pa3); pv_one<1>(o[1], vb, pa0, pa1, pa2, pa3); pv_one<2>(o[2], vb, pa0, pa1, pa2, pa3); pv_one<3>(o[3], vb, pa0, pa1, pa2, pa3);
}

constexpr float THRL = THR * 1.4426950408889634f;
__device__ __forceinline__ void qkt_negm(f32x16& p0, f32x16& p1, const char* Ks, const bf16x8* qr, const f32x16& negm, int r32, int hi, int d0base) {
#pragma unroll
  for (int d0 = 0; d0 < 4; ++d0) { const int cb = ((d0base + d0) * 16 + hi * 8) * 2;
    bf16x8 b0 = *reinterpret_cast<const bf16x8*>(Ks + KSWZ(r32, cb));
    bf16x8 b1 = *reinterpret_cast<const bf16x8*>(Ks + KSWZ(32 + r32, cb));
    if (d0 == 0) { p0 = __builtin_amdgcn_mfma_f32_32x32x16_bf16(b0, qr[0], negm, 0, 0, 0); p1 = __builtin_amdgcn_mfma_f32_32x32x16_bf16(b1, qr[0], negm, 0, 0, 0); }
    else { p0 = __builtin_amdgcn_mfma_f32_32x32x16_bf16(b0, qr[d0], p0, 0, 0, 0); p1 = __builtin_amdgcn_mfma_f32_32x32x16_bf16(b1, qr[d0], p1, 0, 0, 0); } }
}
__device__ __forceinline__ void splat16(f32x16& v, float x) {
#pragma unroll
  for (int r = 0; r < 16; ++r) v[r] = x;
}
__device__ __forceinline__ void partial_first_negm(f32x16& p0, f32x16& p1, float& m_reg, f32x16& negm) {
  float pmax = p0[0];
#pragma unroll
  for (int r = 1; r < 16; ++r) pmax = fmaxf(pmax, p0[r]);
#pragma unroll
  for (int r = 0; r < 16; ++r) pmax = fmaxf(pmax, p1[r]);
  { auto rr = __builtin_amdgcn_permlane32_swap(__float_as_uint(pmax), __float_as_uint(pmax), false, false);
    pmax = fmaxf(__uint_as_float(rr[0]), __uint_as_float(rr[1])); }
  m_reg = pmax; splat16(negm, -pmax);
#pragma unroll
  for (int r = 0; r < 16; ++r) { p0[r] -= pmax; p1[r] -= pmax; }
#pragma unroll
  for (int r = 0; r < 16; ++r) p0[r] = __builtin_amdgcn_exp2f(p0[r]);
}
__device__ __forceinline__ void pv_partial_negm(f32x16* o, int vb, bf16x8 pa0, bf16x8 pa1, bf16x8 pa2, bf16x8 pa3, f32x16& p0, f32x16& p1, float& m_reg, f32x16& negm, float& alpha) {
  pv_one<0>(o[0], vb, pa0, pa1, pa2, pa3);
  float pmax = p0[0];
#pragma unroll
  for (int r = 1; r < 16; ++r) pmax = fmaxf(pmax, p0[r]);
  pv_one<1>(o[1], vb, pa0, pa1, pa2, pa3);
#pragma unroll
  for (int r = 0; r < 16; ++r) pmax = fmaxf(pmax, p1[r]);
  { auto rr = __builtin_amdgcn_permlane32_swap(__float_as_uint(pmax), __float_as_uint(pmax), false, false);
    pmax = fmaxf(__uint_as_float(rr[0]), __uint_as_float(rr[1])); }
  if (__builtin_expect(__all(pmax <= THRL), 1)) { alpha = 1.f; }
  else { const float d = fmaxf(pmax, 0.f); alpha = __builtin_amdgcn_exp2f(-d); m_reg += d; splat16(negm, -m_reg);
#pragma unroll
    for (int r = 0; r < 16; ++r) { p0[r] -= d; p1[r] -= d; } }
  pv_one<2>(o[2], vb, pa0, pa1, pa2, pa3);
  pv_one<3>(o[3], vb, pa0, pa1, pa2, pa3);
#pragma unroll
  for (int r = 0; r < 16; ++r) p0[r] = __builtin_amdgcn_exp2f(p0[r]);
  asm volatile("" : "+v"(p0), "+v"(p1));
  SBAR();
}

template <bool DIFF>
__device__ __forceinline__ void pv_partial(f32x16* o, int vb, bf16x8 pa0, bf16x8 pa1, bf16x8 pa2, bf16x8 pa3, f32x16& p0, f32x16& p1, float& m_reg, float& mn, float& alpha) {
  constexpr float C = Cst<DIFF>::C, SCALE = Cst<DIFF>::SCALE;
  pv_one<0>(o[0], vb, pa0, pa1, pa2, pa3);
  float pmax = p0[0];
#pragma unroll
  for (int r = 1; r < 16; ++r) pmax = fmaxf(pmax, p0[r]);
  pv_one<1>(o[1], vb, pa0, pa1, pa2, pa3);
#pragma unroll
  for (int r = 0; r < 16; ++r) pmax = fmaxf(pmax, p1[r]);
  { auto rr = __builtin_amdgcn_permlane32_swap(__float_as_uint(pmax), __float_as_uint(pmax), false, false);
    pmax = fmaxf(__uint_as_float(rr[0]), __uint_as_float(rr[1])); }
  if (__builtin_expect(__all(pmax - m_reg <= THR / SCALE), 1)) { mn = m_reg; alpha = 1.f; }
  else { mn = fmaxf(m_reg, pmax); alpha = __builtin_amdgcn_exp2f((m_reg - mn) * C); m_reg = mn; }
  pv_one<2>(o[2], vb, pa0, pa1, pa2, pa3);
  const float mnC = -mn * C;
#pragma unroll
  for (int r = 0; r < 16; ++r) p0[r] = fmaf(p0[r], C, mnC);
#pragma unroll
  for (int r = 0; r < 16; ++r) p1[r] = fmaf(p1[r], C, mnC);
  pv_one<3>(o[3], vb, pa0, pa1, pa2, pa3);
#pragma unroll
  for (int r = 0; r < 16; ++r) p0[r] = __builtin_amdgcn_exp2f(p0[r]);
  asm volatile("" : "+v"(p0), "+v"(p1));
  SBAR();
}

template <bool DIFF>
__device__ __forceinline__ void attn_unit(const bf16_t* __restrict__ Qb, int ldq, const bf16_t* __restrict__ Kh, const bf16_t* __restrict__ Vh, int ldk, int seq,
                                          bf16_t* __restrict__ Ob, int ldo, bool rope, int n0, const f32x2* __restrict__ tab,
                                          const float* __restrict__ qg  , const float* __restrict__ subg  , float lam, char* lds, const int wv) {
  constexpr int NQ = DIFF ? 4 : 8;
  const int tid = ltid(wv), wid = wv, lane = tid & 63, r32 = lane & 31, hi = lane >> 5;
  const int qblk = DIFF ? (wid & 3) : wid, map = DIFF ? (wid >> 2) : 0;
  char* V_lds = lds; char* K_lds = lds + 2 * SHM_V;
  float* wsf = (float*)(lds + OFF_WS) + wid * 64; float* li_l = wsf; float* al_l = wsf + 32;
  float m_reg = -1e30f, l_reg = 0; f32x16 o[4] = {}; bf16x8 qr[NQ];
  const int sr = tid >> 4, sc = (tid & 15) * 8, vst0 = v_st(sr, sc), vst1 = v_st(32 + sr, sc);
  const int vb0 = (int)(uintptr_t)V_lds + v_rd_base(lane);
  struct { bf16x8 vs0, vs1, ks0, ks1; } sr_[2] = {};
#define LD8(p) (*reinterpret_cast<const bf16x8*>(p))
#define SLOAD(i, k0) do { sr_[i].vs0 = LD8(&Vh[(size_t)((k0) + sr) * ldk + sc]); sr_[i].vs1 = LD8(&Vh[(size_t)((k0) + 32 + sr) * ldk + sc]); \
    sr_[i].ks0 = LD8(&Kh[(size_t)((k0) + sr) * ldk + sc]); sr_[i].ks1 = LD8(&Kh[(size_t)((k0) + 32 + sr) * ldk + sc]); } while (0)
#define SWRITE(b, i) do { *(bf16x8*)(V_lds + (b) * SHM_V + vst0) = sr_[i].vs0;          \
    *(bf16x8*)(V_lds + (b) * SHM_V + vst1) = sr_[i].vs1; int kc = sc * 2;               \
    *(bf16x8*)(K_lds + (b) * SHM_K + KSWZ(sr, kc)) = sr_[i].ks0;                       \
    *(bf16x8*)(K_lds + (b) * SHM_K + KSWZ(32 + sr, kc)) = sr_[i].ks1; } while (0)
  constexpr int SE = 0, SO = 1;
  SLOAD(SE, 0); SLOAD(SO, KVBLK);
  {
    const bf16_t* Qw = Qb + (size_t)(qblk * 32 + r32) * ldq + map * 64 + hi * 8;
    const int n = n0 + qblk * 32 + r32;
    float qf[NQ][8];
#pragma unroll
    for (int d0 = 0; d0 < NQ; ++d0) { const v4u w = *reinterpret_cast<const v4u*>(Qw + d0 * 16);
      qf[d0][0] = bf_lo(w.x); qf[d0][1] = bf_hi(w.x); qf[d0][2] = bf_lo(w.y); qf[d0][3] = bf_hi(w.y);
      qf[d0][4] = bf_lo(w.z); qf[d0][5] = bf_hi(w.z); qf[d0][6] = bf_lo(w.w); qf[d0][7] = bf_hi(w.w); }
    if constexpr (!DIFF) {
      float ss = 0.f;
#pragma unroll
      for (int d0 = 0; d0 < NQ; ++d0)
#pragma unroll
        for (int j = 0; j < 8; ++j) ss += qf[d0][j] * qf[d0][j];
      ss = xsum<32>(ss);
      const float rs = 1.0f / sqrtf(ss * (1.f / 128.f) + RMS_EPS);
#pragma unroll
      for (int d0 = 0; d0 < NQ; ++d0) { const f32x4 g0 = *(const f32x4*)(qg + d0 * 16 + hi * 8), g1 = *(const f32x4*)(qg + d0 * 16 + hi * 8 + 4);
#pragma unroll
        for (int j = 0; j < 4; ++j) { qf[d0][j] *= rs * g0[j]; qf[d0][4 + j] *= rs * g1[j]; } }
    }
    if (rope) {
      constexpr int NF = DIFF ? 16 : 32;
      constexpr int HB = DIFF ? 1 : 2;
#pragma unroll
      for (int ax = 0; ax < 2; ++ax) { const int pos = ax ? (n & 63) : (n >> 6);
#pragma unroll
        for (int hb = 0; hb < HB; ++hb) { const int dA = ax * 2 * HB + hb, dB = dA + HB;
          const f32x2* tp = tab + pos * NF + hb * 16 + hi * 8;
#pragma unroll
          for (int j = 0; j < 8; ++j) { const f32x2 cs = tp[j]; const float x1 = qf[dA][j], x2 = qf[dB][j];
            qf[dA][j] = x1 * cs.x - x2 * cs.y; qf[dB][j] = x2 * cs.x + x1 * cs.y; } } }
    }
    if constexpr (DIFF) {
#pragma unroll
      for (int d0 = 0; d0 < NQ; ++d0)
#pragma unroll
        for (int j = 0; j < 8; ++j) qf[d0][j] *= Cst<true>::C; }
#pragma unroll
    for (int d0 = 0; d0 < NQ; ++d0) { v4u w = {cvtpk(qf[d0][0], qf[d0][1]), cvtpk(qf[d0][2], qf[d0][3]), cvtpk(qf[d0][4], qf[d0][5]), cvtpk(qf[d0][6], qf[d0][7])};
      qr[d0] = *reinterpret_cast<bf16x8*>(&w); }
  }
#define SWAIT() asm volatile("s_waitcnt vmcnt(4)" ::: "memory")
#define RESC(a) do { if (__any((a) < 1.f)) { if (hi == 0) al_l[r32] = (a); asm volatile("s_waitcnt lgkmcnt(0)" ::: "memory"); \
    _Pragma("unroll") for (int d = 0; d < 4; ++d) _Pragma("unroll") for (int r = 0; r < 16; ++r) o[d][r] *= al_l[crow(r, hi)]; } } while (0)
  f32x16 pA0, pA1, pB0, pB1; float mnA, mnB, alA, alB; bf16x8 pa0, pa1, pa2, pa3; const int NT = seq / KVBLK;
  const int dbase = map * 4;
  f32x16 negm = {};
  if constexpr (DIFF) m_reg = 0.f;
#define QKT(P0, P1, KS) do { if constexpr (DIFF) qkt_negm(P0, P1, KS, qr, negm, r32, hi, dbase); else qkt<NQ>(P0, P1, KS, qr, r32, hi, dbase); } while (0)
#define PVP(VB, P0, P1, MN, AL) do { if constexpr (DIFF) pv_partial_negm(o, VB, pa0, pa1, pa2, pa3, P0, P1, m_reg, negm, AL); else pv_partial<DIFF>(o, VB, pa0, pa1, pa2, pa3, P0, P1, m_reg, MN, AL); } while (0)
  SWAIT(); SWRITE(0, SE); __syncthreads();
  QKT(pA0, pA1, K_lds); if constexpr (DIFF) { partial_first_negm(pA0, pA1, m_reg, negm); alA = 1.f; } else partialSM<DIFF>(pA0, pA1, m_reg, mnA, alA);
  if (2 < NT) SLOAD(SE, 2 * KVBLK);
  SWAIT(); SWRITE(1, SO); __syncthreads();
  for (int j = 1; j + 1 < NT; j += 2) {
    SBAR(); QKT(pB0, pB1, K_lds + SHM_K);
    finishSM(pA0, pA1, alA, l_reg, pa0, pa1, pa2, pa3); SBAR();
    SLOAD(SO, (j + 2) * KVBLK); SBAR();
    PVP(vb0, pB0, pB1, mnB, alB);
    __syncthreads(); SWAIT(); SWRITE(0, SE);
    RESC(alB); __syncthreads();
    SBAR(); QKT(pA0, pA1, K_lds);
    finishSM(pB0, pB1, alB, l_reg, pa0, pa1, pa2, pa3); SBAR();
    if (j + 3 < NT) SLOAD(SE, (j + 3) * KVBLK); SBAR();
    PVP(vb0 + (int)SHM_V, pA0, pA1, mnA, alA);
    __syncthreads(); SWAIT(); SWRITE(1, SO);
    RESC(alA); __syncthreads();
  }
  SBAR(); QKT(pB0, pB1, K_lds + SHM_K);
  finishSM(pA0, pA1, alA, l_reg, pa0, pa1, pa2, pa3); SBAR();
  PVP(vb0, pB0, pB1, mnB, alB);
  __syncthreads(); RESC(alB);
  finishSM(pB0, pB1, alB, l_reg, pa0, pa1, pa2, pa3); SBAR();
  pv_d0(o, vb0 + (int)SHM_V, pa0, pa1, pa2, pa3);
  if (hi == 0) li_l[r32] = l_reg; asm volatile("s_waitcnt lgkmcnt(0)" ::: "memory");
#pragma unroll
  for (int r = 0; r < 16; ++r) { const float rl = __builtin_amdgcn_rcpf(li_l[crow(r, hi)]);
#pragma unroll
    for (int d0 = 0; d0 < 4; ++d0) o[d0][r] *= rl; }
  if constexpr (!DIFF) {
    bf16_t* ost = (bf16_t*)(lds + OFF_XCH) + wid * (32 * 136);
#pragma unroll
    for (int r = 0; r < 16; ++r) { const int orow = crow(r, hi);
#pragma unroll
      for (int d0 = 0; d0 < 4; ++d0) ost[orow * 136 + d0 * 32 + r32] = (bf16_t)(cvtpk(o[d0][r], 0.f) & 0xffffu); }
    asm volatile("s_waitcnt lgkmcnt(0)" ::: "memory");
    bf16_t* Ow = Ob + (size_t)(wid * 32) * ldo;
#pragma unroll
    for (int i = 0; i < 8; ++i) { const int c = i * 64 + lane, orow = c >> 4, ch = c & 15;
      *(v4u*)(Ow + (size_t)orow * ldo + ch * 8) = *(const v4u*)(ost + orow * 136 + ch * 8); }
  } else {
    float* xch = (float*)(lds + OFF_XCH) + qblk * 4096;
    if (map == 1) {
#pragma unroll
      for (int d0 = 0; d0 < 4; ++d0)
#pragma unroll
        for (int r = 0; r < 16; ++r) xch[(d0 * 16 + r) * 64 + lane] = o[d0][r];
    }
    __syncthreads();
    if (map == 0) {
      float ssr[16];
#pragma unroll
      for (int r = 0; r < 16; ++r) { float s = 0.f;
#pragma unroll
        for (int d0 = 0; d0 < 4; ++d0) { const float d = o[d0][r] - lam * xch[(d0 * 16 + r) * 64 + lane]; o[d0][r] = d; s += d * d; }
        ssr[r] = s; }
#pragma unroll
      for (int r = 0; r < 16; ++r) { float s = ssr[r];
        s = sum32(s);
        ssr[r] = (1.0f / sqrtf(s * (1.f / 128.f) + RMS_EPS)) * (1.f - LAMBDA_INIT0); }
      asm volatile("s_waitcnt lgkmcnt(0)" ::: "memory");
      bf16_t* ost = (bf16_t*)xch;
#pragma unroll
      for (int d0 = 0; d0 < 4; ++d0) { const float g = subg[d0 * 32 + r32];
#pragma unroll
        for (int r = 0; r < 16; ++r) ost[crow(r, hi) * 136 + d0 * 32 + r32] = (bf16_t)(cvtpk(o[d0][r] * ssr[r] * g, 0.f) & 0xffffu); }
      asm volatile("s_waitcnt lgkmcnt(0)" ::: "memory");
      bf16_t* Ow = Ob + (size_t)(qblk * 32) * ldo;
#pragma unroll
      for (int i = 0; i < 8; ++i) { const int c = i * 64 + lane, orow = c >> 4, ch = c & 15;
        *(v4u*)(Ow + (size_t)orow * ldo + ch * 8) = *(const v4u*)(ost + orow * 136 + ch * 8); }
    }
  }
#undef QKT
#undef PVP
#undef LD8
#undef SLOAD
#undef SWRITE
#undef SWAIT
#undef RESC
}
#undef KSWZ
#undef SBAR
}

#ifndef REPMASK
#define REPMASK 0
#endif
#ifndef REPN
#define REPN 1
#endif
#ifndef PHMASK
#define PHMASK 0x3ffff
#endif
struct Args { const float* in[28]; float* o_; unsigned char* w_; };
enum { I_X = 0, I_C, I_CTX, I_CCTX, I_WMOD, I_BMOD, I_LNMG, I_LNMB, I_LNFG, I_LNFB, I_DWQKV, I_DWO, I_LQ1, I_LK1, I_LQ2, I_LK2, I_SUBG,
       I_GWQKV, I_GWO, I_GQN, I_GKN, I_WGRP, I_BGRP, I_WRT, I_BRT, I_WGATE, I_WUP, I_WDOWN };

constexpr int PTR_OFF = MISC_OFF + 1024;
__device__ __forceinline__ const float* ldptr(LAS unsigned char* ldsl, int i) {
    int off = PTR_OFF + 8 * i; asm volatile("" : "+v"(off));
    const LAS unsigned* p = (const LAS unsigned*)(ldsl + off);
    const unsigned lo = __builtin_amdgcn_readfirstlane(p[0]), hi = __builtin_amdgcn_readfirstlane(p[1]);
    return (const float*)(GAS const float*)(((unsigned long long)hi << 32) | lo);
}
struct TrItem { const float* W; int N; bf16_t* WT; int KT; int dstrow0; int k0; int n0; int hi_stride; };
__device__ __forceinline__ void transpose_load(const TrItem& I, float (&wv_)[32], int lane) {
    const unsigned vo_ = (unsigned)((lane >> 3) * I.N + (lane & 7) * 4) * 4u;
#pragma unroll
    for (int i = 0; i < 8; ++i) { const f32x4 w = __builtin_nontemporal_load((const f32x4*)((const char*)(I.W + (size_t)(I.k0 + 8 * i) * I.N + I.n0) + vo_));
        wv_[4 * i] = w[0]; wv_[4 * i + 1] = w[1]; wv_[4 * i + 2] = w[2]; wv_[4 * i + 3] = w[3]; }
}
__device__ __forceinline__ void transpose_finish(const TrItem& I, const float (&wv_)[32], LAS float* scr, int lane) {
#pragma unroll
    for (int i = 0; i < 8; ++i)
#pragma unroll
        for (int j = 0; j < 4; ++j) scr[(8 * i + (lane >> 3)) * 33 + (lane & 7) * 4 + j] = wv_[4 * i + j];
    LDS_WAIT(); asm volatile("" ::: "memory");
    const int c = lane & 7;
#pragma unroll
    for (int j = 0; j < 4; ++j) { const int n = (lane >> 3) + 8 * j; const LAS float* s = scr + (8 * c) * 33 + n;
        v4u o; o.x = cvtpk(s[0 * 33], s[1 * 33]); o.y = cvtpk(s[2 * 33], s[3 * 33]); o.z = cvtpk(s[4 * 33], s[5 * 33]); o.w = cvtpk(s[6 * 33], s[7 * 33]);
        *(v4u*)(I.WT + (size_t)(I.dstrow0 + (n & 15) + (n >> 4) * I.hi_stride) * I.KT + I.k0 + 8 * c) = o; }
    LDS_WAIT(); asm volatile("" ::: "memory");
}
__device__ __forceinline__ void transpose_item(const float* __restrict__ W, int N, bf16_t* __restrict__ WT, int KT, int dstrow0, int k0, int n0, LAS float* scr, int lane, int hi_stride = 16) {
    const TrItem I{W, N, WT, KT, dstrow0, k0, n0, hi_stride}; float wv_[32];
    transpose_load(I, wv_, lane); transpose_finish(I, wv_, scr, lane);
}
__device__ __forceinline__ TrItem moe_item_desc(LAS unsigned char* ldsl, int layer, int it, bf16_t* wgu_, bf16_t* wd_) {
    const int e = it / 384, r = it - e * 384;
    const size_t eoff = ((size_t)layer * NEXP + e) * (size_t)DM * FH;
    if (r < 256) {
        const int isup = r >> 7, rr = r & 127, kb = rr >> 3, nb = rr & 7, n0 = nb * 32;
        const float* W = (isup ? ldptr(ldsl, I_WUP) : ldptr(ldsl, I_WGATE)) + eoff;
        return TrItem{W, FH, wgu_, DM, e * 512 + (n0 >> 7) * 256 + isup * 128 + (n0 & 127), kb * 64, n0, 16};
    }
    const int rr = r - 256, kb = rr >> 5, nb = rr & 31;
    return TrItem{ldptr(ldsl, I_WDOWN) + eoff, DM, wd_, FH, e * 1024 + nb * 32, kb * 64, nb * 32, 16};
}
__device__ __forceinline__ void moe_weight_item(LAS unsigned char* ldsl, int layer, int it, bf16_t* wgu_, bf16_t* wd_, LAS float* scr, int lane) {
    const TrItem I = moe_item_desc(ldsl, layer, it, wgu_, wd_); float wv_[32];
    transpose_load(I, wv_, lane); transpose_finish(I, wv_, scr, lane);
}
__device__ __forceinline__ void moe_weight_pair(LAS unsigned char* ldsl, int layer, int ita, int itb, bf16_t* wgu_, bf16_t* wd_, LAS float* scr, int lane) {
    const TrItem A = moe_item_desc(ldsl, layer, ita, wgu_, wd_), B = moe_item_desc(ldsl, layer, itb, wgu_, wd_); float wa_[32], wb_[32];
    transpose_load(A, wa_, lane); transpose_load(B, wb_, lane);
    transpose_finish(A, wa_, scr, lane); transpose_finish(B, wb_, scr, lane);
}
__device__ __forceinline__ int pcol(int lane, int c) { return 8 * lane + 512 * (c >> 1) + 4 * (c & 1); }
__device__ __forceinline__ void store_h_row(const f32x4 (&v)[4], const float* __restrict__ sv, const float* __restrict__ av, bf16_t* __restrict__ hrow, int lane) {
#pragma unroll
    for (int j = 0; j < 2; ++j) { const int col = 8 * lane + 512 * j;
        const f32x4 s0 = *(const f32x4*)(sv + col), s1 = *(const f32x4*)(sv + col + 4), a0 = *(const f32x4*)(av + col), a1 = *(const f32x4*)(av + col + 4);
        const f32x4 h0 = v[2 * j] * (a0 + 1.0f) + s0, h1 = v[2 * j + 1] * (a1 + 1.0f) + s1;
        v4u w; w.x = cvtpk(h0[0], h0[1]); w.y = cvtpk(h0[2], h0[3]); w.z = cvtpk(h1[0], h1[1]); w.w = cvtpk(h1[2], h1[3]); *(v4u*)(hrow + col) = w; }
}
__device__ __forceinline__ void ln_row(f32x4 (&v)[4], const float* __restrict__ g, const float* __restrict__ bb, int lane, float& mean_o, float& rstd_o) {
    float s = 0.f;
#pragma unroll
    for (int j = 0; j < 4; ++j) s += (v[j][0] + v[j][1]) + (v[j][2] + v[j][3]);
    const float mean = wave_sum(s) * (1.f / DM); float s2 = 0.f;
#pragma unroll
    for (int j = 0; j < 4; ++j) { v[j] = v[j] - mean; s2 += (v[j][0] * v[j][0] + v[j][1] * v[j][1]) + (v[j][2] * v[j][2] + v[j][3] * v[j][3]); }
    const float rstd = 1.0f / sqrtf(wave_sum(s2) * (1.f / DM) + LN_EPS);
#pragma unroll
    for (int j = 0; j < 4; ++j) { const int col = pcol(lane, j); const f32x4 gg = *(const f32x4*)(g + col), b4 = *(const f32x4*)(bb + col); v[j] = v[j] * rstd * gg + b4; }
    mean_o = mean; rstd_o = rstd;
}

__device__ __forceinline__ int row_of(int layer, int idx, int per_item, int it, int j) { (void)idx;
    if (layer == 0) return it * per_item + j; const int xi = it * per_item + j; return (xi >> 11) * TT + LCT + (xi & 2047); }
template <int RB>
__device__ __forceinline__ void p8_rows(int idx0, int layer, const int4* __restrict__ tinfo, const LAS int* rowb, const bf16_t* __restrict__ fo, const hf_t* __restrict__ Yp, const f32x2* __restrict__ rst, const float* __restrict__ mg, const float* __restrict__ mb, float* outp, float* xrcp,
                                        const float* __restrict__ modlp, const float* __restrict__ modn, const float* __restrict__ fg, const float* __restrict__ fb, bf16_t* hbp, int lane) {
    f32x4 v[RB][4]; v4u yh[RB][2], fa[RB][2], fc[RB][2]; int rr[RB]; int4 ti[RB];
#pragma unroll
    for (int q = 0; q < RB; ++q) { const int idx = idx0 + q; rr[q] = layer == 0 ? idx : (idx >> 11) * TT + LCT + (idx & 2047); ti[q] = tinfo[rr[q]]; }
    f32x2 st[RB];
#pragma unroll
    for (int q = 0; q < RB; ++q) { const hf_t* xr = Yp + (size_t)rr[q] * DM; st[q] = rst[rr[q]];
        const bf16_t* f1 = fo + (size_t)(rowb[ti[q].x] + ti[q].y) * DM; const bf16_t* f2 = fo + (size_t)(rowb[ti[q].z] + ti[q].w) * DM;
#pragma unroll
        for (int j = 0; j < 2; ++j) yh[q][j] = *(const v4u*)(xr + 8 * lane + 512 * j);
#pragma unroll
        for (int j = 0; j < 2; ++j) { fa[q][j] = *(const v4u*)(f1 + 8 * lane + 512 * j); fc[q][j] = *(const v4u*)(f2 + 8 * lane + 512 * j); } }
#pragma unroll
    for (int q = 0; q < RB; ++q) { const int r = rr[q]; const int b = r / TT, t = r - b * TT; const int cond = t < LCT ? 8 : b;
        const float* gf = modlp + (size_t)cond * NMOD + 5120;
#pragma unroll
        for (int c = 0; c < 4; ++c) { const int col = pcol(lane, c); const v4u a4 = fa[q][c >> 1], c4 = fc[q][c >> 1];
            const unsigned ax = (c & 1) ? a4.z : a4.x, ay = (c & 1) ? a4.w : a4.y, cx = (c & 1) ? c4.z : c4.x, cy = (c & 1) ? c4.w : c4.y;
            const f32x4 f = {bf_lo(ax) + bf_lo(cx), bf_hi(ax) + bf_hi(cx), bf_lo(ay) + bf_lo(cy), bf_hi(ay) + bf_hi(cy)};
            const v4u y4 = yh[q][c >> 1]; const unsigned yx = (c & 1) ? y4.z : y4.x, yy = (c & 1) ? y4.w : y4.y;
            const f32x4 yv = {hf_lo(yx), hf_hi(yx), hf_lo(yy), hf_hi(yy)};
            const f32x4 x1 = (yv - st[q].x) * st[q].y * *(const f32x4*)(mg + col) + *(const f32x4*)(mb + col);
            v[q][c] = x1 * ALPHA + *(const f32x4*)(gf + col) * f; }
        float mean, rstd; ln_row(v[q], fg, fb, lane, mean, rstd); }
#pragma unroll
    for (int q = 0; q < RB; ++q) { const int r = rr[q]; const int b = r / TT, t = r - b * TT; const int cond = t < LCT ? 8 : b;
        if (layer == 0) { if (t >= LCT) { hf_t* xh = (hf_t*)outp + ((size_t)b * NXT + (t - LCT)) * DM;
#pragma unroll
                for (int j = 0; j < 2; ++j) { const f32x4 a = v[q][2 * j], c4 = v[q][2 * j + 1]; v4u w; w.x = pkh(a[0], a[1]); w.y = pkh(a[2], a[3]); w.z = pkh(c4[0], c4[1]); w.w = pkh(c4[2], c4[3]);
                    *(v4u*)(xh + 8 * lane + 512 * j) = w; } } }
        else { float* xr = xr_ptr(outp, xrcp, r);
#pragma unroll
            for (int c = 0; c < 4; ++c) *(f32x4*)(xr + pcol(lane, c)) = v[q][c]; }
        if (layer == 0) { const float* mv = modn + (size_t)cond * NMOD; store_h_row(v[q], mv, mv + 1024, hbp + (size_t)r * DM, lane); } }
}

template <int RB>
__device__ __forceinline__ void h0_rows(int r0, const float* __restrict__ xin, const float* __restrict__ cin, const float* __restrict__ mv0, bf16_t* hb, int lane) {
    f32x4 v[RB][4];
#pragma unroll
    for (int q = 0; q < RB; ++q) { const float* src = in0_ptr(xin, cin, r0 + q);
#pragma unroll
        for (int j = 0; j < 2; ++j) { v[q][2 * j] = *(const f32x4*)(src + 8 * lane + 512 * j); v[q][2 * j + 1] = *(const f32x4*)(src + 8 * lane + 512 * j + 4); } }
#pragma unroll
    for (int q = 0; q < RB; ++q) { const int r = r0 + q; const int b = r / TT, t = r - b * TT; const int cond = t < LCT ? 8 : b;
        const float* sv = mv0 + (size_t)cond * NMOD; const float* av = sv + 1024; bf16_t* hrow = hb + (size_t)r * DM;
#pragma unroll
        for (int j = 0; j < 2; ++j) { const int col = 8 * lane + 512 * j;
            const f32x4 s0 = *(const f32x4*)(sv + col), s1 = *(const f32x4*)(sv + col + 4), a0 = *(const f32x4*)(av + col), a1 = *(const f32x4*)(av + col + 4);
            const f32x4 h0 = v[q][2 * j] * (a0 + 1.0f) + s0, h1 = v[q][2 * j + 1] * (a1 + 1.0f) + s1;
            v4u w; w.x = cvtpk(h0[0], h0[1]); w.y = cvtpk(h0[2], h0[3]); w.z = cvtpk(h1[0], h1[1]); w.w = cvtpk(h1[2], h1[3]); *(v4u*)(hrow + col) = w; } }
}

__global__ void __launch_bounds__(512, 2) fwd_megakernel(Args args) {
    extern __shared__ __attribute__((aligned(16))) unsigned char lds[];
    LAS unsigned char* ldsl = (LAS unsigned char*)lds;
    volatile LAS unsigned* MISC = (volatile LAS unsigned*)(ldsl + MISC_OFF);
    const int G0 = gridDim.x; const int bx0 = blockIdx.x;
    const int vcu0 = (G0 % 8 == 0) ? (bx0 % 8) * (G0 / 8) + bx0 / 8 : bx0;
    const int wv = __builtin_amdgcn_readfirstlane(threadIdx.x >> 6);
#define PHASE_IDS() int G = G0, bx = bx0, vcu = vcu0; asm volatile("" : "+s"(G), "+s"(bx), "+s"(vcu)); const int NGW = G * 8; (void)NGW; (void)bx; int wave = wv; asm volatile("" : "+s"(wave)); const int tid = ltid(wave); (void)tid; const int lane = tid & 63; const int gw = vcu * 8 + wave; (void)gw; (void)lane
#define AIN(i) ldptr(ldsl, (i))
#define WSB ((unsigned char*)ldptr(ldsl, 29))
#define ctl ((gu32*)(WSB + WS_CTL))
#define modv ((float*)(WSB + WS_MOD))
#define tab64 ((f32x2*)(WSB + WS_TAB64))
#define tab128 ((f32x2*)(WSB + WS_TAB128))
#define wrt ((float*)(WSB + WS_WRT))
#define wrs ((bf16_t*)(WSB + WS_WRS))
#define tokinfo ((int4*)(WSB + WS_TOKINFO))
#define tokof ((int*)(WSB + WS_TOKOF))
#define rstats ((f32x2*)(WSB + WS_STATS))
#define gwof ((float*)(WSB + WS_GWOF))
#define ACTB ((bf16_t*)(WSB + WS_QKV))
#define XRC ((float*)(WSB + WS_XRC))
#define wqkv0 ((bf16_t*)(WSB + WS_WQKV0))
#define wo0 ((bf16_t*)(WSB + WS_WO0))
#define wqkv1 ((bf16_t*)(WSB + WS_WQKV1))
#define wo1 ((bf16_t*)(WSB + WS_WO1))
#define wgu ((bf16_t*)(WSB + WS_WGU))
#define wd ((bf16_t*)(WSB + WS_WD))
#define HB ((bf16_t*)(WSB + WS_HBUF))
#define QKV ((bf16_t*)(WSB + WS_QKV))
#define HS QKV
#define Y ((hf_t*)(WSB + WS_YOFF))
#define rowst ((f32x2*)(WSB + WS_ROWST))
#define FO ((bf16_t*)(WSB + WS_Y))
#define out ((float*)ldptr(ldsl, 28))
    for (int u = threadIdx.x; u < (LDS_BYTES - MISC_OFF) / 4; u += 512) ((LAS unsigned*)(ldsl + MISC_OFF))[u] = 0u;
    __syncthreads();
    if (threadIdx.x == 0) { LAS unsigned long long* pt = (LAS unsigned long long*)(ldsl + PTR_OFF);
#pragma unroll
        for (int i = 0; i < 28; ++i) pt[i] = (unsigned long long)args.in[i];
        pt[28] = (unsigned long long)args.o_; pt[29] = (unsigned long long)args.w_; }
    __syncthreads();
    xcd_barrier_post((unsigned*)(ctl + CW_BAR));
#define GRID_BAR() xcd_barrier((unsigned*)(ctl + CW_BAR), MISC + 8, ltid(wv) == 0)

        for (int rep_ = 0; rep_ < ((REPMASK >> 0) & 1) * REPN + 1; ++rep_) {
    if (PHMASK & (1 << 0)) {
        PHASE_IDS();
        for (int it = bx; it < 192; it += G) {
            const int layer = it / 96, col0 = (it % 96) * 64;
            const float* Wm = AIN(I_WMOD) + (size_t)layer * DM * NMOD;
            LAS float* sl = (LAS float*)(ldsl + wave * 8192);
            const int k0 = wave * 128;
            for (int idx = lane; idx < 9 * 128; idx += 64) { const int cond = idx >> 7, kk = idx & 127;
                const float v = cond < 8 ? AIN(I_C)[cond * DM + k0 + kk] : AIN(I_CCTX)[k0 + kk];
                sl[idx] = v / (1.f + expf(-v)); }
            LDS_WAIT(); asm volatile("" ::: "memory");
            const int rg = lane >> 4, c4 = (lane & 15) * 4;
            f32x4 acc[9];
#pragma unroll
            for (int c = 0; c < 9; ++c) acc[c] = (f32x4){0.f, 0.f, 0.f, 0.f};
            const unsigned lofs = (unsigned)(rg * NMOD + c4) * 4u;
#pragma unroll 1
            for (int kb = 0; kb < 128; kb += 64) { f32x4 wv_[16];
#pragma unroll
                for (int i = 0; i < 16; ++i) wv_[i] = __builtin_nontemporal_load((const f32x4*)((const char*)(Wm + (size_t)(k0 + kb + 4 * i) * NMOD + col0) + lofs));
#pragma unroll
                for (int i = 0; i < 16; ++i) {
#pragma unroll
                    for (int c = 0; c < 9; ++c) acc[c] += wv_[i] * sl[c * 128 + kb + 4 * i + rg]; } }
            LAS float* part = (LAS float*)(ldsl + 65536);
#pragma unroll
            for (int c = 0; c < 9; ++c) *(LAS f32x4*)(part + (wave * 4 + rg) * 576 + c * 64 + c4) = acc[c];
            __syncthreads();
            for (int idx = tid; idx < 576; idx += 512) { float s = 0.f;
#pragma unroll
                for (int w = 0; w < 32; ++w) s += part[w * 576 + idx];
                const int cond = idx >> 6, col = col0 + (idx & 63);
                modv[((size_t)layer * 9 + cond) * NMOD + col] = s + AIN(I_BMOD)[layer * NMOD + col]; }
            __syncthreads();
        }
        for (int idx = bx * 512 + tid; idx < 3072 + 2 * 8 * 4 * 3 * 64; idx += G * 512) {
            if (idx < 1024) { const int pos = idx >> 4, f = idx & 15; const float inv = powf(10000.f, -(float)(2 * f) / 32.f); float s, c; sincosf((float)pos * inv, &s, &c); tab64[idx] = (f32x2){c, s}; }
            else if (idx < 3072) { const int i2 = idx - 1024, pos = i2 >> 5, f = i2 & 31; const float inv = powf(10000.f, -(float)(2 * f) / 64.f); float s, c; sincosf((float)pos * inv, &s, &c); tab128[i2] = (f32x2){c, s}; }
            else { const int i2 = idx - 3072, ln = i2 & 63, nb = (i2 >> 6) % 3, s = ((i2 >> 6) / 3) & 3, w = ((i2 >> 6) / 12) & 7, l = (i2 >> 6) / 96;
                const int k0 = 128 * w + 32 * s + 8 * (ln >> 4), o = nb * 16 + (ln & 15); float wv_[8];
#pragma unroll
                for (int j = 0; j < 8; ++j) wv_[j] = o < 4 ? AIN(I_WGRP)[(size_t)l * DM * 4 + (k0 + j) * 4 + o] : (o < 36 ? AIN(I_WRT)[(size_t)l * DM * 32 + (k0 + j) * 32 + (o - 4)] : 0.f);
                unsigned hi_[4], lo_[4];
#pragma unroll
                for (int j = 0; j < 4; ++j) { hi_[j] = cvtpk(wv_[2 * j], wv_[2 * j + 1]); lo_[j] = cvtpk(wv_[2 * j] - bf_lo(hi_[j]), wv_[2 * j + 1] - bf_hi(hi_[j])); }
                bf16_t* dst = wrs + ((size_t)(((l * 8 + w) * 4 + s) * 3 + nb) * 2) * 512 + ln * 8;
                *(v4u*)dst = (v4u){hi_[0], hi_[1], hi_[2], hi_[3]}; *(v4u*)(dst + 512) = (v4u){lo_[0], lo_[1], lo_[2], lo_[3]}; }
        }
        LAS float* scr = (LAS float*)(ldsl + wave * 16384);
        constexpr int S0 = 16 * 96, S1 = 16 * 32, S2 = 16 * 48, S3 = 16 * 32, S4 = NEXP * 384;
        for (int it = gw; it < S0 + S1 + S2 + S3; it += NGW) {
            int r = it;
            if (r < S0) { const int n0 = (r % 96) * 32; const bool kcol = (n0 >= 1024 && n0 < 2048);
                transpose_item(AIN(I_DWQKV), NQKV0, wqkv0, DM, kcol ? (n0 & ~255) + ((n0 >> 6) & 3) * 32 + ((n0 >> 5) & 1) * 16 : n0, (r / 96) * 64, n0, scr, lane, kcol ? 128 : 16); continue; } r -= S0;
            if (r < S1) { transpose_item(AIN(I_DWO), DM, wo0, DM, (r % 32) * 32, (r / 32) * 64, (r % 32) * 32, scr, lane); continue; } r -= S1;
            if (r < S2) { const int n0 = (r % 48) * 32; const bool kcol = (n0 >= 1024 && n0 < 1280);
                transpose_item(AIN(I_GWQKV), NQKV1, wqkv1, DM, kcol ? 1024 + ((n0 >> 5) & 1) * 128 + ((n0 >> 7) & 1) * 64 + ((n0 >> 6) & 1) * 32 : n0, (r / 48) * 64, n0, scr, lane); continue; } r -= S2;
            if (r < S3) { transpose_item(AIN(I_GWO), DM, wo1, DM, (r % 32) * 32, (r / 32) * 64, (r % 32) * 32, scr, lane); continue; }
        }
        { int it = gw; for (; it + NGW < S4; it += 2 * NGW) moe_weight_pair(ldsl, 0, it, it + NGW, wgu, wd, scr, lane);
          if (it < S4) moe_weight_item(ldsl, 0, it, wgu, wd, scr, lane); }
    }
    GRID_BAR(); }
        for (int rep_ = 0; rep_ < ((REPMASK >> 1) & 1) * REPN + 1; ++rep_) {
    if (PHMASK & (1 << 1)) { PHASE_IDS();
    { const float* xin = AIN(I_X); const float* cin = AIN(I_CTX); const float* mv0 = modv; bf16_t* hb = HB;
    const int per = (MALL + NGW - 1) / NGW; int r0 = gw * per; const int r1 = min((int)MALL, r0 + per);
    for (; r0 + 5 <= r1; r0 += 5) h0_rows<5>(r0, xin, cin, mv0, hb, lane);
    for (; r0 + 4 <= r1; r0 += 4) h0_rows<4>(r0, xin, cin, mv0, hb, lane);
    for (; r0 < r1; ++r0) h0_rows<1>(r0, xin, cin, mv0, hb, lane);
    } }
    GRID_BAR(); }

#pragma unroll
    for (int layer = 0; layer < 2; ++layer) {
#define modl (modv + (size_t)layer * 9 * NMOD)
        const int NQ = layer == 0 ? NQKV0 : NQKV1;
        for (int rep_ = 0; rep_ < ((REPMASK >> 2) & 1) * REPN + 1; ++rep_) {
        if (PHMASK & (1 << 2))
        { PHASE_IDS();
            pg8::Gemm g{HB, layer == 0 ? wqkv0 : wqkv1, MALL, NQ, DM};
            SchedRect S; if (layer == 0) S.init(72, NQKV0, G, bx, 0, 0); else S.init(64, NQKV1, G, bx, 1, 16);
            EpiStoreBf16 E{QKV, NQ, 0xffff, layer == 0 ? tab64 : tab128, layer == 0 ? (const float*)nullptr : AIN(I_GKN), (LAS float*)(ldsl + MISC_OFF + 4096)};
            pg8::gemm_phase<EpiStoreBf16, SchedRect, true, true>(ldsl, g, S, E, wave);
        }
        GRID_BAR(); }
        for (int rep_ = 0; rep_ < ((REPMASK >> 4) & 1) * REPN + 1; ++rep_) {
        if (PHMASK & (1 << 4)) {
        if (layer == 0 && (PHMASK & (1 << 16))) { PHASE_IDS();
            float lam;
            { const float s1 = wave_sum(AIN(I_LQ1)[lane] * AIN(I_LK1)[lane]), s2 = wave_sum(AIN(I_LQ2)[lane] * AIN(I_LK2)[lane]);
              lam = expf(s1) - expf(s2) + LAMBDA_INIT0; }
            const int nH = 1024, base = nH / G, rem = nH % G;
            const int u0 = vcu * base + (vcu < rem ? vcu : rem), cnt = base + (vcu < rem ? 1 : 0);
            for (int i = 0; i < cnt; ++i) {
                const int u = u0 + i, bh = u >> 4, qb = u & 15, b = bh >> 3, h = bh & 7;
                const size_t row0 = (size_t)b * TT + LCT + qb * 128;
                const bf16_t* kb = QKV + (size_t)b * TT * NQKV0 + h * 128;
                att::attn_unit<true>(QKV + row0 * NQKV0 + h * 128, NQKV0, kb + 1024, kb + 2048, NQKV0, TT, HB + row0 * DM + h * 128, DM,
                                     true, qb * 128, tab64, nullptr, AIN(I_SUBG), lam, (char*)lds, wave);
            }
            for (int l = vcu; l < 128; l += G) {
                const int bh = l >> 1, qb = l & 1, b = bh >> 3, h = bh & 7;
                const size_t row0 = (size_t)b * TT + qb * 128;
                const bf16_t* kb = QKV + (size_t)b * TT * NQKV0 + h * 128;
                att::attn_unit<true>(QKV + row0 * NQKV0 + h * 128, NQKV0, kb + 1024, kb + 2048, NQKV0, LCT, HB + row0 * DM + h * 128, DM,
                                     false, 0, tab64, nullptr, AIN(I_SUBG), lam, (char*)lds, wave);
            }
        } else if (PHMASK & (1 << 17)) { PHASE_IDS();
            const int nU = 512, base = nU / G, rem = nU % G;
            const int u0 = vcu * base + (vcu < rem ? vcu : rem), cnt = base + (vcu < rem ? 1 : 0);
            for (int i = 0; i < cnt; ++i) {
                const int u = u0 + i, bh = u >> 3, qb = u & 7, b = bh >> 3, h = bh & 7;
                const size_t row0 = (size_t)b * TT + LCT + qb * 256;
                const bf16_t* kb = QKV + (size_t)b * TT * NQKV1 + (h >> 2) * 128;
                att::attn_unit<false>(QKV + row0 * NQKV1 + h * 128, NQKV1, kb + 1024, kb + 1280, NQKV1, TT, HB + row0 * DM + h * 128, DM,
                                      true, qb * 256, tab128, AIN(I_GQN), nullptr, 0.f, (char*)lds, wave);
            }
        } }
        GRID_BAR(); }
        for (int rep_ = 0; rep_ < ((REPMASK >> 5) & 1) * REPN + 1; ++rep_) {
        if (PHMASK & (1 << 5))
        { PHASE_IDS();
            pg8::Gemm g{HB, layer == 0 ? wo0 : wo1, MALL, DM, DM};
            SchedRect S; if (layer == 0) S.init(72, DM, G, bx, 0, 0); else S.init(64, DM, G, bx, 1, 0);
            if (layer == 0) { EpiResid<false> E{Y, AIN(I_X), AIN(I_CTX), modl, rstats}; pg8::gemm_phase<EpiResid<false>, SchedRect, true, true>(ldsl, g, S, E, wave); }
            else { EpiResid<true> E{Y, out, (const float*)nullptr, modl, rstats}; pg8::gemm_phase<EpiResid<true>, SchedRect, true, true>(ldsl, g, S, E, wave); }
        }
        GRID_BAR(); }
        if (PHMASK & (1 << 6))
        { PHASE_IDS();
            const int TR = layer == 0 ? 72 : 64;
            const f32x2* stq = rstats; const hf_t* Yq = Y; float* outq = out; float* xrcq = XRC; const float* modq = modl; bf16_t* hbq = HB;
            const float* lg = AIN(I_LNMG) + layer * DM; const float* lb = AIN(I_LNMB) + layer * DM;
            const bf16_t* wrs_l = wrs + (size_t)layer * 8 * 4 * 3 * 2 * 512;
            LAS float* red = (LAS float*)ldsl;
            LAS float* logits = (LAS float*)(ldsl + 116736);
            LAS float* stats = (LAS float*)(ldsl + 127232);
            LAS int* lcnt = (LAS int*)(ldsl + 127232 + 576);
            LAS int* lbase = lcnt + 32;
            for (int it = bx; it < 256; it += G) {
                if (tid < 32) lcnt[tid] = 0;
                if (tid < TR) { const int r = row_of(layer, 0, TR, it, tid); const f32x2* sp = stq + (size_t)r * 16; float S = 0.f, Q = 0.f;
#pragma unroll
                    for (int p = 0; p < 16; ++p) { const f32x2 v = sp[p]; S += v.x; Q += v.y; }
                    const float mean = S * (1.f / DM); const float var = fmaxf(Q * (1.f / DM) - mean * mean, 0.f);
                    const float rstd = 1.0f / sqrtf(var + LN_EPS); stats[2 * tid] = mean; stats[2 * tid + 1] = rstd; rowst[r] = (f32x2){mean, rstd}; }
                __syncthreads();
                {
                    const int l15 = lane & 15, kg = lane >> 4;
                    pg8::f32x4 acc[5][3];
#pragma unroll
                    for (int mt = 0; mt < 5; ++mt)
#pragma unroll
                        for (int nb = 0; nb < 3; ++nb) acc[mt][nb] = (pg8::f32x4){0.f, 0.f, 0.f, 0.f};
                    int rrow[5]; float rmean[5], rrstd[5]; int rcond[5];
#pragma unroll
                    for (int mt = 0; mt < 5; ++mt) { const int j = mt * 16 + l15; const bool ok = j < TR; const int r = ok ? row_of(layer, 0, TR, it, j) : row_of(layer, 0, TR, it, 0);
                        const int bb = r / TT, tt = r - bb * TT; rrow[mt] = ok ? r : -1; rmean[mt] = stats[2 * (ok ? j : 0)]; rrstd[mt] = stats[2 * (ok ? j : 0) + 1];
                        rcond[mt] = tt < LCT ? 8 : bb; }
#pragma unroll 1
                    for (int s = 0; s < 4; ++s) { const int k0 = 128 * wave + 32 * s + 8 * kg;
                        const f32x4 g0 = *(const f32x4*)(lg + k0), g1 = *(const f32x4*)(lg + k0 + 4), b0 = *(const f32x4*)(lb + k0), b1 = *(const f32x4*)(lb + k0 + 4);
                        bf16x8 bh[3], bl[3];
#pragma unroll
                        for (int nb = 0; nb < 3; ++nb) { const bf16_t* bp = wrs_l + ((size_t)((wave * 4 + s) * 3 + nb) * 2) * 512 + lane * 8; bh[nb] = *(const bf16x8*)bp; bl[nb] = *(const bf16x8*)(bp + 512); }
                        f32x4 y0[5], y1[5];
#pragma unroll
                        for (int mt = 0; mt < 5; ++mt) { y0[mt] = (f32x4){0.f, 0.f, 0.f, 0.f}; y1[mt] = y0[mt];
                            if (rrow[mt] >= 0) { const v4u yh = *(const v4u*)(Yq + (size_t)rrow[mt] * DM + k0);
                                y0[mt] = (f32x4){hf_lo(yh.x), hf_hi(yh.x), hf_lo(yh.y), hf_hi(yh.y)}; y1[mt] = (f32x4){hf_lo(yh.z), hf_hi(yh.z), hf_lo(yh.w), hf_hi(yh.w)}; } }
#pragma unroll
                        for (int mt = 0; mt < 5; ++mt) {
                            int co_ = rcond[mt] * NMOD + k0; asm volatile("" : "+v"(co_));
                            const float* mv = modq + co_ - k0;
                            const f32x4 a0 = *(const f32x4*)(mv + 4096 + k0), a1 = *(const f32x4*)(mv + 4096 + k0 + 4), s0 = *(const f32x4*)(mv + 3072 + k0), s1 = *(const f32x4*)(mv + 3072 + k0 + 4);
                            const f32x4 x0 = (y0[mt] - rmean[mt]) * rrstd[mt] * g0 + b0, x1 = (y1[mt] - rmean[mt]) * rrstd[mt] * g1 + b1;
                            f32x4 h0 = x0 * (a0 + 1.0f) + s0, h1 = x1 * (a1 + 1.0f) + s1;
                            if (rrow[mt] < 0) { h0 = (f32x4){0.f, 0.f, 0.f, 0.f}; h1 = h0; }
                            v4u hh; hh.x = cvtpk(h0[0], h0[1]); hh.y = cvtpk(h0[2], h0[3]); hh.z = cvtpk(h1[0], h1[1]); hh.w = cvtpk(h1[2], h1[3]);
                            v4u hl; hl.x = cvtpk(h0[0] - bf_lo(hh.x), h0[1] - bf_hi(hh.x)); hl.y = cvtpk(h0[2] - bf_lo(hh.y), h0[3] - bf_hi(hh.y));
                            hl.z = cvtpk(h1[0] - bf_lo(hh.z), h1[1] - bf_hi(hh.z)); hl.w = cvtpk(h1[2] - bf_lo(hh.w), h1[3] - bf_hi(hh.w));
                            if (rrow[mt] >= 0) *(v4u*)(hbq + (size_t)rrow[mt] * DM + k0) = hh;
                            const bf16x8 ah = *reinterpret_cast<const bf16x8*>(&hh), al = *reinterpret_cast<const bf16x8*>(&hl);
#pragma unroll
                            for (int nb = 0; nb < 3; ++nb) {
                                acc[mt][nb] = __builtin_amdgcn_mfma_f32_16x16x32_bf16(ah, bh[nb], acc[mt][nb], 0, 0, 0);
                                acc[mt][nb] = __builtin_amdgcn_mfma_f32_16x16x32_bf16(ah, bl[nb], acc[mt][nb], 0, 0, 0);
                                acc[mt][nb] = __builtin_amdgcn_mfma_f32_16x16x32_bf16(al, bh[nb], acc[mt][nb], 0, 0, 0); }
                        }
                    }
                    const int ln2 = ltid(wave) & 63; const int l15b = ln2 & 15, kgb = ln2 >> 4;
#pragma unroll
                    for (int mt = 0; mt < 5; ++mt)
#pragma unroll
                        for (int nb = 0; nb < 3; ++nb)
#pragma unroll
                            for (int q = 0; q < 4; ++q) { const int row = mt * 16 + kgb * 4 + q, col = nb * 16 + l15b; if (row < 72 && col < 36) red[wave * 2592 + row * 36 + col] = acc[mt][nb][q]; }
                }
                const int tidc = ltid(wave);
                __syncthreads();
                for (int idx = tidc; idx < 2592; idx += 512) { const int o = idx % 36;
                    float s = o < 4 ? AIN(I_BGRP)[layer * 4 + o] : AIN(I_BRT)[layer * 32 + o - 4];
#pragma unroll
                    for (int w = 0; w < 8; ++w) s += red[w * 2592 + idx];
                    logits[idx] = s; }
                __syncthreads();
                int e1 = 0, e2 = 0, rk1 = 0, rk2 = 0; float G1 = 0.f, G2 = 0.f; int rme = 0;
                if (tidc < TR) {
                    const LAS float* lgt = logits + tidc * 36;
                    int gi = 0; float gm = lgt[0];
#pragma unroll
                    for (int g = 1; g < 4; ++g) { const float v = lgt[g]; if (v > gm) { gm = v; gi = g; } }
                    float gs = 0.f;
#pragma unroll
                    for (int g = 0; g < 4; ++g) gs += expf(lgt[g] - gm);
                    const float gtop = 1.0f / gs;
                    const LAS float* el = lgt + 4 + gi * 8;
                    int i1 = 0; float v1 = el[0];
#pragma unroll
                    for (int e = 1; e < 8; ++e) { const float v = el[e]; if (v > v1) { v1 = v; i1 = e; } }
                    int i2 = -1; float v2 = -3.0e38f;
#pragma unroll
                    for (int e = 0; e < 8; ++e) { const float v = el[e]; if (e != i1 && v > v2) { v2 = v; i2 = e; } }
                    const float ex = expf(v2 - v1); const float w1 = 1.0f / (1.0f + ex), w2 = ex / (1.0f + ex);
                    e1 = gi * 8 + i1; e2 = gi * 8 + i2; G1 = gtop * w1; G2 = gtop * w2;
                    rk1 = atomicAdd((int*)(lcnt + e1), 1); rk2 = atomicAdd((int*)(lcnt + e2), 1);
                    if (layer == 0) rme = it * 72 + tidc; else { const int xi = it * 64 + tidc; rme = (xi >> 11) * TT + LCT + (xi & 2047); }
                }
                __syncthreads();
                if (tidc < 32) { const int n = lcnt[tidc]; lbase[tidc] = n ? (int)__hip_atomic_fetch_add((unsigned*)(ctl + CW_CNT + layer * 32 + tidc), (unsigned)n, RLX_AGENT) : 0; }
                __syncthreads();
                if (tidc < TR) { const int q1 = lbase[e1] + rk1, q2 = lbase[e2] + rk2; tokinfo[rme] = make_int4(e1, q1, e2, q2);
                    int* tkf = tokof; float* gwf = gwof; tkf[(size_t)e1 * ECAP + q1] = rme; tkf[(size_t)e2 * ECAP + q2] = rme; gwf[(size_t)e1 * ECAP + q1] = G1; gwf[(size_t)e2 * ECAP + q2] = G2; }
                __syncthreads();
            }
        }
        GRID_BAR();
        for (int rep_ = 0; rep_ < ((REPMASK >> 8) & 1) * REPN + 1; ++rep_) {
        if (PHMASK & (1 << 8))
        {
            PHASE_IDS();
            LAS unsigned char* tile_e = ldsl + TILEE_OFF; LAS int* rowb = (LAS int*)(ldsl + ROWB_OFF); LAS int* cntl = (LAS int*)(ldsl + ROWB_OFF + 128); LAS int* tbase = (LAS int*)(ldsl + ROWB_OFF + 256);
            if (tid == 0) { int tt = 0;
#pragma unroll 1
                for (int e = 0; e < NEXP; ++e) { const int cnt = (int)__hip_atomic_load((unsigned*)(ctl + CW_CNT + layer * 32 + e), RLX_AGENT); rowb[e] = tt * 256; tbase[e] = tt; cntl[e] = cnt; tt += (cnt + 255) >> 8; }
                tbase[NEXP] = tt; MISC[16] = (unsigned)tt; }
            __syncthreads();
            if (tid < 176) { int e = 0;
#pragma unroll 1
                for (int q = 1; q < NEXP; ++q) e += (tbase[q] <= tid) ? 1 : 0;
                tile_e[tid] = (unsigned char)e; }
            __syncthreads();
            const int ntile = (int)MISC[16];
            pg8::Gemm g{HB, wgu, SORT_ROWS, NEXP * 512, DM};
            SchedExp S{ldsl + TILEE_OFF, 2, ntile * 2, G, bx};
            EpiGateUp E{ACTB, gwof, tbase};
            pg8::GatherA GA{tokof, tbase, cntl, 2, ECAP};
            pg8::gemm_phase<EpiGateUp, SchedExp, true, true, true, pg8::GatherA>(ldsl, g, S, E, wave, GA);
        }
        GRID_BAR(); }
        for (int rep_ = 0; rep_ < ((REPMASK >> 9) & 1) * REPN + 1; ++rep_) {
        if (PHMASK & (1 << 9))
        { PHASE_IDS();
            const int ntile = (int)MISC[16];
            int kdn = FH; asm volatile("" : "+s"(kdn));
            pg8::Gemm g{ACTB, wd, SORT_ROWS, NEXP * 1024, kdn};
            SchedExp S{ldsl + TILEE_OFF, 4, ntile * 4, G, bx};
            EpiStoreBf16 E{FO, DM, 3, (const f32x2*)nullptr, (const float*)nullptr, (LAS float*)nullptr};
            pg8::gemm_phase<EpiStoreBf16, SchedExp, true, true>(ldsl, g, S, E, wave);
        }
        GRID_BAR(); }
        if (PHMASK & (1 << 10))
        { PHASE_IDS();
            const float* fg = AIN(I_LNFG) + layer * DM; const float* fb = AIN(I_LNFB) + layer * DM;
            const int nrows = layer == 0 ? MALL : MXR;
            { const hf_t* Yq = Y; const f32x2* rsq = rowst; const float* mg = AIN(I_LNMG) + layer * DM; const float* mb = AIN(I_LNMB) + layer * DM; const int4* tinfo = tokinfo; const LAS int* rowb = (const LAS int*)(ldsl + ROWB_OFF); const bf16_t* fo = FO; float* outq = out; float* xrcq = XRC; const float* modq = modl; const float* modn = modv + (size_t)9 * NMOD; bf16_t* hbq = HB;
              if (layer == 0) {
                  const int per = (nrows + NGW - 1) / NGW; int idx0 = gw * per; const int i1 = min(nrows, idx0 + per);
                  for (; idx0 + 3 <= i1; idx0 += 3) p8_rows<3>(idx0, layer, tinfo, rowb, fo, Yq, rsq, mg, mb, outq, xrcq, modq, modn, fg, fb, hbq, lane);
                  for (; idx0 < i1; ++idx0) p8_rows<1>(idx0, layer, tinfo, rowb, fo, Yq, rsq, mg, mb, outq, xrcq, modq, modn, fg, fb, hbq, lane);
              } else
              for (int idx0 = gw * 4; idx0 < nrows; idx0 += NGW * 4) p8_rows<4>(idx0, layer, tinfo, rowb, fo, Yq, rsq, mg, mb, outq, xrcq, modq, modn, fg, fb, hbq, lane); }
            if (layer == 0) {
                LAS float* scr = (LAS float*)(ldsl + wave * 16384);
                { int it = gw; for (; it + NGW < NEXP * 384; it += 2 * NGW) moe_weight_pair(ldsl, 1, it, it + NGW, wgu, wd, scr, lane);
                  if (it < NEXP * 384) moe_weight_item(ldsl, 1, it, wgu, wd, scr, lane); }
                GRID_BAR();
            }
        }
    }
}

#undef out
#undef Y
#undef HS
#undef QKV
#undef HB
#undef ctl
extern "C" void kernel_launch(void* const* d_in, const int* in_sizes, int n_in, void* d_out, int out_size, void* d_ws, size_t ws_size, hipStream_t stream) {
    static int grid = 0;
    if (grid == 0) {
        if (n_in != 28 || in_sizes[0] != MXR * DM || out_size != MXR * DM || ws_size < WS_END) {
            fprintf(stderr, "kernel_launch: unexpected shapes: n_in %d in0 %d out %d ws %zu (need %zu)\n", n_in, n_in > 0 ? in_sizes[0] : -1, out_size, ws_size, (size_t)WS_END); grid = -1; return; }
        int dev = 0, cus = 0, per_cu = 0;
        if (hipGetDevice(&dev) != hipSuccess || hipDeviceGetAttribute(&cus, hipDeviceAttributeMultiprocessorCount, dev) != hipSuccess) { grid = -1; return; }
        if (hipFuncSetAttribute((const void*)fwd_megakernel, hipFuncAttributeMaxDynamicSharedMemorySize, LDS_BYTES) != hipSuccess) { fprintf(stderr, "kernel_launch: hipFuncSetAttribute failed\n"); grid = -1; return; }
        if (hipOccupancyMaxActiveBlocksPerMultiprocessor(&per_cu, (const void*)fwd_megakernel, 512, LDS_BYTES) != hipSuccess || per_cu < 1) { fprintf(stderr, "kernel_launch: occupancy query reports %d\n", per_cu); (void)hipGetLastError(); per_cu = 1; }
        grid = cus;
        if (grid > 256) grid = 256;
    }
    if (grid < 0) return;
    if (hipMemsetAsync((char*)d_ws + WS_CTL, 0, CTL_ZERO_BYTES, stream) != hipSuccess) { fprintf(stderr, "kernel_launch: memset failed\n"); return; }
    Args a{};
    for (int i = 0; i < 28; ++i) a.in[i] = (const float*)d_in[i];
    a.o_ = (float*)d_out; a.w_ = (unsigned char*)d_ws;
    hipLaunchKernelGGL(fwd_megakernel, dim3(grid), dim3(512), LDS_BYTES, stream, a);
    const hipError_t le = hipPeekAtLastError();
    if (le != hipSuccess) fprintf(stderr, "kernel_launch: launch failed: %s\n", hipGetErrorName(le));
}
```

```cpp
#include <hip/hip_runtime.h>
#include <hip/hip_bf16.h>
#include <cstdio>
#include <cstdint>
__device__ __forceinline__ int ltid(int wv) { int l; asm volatile("v_mbcnt_lo_u32_b32 %0, -1, 0\n\tv_mbcnt_hi_u32_b32 %0, -1, %0" : "=v"(l)); return wv * 64 + l; }
namespace pg8 {
#define PG8_LAS __attribute__((address_space(3)))
typedef unsigned short bf16_t;
typedef short bf16x8 __attribute__((ext_vector_type(8)));
typedef float f32x4 __attribute__((ext_vector_type(4)));
typedef unsigned u32x4 __attribute__((ext_vector_type(4)));
constexpr int BM = 256, BK = 64, HALF = 128, HTB = HALF * BK * 2  , STAGE_BYTES = 8 * HTB, NXCD = 8, WGM = 8;

__host__ __device__ __forceinline__ int lds_byte(int r, int c) { const int st = (r >> 4) * 2 + (c >> 5), rr = r & 15, cc = c & 31, ob = rr * 64 + cc * 2; return st * 1024 + (ob ^ (((ob >> 9) & 1) << 5)); }
__host__ __device__ __forceinline__ void stage_rc(int b, int& R, int& C) { const int st = b / 1024, sb = b % 1024, swz = sb ^ (((sb >> 9) & 1) << 5); R = (st >> 1) * 16 + swz / 64; C = (st & 1) * 32 + (swz % 64) / 2; }
__host__ __device__ __forceinline__ int perm32(int rho) { const int n = rho >> 4, i = rho & 15; return 8 * (i >> 2) + 4 * n + (i & 3); }

struct Unit { int pm, pn, hm; };
struct Gemm { const bf16_t* A; const bf16_t* Bt; int M, N, K; };

struct StaticOrder {
    int nM, nN, nwg, G, c;
    __host__ __device__ void init(int M, int N, int G_, int c_) { nM = M / BM; nN = N / BM; nwg = nM * nN; G = G_; c = c_; }
    __host__ __device__ bool next(int i, Unit& u) const { return at((long)i * G + c, u); }
    __host__ __device__ bool at(const long L, Unit& u) const {
        if (L >= nwg) return false; u.hm = 0;
        int wgid = (int)L; { const int q = nwg / NXCD, r = nwg % NXCD, xcd = wgid % NXCD, off = wgid / NXCD; wgid = (xcd < r ? xcd * (q + 1) : r * (q + 1) + (xcd - r) * q) + off; }
        const int nig = WGM * nN, gid = wgid / nig, fm = gid * WGM, gsz = (nM - fm) < WGM ? (nM - fm) : WGM;
        u.pm = fm + ((wgid % nig) % gsz); u.pn = (wgid % nig) / gsz; return true;
    }
    __device__ __forceinline__ void a_ready(const Unit&) const {}
    __device__ __forceinline__ void done(const Unit&) const {}
};

__device__ __forceinline__ unsigned cvt_pk_bf16(float lo, float hi) { unsigned r; asm volatile("v_cvt_pk_bf16_f32 %0, %1, %2" : "=v"(r) : "v"(lo), "v"(hi)); return r; }
typedef float f32x2 __attribute__((ext_vector_type(2)));
struct NoGather {};
struct GatherA { const int* tok; const PG8_LAS int* tbase; const PG8_LAS int* cnt; int NP, cap; };
template <class Epi, class Sched, bool ALIGN_EPI = false, bool SP2 = false, bool GATHER = false, class GAT = NoGather>
__device__ __forceinline__ void gemm_phase(PG8_LAS unsigned char* lds, const Gemm g, const Sched& S, const Epi& E, const int wv, const GAT& GA = GAT()) {
    static_assert(!GATHER || SP2, "gather staging is written for the SP2 loop");
    const int tid = ltid(wv), wid = wv, lane = tid & 63, wr = wid >> 2, wc = wid & 3, fr = lane & 15, fq = lane >> 4;
    const int K = g.K, nt = K / BK;
    unsigned voffA[2], voffB[2];
#pragma unroll
    for (int i = 0; i < 2; ++i) { int R, C; stage_rc(tid * 16 + i * 8192, R, C); const int Rb = Epi::PERM ? ((R & ~31) + perm32(R & 31)) : R;
        voffA[i] = (unsigned)(R * K + C) * 2u; voffB[i] = (unsigned)(Rb * K + C) * 2u; }
    const size_t kstep = (size_t)(BK * 2);
    const size_t hstep = (size_t)HALF * K * 2;
    const size_t tstep = 2 * hstep;
    const unsigned ldsw = (unsigned)wid * 1024u;
    const int aoff = lds_byte(wr * 64 + fr, fq * 8), boff = lds_byte(wc * 32 + fr, fq * 8);
#define PG8_SA(b, h) (((b) * 2 + (h)) * HTB)
#define PG8_SB(b, h) ((4 + (b) * 2 + (h)) * HTB)
#define PG8_STAGE(bufoff, gbase, voff) do { _Pragma("unroll") for (int _i = 0; _i < 2; ++_i) \
        __builtin_amdgcn_global_load_lds((const unsigned*)((const char*)(gbase) + (voff)[_i]), (PG8_LAS unsigned*)(lds + (bufoff) + ldsw + _i * 8192), 16, 0, 0); } while (0)
#define PG8_STAGE_A(bufoff, ngptr, h, kofs, GV) do { if constexpr (GATHER) { PG8_STAGE(bufoff, (const char*)g.A + (kofs), GV[h]); } else { PG8_STAGE(bufoff, ngptr, voffA); } } while (0)
#define PG8_GOFS(dst, U) do { if constexpr (GATHER) { const int e_ = (U).pn / GA.NP; const int rk0_ = ((U).pm - GA.tbase[e_]) * 256; const int c_ = GA.cnt[e_]; \
        _Pragma("unroll") for (int h_ = 0; h_ < 2; ++h_) _Pragma("unroll") for (int i_ = 0; i_ < 2; ++i_) { int R_, C_; stage_rc(tid * 16 + i_ * 8192, R_, C_); const int rk_ = rk0_ + h_ * 128 + R_; \
            const int tk_ = rk_ < c_ ? GA.tok[(size_t)e_ * GA.cap + rk_] : 0; dst[h_][i_] = (unsigned)(tk_ * K + C_) * 2u; } } } while (0)
#define PG8_LDA(dst, b, h) do { _Pragma("unroll") for (int m = 0; m < 4; ++m) _Pragma("unroll") for (int k = 0; k < 2; ++k) dst[m][k] = *(const PG8_LAS bf16x8*)(lds + PG8_SA(b, h) + aoff + m * 2048 + k * 1024); } while (0)
#define PG8_LDB(dst, b, h) do { _Pragma("unroll") for (int n = 0; n < 2; ++n) _Pragma("unroll") for (int k = 0; k < 2; ++k) dst[n][k] = *(const PG8_LAS bf16x8*)(lds + PG8_SB(b, h) + boff + n * 2048 + k * 1024); } while (0)
#define PG8_MMA(ai, bj, At, Bt) do { if (cur.hm != 0 && cur.hm != (ai) + 1) break; __builtin_amdgcn_s_setprio(1); _Pragma("unroll") for (int m = 0; m < 4; ++m) _Pragma("unroll") for (int n = 0; n < 2; ++n) _Pragma("unroll") for (int k = 0; k < 2; ++k) \
        acc[ai][bj][m][n] = __builtin_amdgcn_mfma_f32_16x16x32_bf16(Bt[n][k], At[m][k], acc[ai][bj][m][n], 0, 0, 0); __builtin_amdgcn_s_setprio(0); } while (0)
#define PG8_WAIT_V(n) asm volatile("s_waitcnt vmcnt(" #n ")" ::: "memory")
#define PG8_WAIT_L(n) asm volatile("s_waitcnt lgkmcnt(" #n ")" ::: "memory")
#define PG8_BAR __builtin_amdgcn_s_barrier()
#define PG8_SCHED __builtin_amdgcn_sched_barrier(0)
    Unit cur, nxt; int ui = 0;
    if (!S.next(0, cur)) return;
    f32x4 acc[2][2][4][2];
#pragma unroll
    for (int a = 0; a < 2; ++a)
#pragma unroll
        for (int b = 0; b < 2; ++b)
#pragma unroll
            for (int m = 0; m < 4; ++m)
#pragma unroll
                for (int n = 0; n < 2; ++n) acc[a][b][m][n] = (f32x4){0.f, 0.f, 0.f, 0.f};
    bf16x8 At[4][2], B0[2][2], B1[2][2];
    const char* cA = (const char*)g.A + (size_t)cur.pm * tstep; const char* cB = (const char*)g.Bt + (size_t)cur.pn * tstep;
    S.a_ready(cur);
    unsigned curG[2][2] = {{0u, 0u}, {0u, 0u}}, nxtG[2][2] = {{0u, 0u}, {0u, 0u}};
    PG8_GOFS(curG, cur); { Unit n0_; if (S.next(1, n0_)) PG8_GOFS(nxtG, n0_); }
    if constexpr (SP2) {
        PG8_STAGE(PG8_SB(0, 0), cB, voffB); PG8_STAGE(PG8_SB(0, 1), cB + hstep, voffB); PG8_STAGE_A(PG8_SA(0, 0), cA, 0, (size_t)0, curG); PG8_STAGE_A(PG8_SA(0, 1), cA + hstep, 1, (size_t)0, curG);
        if (wr == 1) PG8_BAR;
        PG8_WAIT_V(2); PG8_BAR;
        PG8_STAGE(PG8_SB(1, 0), cB + kstep, voffB); PG8_STAGE_A(PG8_SA(1, 0), cA + kstep, 0, kstep, curG); PG8_STAGE(PG8_SB(1, 1), cB + hstep + kstep, voffB);
        PG8_WAIT_V(6); PG8_BAR;
    } else {
        PG8_STAGE(PG8_SB(0, 0), cB, voffB); PG8_STAGE(PG8_SA(0, 0), cA, voffA); PG8_STAGE(PG8_SB(0, 1), cB + hstep, voffB); PG8_STAGE(PG8_SA(0, 1), cA + hstep, voffA);
        if (wr == 1) PG8_BAR;
        PG8_WAIT_V(4); PG8_BAR;
        PG8_STAGE(PG8_SB(1, 0), cB + kstep, voffB); PG8_STAGE(PG8_SA(1, 0), cA + kstep, voffA); PG8_STAGE(PG8_SB(1, 1), cB + hstep + kstep, voffB);
        PG8_WAIT_V(6); PG8_BAR;
    }
    for (;;) {
        const bool has_next = S.next(ui + 1, nxt);
        if (GATHER && has_next && ui >= 1) PG8_GOFS(nxtG, nxt);
        const char* nA = has_next ? (const char*)g.A + (size_t)nxt.pm * tstep : cA; const char* nB = has_next ? (const char*)g.Bt + (size_t)nxt.pn * tstep : cB;
        for (int t = 0; t < nt; t += 2) {
            const bool last = (t == nt - 2);
            const char* a1 = cA + (size_t)(t + 1) * kstep;
            const char* a2 = last ? nA : cA + (size_t)(t + 2) * kstep; const char* b2 = last ? nB : cB + (size_t)(t + 2) * kstep;
            const char* a3 = a2 + kstep; const char* b3 = b2 + kstep;
            if (last && has_next) S.a_ready(nxt);
            const size_t k1o = (size_t)(t + 1) * kstep, k2o = last ? (size_t)0 : (size_t)(t + 2) * kstep; unsigned selG[2][2];
            _Pragma("unroll") for (int h_ = 0; h_ < 2; ++h_) _Pragma("unroll") for (int i_ = 0; i_ < 2; ++i_) selG[h_][i_] = (last && has_next) ? nxtG[h_][i_] : curG[h_][i_];
            if constexpr (SP2) {
            PG8_LDB(B0, 0, 0); PG8_LDB(B1, 0, 1); PG8_SCHED; PG8_LDA(At, 0, 0); PG8_STAGE_A(PG8_SA(1, 1), a1 + hstep, 1, k1o, curG);
            PG8_WAIT_V(8); PG8_WAIT_L(0); PG8_BAR; PG8_MMA(0, 0, At, B0); PG8_MMA(0, 1, At, B1); PG8_BAR; PG8_SCHED;
            PG8_LDA(At, 0, 1); PG8_STAGE(PG8_SB(0, 0), b2, voffB); PG8_STAGE(PG8_SB(0, 1), b2 + hstep, voffB); PG8_STAGE_A(PG8_SA(0, 0), a2, 0, k2o, selG);
            PG8_WAIT_V(8); PG8_WAIT_L(0); PG8_BAR; PG8_MMA(1, 0, At, B0); PG8_MMA(1, 1, At, B1); PG8_BAR; PG8_SCHED;
            PG8_LDB(B0, 1, 0); PG8_LDB(B1, 1, 1); PG8_SCHED; PG8_LDA(At, 1, 0); PG8_STAGE_A(PG8_SA(0, 1), a2 + hstep, 1, k2o, selG);
            PG8_WAIT_V(8); PG8_WAIT_L(0); PG8_BAR; PG8_MMA(0, 0, At, B0); PG8_MMA(0, 1, At, B1); PG8_BAR; PG8_SCHED;
            PG8_LDA(At, 1, 1); PG8_STAGE(PG8_SB(1, 0), b3, voffB); PG8_STAGE(PG8_SB(1, 1), b3 + hstep, voffB); PG8_STAGE_A(PG8_SA(1, 0), a3, 0, k2o + kstep, selG);
            PG8_WAIT_V(8); PG8_WAIT_L(0); PG8_BAR; PG8_MMA(1, 0, At, B0); PG8_MMA(1, 1, At, B1); PG8_BAR; PG8_SCHED;
            } else {
            PG8_LDB(B0, 0, 0); PG8_SCHED; PG8_LDA(At, 0, 0); PG8_STAGE(PG8_SA(1, 1), a1 + hstep, voffA);
            PG8_WAIT_L(8); PG8_BAR; PG8_WAIT_L(0); PG8_MMA(0, 0, At, B0); PG8_BAR; PG8_SCHED;
            PG8_LDB(B1, 0, 1); PG8_STAGE(PG8_SB(0, 0), b2, voffB);
            PG8_BAR; PG8_WAIT_L(0); PG8_MMA(0, 1, At, B1); PG8_BAR;
            PG8_LDA(At, 0, 1); PG8_STAGE(PG8_SA(0, 0), a2, voffA);
            PG8_BAR; PG8_WAIT_L(0); PG8_MMA(1, 0, At, B0); PG8_BAR; PG8_SCHED;
            PG8_STAGE(PG8_SB(0, 1), b2 + hstep, voffB);
            PG8_WAIT_V(6); PG8_BAR; PG8_MMA(1, 1, At, B1); PG8_BAR;
            PG8_LDB(B0, 1, 0); PG8_SCHED; PG8_LDA(At, 1, 0); PG8_STAGE(PG8_SA(0, 1), a2 + hstep, voffA);
            PG8_WAIT_L(8); PG8_BAR; PG8_WAIT_L(0); PG8_MMA(0, 0, At, B0); PG8_BAR; PG8_SCHED;
            PG8_LDB(B1, 1, 1); PG8_STAGE(PG8_SB(1, 0), b3, voffB);
            PG8_BAR; PG8_WAIT_L(0); PG8_MMA(0, 1, At, B1); PG8_BAR;
            PG8_LDA(At, 1, 1); PG8_STAGE(PG8_SA(1, 0), a3, voffA);
            PG8_BAR; PG8_WAIT_L(0); PG8_MMA(1, 0, At, B0); PG8_BAR; PG8_SCHED;
            PG8_STAGE(PG8_SB(1, 1), b3 + hstep, voffB);
            PG8_WAIT_V(6); PG8_BAR; PG8_MMA(1, 1, At, B1); PG8_BAR;
            }
        }
        if constexpr (ALIGN_EPI) { if (wr == 0) PG8_BAR; }
        if constexpr (!Epi::AFTER_DRAIN) { E(acc, cur, wr, wc, fr, fq); S.done(cur); }
        if (!has_next) break;
#pragma unroll
        for (int a = 0; a < 2; ++a)
#pragma unroll
            for (int b = 0; b < 2; ++b)
#pragma unroll
                for (int m = 0; m < 4; ++m)
#pragma unroll
                    for (int n = 0; n < 2; ++n) acc[a][b][m][n] = (f32x4){0.f, 0.f, 0.f, 0.f};
        cur = nxt; cA = nA; cB = nB; ++ui;
        _Pragma("unroll") for (int h_ = 0; h_ < 2; ++h_) _Pragma("unroll") for (int i_ = 0; i_ < 2; ++i_) curG[h_][i_] = nxtG[h_][i_];
        if constexpr (ALIGN_EPI) { if (wr == 1) PG8_BAR; }
    }
    PG8_WAIT_V(0);
    if constexpr (!ALIGN_EPI) { if (wr == 0) PG8_BAR; }
    PG8_BAR;
    if constexpr (Epi::AFTER_DRAIN) { E.fused(acc, cur, wr, wc, fr, fq, lds, wid, lane); S.done(cur); }
#undef PG8_SA
#undef PG8_SB
#undef PG8_STAGE
#undef PG8_LDA
#undef PG8_STAGE_A
#undef PG8_GOFS
#undef PG8_LDB
#undef PG8_MMA
#undef PG8_WAIT_V
#undef PG8_WAIT_L
#undef PG8_BAR
#undef PG8_SCHED
}
}

constexpr int NB = 8, NXT = 2048, LCT = 256, TT = 2304, DM = 1024;
constexpr int MALL = NB * TT;
constexpr int MXR = NB * NXT;
constexpr int NQKV0 = 3072, NQKV1 = 1536;
constexpr int NEXP = 32, FH = 256, NMOD = 6144;
constexpr float ALPHA = 1.41421356237309515f;
constexpr float LAMBDA_INIT0 = 0.2f;
constexpr float LN_EPS = 1e-5f, RMS_EPS = 1e-6f;
constexpr int SORT_ROWS = 45056;

#define GAS __attribute__((address_space(1)))
#define LAS __attribute__((address_space(3)))
typedef unsigned short bf16_t;
typedef unsigned v4u __attribute__((ext_vector_type(4)));
typedef unsigned v2u __attribute__((ext_vector_type(2)));
typedef float f32x4 __attribute__((ext_vector_type(4)));
typedef float f32x2 __attribute__((ext_vector_type(2)));
typedef short bf16x8 __attribute__((ext_vector_type(8)));
typedef short s16x4 __attribute__((ext_vector_type(4)));
typedef float f32x16 __attribute__((ext_vector_type(16)));
typedef GAS unsigned gu32;
#define RLX_AGENT __ATOMIC_RELAXED, __HIP_MEMORY_SCOPE_AGENT
#define LDS_WAIT() asm volatile("s_waitcnt lgkmcnt(0)" ::: "memory")
#define VM_WAIT() asm volatile("s_waitcnt vmcnt(0)" ::: "memory")

constexpr size_t MiB = 1u << 20;
constexpr size_t WS_CTL = 0, CTL_ZERO_BYTES = 1 * MiB;
constexpr size_t WS_MOD = 1 * MiB;
constexpr size_t WS_TAB64 = 1 * MiB + 512 * 1024;
constexpr size_t WS_TAB128 = WS_TAB64 + 8192;
constexpr size_t WS_WRT = WS_TAB64 + 65536;
constexpr size_t WS_TOKINFO = 2 * MiB;
constexpr size_t WS_TOKW = WS_TOKINFO + (size_t)MALL * 16;
constexpr size_t WS_TOKPOS = WS_TOKW + (size_t)MALL * 8;
constexpr size_t WS_GW = 3 * MiB;
constexpr size_t WS_XRC = 4 * MiB;
constexpr size_t WS_WQKV0 = 12 * MiB, WS_WO0 = 18 * MiB, WS_WQKV1 = 20 * MiB, WS_WO1 = 23 * MiB;
constexpr size_t WS_WGU = 26 * MiB;
constexpr size_t WS_WD = 58 * MiB;
constexpr size_t WS_HBUF = 74 * MiB;
constexpr size_t WS_QKV = 110 * MiB;
constexpr size_t WS_Y = 218 * MiB;
constexpr size_t WS_TOKOF = 306 * MiB;
constexpr size_t WS_GWOF = 309 * MiB;
constexpr int ECAP = 18432;
constexpr size_t WS_STATS = 312 * MiB;
constexpr size_t WS_ROWST = 315 * MiB;
constexpr size_t WS_YOFF = WS_QKV + 24 * MiB;
constexpr size_t WS_WRS = 316 * MiB;
constexpr size_t WS_END = 317 * MiB;
static_assert(WS_TOKPOS + (size_t)MALL * 8 <= WS_GW && WS_GW + SORT_ROWS * 4 <= WS_XRC && WS_XRC + 2048 * 4096 <= WS_WQKV0, "ws map");
static_assert(WS_YOFF + (size_t)MALL * DM * 4 <= WS_Y && (size_t)SORT_ROWS * FH * 2 <= 24 * MiB && WS_QKV + (size_t)MALL * 3072 * 2 <= WS_Y && WS_Y + (size_t)SORT_ROWS * 2048 <= WS_END && WS_HBUF + (size_t)MALL * 2048 <= WS_QKV, "ws map");
constexpr int CW_BAR = 4096;
constexpr int CW_CNT = 8192;

constexpr int RING_BYTES = 131072;
constexpr int MISC_OFF = 139264;
constexpr int TILEE_OFF = MISC_OFF + 256;
constexpr int ROWB_OFF = MISC_OFF + 512;
constexpr int LDS_BYTES = 147456;

__device__ __forceinline__ unsigned cvtpk(float lo, float hi) { unsigned r; asm volatile("v_cvt_pk_bf16_f32 %0, %1, %2" : "=v"(r) : "v"(lo), "v"(hi)); return r; }
__device__ __forceinline__ float bf_lo(unsigned u) { return __uint_as_float(u << 16); }
__device__ __forceinline__ float bf_hi(unsigned u) { return __uint_as_float(u & 0xffff0000u); }
template <int M> __device__ __forceinline__ float xsum(float v) {
    if constexpr (M < 32) return v + __int_as_float(__builtin_amdgcn_ds_swizzle(__float_as_int(v), (M << 10) | 0x1f));
    else { auto rr = __builtin_amdgcn_permlane32_swap(__float_as_uint(v), __float_as_uint(v), false, false); return __uint_as_float(rr[0]) + __uint_as_float(rr[1]); }
}
__device__ __forceinline__ float sum32(float v) { v = xsum<1>(v); v = xsum<2>(v); v = xsum<4>(v); v = xsum<8>(v); v = xsum<16>(v); return v; }
__device__ __forceinline__ float wave_sum(float v) { return xsum<32>(sum32(v)); }
__device__ __forceinline__ int row_b(int r) { return r / TT; }
__device__ __forceinline__ float* xr_ptr(float* out, float* xrc, int r) {
    const int b = r / TT, t = r - b * TT;
    return t < LCT ? xrc + ((size_t)b * LCT + t) * DM : out + ((size_t)b * NXT + (t - LCT)) * DM;
}
__device__ __forceinline__ const float* in0_ptr(const float* x, const float* ctx, int r) {
    const int b = r / TT, t = r - b * TT;
    return t < LCT ? ctx + ((size_t)b * LCT + t) * DM : x + ((size_t)b * NXT + (t - LCT)) * DM;
}

#define XB_TMO      128
#define XB_XCNT(j)  (256  + 64 * (j))
#define XB_XSUB(j)  (1280 + 64 * (j))
#define XB_XGEN(j)  (2304 + 64 * (j))
#define XB_TOP      3328
#define XB_TOPGEN   3392
#define XCD_BAR_WORDS 3456
#define XB_SPIN_CAP (1u << 18)
__device__ __forceinline__ unsigned xb_ld(unsigned* p)              { return __hip_atomic_load(p, __ATOMIC_RELAXED, __HIP_MEMORY_SCOPE_AGENT); }
__device__ __forceinline__ unsigned xb_add(unsigned* p, unsigned v) { return __hip_atomic_fetch_add(p, v, __ATOMIC_RELAXED, __HIP_MEMORY_SCOPE_AGENT); }
__device__ __forceinline__ unsigned xb_xcc_id() { return (unsigned)__builtin_amdgcn_s_getreg((3 << 11) | 20) & 0xFu; }
#define XB_SPIN(cond, bar) do { unsigned _sp = 0; while (cond) { __builtin_amdgcn_s_sleep(1); \
    if ((++_sp & 255u) == 0u) { if (xb_ld(&(bar)[XB_TMO])) break; if (_sp > XB_SPIN_CAP) { atomicAdd(&(bar)[XB_TMO], 1u); break; } } } } while (0)
__device__ __forceinline__ void xcd_barrier_post(unsigned* bar) {
    const unsigned x = xb_xcc_id();
    if (threadIdx.x == 0) (void)xb_add(&bar[XB_XCNT(x)], 1u);
}
__device__ __forceinline__ void xcd_barrier_complete(unsigned* bar, unsigned x, unsigned& nloc, unsigned& nx) {
    const unsigned G = gridDim.x * gridDim.y * gridDim.z;
    unsigned sum, cnt, mine, sp = 0u;
    for (;;) {
        sum = 0u; cnt = 0u; mine = 0u;
#pragma unroll
        for (unsigned j = 0; j < 16; ++j) { const unsigned c = xb_ld(&bar[XB_XCNT(j)]); sum += c; cnt += (c > 0u) ? 1u : 0u; mine = (j == x) ? c : mine; }
        if (sum == G) break;
        __builtin_amdgcn_s_sleep(1);
        if ((++sp & 255u) == 0u) { if (xb_ld(&bar[XB_TMO])) break; if (sp > XB_SPIN_CAP) { atomicAdd(&bar[XB_TMO], 1u); break; } }
    }
    nloc = mine > 0u ? mine : 1u; nx = cnt > 0u ? cnt : 1u;
}
__device__ __forceinline__ void xcd_barrier(unsigned* bar_in, volatile LAS unsigned* st, bool leader) {
    asm volatile("s_waitcnt vmcnt(0)" ::: "memory");
    __syncthreads();
    if (leader) {
        unsigned* bar = bar_in;
        unsigned bx_ = xb_xcc_id(); asm volatile("" : "+s"(bx_));
        __builtin_amdgcn_s_waitcnt(0);
        unsigned nloc = st[0], nx = st[1];
        if (nloc == 0u) { xcd_barrier_complete(bar, bx_, nloc, nx); st[0] = nloc; st[1] = nx; }
        const unsigned old = xb_add(&bar[XB_XSUB(bx_)], 1u);
        const unsigned gen = old / nloc;
        if (old + 1u == (gen + 1u) * nloc) {
            __builtin_amdgcn_fence(__ATOMIC_RELEASE, "agent");
            asm volatile("s_waitcnt vmcnt(0)" ::: "memory");
            const unsigned og = xb_add(&bar[XB_TOP], 1u);
            const unsigned tg = og / nx;
            if (og + 1u == (tg + 1u) * nx) xb_add(&bar[XB_TOPGEN], 1u);
            else XB_SPIN(xb_ld(&bar[XB_TOPGEN]) == tg, bar);
            __builtin_amdgcn_fence(__ATOMIC_ACQUIRE, "agent");
            asm volatile("s_waitcnt vmcnt(0)" ::: "memory");
        } else {
            XB_SPIN(xb_ld(&bar[XB_TOPGEN]) == gen, bar);
            __builtin_amdgcn_fence(__ATOMIC_ACQUIRE, "agent");
            asm volatile("s_waitcnt vmcnt(0)" ::: "memory");
        }
    }
    __syncthreads();
}

struct SchedRect {
    pg8::StaticOrder so; int xonly, n_extra, G, c, full, rsplit;
    __device__ void init(int nMt, int N, int G_, int c_, int xonly_, int n_extra_) { so.init(nMt * 256, N, G_, c_); xonly = xonly_; n_extra = n_extra_; G = G_; c = c_;
        const int r = so.nwg % G; full = so.nwg - r; rsplit = (n_extra == 0 && r > 0 && 2 * r <= G) ? r : 0; }
    __device__ bool next(int i, pg8::Unit& u) const {
        const long L = (long)i * G + c;
        if (rsplit && L >= full) { const int j = (int)(L - full); if (j >= 2 * rsplit) return false;
            so.at(full + (j >> 1), u); u.hm = 1 + (j & 1); if (xonly) u.pm = (u.pm >> 3) * 9 + 1 + (u.pm & 7); return true; }
        if (L < so.nwg) { so.at(L, u); if (xonly) u.pm = (u.pm >> 3) * 9 + 1 + (u.pm & 7); return true; }
        const int j = (int)(L - so.nwg); if (j >= n_extra) return false;
        u.pm = (j >> 1) * 9; u.pn = 4 + (j & 1); u.hm = 0; return true;
    }
    __device__ __forceinline__ void a_ready(const pg8::Unit&) const {}
    __device__ __forceinline__ void done(const pg8::Unit&) const {}
};
struct SchedExp {
    const LAS unsigned char* tile_e; int NP, nunits, G, c;
    __device__ bool next(int i, pg8::Unit& u) const {
        long L = (long)i * G + c; int hm = 0;
        const int rr = nunits % G, full = nunits - rr;
        if (rr > 0 && 2 * rr <= G && L >= full) { const int j = (int)(L - full); if (j >= 2 * rr) return false; L = full + (j >> 1); hm = 1 + (j & 1); }
        if (L >= nunits) return false;
        const int q = nunits / 8, r = nunits % 8, xcd = (int)(L % 8), off = (int)(L / 8);
        const int Lr = (xcd < r ? xcd * (q + 1) : r * (q + 1) + (xcd - r) * q) + off;
        const int tm = Lr / NP, pl = Lr % NP;
        u.pm = tm; u.pn = (int)tile_e[tm] * NP + pl; u.hm = hm; return true;
    }
    __device__ __forceinline__ void a_ready(const pg8::Unit&) const {}
    __device__ __forceinline__ void done(const pg8::Unit&) const {}
};

struct EpiStoreBf16 {
    static constexpr bool PERM = true, AFTER_DRAIN = false;
    bf16_t* O; int ldc; int pn_mask; const f32x2* tab; const float* kg; LAS float* xch;
    __device__ __forceinline__ void operator()(const pg8::f32x4 (&acc)[2][2][4][2], const pg8::Unit& u, int wr, int wc, int fr_in, int fq_in) const {
        int fr = fr_in, fq = fq_in; asm volatile("" : "+v"(fr), "+v"(fq));
        const int row0 = u.pm * 256 + wr * 64 + fr;
        if (kg == nullptr && tab != nullptr && u.pn >= 4 && u.pn < 8) {
            const int tj = u.pm % 9; const bool lat = tj != 0; const int nbase = (tj - 1) * 256 + wr * 64 + fr;
            const int ax = fq >> 1, f0 = (fq & 1) * 8; const int col0 = u.pn * 256 + wc * 64 + ax * 32 + f0;
#pragma unroll
            for (int ai = 0; ai < 2; ++ai) { if (u.hm != 0 && u.hm != ai + 1) continue;
#pragma unroll
                for (int m = 0; m < 4; ++m) { bf16_t* rowp = O + (size_t)(row0 + ai * 128 + m * 16) * ldc + col0;
                    float x1[8], x2[8];
#pragma unroll
                    for (int n = 0; n < 2; ++n)
#pragma unroll
                        for (int q = 0; q < 4; ++q) { x1[n * 4 + q] = acc[ai][0][m][n][q]; x2[n * 4 + q] = acc[ai][1][m][n][q]; }
                    if (lat) { const int nr = nbase + ai * 128 + m * 16; const int pos = ax ? (nr & 63) : (nr >> 6);
                        const pg8::f32x4* tp = (const pg8::f32x4*)(tab + pos * 16 + f0);
#pragma unroll
                        for (int q = 0; q < 4; ++q) { const pg8::f32x4 cs = tp[q];
                            const float a0 = x1[2 * q], b0 = x2[2 * q], a1 = x1[2 * q + 1], b1 = x2[2 * q + 1];
                            x1[2 * q] = a0 * cs[0] - b0 * cs[1]; x2[2 * q] = b0 * cs[0] + a0 * cs[1];
                            x1[2 * q + 1] = a1 * cs[2] - b1 * cs[3]; x2[2 * q + 1] = b1 * cs[2] + a1 * cs[3]; } }
                    v4u w; w.x = cvtpk(x1[0], x1[1]); w.y = cvtpk(x1[2], x1[3]); w.z = cvtpk(x1[4], x1[5]); w.w = cvtpk(x1[6], x1[7]);
                    *(v4u*)rowp = w;
                    w.x = cvtpk(x2[0], x2[1]); w.y = cvtpk(x2[2], x2[3]); w.z = cvtpk(x2[4], x2[5]); w.w = cvtpk(x2[6], x2[7]);
                    *(v4u*)(rowp + 16) = w; } }
            return;
        }
        if (kg != nullptr && u.pn == 4) {
            const int tj = u.pm % 9; const bool lat = tj != 0; const int nbase = (tj - 1) * 256 + wr * 64 + fr;
            const int hl = wc >> 1, ax = wc & 1, f0 = 8 * fq; const int col0k = 1024 + hl * 128 + ax * 64 + f0; const int wid = wr * 4 + wc;
            float ssq[2][4];
#pragma unroll
            for (int ai = 0; ai < 2; ++ai)
#pragma unroll
                for (int m = 0; m < 4; ++m) { float s = 0.f;
#pragma unroll
                    for (int bj = 0; bj < 2; ++bj)
#pragma unroll
                        for (int n = 0; n < 2; ++n)
#pragma unroll
                            for (int q = 0; q < 4; ++q) s += acc[ai][bj][m][n][q] * acc[ai][bj][m][n][q];
                    s = xsum<16>(s); s = xsum<32>(s);
                    ssq[ai][m] = s; if (fq == 0) xch[wid * 128 + ai * 64 + m * 16 + fr] = s; }
            asm volatile("s_waitcnt lgkmcnt(0)" ::: "memory"); __builtin_amdgcn_s_barrier(); asm volatile("" ::: "memory");
            const float g00 = 0.f; (void)g00;
            pg8::f32x4 gA[2][2];
#pragma unroll
            for (int bj = 0; bj < 2; ++bj)
#pragma unroll
                for (int n = 0; n < 2; ++n) gA[bj][n] = *(const pg8::f32x4*)(kg + ax * 64 + bj * 32 + f0 + 4 * n);
#pragma unroll
            for (int ai = 0; ai < 2; ++ai) { if (u.hm != 0 && u.hm != ai + 1) continue;
#pragma unroll
                for (int m = 0; m < 4; ++m) { bf16_t* rowp = O + (size_t)(row0 + ai * 128 + m * 16) * ldc + col0k;
                    const float tot = ssq[ai][m] + xch[(wid ^ 1) * 128 + ai * 64 + m * 16 + fr];
                    const float rs = 1.0f / sqrtf(tot * (1.f / 128.f) + RMS_EPS);
                    float x1[8], x2[8];
#pragma unroll
                    for (int n = 0; n < 2; ++n)
#pragma unroll
                        for (int q = 0; q < 4; ++q) { x1[n * 4 + q] = acc[ai][0][m][n][q] * rs * gA[0][n][q]; x2[n * 4 + q] = acc[ai][1][m][n][q] * rs * gA[1][n][q]; }
                    if (lat) { const int nr = nbase + ai * 128 + m * 16; const int pos = ax ? (nr & 63) : (nr >> 6);
                        const pg8::f32x4* tp = (const pg8::f32x4*)(tab + pos * 32 + f0);
#pragma unroll
                        for (int q = 0; q < 4; ++q) { const pg8::f32x4 cs = tp[q];
                            const float a0 = x1[2 * q], b0 = x2[2 * q], a1 = x1[2 * q + 1], b1 = x2[2 * q + 1];
                            x1[2 * q] = a0 * cs[0] - b0 * cs[1]; x2[2 * q] = b0 * cs[0] + a0 * cs[1];
                            x1[2 * q + 1] = a1 * cs[2] - b1 * cs[3]; x2[2 * q + 1] = b1 * cs[2] + a1 * cs[3]; } }
                    v4u w; w.x = cvtpk(x1[0], x1[1]); w.y = cvtpk(x1[2], x1[3]); w.z = cvtpk(x1[4], x1[5]); w.w = cvtpk(x1[6], x1[7]);
                    *(v4u*)rowp = w;
                    w.x = cvtpk(x2[0], x2[1]); w.y = cvtpk(x2[2], x2[3]); w.z = cvtpk(x2[4], x2[5]); w.w = cvtpk(x2[6], x2[7]);
                    *(v4u*)(rowp + 32) = w; } }
            asm volatile("s_waitcnt lgkmcnt(0)" ::: "memory"); __builtin_amdgcn_s_barrier(); asm volatile("" ::: "memory");
            return;
        }
        const int col0 = (u.pn & pn_mask) * 256 + wc * 32 + 8 * fq;
#pragma unroll
        for (int ai = 0; ai < 2; ++ai) { if (u.hm != 0 && u.hm != ai + 1) continue;
#pragma unroll
            for (int m = 0; m < 4; ++m) { bf16_t* rowp = O + (size_t)(row0 + ai * 128 + m * 16) * ldc + col0;
#pragma unroll
                for (int bj = 0; bj < 2; ++bj) { const pg8::f32x4 v0 = acc[ai][bj][m][0], v1 = acc[ai][bj][m][1];
                    v4u w; w.x = cvtpk(v0[0], v0[1]); w.y = cvtpk(v0[2], v0[3]); w.z = cvtpk(v1[0], v1[1]); w.w = cvtpk(v1[2], v1[3]);
                    *(v4u*)(rowp + bj * 128) = w; } } }
    }
};
typedef _Float16 hf_t;
typedef _Float16 hf2_t __attribute__((ext_vector_type(2)));
__device__ __forceinline__ unsigned pkh(float a, float b_) { const hf2_t v = {(hf_t)a, (hf_t)b_}; return __builtin_bit_cast(unsigned, v); }
__device__ __forceinline__ float hf_lo(unsigned u) { const hf2_t v = __builtin_bit_cast(hf2_t, u); return (float)v[0]; }
__device__ __forceinline__ float hf_hi(unsigned u) { const hf2_t v = __builtin_bit_cast(hf2_t, u); return (float)v[1]; }
template <bool RH>
struct EpiResid {
    static constexpr bool PERM = true, AFTER_DRAIN = false;
    hf_t* Y; const float* xbase; const float* cbase; const float* modl; f32x2* stats;
    __device__ __forceinline__ void operator()(const pg8::f32x4 (&acc)[2][2][4][2], const pg8::Unit& u, int wr, int wc, int fr_in, int fq_in) const {
        int fr = fr_in, fq = fq_in; asm volatile("" : "+v"(fr), "+v"(fq));
        const int b = u.pm / 9, j = u.pm - b * 9;
        const size_t roff0 = (j == 0) ? (size_t)b * LCT * DM : ((size_t)b * NXT + (size_t)(j - 1) * 256) * DM;
        const float* rb = ((j == 0) ? cbase : xbase) + roff0; const hf_t* rbh = (const hf_t*)xbase + roff0;
        const float* g = modl + (size_t)(j == 0 ? 8 : b) * NMOD + 2048;
        const int col0 = u.pn * 256 + wc * 32 + 8 * fq;
        pg8::f32x4 gv[2][2];
#pragma unroll
        for (int bj = 0; bj < 2; ++bj)
#pragma unroll
            for (int n = 0; n < 2; ++n) gv[bj][n] = *(const pg8::f32x4*)(g + col0 + bj * 128 + n * 4);
#pragma unroll
        for (int ai = 0; ai < 2; ++ai) { if (u.hm != 0 && u.hm != ai + 1) continue;
#pragma unroll
            for (int mh = 0; mh < 2; ++mh) {
            pg8::f32x4 rva[2][2][2]; v4u rvh[2][2];
#pragma unroll
            for (int mm = 0; mm < 2; ++mm) { const size_t ro = (size_t)(ai * 128 + wr * 64 + (2 * mh + mm) * 16 + fr) * DM + col0;
#pragma unroll
                for (int bj = 0; bj < 2; ++bj) {
                    if constexpr (RH) rvh[mm][bj] = *(const v4u*)(rbh + ro + bj * 128);
                    else {
#pragma unroll
                        for (int n = 0; n < 2; ++n) rva[mm][bj][n] = *(const pg8::f32x4*)(rb + ro + bj * 128 + n * 4); } } }
#pragma unroll
            for (int mm = 0; mm < 2; ++mm) { const int m = 2 * mh + mm; const int lr = ai * 128 + wr * 64 + m * 16 + fr;
                hf_t* yrow = Y + ((size_t)u.pm * 256 + lr) * DM + col0;
                float s = 0.f, q = 0.f;
#pragma unroll
                for (int bj = 0; bj < 2; ++bj) {
                    if constexpr (RH) { const v4u h = rvh[mm][bj]; rva[mm][bj][0] = (pg8::f32x4){hf_lo(h.x), hf_hi(h.x), hf_lo(h.y), hf_hi(h.y)}; rva[mm][bj][1] = (pg8::f32x4){hf_lo(h.z), hf_hi(h.z), hf_lo(h.w), hf_hi(h.w)}; }
                    const pg8::f32x4 o0 = rva[mm][bj][0] * ALPHA + gv[bj][0] * acc[ai][bj][m][0], o1 = rva[mm][bj][1] * ALPHA + gv[bj][1] * acc[ai][bj][m][1];
                    s += ((o0[0] + o0[1]) + (o0[2] + o0[3])) + ((o1[0] + o1[1]) + (o1[2] + o1[3]));
                    q += ((o0[0] * o0[0] + o0[1] * o0[1]) + (o0[2] * o0[2] + o0[3] * o0[3])) + ((o1[0] * o1[0] + o1[1] * o1[1]) + (o1[2] * o1[2] + o1[3] * o1[3]));
                    v4u w; w.x = pkh(o0[0], o0[1]); w.y = pkh(o0[2], o0[3]); w.z = pkh(o1[0], o1[1]); w.w = pkh(o1[2], o1[3]);
                    *(v4u*)(yrow + bj * 128) = w; }
                s = xsum<16>(s); q = xsum<16>(q); s = xsum<32>(s); q = xsum<32>(q);
                if (fq == 0) stats[((size_t)u.pm * 256 + lr) * 16 + u.pn * 4 + wc] = (f32x2){s, q}; } } }
    }
};
struct EpiGateUp {
    static constexpr bool PERM = true, AFTER_DRAIN = false;
    bf16_t* ACT; const float* gwof; const LAS int* tbase;
    __device__ __forceinline__ void operator()(const pg8::f32x4 (&acc)[2][2][4][2], const pg8::Unit& u, int wr, int wc, int fr_in, int fq_in) const {
        int fr = fr_in, fq = fq_in; asm volatile("" : "+v"(fr), "+v"(fq));
        const int e = u.pn >> 1; const float* gwe = gwof + (size_t)e * ECAP + (u.pm - tbase[e]) * 256;
        const int lr0 = wr * 64 + fr; const int f0 = (u.pn & 1) * 128 + wc * 32 + 8 * fq;
#pragma unroll
        for (int ai = 0; ai < 2; ++ai) { if (u.hm != 0 && u.hm != ai + 1) continue;
#pragma unroll
            for (int m = 0; m < 4; ++m) { const int lr = lr0 + ai * 128 + m * 16; const float gw = gwe[lr];
                float o[8];
#pragma unroll
                for (int n = 0; n < 2; ++n)
#pragma unroll
                    for (int q = 0; q < 4; ++q) { const float a = acc[ai][0][m][n][q], up = acc[ai][1][m][n][q];
                        o[n * 4 + q] = a * __builtin_amdgcn_rcpf(1.f + __expf(-a)) * up * gw; }
                v4u w; w.x = cvtpk(o[0], o[1]); w.y = cvtpk(o[2], o[3]); w.z = cvtpk(o[4], o[5]); w.w = cvtpk(o[6], o[7]);
                *(v4u*)(ACT + ((size_t)u.pm * 256 + lr) * FH + f0) = w; } }
    }
};

namespace att {
constexpr int KVBLK = 64;
constexpr int SHM_V = KVBLK * 128 * 2, SHM_K = KVBLK * 128 * 2;
constexpr int OFF_WS = 2 * SHM_V + 2 * SHM_K;
constexpr int OFF_XCH = OFF_WS + 8 * 256;
constexpr int LDS_NEED = OFF_XCH + 4 * 16384;
static_assert(LDS_NEED <= MISC_OFF, "attention LDS");
constexpr float THR = 8.f;
#define KSWZ(row, colB) ((row) * 256 + ((colB) ^ (((row) & 7) << 4)))
#define SBAR() __builtin_amdgcn_sched_barrier(0)
__device__ __forceinline__ int crow(int r, int hi) { return (r & 3) + 8 * (r >> 2) + 4 * hi; }

template <bool DIFF> struct Cst { static constexpr float SCALE = DIFF ? 0.125f : 0.088388347648318440f; static constexpr float C = SCALE * 1.4426950408889634f; };

template <bool DIFF>
__device__ __forceinline__ void partialSM(f32x16& p0, f32x16& p1, float& m_reg, float& mn, float& alpha) {
  constexpr float C = Cst<DIFF>::C, SCALE = Cst<DIFF>::SCALE;
  float pmax = p0[0];
#pragma unroll
  for (int r = 1; r < 16; ++r) pmax = fmaxf(pmax, p0[r]);
#pragma unroll
  for (int r = 0; r < 16; ++r) pmax = fmaxf(pmax, p1[r]);
  { auto rr = __builtin_amdgcn_permlane32_swap(__float_as_uint(pmax), __float_as_uint(pmax), false, false);
    pmax = fmaxf(__uint_as_float(rr[0]), __uint_as_float(rr[1])); }
  if (__builtin_expect(__all(pmax - m_reg <= THR / SCALE), 1)) { mn = m_reg; alpha = 1.f; }
  else { mn = fmaxf(m_reg, pmax); alpha = __builtin_amdgcn_exp2f((m_reg - mn) * C); m_reg = mn; }
  float mnC = -mn * C;
#pragma unroll
  for (int r = 0; r < 16; ++r) p0[r] = fmaf(p0[r], C, mnC);
#pragma unroll
  for (int r = 0; r < 16; ++r) p1[r] = fmaf(p1[r], C, mnC);
#pragma unroll
  for (int r = 0; r < 16; ++r) p0[r] = __builtin_amdgcn_exp2f(p0[r]);
}
__device__ __forceinline__ void finishSM(f32x16& p0, f32x16& p1, float alpha, float& l_reg, bf16x8& pa0, bf16x8& pa1, bf16x8& pa2, bf16x8& pa3) {
#pragma unroll
  for (int r = 0; r < 16; ++r) p1[r] = __builtin_amdgcn_exp2f(p1[r]);
  float ps = 0;
#pragma unroll
  for (int r = 0; r < 16; ++r) ps += p0[r];
#pragma unroll
  for (int r = 0; r < 16; ++r) ps += p1[r];
  { auto rr = __builtin_amdgcn_permlane32_swap(__float_as_uint(ps), __float_as_uint(ps), false, false);
    ps = __uint_as_float(rr[0]) + __uint_as_float(rr[1]); }
  l_reg = l_reg * alpha + ps;
#define PK4(P, BASE, OUT) do { unsigned a0 = cvtpk(P[BASE + 0], P[BASE + 1]), a1 = cvtpk(P[BASE + 2], P[BASE + 3]);   \
    unsigned b0 = cvtpk(P[BASE + 4], P[BASE + 5]), b1 = cvtpk(P[BASE + 6], P[BASE + 7]);                              \
    auto r0 = __builtin_amdgcn_permlane32_swap(a0, b0, false, false); auto r1 = __builtin_amdgcn_permlane32_swap(a1, b1, false, false); \
    v4u w = {r0[0], r1[0], r0[1], r1[1]}; OUT = *reinterpret_cast<bf16x8*>(&w); } while (0)
  PK4(p0, 0, pa0); PK4(p0, 8, pa1); PK4(p1, 0, pa2); PK4(p1, 8, pa3);
#undef PK4
}
template <int NQ>
__device__ __forceinline__ void qkt(f32x16& p0, f32x16& p1, const char* Ks, const bf16x8* qr, int r32, int hi, int d0base) {
  p0 = f32x16{}; p1 = f32x16{};
#pragma unroll
  for (int d0 = 0; d0 < NQ; ++d0) { const int cb = ((d0base + d0) * 16 + hi * 8) * 2;
    bf16x8 b0 = *reinterpret_cast<const bf16x8*>(Ks + KSWZ(r32, cb));
    bf16x8 b1 = *reinterpret_cast<const bf16x8*>(Ks + KSWZ(32 + r32, cb));
    p0 = __builtin_amdgcn_mfma_f32_32x32x16_bf16(b0, qr[d0], p0, 0, 0, 0);
    p1 = __builtin_amdgcn_mfma_f32_32x32x16_bf16(b1, qr[d0], p1, 0, 0, 0); }
}
__device__ __forceinline__ int v_st(int k, int c) { const int kk = (k & ~0xC) | ((k & 4) << 1) | ((k & 8) >> 1); return ((kk >> 3) * 4 + (c >> 5)) * 512 + ((kk & 7) * 32 + (c & 31)) * 2; }
__device__ __forceinline__ int v_rd_base(int lane) { return ((lane & 3) << 3) | (((lane >> 2) & 3) << 6) | (((lane >> 4) & 1) << 5) | (((lane >> 5) & 1) << 8); }
constexpr int v_rd_off(int d0, int ks, int half) { return d0 * 512 + ks * 4096 + half * 2048; }
template <int OFF> __device__ __forceinline__ s16x4 tr_read(int vb) {
  s16x4 r; asm volatile("ds_read_b64_tr_b16 %0, %1 offset:%2" : "=&v"(r) : "v"(vb), "i"(OFF) : "memory"); return r;
}
template <int D0> __device__ __forceinline__ void pv_one(f32x16& od, int vb, bf16x8 pa0, bf16x8 pa1, bf16x8 pa2, bf16x8 pa3) {
  const s16x4 l0 = tr_read<v_rd_off(D0, 0, 0)>(vb), h0 = tr_read<v_rd_off(D0, 0, 1)>(vb), l1 = tr_read<v_rd_off(D0, 1, 0)>(vb), h1 = tr_read<v_rd_off(D0, 1, 1)>(vb);
  const s16x4 l2 = tr_read<v_rd_off(D0, 2, 0)>(vb), h2 = tr_read<v_rd_off(D0, 2, 1)>(vb), l3 = tr_read<v_rd_off(D0, 3, 0)>(vb), h3 = tr_read<v_rd_off(D0, 3, 1)>(vb);
  asm volatile("s_waitcnt lgkmcnt(0)" ::: "memory"); SBAR();
#define PK(L, H) (bf16x8){L[0], L[1], L[2], L[3], H[0], H[1], H[2], H[3]}
  od = __builtin_amdgcn_mfma_f32_32x32x16_bf16(pa0, PK(l0, h0), od, 0, 0, 0);
  od = __builtin_amdgcn_mfma_f32_32x32x16_bf16(pa1, PK(l1, h1), od, 0, 0, 0);
  od = __builtin_amdgcn_mfma_f32_32x32x16_bf16(pa2, PK(l2, h2), od, 0, 0, 0);
  od = __builtin_amdgcn_mfma_f32_32x32x16_bf16(pa3, PK(l3, h3), od, 0, 0, 0);
#undef PK
}
__device__ __forceinline__ void pv_d0(f32x16* o, int vb, bf16x8 pa0, bf16x8 pa1, bf16x8 pa2, bf16x8 pa3) {
  pv_one<0>(o[0], vb, pa0, pa1, pa2, pa3); pv_one<1>(o[1], vb, pa0, pa1, pa2, pa3); pv_one<2>(o[2], vb, pa0, pa1, pa2, pa3); pv_one<3>(o[3], vb, pa0, pa1, pa2, pa3);
}

constexpr float THRL = THR * 1.4426950408889634f;
__device__ __forceinline__ void qkt_negm(f32x16& p0, f32x16& p1, const char* Ks, const bf16x8* qr, const f32x16& negm, int r32, int hi, int d0base) {
#pragma unroll
  for (int d0 = 0; d0 < 4; ++d0) { const int cb = ((d0base + d0) * 16 + hi * 8) * 2;
    bf16x8 b0 = *reinterpret_cast<const bf16x8*>(Ks + KSWZ(r32, cb));
    bf16x8 b1 = *reinterpret_cast<const bf16x8*>(Ks + KSWZ(32 + r32, cb));
    if (d0 == 0) { p0 = __builtin_amdgcn_mfma_f32_32x32x16_bf16(b0, qr[0], negm, 0, 0, 0); p1 = __builtin_amdgcn_mfma_f32_32x32x16_bf16(b1, qr[0], negm, 0, 0, 0); }
    else { p0 = __builtin_amdgcn_mfma_f32_32x32x16_bf16(b0, qr[d0], p0, 0, 0, 0); p1 = __builtin_amdgcn_mfma_f32_32x32x16_bf16(b1, qr[d0], p1, 0, 0, 0); } }
}
__device__ __forceinline__ void splat16(f32x16& v, float x) {
#pragma unroll
  for (int r = 0; r < 16; ++r) v[r] = x;
}
__device__ __forceinline__ void partial_first_negm(f32x16& p0, f32x16& p1, float& m_reg, f32x16& negm) {
  float pmax = p0[0];
#pragma unroll
  for (int r = 1; r < 16; ++r) pmax = fmaxf(pmax, p0[r]);
#pragma unroll
  for (int r = 0; r < 16; ++r) pmax = fmaxf(pmax, p1[r]);
  { auto rr = __builtin_amdgcn_permlane32_swap(__float_as_uint(pmax), __float_as_uint(pmax), false, false);
    pmax = fmaxf(__uint_as_float(rr[0]), __uint_as_float(rr[1])); }
  m_reg = pmax; splat16(negm, -pmax);
#pragma unroll
  for (int r = 0; r < 16; ++r) { p0[r] -= pmax; p1[r] -= pmax; }
#pragma unroll
  for (int r = 0; r < 16; ++r) p0[r] = __builtin_amdgcn_exp2f(p0[r]);
}
__device__ __forceinline__ void pv_partial_negm(f32x16* o, int vb, bf16x8 pa0, bf16x8 pa1, bf16x8 pa2, bf16x8 pa3, f32x16& p0, f32x16& p1, float& m_reg, f32x16& negm, float& alpha) {
  pv_one<0>(o[0], vb, pa0, pa1, pa2, pa3);
  float pmax = p0[0];
#pragma unroll
  for (int r = 1; r < 16; ++r) pmax = fmaxf(pmax, p0[r]);
  pv_one<1>(o[1], vb, pa0, pa1, pa2, pa3);
#pragma unroll
  for (int r = 0; r < 16; ++r) pmax = fmaxf(pmax, p1[r]);
  { auto rr = __builtin_amdgcn_permlane32_swap(__float_as_uint(pmax), __float_as_uint(pmax), false, false);
    pmax = fmaxf(__uint_as_float(rr[0]), __uint_as_float(rr[1])); }
  if (__builtin_expect(__all(pmax <= THRL), 1)) { alpha = 1.f; }
  else { const float d = fmaxf(pmax, 0.f); alpha = __builtin_amdgcn_exp2f(-d); m_reg += d; splat16(negm, -m_reg);
#pragma unroll
    for (int r = 0; r < 16; ++r) { p0[r] -= d; p1[r] -= d; } }
  pv_one<2>(o[2], vb, pa0, pa1, pa2, pa3);
  pv_one<3>(o[3], vb, pa0, pa1, pa2, pa3);
#pragma unroll
  for (int r = 0; r < 16; ++r) p0[r] = __builtin_amdgcn_exp2f(p0[r]);
  asm volatile("" : "+v"(p0), "+v"(p1));
  SBAR();
}

template <bool DIFF>
__device__ __forceinline__ void pv_partial(f32x16* o, int vb, bf16x8 pa0, bf16x8 pa1, bf16x8 pa2, bf16x8 pa3, f32x16& p0, f32x16& p1, float& m_reg, float& mn, float& alpha) {
  constexpr float C = Cst<DIFF>::C, SCALE = Cst<DIFF>::SCALE;
  pv_one<0>(o[0], vb, pa0, pa1, pa2, pa3);
  float pmax = p0[0];
#pragma unroll
  for (int r = 1; r < 16; ++r) pmax = fmaxf(pmax, p0[r]);
  pv_one<1>(o[1], vb, pa0, pa1, pa2, pa3);
#pragma unroll
  for (int r = 0; r < 16; ++r) pmax = fmaxf(pmax, p1[r]);
  { auto rr = __builtin_amdgcn_permlane32_swap(__float_as_uint(pmax), __float_as_uint(pmax), false, false);
    pmax = fmaxf(__uint_as_float(rr[0]), __uint_as_float(rr[1])); }
  if (__builtin_expect(__all(pmax - m_reg <= THR / SCALE), 1)) { mn = m_reg; alpha = 1.f; }
  else { mn = fmaxf(m_reg, pmax); alpha = __builtin_amdgcn_exp2f((m_reg - mn) * C); m_reg = mn; }
  pv_one<2>(o[2], vb, pa0, pa1, pa2, pa3);
  const float mnC = -mn * C;
#pragma unroll
  for (int r = 0; r < 16; ++r) p0[r] = fmaf(p0[r], C, mnC);
#pragma unroll
  for (int r = 0; r < 16; ++r) p1[r] = fmaf(p1[r], C, mnC);
  pv_one<3>(o[3], vb, pa0, pa1, pa2, pa3);
#pragma unroll
  for (int r = 0; r < 16; ++r) p0[r] = __builtin_amdgcn_exp2f(p0[r]);
  asm volatile("" : "+v"(p0), "+v"(p1));
  SBAR();
}

template <bool DIFF>
__device__ __forceinline__ void attn_unit(const bf16_t* __restrict__ Qb, int ldq, const bf16_t* __restrict__ Kh, const bf16_t* __restrict__ Vh, int ldk, int seq,
                                          bf16_t* __restrict__ Ob, int ldo, bool rope, int n0, const f32x2* __restrict__ tab,
                                          const float* __restrict__ qg  , const float* __restrict__ subg  , float lam, char* lds, const int wv) {
  constexpr int NQ = DIFF ? 4 : 8;
  const int tid = ltid(wv), wid = wv, lane = tid & 63, r32 = lane & 31, hi = lane >> 5;
  const int qblk = DIFF ? (wid & 3) : wid, map = DIFF ? (wid >> 2) : 0;
  char* V_lds = lds; char* K_lds = lds + 2 * SHM_V;
  float* wsf = (float*)(lds + OFF_WS) + wid * 64; float* li_l = wsf; float* al_l = wsf + 32;
  float m_reg = -1e30f, l_reg = 0; f32x16 o[4] = {}; bf16x8 qr[NQ];
  const int sr = tid >> 4, sc = (tid & 15) * 8, vst0 = v_st(sr, sc), vst1 = v_st(32 + sr, sc);
  const int vb0 = (int)(uintptr_t)V_lds + v_rd_base(lane);
  struct { bf16x8 vs0, vs1, ks0, ks1; } sr_[2] = {};
#define LD8(p) (*reinterpret_cast<const bf16x8*>(p))
#define SLOAD(i, k0) do { sr_[i].vs0 = LD8(&Vh[(size_t)((k0) + sr) * ldk + sc]); sr_[i].vs1 = LD8(&Vh[(size_t)((k0) + 32 + sr) * ldk + sc]); \
    sr_[i].ks0 = LD8(&Kh[(size_t)((k0) + sr) * ldk + sc]); sr_[i].ks1 = LD8(&Kh[(size_t)((k0) + 32 + sr) * ldk + sc]); } while (0)
#define SWRITE(b, i) do { *(bf16x8*)(V_lds + (b) * SHM_V + vst0) = sr_[i].vs0;          \
    *(bf16x8*)(V_lds + (b) * SHM_V + vst1) = sr_[i].vs1; int kc = sc * 2;               \
    *(bf16x8*)(K_lds + (b) * SHM_K + KSWZ(sr, kc)) = sr_[i].ks0;                       \
    *(bf16x8*)(K_lds + (b) * SHM_K + KSWZ(32 + sr, kc)) = sr_[i].ks1; } while (0)
  constexpr int SE = 0, SO = 1;
  SLOAD(SE, 0); SLOAD(SO, KVBLK);
  {
    const bf16_t* Qw = Qb + (size_t)(qblk * 32 + r32) * ldq + map * 64 + hi * 8;
    const int n = n0 + qblk * 32 + r32;
    float qf[NQ][8];
#pragma unroll
    for (int d0 = 0; d0 < NQ; ++d0) { const v4u w = *reinterpret_cast<const v4u*>(Qw + d0 * 16);
      qf[d0][0] = bf_lo(w.x); qf[d0][1] = bf_hi(w.x); qf[d0][2] = bf_lo(w.y); qf[d0][3] = bf_hi(w.y);
      qf[d0][4] = bf_lo(w.z); qf[d0][5] = bf_hi(w.z); qf[d0][6] = bf_lo(w.w); qf[d0][7] = bf_hi(w.w); }
    if constexpr (!DIFF) {
      float ss = 0.f;
#pragma unroll
      for (int d0 = 0; d0 < NQ; ++d0)
#pragma unroll
        for (int j = 0; j < 8; ++j) ss += qf[d0][j] * qf[d0][j];
      ss = xsum<32>(ss);
      const float rs = 1.0f / sqrtf(ss * (1.f / 128.f) + RMS_EPS);
#pragma unroll
      for (int d0 = 0; d0 < NQ; ++d0) { const f32x4 g0 = *(const f32x4*)(qg + d0 * 16 + hi * 8), g1 = *(const f32x4*)(qg + d0 * 16 + hi * 8 + 4);
#pragma unroll
        for (int j = 0; j < 4; ++j) { qf[d0][j] *= rs * g0[j]; qf[d0][4 + j] *= rs * g1[j]; } }
    }
    if (rope) {
      constexpr int NF = DIFF ? 16 : 32;
      constexpr int HB = DIFF ? 1 : 2;
#pragma unroll
      for (int ax = 0; ax < 2; ++ax) { const int pos = ax ? (n & 63) : (n >> 6);
#pragma unroll
        for (int hb = 0; hb < HB; ++hb) { const int dA = ax * 2 * HB + hb, dB = dA + HB;
          const f32x2* tp = tab + pos * NF + hb * 16 + hi * 8;
#pragma unroll
          for (int j = 0; j < 8; ++j) { const f32x2 cs = tp[j]; const float x1 = qf[dA][j], x2 = qf[dB][j];
            qf[dA][j] = x1 * cs.x - x2 * cs.y; qf[dB][j] = x2 * cs.x + x1 * cs.y; } } }
    }
    if constexpr (DIFF) {
#pragma unroll
      for (int d0 = 0; d0 < NQ; ++d0)
#pragma unroll
        for (int j = 0; j < 8; ++j) qf[d0][j] *= Cst<true>::C; }
#pragma unroll
    for (int d0 = 0; d0 < NQ; ++d0) { v4u w = {cvtpk(qf[d0][0], qf[d0][1]), cvtpk(qf[d0][2], qf[d0][3]), cvtpk(qf[d0][4], qf[d0][5]), cvtpk(qf[d0][6], qf[d0][7])};
      qr[d0] = *reinterpret_cast<bf16x8*>(&w); }
  }
#define SWAIT() asm volatile("s_waitcnt vmcnt(4)" ::: "memory")
#define RESC(a) do { if (__any((a) < 1.f)) { if (hi == 0) al_l[r32] = (a); asm volatile("s_waitcnt lgkmcnt(0)" ::: "memory"); \
    _Pragma("unroll") for (int d = 0; d < 4; ++d) _Pragma("unroll") for (int r = 0; r < 16; ++r) o[d][r] *= al_l[crow(r, hi)]; } } while (0)
  f32x16 pA0, pA1, pB0, pB1; float mnA, mnB, alA, alB; bf16x8 pa0, pa1, pa2, pa3; const int NT = seq / KVBLK;
  const int dbase = map * 4;
  f32x16 negm = {};
  if constexpr (DIFF) m_reg = 0.f;
#define QKT(P0, P1, KS) do { if constexpr (DIFF) qkt_negm(P0, P1, KS, qr, negm, r32, hi, dbase); else qkt<NQ>(P0, P1, KS, qr, r32, hi, dbase); } while (0)
#define PVP(VB, P0, P1, MN, AL) do { if constexpr (DIFF) pv_partial_negm(o, VB, pa0, pa1, pa2, pa3, P0, P1, m_reg, negm, AL); else pv_partial<DIFF>(o, VB, pa0, pa1, pa2, pa3, P0, P1, m_reg, MN, AL); } while (0)
  SWAIT(); SWRITE(0, SE); __syncthreads();
  QKT(pA0, pA1, K_lds); if constexpr (DIFF) { partial_first_negm(pA0, pA1, m_reg, negm); alA = 1.f; } else partialSM<DIFF>(pA0, pA1, m_reg, mnA, alA);
  if (2 < NT) SLOAD(SE, 2 * KVBLK);
  SWAIT(); SWRITE(1, SO); __syncthreads();
  for (int j = 1; j + 1 < NT; j += 2) {
    SBAR(); QKT(pB0, pB1, K_lds + SHM_K);
    finishSM(pA0, pA1, alA, l_reg, pa0, pa1, pa2, pa3); SBAR();
    SLOAD(SO, (j + 2) * KVBLK); SBAR();
    PVP(vb0, pB0, pB1, mnB, alB);
    __syncthreads(); SWAIT(); SWRITE(0, SE);
    RESC(alB); __syncthreads();
    SBAR(); QKT(pA0, pA1, K_lds);
    finishSM(pB0, pB1, alB, l_reg, pa0, pa1, pa2, pa3); SBAR();
    if (j + 3 < NT) SLOAD(SE, (j + 3) * KVBLK); SBAR();
    PVP(vb0 + (int)SHM_V, pA0, pA1, mnA, alA);
    __syncthreads(); SWAIT(); SWRITE(1, SO);
    RESC(alA); __syncthreads();
  }
  SBAR(); QKT(pB0, pB1, K_lds + SHM_K);
  finishSM(pA0, pA1, alA, l_reg, pa0, pa1, pa2, pa3); SBAR();
  PVP(vb0, pB0, pB1, mnB, alB);
  __syncthreads(); RESC(alB);
  finishSM(pB0, pB1, alB, l_reg, pa0, pa1, pa2, pa3); SBAR();
  pv_d0(o, vb0 + (int)SHM_V, pa0, pa1, pa2, pa3);
  if (hi == 0) li_l[r32] = l_reg; asm volatile("s_waitcnt lgkmcnt(0)" ::: "memory");
#pragma unroll
  for (int r = 0; r < 16; ++r) { const float rl = __builtin_amdgcn_rcpf(li_l[crow(r, hi)]);
#pragma unroll
    for (int d0 = 0; d0 < 4; ++d0) o[d0][r] *= rl; }
  if constexpr (!DIFF) {
    bf16_t* ost = (bf16_t*)(lds + OFF_XCH) + wid * (32 * 136);
#pragma unroll
    for (int r = 0; r < 16; ++r) { const int orow = crow(r, hi);
#pragma unroll
      for (int d0 = 0; d0 < 4; ++d0) ost[orow * 136 + d0 * 32 + r32] = (bf16_t)(cvtpk(o[d0][r], 0.f) & 0xffffu); }
    asm volatile("s_waitcnt lgkmcnt(0)" ::: "memory");
    bf16_t* Ow = Ob + (size_t)(wid * 32) * ldo;
#pragma unroll
    for (int i = 0; i < 8; ++i) { const int c = i * 64 + lane, orow = c >> 4, ch = c & 15;
      *(v4u*)(Ow + (size_t)orow * ldo + ch * 8) = *(const v4u*)(ost + orow * 136 + ch * 8); }
  } else {
    float* xch = (float*)(lds + OFF_XCH) + qblk * 4096;
    if (map == 1) {
#pragma unroll
      for (int d0 = 0; d0 < 4; ++d0)
#pragma unroll
        for (int r = 0; r < 16; ++r) xch[(d0 * 16 + r) * 64 + lane] = o[d0][r];
    }
    __syncthreads();
    if (map == 0) {
      float ssr[16];
#pragma unroll
      for (int r = 0; r < 16; ++r) { float s = 0.f;
#pragma unroll
        for (int d0 = 0; d0 < 4; ++d0) { const float d = o[d0][r] - lam * xch[(d0 * 16 + r) * 64 + lane]; o[d0][r] = d; s += d * d; }
        ssr[r] = s; }
#pragma unroll
      for (int r = 0; r < 16; ++r) { float s = ssr[r];
        s = sum32(s);
        ssr[r] = (1.0f / sqrtf(s * (1.f / 128.f) + RMS_EPS)) * (1.f - LAMBDA_INIT0); }
      asm volatile("s_waitcnt lgkmcnt(0)" ::: "memory");
      bf16_t* ost = (bf16_t*)xch;
#pragma unroll
      for (int d0 = 0; d0 < 4; ++d0) { const float g = subg[d0 * 32 + r32];
#pragma unroll
        for (int r = 0; r < 16; ++r) ost[crow(r, hi) * 136 + d0 * 32 + r32] = (bf16_t)(cvtpk(o[d0][r] * ssr[r] * g, 0.f) & 0xffffu); }
      asm volatile("s_waitcnt lgkmcnt(0)" ::: "memory");
      bf16_t* Ow = Ob + (size_t)(qblk * 32) * ldo;
#pragma unroll
      for (int i = 0; i < 8; ++i) { const int c = i * 64 + lane, orow = c >> 4, ch = c & 15;
        *(v4u*)(Ow + (size_t)orow * ldo + ch * 8) = *(const v4u*)(ost + orow * 136 + ch * 8); }
    }
  }
#undef QKT
#undef PVP
#undef LD8
#undef SLOAD
#undef SWRITE
#undef SWAIT
#undef RESC
}
#undef KSWZ
#undef SBAR
}

#ifndef REPMASK
#define REPMASK 0
#endif
#ifndef REPN
#define REPN 1
#endif
#ifndef PHMASK
#define PHMASK 0x3ffff
#endif
struct Args { const float* in[28]; float* o_; unsigned char* w_; };
enum { I_X = 0, I_C, I_CTX, I_CCTX, I_WMOD, I_BMOD, I_LNMG, I_LNMB, I_LNFG, I_LNFB, I_DWQKV, I_DWO, I_LQ1, I_LK1, I_LQ2, I_LK2, I_SUBG,
       I_GWQKV, I_GWO, I_GQN, I_GKN, I_WGRP, I_BGRP, I_WRT, I_BRT, I_WGATE, I_WUP, I_WDOWN };

constexpr int PTR_OFF = MISC_OFF + 1024;
__device__ __forceinline__ const float* ldptr(LAS unsigned char* ldsl, int i) {
    int off = PTR_OFF + 8 * i; asm volatile("" : "+v"(off));
    const LAS unsigned* p = (const LAS unsigned*)(ldsl + off);
    const unsigned lo = __builtin_amdgcn_readfirstlane(p[0]), hi = __builtin_amdgcn_readfirstlane(p[1]);
    return (const float*)(GAS const float*)(((unsigned long long)hi << 32) | lo);
}
struct TrItem { const float* W; int N; bf16_t* WT; int KT; int dstrow0; int k0; int n0; int hi_stride; };
__device__ __forceinline__ void transpose_load(const TrItem& I, float (&wv_)[32], int lane) {
    const unsigned vo_ = (unsigned)((lane >> 3) * I.N + (lane & 7) * 4) * 4u;
#pragma unroll
    for (int i = 0; i < 8; ++i) { const f32x4 w = __builtin_nontemporal_load((const f32x4*)((const char*)(I.W + (size_t)(I.k0 + 8 * i) * I.N + I.n0) + vo_));
        wv_[4 * i] = w[0]; wv_[4 * i + 1] = w[1]; wv_[4 * i + 2] = w[2]; wv_[4 * i + 3] = w[3]; }
}
__device__ __forceinline__ void transpose_finish(const TrItem& I, const float (&wv_)[32], LAS float* scr, int lane) {
#pragma unroll
    for (int i = 0; i < 8; ++i)
#pragma unroll
        for (int j = 0; j < 4; ++j) scr[(8 * i + (lane >> 3)) * 33 + (lane & 7) * 4 + j] = wv_[4 * i + j];
    LDS_WAIT(); asm volatile("" ::: "memory");
    const int c = lane & 7;
#pragma unroll
    for (int j = 0; j < 4; ++j) { const int n = (lane >> 3) + 8 * j; const LAS float* s = scr + (8 * c) * 33 + n;
        v4u o; o.x = cvtpk(s[0 * 33], s[1 * 33]); o.y = cvtpk(s[2 * 33], s[3 * 33]); o.z = cvtpk(s[4 * 33], s[5 * 33]); o.w = cvtpk(s[6 * 33], s[7 * 33]);
        *(v4u*)(I.WT + (size_t)(I.dstrow0 + (n & 15) + (n >> 4) * I.hi_stride) * I.KT + I.k0 + 8 * c) = o; }
    LDS_WAIT(); asm volatile("" ::: "memory");
}
__device__ __forceinline__ void transpose_item(const float* __restrict__ W, int N, bf16_t* __restrict__ WT, int KT, int dstrow0, int k0, int n0, LAS float* scr, int lane, int hi_stride = 16) {
    const TrItem I{W, N, WT, KT, dstrow0, k0, n0, hi_stride}; float wv_[32];
    transpose_load(I, wv_, lane); transpose_finish(I, wv_, scr, lane);
}
__device__ __forceinline__ TrItem moe_item_desc(LAS unsigned char* ldsl, int layer, int it, bf16_t* wgu_, bf16_t* wd_) {
    const int e = it / 384, r = it - e * 384;
    const size_t eoff = ((size_t)layer * NEXP + e) * (size_t)DM * FH;
    if (r < 256) {
        const int isup = r >> 7, rr = r & 127, kb = rr >> 3, nb = rr & 7, n0 = nb * 32;
        const float* W = (isup ? ldptr(ldsl, I_WUP) : ldptr(ldsl, I_WGATE)) + eoff;
        return TrItem{W, FH, wgu_, DM, e * 512 + (n0 >> 7) * 256 + isup * 128 + (n0 & 127), kb * 64, n0, 16};
    }
    const int rr = r - 256, kb = rr >> 5, nb = rr & 31;
    return TrItem{ldptr(ldsl, I_WDOWN) + eoff, DM, wd_, FH, e * 1024 + nb * 32, kb * 64, nb * 32, 16};
}
__device__ __forceinline__ void moe_weight_item(LAS unsigned char* ldsl, int layer, int it, bf16_t* wgu_, bf16_t* wd_, LAS float* scr, int lane) {
    const TrItem I = moe_item_desc(ldsl, layer, it, wgu_, wd_); float wv_[32];
    transpose_load(I, wv_, lane); transpose_finish(I, wv_, scr, lane);
}
__device__ __forceinline__ void moe_weight_pair(LAS unsigned char* ldsl, int layer, int ita, int itb, bf16_t* wgu_, bf16_t* wd_, LAS float* scr, int lane) {
    const TrItem A = moe_item_desc(ldsl, layer, ita, wgu_, wd_), B = moe_item_desc(ldsl, layer, itb, wgu_, wd_); float wa_[32], wb_[32];
    transpose_load(A, wa_, lane); transpose_load(B, wb_, lane);
    transpose_finish(A, wa_, scr, lane); transpose_finish(B, wb_, scr, lane);
}
__device__ __forceinline__ int pcol(int lane, int c) { return 8 * lane + 512 * (c >> 1) + 4 * (c & 1); }
__device__ __forceinline__ void store_h_row(const f32x4 (&v)[4], const float* __restrict__ sv, const float* __restrict__ av, bf16_t* __restrict__ hrow, int lane) {
#pragma unroll
    for (int j = 0; j < 2; ++j) { const int col = 8 * lane + 512 * j;
        const f32x4 s0 = *(const f32x4*)(sv + col), s1 = *(const f32x4*)(sv + col + 4), a0 = *(const f32x4*)(av + col), a1 = *(const f32x4*)(av + col + 4);
        const f32x4 h0 = v[2 * j] * (a0 + 1.0f) + s0, h1 = v[2 * j + 1] * (a1 + 1.0f) + s1;
        v4u w; w.x = cvtpk(h0[0], h0[1]); w.y = cvtpk(h0[2], h0[3]); w.z = cvtpk(h1[0], h1[1]); w.w = cvtpk(h1[2], h1[3]); *(v4u*)(hrow + col) = w; }
}
__device__ __forceinline__ void ln_row(f32x4 (&v)[4], const float* __restrict__ g, const float* __restrict__ bb, int lane, float& mean_o, float& rstd_o) {
    float s = 0.f;
#pragma unroll
    for (int j = 0; j < 4; ++j) s += (v[j][0] + v[j][1]) + (v[j][2] + v[j][3]);
    const float mean = wave_sum(s) * (1.f / DM); float s2 = 0.f;
#pragma unroll
    for (int j = 0; j < 4; ++j) { v[j] = v[j] - mean; s2 += (v[j][0] * v[j][0] + v[j][1] * v[j][1]) + (v[j][2] * v[j][2] + v[j][3] * v[j][3]); }
    const float rstd = 1.0f / sqrtf(wave_sum(s2) * (1.f / DM) + LN_EPS);
#pragma unroll
    for (int j = 0; j < 4; ++j) { const int col = pcol(lane, j); const f32x4 gg = *(const f32x4*)(g + col), b4 = *(const f32x4*)(bb + col); v[j] = v[j] * rstd * gg + b4; }
    mean_o = mean; rstd_o = rstd;
}

__device__ __forceinline__ int row_of(int layer, int idx, int per_item, int it, int j) { (void)idx;
    if (layer == 0) return it * per_item + j; const int xi = it * per_item + j; return (xi >> 11) * TT + LCT + (xi & 2047); }
template <int RB>
__device__ __forceinline__ void p8_rows(int idx0, int layer, const int4* __restrict__ tinfo, const LAS int* rowb, const bf16_t* __restrict__ fo, const hf_t* __restrict__ Yp, const f32x2* __restrict__ rst, const float* __restrict__ mg, const float* __restrict__ mb, float* outp, float* xrcp,
                                        const float* __restrict__ modlp, const float* __restrict__ modn, const float* __restrict__ fg, const float* __restrict__ fb, bf16_t* hbp, int lane) {
    f32x4 v[RB][4]; v4u yh[RB][2], fa[RB][2], fc[RB][2]; int rr[RB]; int4 ti[RB];
#pragma unroll
    for (int q = 0; q < RB; ++q) { const int idx = idx0 + q; rr[q] = layer == 0 ? idx : (idx >> 11) * TT + LCT + (idx & 2047); ti[q] = tinfo[rr[q]]; }
    f32x2 st[RB];
#pragma unroll
    for (int q = 0; q < RB; ++q) { const hf_t* xr = Yp + (size_t)rr[q] * DM; st[q] = rst[rr[q]];
        const bf16_t* f1 = fo + (size_t)(rowb[ti[q].x] + ti[q].y) * DM; const bf16_t* f2 = fo + (size_t)(rowb[ti[q].z] + ti[q].w) * DM;
#pragma unroll
        for (int j = 0; j < 2; ++j) yh[q][j] = *(const v4u*)(xr + 8 * lane + 512 * j);
#pragma unroll
        for (int j = 0; j < 2; ++j) { fa[q][j] = *(const v4u*)(f1 + 8 * lane + 512 * j); fc[q][j] = *(const v4u*)(f2 + 8 * lane + 512 * j); } }
#pragma unroll
    for (int q = 0; q < RB; ++q) { const int r = rr[q]; const int b = r / TT, t = r - b * TT; const int cond = t < LCT ? 8 : b;
        const float* gf = modlp + (size_t)cond * NMOD + 5120;
#pragma unroll
        for (int c = 0; c < 4; ++c) { const int col = pcol(lane, c); const v4u a4 = fa[q][c >> 1], c4 = fc[q][c >> 1];
            const unsigned ax = (c & 1) ? a4.z : a4.x, ay = (c & 1) ? a4.w : a4.y, cx = (c & 1) ? c4.z : c4.x, cy = (c & 1) ? c4.w : c4.y;
            const f32x4 f = {bf_lo(ax) + bf_lo(cx), bf_hi(ax) + bf_hi(cx), bf_lo(ay) + bf_lo(cy), bf_hi(ay) + bf_hi(cy)};
            const v4u y4 = yh[q][c >> 1]; const unsigned yx = (c & 1) ? y4.z : y4.x, yy = (c & 1) ? y4.w : y4.y;
            const f32x4 yv = {hf_lo(yx), hf_hi(yx), hf_lo(yy), hf_hi(yy)};
            const f32x4 x1 = (yv - st[q].x) * st[q].y * *(const f32x4*)(mg + col) + *(const f32x4*)(mb + col);
            v[q][c] = x1 * ALPHA + *(const f32x4*)(gf + col) * f; }
        float mean, rstd; ln_row(v[q], fg, fb, lane, mean, rstd); }
#pragma unroll
    for (int q = 0; q < RB; ++q) { const int r = rr[q]; const int b = r / TT, t = r - b * TT; const int cond = t < LCT ? 8 : b;
        if (layer == 0) { if (t >= LCT) { hf_t* xh = (hf_t*)outp + ((size_t)b * NXT + (t - LCT)) * DM;
#pragma unroll
                for (int j = 0; j < 2; ++j) { const f32x4 a = v[q][2 * j], c4 = v[q][2 * j + 1]; v4u w; w.x = pkh(a[0], a[1]); w.y = pkh(a[2], a[3]); w.z = pkh(c4[0], c4[1]); w.w = pkh(c4[2], c4[3]);
                    *(v4u*)(xh + 8 * lane + 512 * j) = w; } } }
        else { float* xr = xr_ptr(outp, xrcp, r);
#pragma unroll
            for (int c = 0; c < 4; ++c) *(f32x4*)(xr + pcol(lane, c)) = v[q][c]; }
        if (layer == 0) { const float* mv = modn + (size_t)cond * NMOD; store_h_row(v[q], mv, mv + 1024, hbp + (size_t)r * DM, lane); } }
}

template <int RB>
__device__ __forceinline__ void h0_rows(int r0, const float* __restrict__ xin, const float* __restrict__ cin, const float* __restrict__ mv0, bf16_t* hb, int lane) {
    f32x4 v[RB][4];
#pragma unroll
    for (int q = 0; q < RB; ++q) { const float* src = in0_ptr(xin, cin, r0 + q);
#pragma unroll
        for (int j = 0; j < 2; ++j) { v[q][2 * j] = *(const f32x4*)(src + 8 * lane + 512 * j); v[q][2 * j + 1] = *(const f32x4*)(src + 8 * lane + 512 * j + 4); } }
#pragma unroll
    for (int q = 0; q < RB; ++q) { const int r = r0 + q; const int b = r / TT, t = r - b * TT; const int cond = t < LCT ? 8 : b;
        const float* sv = mv0 + (size_t)cond * NMOD; const float* av = sv + 1024; bf16_t* hrow = hb + (size_t)r * DM;
#pragma unroll
        for (int j = 0; j < 2; ++j) { const int col = 8 * lane + 512 * j;
            const f32x4 s0 = *(const f32x4*)(sv + col), s1 = *(const f32x4*)(sv + col + 4), a0 = *(const f32x4*)(av + col), a1 = *(const f32x4*)(av + col + 4);
            const f32x4 h0 = v[q][2 * j] * (a0 + 1.0f) + s0, h1 = v[q][2 * j + 1] * (a1 + 1.0f) + s1;
            v4u w; w.x = cvtpk(h0[0], h0[1]); w.y = cvtpk(h0[2], h0[3]); w.z = cvtpk(h1[0], h1[1]); w.w = cvtpk(h1[2], h1[3]); *(v4u*)(hrow + col) = w; } }
}

__global__ void __launch_bounds__(512, 2) fwd_megakernel(Args args) {
    extern __shared__ __attribute__((aligned(16))) unsigned char lds[];
    LAS unsigned char* ldsl = (LAS unsigned char*)lds;
    volatile LAS unsigned* MISC = (volatile LAS unsigned*)(ldsl + MISC_OFF);
    const int G0 = gridDim.x; const int bx0 = blockIdx.x;
    const int vcu0 = (G0 % 8 == 0) ? (bx0 % 8) * (G0 / 8) + bx0 / 8 : bx0;
    const int wv = __builtin_amdgcn_readfirstlane(threadIdx.x >> 6);
#define PHASE_IDS() int G = G0, bx = bx0, vcu = vcu0; asm volatile("" : "+s"(G), "+s"(bx), "+s"(vcu)); const int NGW = G * 8; (void)NGW; (void)bx; int wave = wv; asm volatile("" : "+s"(wave)); const int tid = ltid(wave); (void)tid; const int lane = tid & 63; const int gw = vcu * 8 + wave; (void)gw; (void)lane
#define AIN(i) ldptr(ldsl, (i))
#define WSB ((unsigned char*)ldptr(ldsl, 29))
#define ctl ((gu32*)(WSB + WS_CTL))
#define modv ((float*)(WSB + WS_MOD))
#define tab64 ((f32x2*)(WSB + WS_TAB64))
#define tab128 ((f32x2*)(WSB + WS_TAB128))
#define wrt ((float*)(WSB + WS_WRT))
#define wrs ((bf16_t*)(WSB + WS_WRS))
#define tokinfo ((int4*)(WSB + WS_TOKINFO))
#define tokof ((int*)(WSB + WS_TOKOF))
#define rstats ((f32x2*)(WSB + WS_STATS))
#define gwof ((float*)(WSB + WS_GWOF))
#define ACTB ((bf16_t*)(WSB + WS_QKV))
#define XRC ((float*)(WSB + WS_XRC))
#define wqkv0 ((bf16_t*)(WSB + WS_WQKV0))
#define wo0 ((bf16_t*)(WSB + WS_WO0))
#define wqkv1 ((bf16_t*)(WSB + WS_WQKV1))
#define wo1 ((bf16_t*)(WSB + WS_WO1))
#define wgu ((bf16_t*)(WSB + WS_WGU))
#define wd ((bf16_t*)(WSB + WS_WD))
#define HB ((bf16_t*)(WSB + WS_HBUF))
#define QKV ((bf16_t*)(WSB + WS_QKV))
#define HS QKV
#define Y ((hf_t*)(WSB + WS_YOFF))
#define rowst ((f32x2*)(WSB + WS_ROWST))
#define FO ((bf16_t*)(WSB + WS_Y))
#define out ((float*)ldptr(ldsl, 28))
    for (int u = threadIdx.x; u < (LDS_BYTES - MISC_OFF) / 4; u += 512) ((LAS unsigned*)(ldsl + MISC_OFF))[u] = 0u;
    __syncthreads();
    if (threadIdx.x == 0) { LAS unsigned long long* pt = (LAS unsigned long long*)(ldsl + PTR_OFF);
#pragma unroll
        for (int i = 0; i < 28; ++i) pt[i] = (unsigned long long)args.in[i];
        pt[28] = (unsigned long long)args.o_; pt[29] = (unsigned long long)args.w_; }
    __syncthreads();
    xcd_barrier_post((unsigned*)(ctl + CW_BAR));
#define GRID_BAR() xcd_barrier((unsigned*)(ctl + CW_BAR), MISC + 8, ltid(wv) == 0)

        for (int rep_ = 0; rep_ < ((REPMASK >> 0) & 1) * REPN + 1; ++rep_) {
    if (PHMASK & (1 << 0)) {
        PHASE_IDS();
        for (int it = bx; it < 192; it += G) {
            const int layer = it / 96, col0 = (it % 96) * 64;
            const float* Wm = AIN(I_WMOD) + (size_t)layer * DM * NMOD;
            LAS float* sl = (LAS float*)(ldsl + wave * 8192);
            const int k0 = wave * 128;
            for (int idx = lane; idx < 9 * 128; idx += 64) { const int cond = idx >> 7, kk = idx & 127;
                const float v = cond < 8 ? AIN(I_C)[cond * DM + k0 + kk] : AIN(I_CCTX)[k0 + kk];
                sl[idx] = v / (1.f + expf(-v)); }
            LDS_WAIT(); asm volatile("" ::: "memory");
            const int rg = lane >> 4, c4 = (lane & 15) * 4;
            f32x4 acc[9];
#pragma unroll
            for (int c = 0; c < 9; ++c) acc[c] = (f32x4){0.f, 0.f, 0.f, 0.f};
            const unsigned lofs = (unsigned)(rg * NMOD + c4) * 4u;
#pragma unroll 1
            for (int kb = 0; kb < 128; kb += 64) { f32x4 wv_[16];
#pragma unroll
                for (int i = 0; i < 16; ++i) wv_[i] = __builtin_nontemporal_load((const f32x4*)((const char*)(Wm + (size_t)(k0 + kb + 4 * i) * NMOD + col0) + lofs));
#pragma unroll
                for (int i = 0; i < 16; ++i) {
#pragma unroll
                    for (int c = 0; c < 9; ++c) acc[c] += wv_[i] * sl[c * 128 + kb + 4 * i + rg]; } }
            LAS float* part = (LAS float*)(ldsl + 65536);
#pragma unroll
            for (int c = 0; c < 9; ++c) *(LAS f32x4*)(part + (wave * 4 + rg) * 576 + c * 64 + c4) = acc[c];
            __syncthreads();
            for (int idx = tid; idx < 576; idx += 512) { float s = 0.f;
#pragma unroll
                for (int w = 0; w < 32; ++w) s += part[w * 576 + idx];
                const int cond = idx >> 6, col = col0 + (idx & 63);
                modv[((size_t)layer * 9 + cond) * NMOD + col] = s + AIN(I_BMOD)[layer * NMOD + col]; }
            __syncthreads();
        }
        for (int idx = bx * 512 + tid; idx < 3072 + 2 * 8 * 4 * 3 * 64; idx += G * 512) {
            if (idx < 1024) { const int pos = idx >> 4, f = idx & 15; const float inv = powf(10000.f, -(float)(2 * f) / 32.f); float s, c; sincosf((float)pos * inv, &s, &c); tab64[idx] = (f32x2){c, s}; }
            else if (idx < 3072) { const int i2 = idx - 1024, pos = i2 >> 5, f = i2 & 31; const float inv = powf(10000.f, -(float)(2 * f) / 64.f); float s, c; sincosf((float)pos * inv, &s, &c); tab128[i2] = (f32x2){c, s}; }
            else { const int i2 = idx - 3072, ln = i2 & 63, nb = (i2 >> 6) % 3, s = ((i2 >> 6) / 3) & 3, w = ((i2 >> 6) / 12) & 7, l = (i2 >> 6) / 96;
                const int k0 = 128 * w + 32 * s + 8 * (ln >> 4), o = nb * 16 + (ln & 15); float wv_[8];
#pragma unroll
                for (int j = 0; j < 8; ++j) wv_[j] = o < 4 ? AIN(I_WGRP)[(size_t)l * DM * 4 + (k0 + j) * 4 + o] : (o < 36 ? AIN(I_WRT)[(size_t)l * DM * 32 + (k0 + j) * 32 + (o - 4)] : 0.f);
                unsigned hi_[4], lo_[4];
#pragma unroll
                for (int j = 0; j < 4; ++j) { hi_[j] = cvtpk(wv_[2 * j], wv_[2 * j + 1]); lo_[j] = cvtpk(wv_[2 * j] - bf_lo(hi_[j]), wv_[2 * j + 1] - bf_hi(hi_[j])); }
                bf16_t* dst = wrs + ((size_t)(((l * 8 + w) * 4 + s) * 3 + nb) * 2) * 512 + ln * 8;
                *(v4u*)dst = (v4u){hi_[0], hi_[1], hi_[2], hi_[3]}; *(v4u*)(dst + 512) = (v4u){lo_[0], lo_[1], lo_[2], lo_[3]}; }
        }
        LAS float* scr = (LAS float*)(ldsl + wave * 16384);
        constexpr int S0 = 16 * 96, S1 = 16 * 32, S2 = 16 * 48, S3 = 16 * 32, S4 = NEXP * 384;
        for (int it = gw; it < S0 + S1 + S2 + S3; it += NGW) {
            int r = it;
            if (r < S0) { const int n0 = (r % 96) * 32; const bool kcol = (n0 >= 1024 && n0 < 2048);
                transpose_item(AIN(I_DWQKV), NQKV0, wqkv0, DM, kcol ? (n0 & ~255) + ((n0 >> 6) & 3) * 32 + ((n0 >> 5) & 1) * 16 : n0, (r / 96) * 64, n0, scr, lane, kcol ? 128 : 16); continue; } r -= S0;
            if (r < S1) { transpose_item(AIN(I_DWO), DM, wo0, DM, (r % 32) * 32, (r / 32) * 64, (r % 32) * 32, scr, lane); continue; } r -= S1;
            if (r < S2) { const int n0 = (r % 48) * 32; const bool kcol = (n0 >= 1024 && n0 < 1280);
                transpose_item(AIN(I_GWQKV), NQKV1, wqkv1, DM, kcol ? 1024 + ((n0 >> 5) & 1) * 128 + ((n0 >> 7) & 1) * 64 + ((n0 >> 6) & 1) * 32 : n0, (r / 48) * 64, n0, scr, lane); continue; } r -= S2;
            if (r < S3) { transpose_item(AIN(I_GWO), DM, wo1, DM, (r % 32) * 32, (r / 32) * 64, (r % 32) * 32, scr, lane); continue; }
        }
        { int it = gw; for (; it + NGW < S4; it += 2 * NGW) moe_weight_pair(ldsl, 0, it, it + NGW, wgu, wd, scr, lane);
          if (it < S4) moe_weight_item(ldsl, 0, it, wgu, wd, scr, lane); }
    }
    GRID_BAR(); }
        for (int rep_ = 0; rep_ < ((REPMASK >> 1) & 1) * REPN + 1; ++rep_) {
    if (PHMASK & (1 << 1)) { PHASE_IDS();
    { const float* xin = AIN(I_X); const float* cin = AIN(I_CTX); const float* mv0 = modv; bf16_t* hb = HB;
    const int per = (MALL + NGW - 1) / NGW; int r0 = gw * per; const int r1 = min((int)MALL, r0 + per);
    for (; r0 + 5 <= r1; r0 += 5) h0_rows<5>(r0, xin, cin, mv0, hb, lane);
    for (; r0 + 4 <= r1; r0 += 4) h0_rows<4>(r0, xin, cin, mv0, hb, lane);
    for (; r0 < r1; ++r0) h0_rows<1>(r0, xin, cin, mv0, hb, lane);
    } }
    GRID_BAR(); }

#pragma unroll
    for (int layer = 0; layer < 2; ++layer) {
#define modl (modv + (size_t)layer * 9 * NMOD)
        const int NQ = layer == 0 ? NQKV0 : NQKV1;
        for (int rep_ = 0; rep_ < ((REPMASK >> 2) & 1) * REPN + 1; ++rep_) {
        if (PHMASK & (1 << 2))
        { PHASE_IDS();
            pg8::Gemm g{HB, layer == 0 ? wqkv0 : wqkv1, MALL, NQ, DM};
            SchedRect S; if (layer == 0) S.init(72, NQKV0, G, bx, 0, 0); else S.init(64, NQKV1, G, bx, 1, 16);
            EpiStoreBf16 E{QKV, NQ, 0xffff, layer == 0 ? tab64 : tab128, layer == 0 ? (const float*)nullptr : AIN(I_GKN), (LAS float*)(ldsl + MISC_OFF + 4096)};
            pg8::gemm_phase<EpiStoreBf16, SchedRect, true, true>(ldsl, g, S, E, wave);
        }
        GRID_BAR(); }
        for (int rep_ = 0; rep_ < ((REPMASK >> 4) & 1) * REPN + 1; ++rep_) {
        if (PHMASK & (1 << 4)) {
        if (layer == 0 && (PHMASK & (1 << 16))) { PHASE_IDS();
            float lam;
            { const float s1 = wave_sum(AIN(I_LQ1)[lane] * AIN(I_LK1)[lane]), s2 = wave_sum(AIN(I_LQ2)[lane] * AIN(I_LK2)[lane]);
              lam = expf(s1) - expf(s2) + LAMBDA_INIT0; }
            const int nH = 1024, base = nH / G, rem = nH % G;
            const int u0 = vcu * base + (vcu < rem ? vcu : rem), cnt = base + (vcu < rem ? 1 : 0);
            for (int i = 0; i < cnt; ++i) {
                const int u = u0 + i, bh = u >> 4, qb = u & 15, b = bh >> 3, h = bh & 7;
                const size_t row0 = (size_t)b * TT + LCT + qb * 128;
                const bf16_t* kb = QKV + (size_t)b * TT * NQKV0 + h * 128;
                att::attn_unit<true>(QKV + row0 * NQKV0 + h * 128, NQKV0, kb + 1024, kb + 2048, NQKV0, TT, HB + row0 * DM + h * 128, DM,
                                     true, qb * 128, tab64, nullptr, AIN(I_SUBG), lam, (char*)lds, wave);
            }
            for (int l = vcu; l < 128; l += G) {
                const int bh = l >> 1, qb = l & 1, b = bh >> 3, h = bh & 7;
                const size_t row0 = (size_t)b * TT + qb * 128;
                const bf16_t* kb = QKV + (size_t)b * TT * NQKV0 + h * 128;
                att::attn_unit<true>(QKV + row0 * NQKV0 + h * 128, NQKV0, kb + 1024, kb + 2048, NQKV0, LCT, HB + row0 * DM + h * 128, DM,
                                     false, 0, tab64, nullptr, AIN(I_SUBG), lam, (char*)lds, wave);
            }
        } else if (PHMASK & (1 << 17)) { PHASE_IDS();
            const int nU = 512, base = nU / G, rem = nU % G;
            const int u0 = vcu * base + (vcu < rem ? vcu : rem), cnt = base + (vcu < rem ? 1 : 0);
            for (int i = 0; i < cnt; ++i) {
                const int u = u0 + i, bh = u >> 3, qb = u & 7, b = bh >> 3, h = bh & 7;
                const size_t row0 = (size_t)b * TT + LCT + qb * 256;
                const bf16_t* kb = QKV + (size_t)b * TT * NQKV1 + (h >> 2) * 128;
                att::attn_unit<false>(QKV + row0 * NQKV1 + h * 128, NQKV1, kb + 1024, kb + 1280, NQKV1, TT, HB + row0 * DM + h * 128, DM,
                                      true, qb * 256, tab128, AIN(I_GQN), nullptr, 0.f, (char*)lds, wave);
            }
        } }
        GRID_BAR(); }
        for (int rep_ = 0; rep_ < ((REPMASK >> 5) & 1) * REPN + 1; ++rep_) {
        if (PHMASK & (1 << 5))
        { PHASE_IDS();
            pg8::Gemm g{HB, layer == 0 ? wo0 : wo1, MALL, DM, DM};
            SchedRect S; if (layer == 0) S.init(72, DM, G, bx, 0, 0); else S.init(64, DM, G, bx, 1, 0);
            if (layer == 0) { EpiResid<false> E{Y, AIN(I_X), AIN(I_CTX), modl, rstats}; pg8::gemm_phase<EpiResid<false>, SchedRect, true, true>(ldsl, g, S, E, wave); }
            else { EpiResid<true> E{Y, out, (const float*)nullptr, modl, rstats}; pg8::gemm_phase<EpiResid<true>, SchedRect, true, true>(ldsl, g, S, E, wave); }
        }
        GRID_BAR(); }
        if (PHMASK & (1 << 6))
        { PHASE_IDS();
            const int TR = layer == 0 ? 72 : 64;
            const f32x2* stq = rstats; const hf_t* Yq = Y; float* outq = out; float* xrcq = XRC; const float* modq = modl; bf16_t* hbq = HB;
            const float* lg = AIN(I_LNMG) + layer * DM; const float* lb = AIN(I_LNMB) + layer * DM;
            const bf16_t* wrs_l = wrs + (size_t)layer * 8 * 4 * 3 * 2 * 512;
            LAS float* red = (LAS float*)ldsl;
            LAS float* logits = (LAS float*)(ldsl + 116736);
            LAS float* stats = (LAS float*)(ldsl + 127232);
            LAS int* lcnt = (LAS int*)(ldsl + 127232 + 576);
            LAS int* lbase = lcnt + 32;
            for (int it = bx; it < 256; it += G) {
                if (tid < 32) lcnt[tid] = 0;
                if (tid < TR) { const int r = row_of(layer, 0, TR, it, tid); const f32x2* sp = stq + (size_t)r * 16; float S = 0.f, Q = 0.f;
#pragma unroll
                    for (int p = 0; p < 16; ++p) { const f32x2 v = sp[p]; S += v.x; Q += v.y; }
                    const float mean = S * (1.f / DM); const float var = fmaxf(Q * (1.f / DM) - mean * mean, 0.f);
                    const float rstd = 1.0f / sqrtf(var + LN_EPS); stats[2 * tid] = mean; stats[2 * tid + 1] = rstd; rowst[r] = (f32x2){mean, rstd}; }
                __syncthreads();
                {
                    const int l15 = lane & 15, kg = lane >> 4;
                    pg8::f32x4 acc[5][3];
#pragma unroll
                    for (int mt = 0; mt < 5; ++mt)
#pragma unroll
                        for (int nb = 0; nb < 3; ++nb) acc[mt][nb] = (pg8::f32x4){0.f, 0.f, 0.f, 0.f};
                    int rrow[5]; float rmean[5], rrstd[5]; int rcond[5];
#pragma unroll
                    for (int mt = 0; mt < 5; ++mt) { const int j = mt * 16 + l15; const bool ok = j < TR; const int r = ok ? row_of(layer, 0, TR, it, j) : row_of(layer, 0, TR, it, 0);
                        const int bb = r / TT, tt = r - bb * TT; rrow[mt] = ok ? r : -1; rmean[mt] = stats[2 * (ok ? j : 0)]; rrstd[mt] = stats[2 * (ok ? j : 0) + 1];
                        rcond[mt] = tt < LCT ? 8 : bb; }
                    const int rfirst = row_of(layer, 0, TR, it, 0);
#define P4_LOADY(YB, S_) do { const int k0_ = 128 * wave + 32 * (S_) + 8 * kg; _Pragma("unroll") for (int mt = 0; mt < 5; ++mt) YB[mt] = *(const v4u*)(Yq + (size_t)(rrow[mt] >= 0 ? rrow[mt] : rfirst) * DM + k0_); } while (0)
#define P4_STEP(YB, S_) do { const int s = (S_); const int k0 = 128 * wave + 32 * s + 8 * kg; \
                        const f32x4 g0 = *(const f32x4*)(lg + k0), g1 = *(const f32x4*)(lg + k0 + 4), b0 = *(const f32x4*)(lb + k0), b1 = *(const f32x4*)(lb + k0 + 4); \
                        bf16x8 bh[3], bl[3]; \
                        _Pragma("unroll") for (int nb = 0; nb < 3; ++nb) { const bf16_t* bp = wrs_l + ((size_t)((wave * 4 + s) * 3 + nb) * 2) * 512 + lane * 8; bh[nb] = *(const bf16x8*)bp; bl[nb] = *(const bf16x8*)(bp + 512); } \
                        _Pragma("unroll") for (int mt = 0; mt < 5; ++mt) { \
                            int co_ = rcond[mt] * NMOD + k0; asm volatile("" : "+v"(co_)); \
                            const float* mv = modq + co_ - k0; \
                            const f32x4 a0 = *(const f32x4*)(mv + 4096 + k0), a1 = *(const f32x4*)(mv + 4096 + k0 + 4), s0 = *(const f32x4*)(mv + 3072 + k0), s1 = *(const f32x4*)(mv + 3072 + k0 + 4); \
                            const v4u yh = YB[mt]; \
                            const f32x4 y0 = {hf_lo(yh.x), hf_hi(yh.x), hf_lo(yh.y), hf_hi(yh.y)}, y1 = {hf_lo(yh.z), hf_hi(yh.z), hf_lo(yh.w), hf_hi(yh.w)}; \
                            const f32x4 x0 = (y0 - rmean[mt]) * rrstd[mt] * g0 + b0, x1 = (y1 - rmean[mt]) * rrstd[mt] * g1 + b1; \
                            f32x4 h0 = x0 * (a0 + 1.0f) + s0, h1 = x1 * (a1 + 1.0f) + s1; \
                            if (rrow[mt] < 0) { h0 = (f32x4){0.f, 0.f, 0.f, 0.f}; h1 = h0; } \
                            v4u hh; hh.x = cvtpk(h0[0], h0[1]); hh.y = cvtpk(h0[2], h0[3]); hh.z = cvtpk(h1[0], h1[1]); hh.w = cvtpk(h1[2], h1[3]); \
                            v4u hl; hl.x = cvtpk(h0[0] - bf_lo(hh.x), h0[1] - bf_hi(hh.x)); hl.y = cvtpk(h0[2] - bf_lo(hh.y), h0[3] - bf_hi(hh.y)); \
                            hl.z = cvtpk(h1[0] - bf_lo(hh.z), h1[1] - bf_hi(hh.z)); hl.w = cvtpk(h1[2] - bf_lo(hh.w), h1[3] - bf_hi(hh.w)); \
                            if (rrow[mt] >= 0) *(v4u*)(hbq + (size_t)rrow[mt] * DM + k0) = hh; \
                            const bf16x8 ah = *reinterpret_cast<const bf16x8*>(&hh), al = *reinterpret_cast<const bf16x8*>(&hl); \
                            _Pragma("unroll") for (int nb = 0; nb < 3; ++nb) { \
                                acc[mt][nb] = __builtin_amdgcn_mfma_f32_16x16x32_bf16(ah, bh[nb], acc[mt][nb], 0, 0, 0); \
                                acc[mt][nb] = __builtin_amdgcn_mfma_f32_16x16x32_bf16(ah, bl[nb], acc[mt][nb], 0, 0, 0); \
                                acc[mt][nb] = __builtin_amdgcn_mfma_f32_16x16x32_bf16(al, bh[nb], acc[mt][nb], 0, 0, 0); } } } while (0)
                    { v4u ya[5], yb[5];
                      P4_LOADY(ya, 0);
#pragma unroll 1
                      for (int s2 = 0; s2 < 4; s2 += 2) {
                          P4_LOADY(yb, s2 + 1); __builtin_amdgcn_sched_barrier(0);
                          P4_STEP(ya, s2); __builtin_amdgcn_sched_barrier(0);
                          P4_LOADY(ya, (s2 + 2) & 3); __builtin_amdgcn_sched_barrier(0);
                          P4_STEP(yb, s2 + 1); __builtin_amdgcn_sched_barrier(0); } }
#undef P4_LOADY
#undef P4_STEP
                    const int ln2 = ltid(wave) & 63; const int l15b = ln2 & 15, kgb = ln2 >> 4;
#pragma unroll
                    for (int mt = 0; mt < 5; ++mt)
#pragma unroll
                        for (int nb = 0; nb < 3; ++nb)
#pragma unroll
                            for (int q = 0; q < 4; ++q) { const int row = mt * 16 + kgb * 4 + q, col = nb * 16 + l15b; if (row < 72 && col < 36) red[wave * 2592 + row * 36 + col] = acc[mt][nb][q]; }
                }
                const int tidc = ltid(wave);
                __syncthreads();
                for (int idx = tidc; idx < 2592; idx += 512) { const int o = idx % 36;
                    float s = o < 4 ? AIN(I_BGRP)[layer * 4 + o] : AIN(I_BRT)[layer * 32 + o - 4];
#pragma unroll
                    for (int w = 0; w < 8; ++w) s += red[w * 2592 + idx];
                    logits[idx] = s; }
                __syncthreads();
                int e1 = 0, e2 = 0, rk1 = 0, rk2 = 0; float G1 = 0.f, G2 = 0.f; int rme = 0;
                if (tidc < TR) {
                    const LAS float* lgt = logits + tidc * 36;
                    int gi = 0; float gm = lgt[0];
#pragma unroll
                    for (int g = 1; g < 4; ++g) { const float v = lgt[g]; if (v > gm) { gm = v; gi = g; } }
                    float gs = 0.f;
#pragma unroll
                    for (int g = 0; g < 4; ++g) gs += expf(lgt[g] - gm);
                    const float gtop = 1.0f / gs;
                    const LAS float* el = lgt + 4 + gi * 8;
                    int i1 = 0; float v1 = el[0];
#pragma unroll
                    for (int e = 1; e < 8; ++e) { const float v = el[e]; if (v > v1) { v1 = v; i1 = e; } }
                    int i2 = -1; float v2 = -3.0e38f;
#pragma unroll
                    for (int e = 0; e < 8; ++e) { const float v = el[e]; if (e != i1 && v > v2) { v2 = v; i2 = e; } }
                    const float ex = expf(v2 - v1); const float w1 = 1.0f / (1.0f + ex), w2 = ex / (1.0f + ex);
                    e1 = gi * 8 + i1; e2 = gi * 8 + i2; G1 = gtop * w1; G2 = gtop * w2;
                    rk1 = atomicAdd((int*)(lcnt + e1), 1); rk2 = atomicAdd((int*)(lcnt + e2), 1);
                    if (layer == 0) rme = it * 72 + tidc; else { const int xi = it * 64 + tidc; rme = (xi >> 11) * TT + LCT + (xi & 2047); }
                }
                __syncthreads();
                if (tidc < 32) { const int n = lcnt[tidc]; lbase[tidc] = n ? (int)__hip_atomic_fetch_add((unsigned*)(ctl + CW_CNT + layer * 32 + tidc), (unsigned)n, RLX_AGENT) : 0; }
                __syncthreads();
                if (tidc < TR) { const int q1 = lbase[e1] + rk1, q2 = lbase[e2] + rk2; tokinfo[rme] = make_int4(e1, q1, e2, q2);
                    int* tkf = tokof; float* gwf = gwof; tkf[(size_t)e1 * ECAP + q1] = rme; tkf[(size_t)e2 * ECAP + q2] = rme; gwf[(size_t)e1 * ECAP + q1] = G1; gwf[(size_t)e2 * ECAP + q2] = G2; }
                __syncthreads();
            }
        }
        GRID_BAR();
        for (int rep_ = 0; rep_ < ((REPMASK >> 8) & 1) * REPN + 1; ++rep_) {
        if (PHMASK & (1 << 8))
        {
            PHASE_IDS();
            LAS unsigned char* tile_e = ldsl + TILEE_OFF; LAS int* rowb = (LAS int*)(ldsl + ROWB_OFF); LAS int* cntl = (LAS int*)(ldsl + ROWB_OFF + 128); LAS int* tbase = (LAS int*)(ldsl + ROWB_OFF + 256);
            if (tid == 0) { int tt = 0;
#pragma unroll 1
                for (int e = 0; e < NEXP; ++e) { const int cnt = (int)__hip_atomic_load((unsigned*)(ctl + CW_CNT + layer * 32 + e), RLX_AGENT); rowb[e] = tt * 256; tbase[e] = tt; cntl[e] = cnt; tt += (cnt + 255) >> 8; }
                tbase[NEXP] = tt; MISC[16] = (unsigned)tt; }
            __syncthreads();
            if (tid < 176) { int e = 0;
#pragma unroll 1
                for (int q = 1; q < NEXP; ++q) e += (tbase[q] <= tid) ? 1 : 0;
                tile_e[tid] = (unsigned char)e; }
            __syncthreads();
            const int ntile = (int)MISC[16];
            pg8::Gemm g{HB, wgu, SORT_ROWS, NEXP * 512, DM};
            SchedExp S{ldsl + TILEE_OFF, 2, ntile * 2, G, bx};
            EpiGateUp E{ACTB, gwof, tbase};
            pg8::GatherA GA{tokof, tbase, cntl, 2, ECAP};
            pg8::gemm_phase<EpiGateUp, SchedExp, true, true, true, pg8::GatherA>(ldsl, g, S, E, wave, GA);
        }
        GRID_BAR(); }
        for (int rep_ = 0; rep_ < ((REPMASK >> 9) & 1) * REPN + 1; ++rep_) {
        if (PHMASK & (1 << 9))
        { PHASE_IDS();
            const int ntile = (int)MISC[16];
            int kdn = FH; asm volatile("" : "+s"(kdn));
            pg8::Gemm g{ACTB, wd, SORT_ROWS, NEXP * 1024, kdn};
            SchedExp S{ldsl + TILEE_OFF, 4, ntile * 4, G, bx};
            EpiStoreBf16 E{FO, DM, 3, (const f32x2*)nullptr, (const float*)nullptr, (LAS float*)nullptr};
            pg8::gemm_phase<EpiStoreBf16, SchedExp, true, true>(ldsl, g, S, E, wave);
        }
        GRID_BAR(); }
        if (PHMASK & (1 << 10))
        { PHASE_IDS();
            const float* fg = AIN(I_LNFG) + layer * DM; const float* fb = AIN(I_LNFB) + layer * DM;
            const int nrows = layer == 0 ? MALL : MXR;
            { const hf_t* Yq = Y; const f32x2* rsq = rowst; const float* mg = AIN(I_LNMG) + layer * DM; const float* mb = AIN(I_LNMB) + layer * DM; const int4* tinfo = tokinfo; const LAS int* rowb = (const LAS int*)(ldsl + ROWB_OFF); const bf16_t* fo = FO; float* outq = out; float* xrcq = XRC; const float* modq = modl; const float* modn = modv + (size_t)9 * NMOD; bf16_t* hbq = HB;
              if (layer == 0) {
                  const int per = (nrows + NGW - 1) / NGW; int idx0 = gw * per; const int i1 = min(nrows, idx0 + per);
                  for (; idx0 + 3 <= i1; idx0 += 3) p8_rows<3>(idx0, layer, tinfo, rowb, fo, Yq, rsq, mg, mb, outq, xrcq, modq, modn, fg, fb, hbq, lane);
                  for (; idx0 < i1; ++idx0) p8_rows<1>(idx0, layer, tinfo, rowb, fo, Yq, rsq, mg, mb, outq, xrcq, modq, modn, fg, fb, hbq, lane);
              } else
              for (int idx0 = gw * 4; idx0 < nrows; idx0 += NGW * 4) p8_rows<4>(idx0, layer, tinfo, rowb, fo, Yq, rsq, mg, mb, outq, xrcq, modq, modn, fg, fb, hbq, lane); }
            if (layer == 0) {
                LAS float* scr = (LAS float*)(ldsl + wave * 16384);
                { int it = gw; for (; it + NGW < NEXP * 384; it += 2 * NGW) moe_weight_pair(ldsl, 1, it, it + NGW, wgu, wd, scr, lane);
                  if (it < NEXP * 384) moe_weight_item(ldsl, 1, it, wgu, wd, scr, lane); }
                GRID_BAR();
            }
        }
    }
}

#undef out
#undef Y
#undef HS
#undef QKV
#undef HB
#undef ctl
extern "C" void kernel_launch(void* const* d_in, const int* in_sizes, int n_in, void* d_out, int out_size, void* d_ws, size_t ws_size, hipStream_t stream) {
    static int grid = 0;
    if (grid == 0) {
        if (n_in != 28 || in_sizes[0] != MXR * DM || out_size != MXR * DM || ws_size < WS_END) {
            fprintf(stderr, "kernel_launch: unexpected shapes: n_in %d in0 %d out %d ws %zu (need %zu)\n", n_in, n_in > 0 ? in_sizes[0] : -1, out_size, ws_size, (size_t)WS_END); grid = -1; return; }
        int dev = 0, cus = 0, per_cu = 0;
        if (hipGetDevice(&dev) != hipSuccess || hipDeviceGetAttribute(&cus, hipDeviceAttributeMultiprocessorCount, dev) != hipSuccess) { grid = -1; return; }
        if (hipFuncSetAttribute((const void*)fwd_megakernel, hipFuncAttributeMaxDynamicSharedMemorySize, LDS_BYTES) != hipSuccess) { fprintf(stderr, "kernel_launch: hipFuncSetAttribute failed\n"); grid = -1; return; }
        if (hipOccupancyMaxActiveBlocksPerMultiprocessor(&per_cu, (const void*)fwd_megakernel, 512, LDS_BYTES) != hipSuccess || per_cu < 1) { fprintf(stderr, "kernel_launch: occupancy query reports %d\n", per_cu); (void)hipGetLastError(); per_cu = 1; }
        grid = cus;
        if (grid > 256) grid = 256;
    }
    if (grid < 0) return;
    if (hipMemsetAsync((char*)d_ws + WS_CTL, 0, CTL_ZERO_BYTES, stream) != hipSuccess) { fprintf(stderr, "kernel_launch: memset failed\n"); return; }
    Args a{};
    for (int i = 0; i < 28; ++i) a.in[i] = (const float*)d_in[i];
    a.o_ = (float*)d_out; a.w_ = (unsigned char*)d_ws;
    hipLaunchKernelGGL(fwd_megakernel, dim3(grid), dim3(512), LDS_BYTES, stream, a);
    const hipError_t le = hipPeekAtLastError();
    if (le != hipSuccess) fprintf(stderr, "kernel_launch: launch failed: %s\n", hipGetErrorName(le));
}
```

```cpp
#include <hip/hip_runtime.h>
#include <hip/hip_bf16.h>
#include <cstdio>
#include <cstdint>
__device__ __forceinline__ int ltid(int wv) { int l; asm volatile("v_mbcnt_lo_u32_b32 %0, -1, 0\n\tv_mbcnt_hi_u32_b32 %0, -1, %0" : "=v"(l)); return wv * 64 + l; }
namespace pg8 {
#define PG8_LAS __attribute__((address_space(3)))
typedef unsigned short bf16_t;
typedef short bf16x8 __attribute__((ext_vector_type(8)));
typedef float f32x4 __attribute__((ext_vector_type(4)));
typedef unsigned u32x4 __attribute__((ext_vector_type(4)));
constexpr int BM = 256, BK = 64, HALF = 128, HTB = HALF * BK * 2  , STAGE_BYTES = 8 * HTB, NXCD = 8, WGM = 8;

__host__ __device__ __forceinline__ int lds_byte(int r, int c) { const int st = (r >> 4) * 2 + (c >> 5), rr = r & 15, cc = c & 31, ob = rr * 64 + cc * 2; return st * 1024 + (ob ^ (((ob >> 9) & 1) << 5)); }
__host__ __device__ __forceinline__ void stage_rc(int b, int& R, int& C) { const int st = b / 1024, sb = b % 1024, swz = sb ^ (((sb >> 9) & 1) << 5); R = (st >> 1) * 16 + swz / 64; C = (st & 1) * 32 + (swz % 64) / 2; }
__host__ __device__ __forceinline__ int perm32(int rho) { const int n = rho >> 4, i = rho & 15; return 8 * (i >> 2) + 4 * n + (i & 3); }

struct Unit { int pm, pn, hm; };
struct Gemm { const bf16_t* A; const bf16_t* Bt; int M, N, K; };

struct StaticOrder {
    int nM, nN, nwg, G, c;
    __host__ __device__ void init(int M, int N, int G_, int c_) { nM = M / BM; nN = N / BM; nwg = nM * nN; G = G_; c = c_; }
    __host__ __device__ bool next(int i, Unit& u) const { return at((long)i * G + c, u); }
    __host__ __device__ bool at(const long L, Unit& u) const {
        if (L >= nwg) return false; u.hm = 0;
        int wgid = (int)L; { const int q = nwg / NXCD, r = nwg % NXCD, xcd = wgid % NXCD, off = wgid / NXCD; wgid = (xcd < r ? xcd * (q + 1) : r * (q + 1) + (xcd - r) * q) + off; }
        const int nig = WGM * nN, gid = wgid / nig, fm = gid * WGM, gsz = (nM - fm) < WGM ? (nM - fm) : WGM;
        u.pm = fm + ((wgid % nig) % gsz); u.pn = (wgid % nig) / gsz; return true;
    }
    __device__ __forceinline__ void a_ready(const Unit&) const {}
    __device__ __forceinline__ void done(const Unit&) const {}
};

__device__ __forceinline__ unsigned cvt_pk_bf16(float lo, float hi) { unsigned r; asm volatile("v_cvt_pk_bf16_f32 %0, %1, %2" : "=v"(r) : "v"(lo), "v"(hi)); return r; }
typedef float f32x2 __attribute__((ext_vector_type(2)));
struct NoGather {};
struct GatherA { const int* tok; const PG8_LAS int* tbase; const PG8_LAS int* cnt; int NP, cap; };
template <class Epi, class Sched, bool ALIGN_EPI = false, bool SP2 = false, bool GATHER = false, class GAT = NoGather>
__device__ __forceinline__ void gemm_phase(PG8_LAS unsigned char* lds, const Gemm g, const Sched& S, const Epi& E, const int wv, const GAT& GA = GAT()) {
    static_assert(!GATHER || SP2, "gather staging is written for the SP2 loop");
    const int tid = ltid(wv), wid = wv, lane = tid & 63, wr = wid >> 2, wc = wid & 3, fr = lane & 15, fq = lane >> 4;
    const int K = g.K, nt = K / BK;
    unsigned voffA[2], voffB[2];
#pragma unroll
    for (int i = 0; i < 2; ++i) { int R, C; stage_rc(tid * 16 + i * 8192, R, C); const int Rb = Epi::PERM ? ((R & ~31) + perm32(R & 31)) : R;
        voffA[i] = (unsigned)(R * K + C) * 2u; voffB[i] = (unsigned)(Rb * K + C) * 2u; }
    const size_t kstep = (size_t)(BK * 2);
    const size_t hstep = (size_t)HALF * K * 2;
    const size_t tstep = 2 * hstep;
    const unsigned ldsw = (unsigned)wid * 1024u;
    const int aoff = lds_byte(wr * 64 + fr, fq * 8), boff = lds_byte(wc * 32 + fr, fq * 8);
#define PG8_SA(b, h) (((b) * 2 + (h)) * HTB)
#define PG8_SB(b, h) ((4 + (b) * 2 + (h)) * HTB)
#define PG8_STAGE(bufoff, gbase, voff) do { _Pragma("unroll") for (int _i = 0; _i < 2; ++_i) \
        __builtin_amdgcn_global_load_lds((const unsigned*)((const char*)(gbase) + (voff)[_i]), (PG8_LAS unsigned*)(lds + (bufoff) + ldsw + _i * 8192), 16, 0, 0); } while (0)
#define PG8_STAGE_A(bufoff, ngptr, h, kofs, GV) do { if constexpr (GATHER) { PG8_STAGE(bufoff, (const char*)g.A + (kofs), GV[h]); } else { PG8_STAGE(bufoff, ngptr, voffA); } } while (0)
#define PG8_GOFS(dst, U) do { if constexpr (GATHER) { const int e_ = (U).pn / GA.NP; const int rk0_ = ((U).pm - GA.tbase[e_]) * 256; const int c_ = GA.cnt[e_]; \
        _Pragma("unroll") for (int h_ = 0; h_ < 2; ++h_) _Pragma("unroll") for (int i_ = 0; i_ < 2; ++i_) { int R_, C_; stage_rc(tid * 16 + i_ * 8192, R_, C_); const int rk_ = rk0_ + h_ * 128 + R_; \
            const int tk_ = rk_ < c_ ? GA.tok[(size_t)e_ * GA.cap + rk_] : 0; dst[h_][i_] = (unsigned)(tk_ * K + C_) * 2u; } } } while (0)
#define PG8_LDA(dst, b, h) do { _Pragma("unroll") for (int m = 0; m < 4; ++m) _Pragma("unroll") for (int k = 0; k < 2; ++k) dst[m][k] = *(const PG8_LAS bf16x8*)(lds + PG8_SA(b, h) + aoff + m * 2048 + k * 1024); } while (0)
#define PG8_LDB(dst, b, h) do { _Pragma("unroll") for (int n = 0; n < 2; ++n) _Pragma("unroll") for (int k = 0; k < 2; ++k) dst[n][k] = *(const PG8_LAS bf16x8*)(lds + PG8_SB(b, h) + boff + n * 2048 + k * 1024); } while (0)
#define PG8_MMA(ai, bj, At, Bt) do { if (cur.hm != 0 && cur.hm != (ai) + 1) break; __builtin_amdgcn_s_setprio(1); _Pragma("unroll") for (int m = 0; m < 4; ++m) _Pragma("unroll") for (int n = 0; n < 2; ++n) _Pragma("unroll") for (int k = 0; k < 2; ++k) \
        acc[ai][bj][m][n] = __builtin_amdgcn_mfma_f32_16x16x32_bf16(Bt[n][k], At[m][k], acc[ai][bj][m][n], 0, 0, 0); __builtin_amdgcn_s_setprio(0); } while (0)
#define PG8_WAIT_V(n) asm volatile("s_waitcnt vmcnt(" #n ")" ::: "memory")
#define PG8_WAIT_L(n) asm volatile("s_waitcnt lgkmcnt(" #n ")" ::: "memory")
#define PG8_BAR __builtin_amdgcn_s_barrier()
#define PG8_SCHED __builtin_amdgcn_sched_barrier(0)
    Unit cur, nxt; int ui = 0;
    if (!S.next(0, cur)) return;
    f32x4 acc[2][2][4][2];
#pragma unroll
    for (int a = 0; a < 2; ++a)
#pragma unroll
        for (int b = 0; b < 2; ++b)
#pragma unroll
            for (int m = 0; m < 4; ++m)
#pragma unroll
                for (int n = 0; n < 2; ++n) acc[a][b][m][n] = (f32x4){0.f, 0.f, 0.f, 0.f};
    bf16x8 At[4][2], B0[2][2], B1[2][2];
    const char* cA = (const char*)g.A + (size_t)cur.pm * tstep; const char* cB = (const char*)g.Bt + (size_t)cur.pn * tstep;
    S.a_ready(cur);
    unsigned curG[2][2] = {{0u, 0u}, {0u, 0u}}, nxtG[2][2] = {{0u, 0u}, {0u, 0u}};
    PG8_GOFS(curG, cur); { Unit n0_; if (S.next(1, n0_)) PG8_GOFS(nxtG, n0_); }
    if constexpr (SP2) {
        PG8_STAGE(PG8_SB(0, 0), cB, voffB); PG8_STAGE(PG8_SB(0, 1), cB + hstep, voffB); PG8_STAGE_A(PG8_SA(0, 0), cA, 0, (size_t)0, curG); PG8_STAGE_A(PG8_SA(0, 1), cA + hstep, 1, (size_t)0, curG);
        if (wr == 1) PG8_BAR;
        PG8_WAIT_V(2); PG8_BAR;
        PG8_STAGE(PG8_SB(1, 0), cB + kstep, voffB); PG8_STAGE_A(PG8_SA(1, 0), cA + kstep, 0, kstep, curG); PG8_STAGE(PG8_SB(1, 1), cB + hstep + kstep, voffB);
        PG8_WAIT_V(6); PG8_BAR;
    } else {
        PG8_STAGE(PG8_SB(0, 0), cB, voffB); PG8_STAGE(PG8_SA(0, 0), cA, voffA); PG8_STAGE(PG8_SB(0, 1), cB + hstep, voffB); PG8_STAGE(PG8_SA(0, 1), cA + hstep, voffA);
        if (wr == 1) PG8_BAR;
        PG8_WAIT_V(4); PG8_BAR;
        PG8_STAGE(PG8_SB(1, 0), cB + kstep, voffB); PG8_STAGE(PG8_SA(1, 0), cA + kstep, voffA); PG8_STAGE(PG8_SB(1, 1), cB + hstep + kstep, voffB);
        PG8_WAIT_V(6); PG8_BAR;
    }
    for (;;) {
        const bool has_next = S.next(ui + 1, nxt);
        if (GATHER && has_next && ui >= 1) PG8_GOFS(nxtG, nxt);
        const char* nA = has_next ? (const char*)g.A + (size_t)nxt.pm * tstep : cA; const char* nB = has_next ? (const char*)g.Bt + (size_t)nxt.pn * tstep : cB;
        for (int t = 0; t < nt; t += 2) {
            const bool last = (t == nt - 2);
            const char* a1 = cA + (size_t)(t + 1) * kstep;
            const char* a2 = last ? nA : cA + (size_t)(t + 2) * kstep; const char* b2 = last ? nB : cB + (size_t)(t + 2) * kstep;
            const char* a3 = a2 + kstep; const char* b3 = b2 + kstep;
            if (last && has_next) S.a_ready(nxt);
            const size_t k1o = (size_t)(t + 1) * kstep, k2o = last ? (size_t)0 : (size_t)(t + 2) * kstep; unsigned selG[2][2];
            _Pragma("unroll") for (int h_ = 0; h_ < 2; ++h_) _Pragma("unroll") for (int i_ = 0; i_ < 2; ++i_) selG[h_][i_] = (last && has_next) ? nxtG[h_][i_] : curG[h_][i_];
            if constexpr (SP2) {
            PG8_LDB(B0, 0, 0); PG8_LDB(B1, 0, 1); PG8_SCHED; PG8_LDA(At, 0, 0); PG8_STAGE_A(PG8_SA(1, 1), a1 + hstep, 1, k1o, curG);
            PG8_WAIT_V(8); PG8_WAIT_L(0); PG8_BAR; PG8_MMA(0, 0, At, B0); PG8_MMA(0, 1, At, B1); PG8_BAR; PG8_SCHED;
            PG8_LDA(At, 0, 1); PG8_STAGE(PG8_SB(0, 0), b2, voffB); PG8_STAGE(PG8_SB(0, 1), b2 + hstep, voffB); PG8_STAGE_A(PG8_SA(0, 0), a2, 0, k2o, selG);
            PG8_WAIT_V(8); PG8_WAIT_L(0); PG8_BAR; PG8_MMA(1, 0, At, B0); PG8_MMA(1, 1, At, B1); PG8_BAR; PG8_SCHED;
            PG8_LDB(B0, 1, 0); PG8_LDB(B1, 1, 1); PG8_SCHED; PG8_LDA(At, 1, 0); PG8_STAGE_A(PG8_SA(0, 1), a2 + hstep, 1, k2o, selG);
            PG8_WAIT_V(8); PG8_WAIT_L(0); PG8_BAR; PG8_MMA(0, 0, At, B0); PG8_MMA(0, 1, At, B1); PG8_BAR; PG8_SCHED;
            PG8_LDA(At, 1, 1); PG8_STAGE(PG8_SB(1, 0), b3, voffB); PG8_STAGE(PG8_SB(1, 1), b3 + hstep, voffB); PG8_STAGE_A(PG8_SA(1, 0), a3, 0, k2o + kstep, selG);
            PG8_WAIT_V(8); PG8_WAIT_L(0); PG8_BAR; PG8_MMA(1, 0, At, B0); PG8_MMA(1, 1, At, B1); PG8_BAR; PG8_SCHED;
            } else {
            PG8_LDB(B0, 0, 0); PG8_SCHED; PG8_LDA(At, 0, 0); PG8_STAGE(PG8_SA(1, 1), a1 + hstep, voffA);
            PG8_WAIT_L(8); PG8_BAR; PG8_WAIT_L(0); PG8_MMA(0, 0, At, B0); PG8_BAR; PG8_SCHED;
            PG8_LDB(B1, 0, 1); PG8_STAGE(PG8_SB(0, 0), b2, voffB);
            PG8_BAR; PG8_WAIT_L(0); PG8_MMA(0, 1, At, B1); PG8_BAR;
            PG8_LDA(At, 0, 1); PG8_STAGE(PG8_SA(0, 0), a2, voffA);
            PG8_BAR; PG8_WAIT_L(0); PG8_MMA(1, 0, At, B0); PG8_BAR; PG8_SCHED;
            PG8_STAGE(PG8_SB(0, 1), b2 + hstep, voffB);
            PG8_WAIT_V(6); PG8_BAR; PG8_MMA(1, 1, At, B1); PG8_BAR;
            PG8_LDB(B0, 1, 0); PG8_SCHED; PG8_LDA(At, 1, 0); PG8_STAGE(PG8_SA(0, 1), a2 + hstep, voffA);
            PG8_WAIT_L(8); PG8_BAR; PG8_WAIT_L(0); PG8_MMA(0, 0, At, B0); PG8_BAR; PG8_SCHED;
            PG8_LDB(B1, 1, 1); PG8_STAGE(PG8_SB(1, 0), b3, voffB);
            PG8_BAR; PG8_WAIT_L(0); PG8_MMA(0, 1, At, B1); PG8_BAR;
            PG8_LDA(At, 1, 1); PG8_STAGE(PG8_SA(1, 0), a3, voffA);
            PG8_BAR; PG8_WAIT_L(0); PG8_MMA(1, 0, At, B0); PG8_BAR; PG8_SCHED;
            PG8_STAGE(PG8_SB(1, 1), b3 + hstep, voffB);
            PG8_WAIT_V(6); PG8_BAR; PG8_MMA(1, 1, At, B1); PG8_BAR;
            }
        }
        if constexpr (ALIGN_EPI) { if (wr == 0) PG8_BAR; }
        if constexpr (!Epi::AFTER_DRAIN) { E(acc, cur, wr, wc, fr, fq); S.done(cur); }
        if (!has_next) break;
#pragma unroll
        for (int a = 0; a < 2; ++a)
#pragma unroll
            for (int b = 0; b < 2; ++b)
#pragma unroll
                for (int m = 0; m < 4; ++m)
#pragma unroll
                    for (int n = 0; n < 2; ++n) acc[a][b][m][n] = (f32x4){0.f, 0.f, 0.f, 0.f};
        cur = nxt; cA = nA; cB = nB; ++ui;
        _Pragma("unroll") for (int h_ = 0; h_ < 2; ++h_) _Pragma("unroll") for (int i_ = 0; i_ < 2; ++i_) curG[h_][i_] = nxtG[h_][i_];
        if constexpr (ALIGN_EPI) { if (wr == 1) PG8_BAR; }
    }
    PG8_WAIT_V(0);
    if constexpr (!ALIGN_EPI) { if (wr == 0) PG8_BAR; }
    PG8_BAR;
    if constexpr (Epi::AFTER_DRAIN) { E.fused(acc, cur, wr, wc, fr, fq, lds, wid, lane); S.done(cur); }
#undef PG8_SA
#undef PG8_SB
#undef PG8_STAGE
#undef PG8_LDA
#undef PG8_STAGE_A
#undef PG8_GOFS
#undef PG8_LDB
#undef PG8_MMA
#undef PG8_WAIT_V
#undef PG8_WAIT_L
#undef PG8_BAR
#undef PG8_SCHED
}
}

constexpr int NB = 8, NXT = 2048, LCT = 256, TT = 2304, DM = 1024;
constexpr int MALL = NB * TT;
constexpr int MXR = NB * NXT;
constexpr int NQKV0 = 3072, NQKV1 = 1536;
constexpr int NEXP = 32, FH = 256, NMOD = 6144;
constexpr float ALPHA = 1.41421356237309515f;
constexpr float LAMBDA_INIT0 = 0.2f;
constexpr float LN_EPS = 1e-5f, RMS_EPS = 1e-6f;
constexpr int SORT_ROWS = 45056;

#define GAS __attribute__((address_space(1)))
#define LAS __attribute__((address_space(3)))
typedef unsigned short bf16_t;
typedef unsigned v4u __attribute__((ext_vector_type(4)));
typedef unsigned v2u __attribute__((ext_vector_type(2)));
typedef float f32x4 __attribute__((ext_vector_type(4)));
typedef float f32x2 __attribute__((ext_vector_type(2)));
typedef short bf16x8 __attribute__((ext_vector_type(8)));
typedef short s16x4 __attribute__((ext_vector_type(4)));
typedef float f32x16 __attribute__((ext_vector_type(16)));
typedef GAS unsigned gu32;
#define RLX_AGENT __ATOMIC_RELAXED, __HIP_MEMORY_SCOPE_AGENT
#define LDS_WAIT() asm volatile("s_waitcnt lgkmcnt(0)" ::: "memory")
#define VM_WAIT() asm volatile("s_waitcnt vmcnt(0)" ::: "memory")

constexpr size_t MiB = 1u << 20;
constexpr size_t WS_CTL = 0, CTL_ZERO_BYTES = 1 * MiB;
constexpr size_t WS_MOD = 1 * MiB;
constexpr size_t WS_TAB64 = 1 * MiB + 512 * 1024;
constexpr size_t WS_TAB128 = WS_TAB64 + 8192;
constexpr size_t WS_WRT = WS_TAB64 + 65536;
constexpr size_t WS_TOKINFO = 2 * MiB;
constexpr size_t WS_TOKW = WS_TOKINFO + (size_t)MALL * 16;
constexpr size_t WS_TOKPOS = WS_TOKW + (size_t)MALL * 8;
constexpr size_t WS_GW = 3 * MiB;
constexpr size_t WS_XRC = 4 * MiB;
constexpr size_t WS_WQKV0 = 12 * MiB, WS_WO0 = 18 * MiB, WS_WQKV1 = 20 * MiB, WS_WO1 = 23 * MiB;
constexpr size_t WS_WGU = 26 * MiB;
constexpr size_t WS_WD = 58 * MiB;
constexpr size_t WS_HBUF = 74 * MiB;
constexpr size_t WS_QKV = 110 * MiB;
constexpr size_t WS_Y = 218 * MiB;
constexpr size_t WS_TOKOF = 306 * MiB;
constexpr size_t WS_GWOF = 309 * MiB;
constexpr int ECAP = 18432;
constexpr size_t WS_STATS = 312 * MiB;
constexpr size_t WS_ROWST = 315 * MiB;
constexpr size_t WS_YOFF = WS_QKV + 24 * MiB;
constexpr size_t WS_WRS = 316 * MiB;
constexpr size_t WS_END = 317 * MiB;
static_assert(WS_TOKPOS + (size_t)MALL * 8 <= WS_GW && WS_GW + SORT_ROWS * 4 <= WS_XRC && WS_XRC + 2048 * 4096 <= WS_WQKV0, "ws map");
static_assert(WS_YOFF + (size_t)MALL * DM * 4 <= WS_Y && (size_t)SORT_ROWS * FH * 2 <= 24 * MiB && WS_QKV + (size_t)MALL * 3072 * 2 <= WS_Y && WS_Y + (size_t)SORT_ROWS * 2048 <= WS_END && WS_HBUF + (size_t)MALL * 2048 <= WS_QKV, "ws map");
constexpr int CW_BAR = 4096;
constexpr int CW_CNT = 8192;

constexpr int RING_BYTES = 131072;
constexpr int MISC_OFF = 139264;
constexpr int TILEE_OFF = MISC_OFF + 256;
constexpr int ROWB_OFF = MISC_OFF + 512;
constexpr int LDS_BYTES = 147456;

__device__ __forceinline__ unsigned cvtpk(float lo, float hi) { unsigned r; asm volatile("v_cvt_pk_bf16_f32 %0, %1, %2" : "=v"(r) : "v"(lo), "v"(hi)); return r; }
__device__ __forceinline__ float bf_lo(unsigned u) { return __uint_as_float(u << 16); }
__device__ __forceinline__ float bf_hi(unsigned u) { return __uint_as_float(u & 0xffff0000u); }
template <int M> __device__ __forceinline__ float xsum(float v) {
    if constexpr (M < 32) return v + __int_as_float(__builtin_amdgcn_ds_swizzle(__float_as_int(v), (M << 10) | 0x1f));
    else { auto rr = __builtin_amdgcn_permlane32_swap(__float_as_uint(v), __float_as_uint(v), false, false); return __uint_as_float(rr[0]) + __uint_as_float(rr[1]); }
}
__device__ __forceinline__ float sum32(float v) { v = xsum<1>(v); v = xsum<2>(v); v = xsum<4>(v); v = xsum<8>(v); v = xsum<16>(v); return v; }
__device__ __forceinline__ float wave_sum(float v) { return xsum<32>(sum32(v)); }
__device__ __forceinline__ int row_b(int r) { return r / TT; }
__device__ __forceinline__ float* xr_ptr(float* out, float* xrc, int r) {
    const int b = r / TT, t = r - b * TT;
    return t < LCT ? xrc + ((size_t)b * LCT + t) * DM : out + ((size_t)b * NXT + (t - LCT)) * DM;
}
__device__ __forceinline__ const float* in0_ptr(const float* x, const float* ctx, int r) {
    const int b = r / TT, t = r - b * TT;
    return t < LCT ? ctx + ((size_t)b * LCT + t) * DM : x + ((size_t)b * NXT + (t - LCT)) * DM;
}

#define XB_TMO      128
#define XB_XCNT(j)  (256  + 64 * (j))
#define XB_XSUB(j)  (1280 + 64 * (j))
#define XB_XGEN(j)  (2304 + 64 * (j))
#define XB_TOP      3328
#define XB_TOPGEN   3392
#define XCD_BAR_WORDS 3456
#define XB_SPIN_CAP (1u << 18)
__device__ __forceinline__ unsigned xb_ld(unsigned* p)              { return __hip_atomic_load(p, __ATOMIC_RELAXED, __HIP_MEMORY_SCOPE_AGENT); }
__device__ __forceinline__ unsigned xb_add(unsigned* p, unsigned v) { return __hip_atomic_fetch_add(p, v, __ATOMIC_RELAXED, __HIP_MEMORY_SCOPE_AGENT); }
__device__ __forceinline__ unsigned xb_xcc_id() { return (unsigned)__builtin_amdgcn_s_getreg((3 << 11) | 20) & 0xFu; }
#define XB_SPIN(cond, bar) do { unsigned _sp = 0; while (cond) { __builtin_amdgcn_s_sleep(1); \
    if ((++_sp & 255u) == 0u) { if (xb_ld(&(bar)[XB_TMO])) break; if (_sp > XB_SPIN_CAP) { atomicAdd(&(bar)[XB_TMO], 1u); break; } } } } while (0)
__device__ __forceinline__ void xcd_barrier_post(unsigned* bar) {
    const unsigned x = xb_xcc_id();
    if (threadIdx.x == 0) (void)xb_add(&bar[XB_XCNT(x)], 1u);
}
__device__ __forceinline__ void xcd_barrier_complete(unsigned* bar, unsigned x, unsigned& nloc, unsigned& nx) {
    const unsigned G = gridDim.x * gridDim.y * gridDim.z;
    unsigned sum, cnt, mine, sp = 0u;
    for (;;) {
        sum = 0u; cnt = 0u; mine = 0u;
#pragma unroll
        for (unsigned j = 0; j < 16; ++j) { const unsigned c = xb_ld(&bar[XB_XCNT(j)]); sum += c; cnt += (c > 0u) ? 1u : 0u; mine = (j == x) ? c : mine; }
        if (sum == G) break;
        __builtin_amdgcn_s_sleep(1);
        if ((++sp & 255u) == 0u) { if (xb_ld(&bar[XB_TMO])) break; if (sp > XB_SPIN_CAP) { atomicAdd(&bar[XB_TMO], 1u); break; } }
    }
    nloc = mine > 0u ? mine : 1u; nx = cnt > 0u ? cnt : 1u;
}
__device__ __forceinline__ void xcd_barrier(unsigned* bar_in, volatile LAS unsigned* st, bool leader) {
    asm volatile("s_waitcnt vmcnt(0)" ::: "memory");
    __syncthreads();
    if (leader) {
        unsigned* bar = bar_in;
        unsigned bx_ = xb_xcc_id(); asm volatile("" : "+s"(bx_));
        __builtin_amdgcn_s_waitcnt(0);
        unsigned nloc = st[0], nx = st[1];
        if (nloc == 0u) { xcd_barrier_complete(bar, bx_, nloc, nx); st[0] = nloc; st[1] = nx; }
        const unsigned old = xb_add(&bar[XB_XSUB(bx_)], 1u);
        const unsigned gen = old / nloc;
        if (old + 1u == (gen + 1u) * nloc) {
            __builtin_amdgcn_fence(__ATOMIC_RELEASE, "agent");
            asm volatile("s_waitcnt vmcnt(0)" ::: "memory");
            const unsigned og = xb_add(&bar[XB_TOP], 1u);
            const unsigned tg = og / nx;
            if (og + 1u == (tg + 1u) * nx) xb_add(&bar[XB_TOPGEN], 1u);
            else XB_SPIN(xb_ld(&bar[XB_TOPGEN]) == tg, bar);
            __builtin_amdgcn_fence(__ATOMIC_ACQUIRE, "agent");
            asm volatile("s_waitcnt vmcnt(0)" ::: "memory");
        } else {
            XB_SPIN(xb_ld(&bar[XB_TOPGEN]) == gen, bar);
            __builtin_amdgcn_fence(__ATOMIC_ACQUIRE, "agent");
            asm volatile("s_waitcnt vmcnt(0)" ::: "memory");
        }
    }
    __syncthreads();
}

struct SchedRect {
    pg8::StaticOrder so; int xonly, n_extra, G, c, full, rsplit;
    __device__ void init(int nMt, int N, int G_, int c_, int xonly_, int n_extra_) { so.init(nMt * 256, N, G_, c_); xonly = xonly_; n_extra = n_extra_; G = G_; c = c_;
        const int r = so.nwg % G; full = so.nwg - r; rsplit = (n_extra == 0 && r > 0 && 2 * r <= G) ? r : 0; }
    __device__ bool next(int i, pg8::Unit& u) const {
        const long L = (long)i * G + c;
        if (rsplit && L >= full) { const int j = (int)(L - full); if (j >= 2 * rsplit) return false;
            so.at(full + (j >> 1), u); u.hm = 1 + (j & 1); if (xonly) u.pm = (u.pm >> 3) * 9 + 1 + (u.pm & 7); return true; }
        if (L < so.nwg) { so.at(L, u); if (xonly) u.pm = (u.pm >> 3) * 9 + 1 + (u.pm & 7); return true; }
        const int j = (int)(L - so.nwg); if (j >= n_extra) return false;
        u.pm = (j >> 1) * 9; u.pn = 4 + (j & 1); u.hm = 0; return true;
    }
    __device__ __forceinline__ void a_ready(const pg8::Unit&) const {}
    __device__ __forceinline__ void done(const pg8::Unit&) const {}
};
struct SchedExp {
    const LAS unsigned char* tile_e; int NP, nunits, G, c;
    __device__ bool next(int i, pg8::Unit& u) const {
        long L = (long)i * G + c; int hm = 0;
        const int rr = nunits % G, full = nunits - rr;
        if (rr > 0 && 2 * rr <= G && L >= full) { const int j = (int)(L - full); if (j >= 2 * rr) return false; L = full + (j >> 1); hm = 1 + (j & 1); }
        if (L >= nunits) return false;
        const int q = nunits / 8, r = nunits % 8, xcd = (int)(L % 8), off = (int)(L / 8);
        const int Lr = (xcd < r ? xcd * (q + 1) : r * (q + 1) + (xcd - r) * q) + off;
        const int tm = Lr / NP, pl = Lr % NP;
        u.pm = tm; u.pn = (int)tile_e[tm] * NP + pl; u.hm = hm; return true;
    }
    __device__ __forceinline__ void a_ready(const pg8::Unit&) const {}
    __device__ __forceinline__ void done(const pg8::Unit&) const {}
};

struct EpiStoreBf16 {
    static constexpr bool PERM = true, AFTER_DRAIN = false;
    bf16_t* O; int ldc; int pn_mask; const f32x2* tab; const float* kg; LAS float* xch;
    __device__ __forceinline__ void operator()(const pg8::f32x4 (&acc)[2][2][4][2], const pg8::Unit& u, int wr, int wc, int fr_in, int fq_in) const {
        int fr = fr_in, fq = fq_in; asm volatile("" : "+v"(fr), "+v"(fq));
        const int row0 = u.pm * 256 + wr * 64 + fr;
        if (kg == nullptr && tab != nullptr && u.pn >= 4 && u.pn < 8) {
            const int tj = u.pm % 9; const bool lat = tj != 0; const int nbase = (tj - 1) * 256 + wr * 64 + fr;
            const int ax = fq >> 1, f0 = (fq & 1) * 8; const int col0 = u.pn * 256 + wc * 64 + ax * 32 + f0;
#pragma unroll
            for (int ai = 0; ai < 2; ++ai) { if (u.hm != 0 && u.hm != ai + 1) continue;
#pragma unroll
                for (int m = 0; m < 4; ++m) { bf16_t* rowp = O + (size_t)(row0 + ai * 128 + m * 16) * ldc + col0;
                    float x1[8], x2[8];
#pragma unroll
                    for (int n = 0; n < 2; ++n)
#pragma unroll
                        for (int q = 0; q < 4; ++q) { x1[n * 4 + q] = acc[ai][0][m][n][q]; x2[n * 4 + q] = acc[ai][1][m][n][q]; }
                    if (lat) { const int nr = nbase + ai * 128 + m * 16; const int pos = ax ? (nr & 63) : (nr >> 6);
                        const pg8::f32x4* tp = (const pg8::f32x4*)(tab + pos * 16 + f0);
#pragma unroll
                        for (int q = 0; q < 4; ++q) { const pg8::f32x4 cs = tp[q];
                            const float a0 = x1[2 * q], b0 = x2[2 * q], a1 = x1[2 * q + 1], b1 = x2[2 * q + 1];
                            x1[2 * q] = a0 * cs[0] - b0 * cs[1]; x2[2 * q] = b0 * cs[0] + a0 * cs[1];
                            x1[2 * q + 1] = a1 * cs[2] - b1 * cs[3]; x2[2 * q + 1] = b1 * cs[2] + a1 * cs[3]; } }
                    v4u w; w.x = cvtpk(x1[0], x1[1]); w.y = cvtpk(x1[2], x1[3]); w.z = cvtpk(x1[4], x1[5]); w.w = cvtpk(x1[6], x1[7]);
                    *(v4u*)rowp = w;
                    w.x = cvtpk(x2[0], x2[1]); w.y = cvtpk(x2[2], x2[3]); w.z = cvtpk(x2[4], x2[5]); w.w = cvtpk(x2[6], x2[7]);
                    *(v4u*)(rowp + 16) = w; } }
            return;
        }
        if (kg != nullptr && u.pn == 4) {
            const int tj = u.pm % 9; const bool lat = tj != 0; const int nbase = (tj - 1) * 256 + wr * 64 + fr;
            const int hl = wc >> 1, ax = wc & 1, f0 = 8 * fq; const int col0k = 1024 + hl * 128 + ax * 64 + f0; const int wid = wr * 4 + wc;
            float ssq[2][4];
#pragma unroll
            for (int ai = 0; ai < 2; ++ai)
#pragma unroll
                for (int m = 0; m < 4; ++m) { float s = 0.f;
#pragma unroll
                    for (int bj = 0; bj < 2; ++bj)
#pragma unroll
                        for (int n = 0; n < 2; ++n)
#pragma unroll
                            for (int q = 0; q < 4; ++q) s += acc[ai][bj][m][n][q] * acc[ai][bj][m][n][q];
                    s = xsum<16>(s); s = xsum<32>(s);
                    ssq[ai][m] = s; if (fq == 0) xch[wid * 128 + ai * 64 + m * 16 + fr] = s; }
            asm volatile("s_waitcnt lgkmcnt(0)" ::: "memory"); __builtin_amdgcn_s_barrier(); asm volatile("" ::: "memory");
            const float g00 = 0.f; (void)g00;
            pg8::f32x4 gA[2][2];
#pragma unroll
            for (int bj = 0; bj < 2; ++bj)
#pragma unroll
                for (int n = 0; n < 2; ++n) gA[bj][n] = *(const pg8::f32x4*)(kg + ax * 64 + bj * 32 + f0 + 4 * n);
#pragma unroll
            for (int ai = 0; ai < 2; ++ai) { if (u.hm != 0 && u.hm != ai + 1) continue;
#pragma unroll
                for (int m = 0; m < 4; ++m) { bf16_t* rowp = O + (size_t)(row0 + ai * 128 + m * 16) * ldc + col0k;
                    const float tot = ssq[ai][m] + xch[(wid ^ 1) * 128 + ai * 64 + m * 16 + fr];
                    const float rs = 1.0f / sqrtf(tot * (1.f / 128.f) + RMS_EPS);
                    float x1[8], x2[8];
#pragma unroll
                    for (int n = 0; n < 2; ++n)
#pragma unroll
                        for (int q = 0; q < 4; ++q) { x1[n * 4 + q] = acc[ai][0][m][n][q] * rs * gA[0][n][q]; x2[n * 4 + q] = acc[ai][1][m][n][q] * rs * gA[1][n][q]; }
                    if (lat) { const int nr = nbase + ai * 128 + m * 16; const int pos = ax ? (nr & 63) : (nr >> 6);
                        const pg8::f32x4* tp = (const pg8::f32x4*)(tab + pos * 32 + f0);
#pragma unroll
                        for (int q = 0; q < 4; ++q) { const pg8::f32x4 cs = tp[q];
                            const float a0 = x1[2 * q], b0 = x2[2 * q], a1 = x1[2 * q + 1], b1 = x2[2 * q + 1];
                            x1[2 * q] = a0 * cs[0] - b0 * cs[1]; x2[2 * q] = b0 * cs[0] + a0 * cs[1];
                            x1[2 * q + 1] = a1 * cs[2] - b1 * cs[3]; x2[2 * q + 1] = b1 * cs[2] + a1 * cs[3]; } }
                    v4u w; w.x = cvtpk(x1[0], x1[1]); w.y = cvtpk(x1[2], x1[3]); w.z = cvtpk(x1[4], x1[5]); w.w = cvtpk(x1[6], x1[7]);
                    *(v4u*)rowp = w;
                    w.x = cvtpk(x2[0], x2[1]); w.y = cvtpk(x2[2], x2[3]); w.z = cvtpk(x2[4], x2[5]); w.w = cvtpk(x2[6], x2[7]);
                    *(v4u*)(rowp + 32) = w; } }
            asm volatile("s_waitcnt lgkmcnt(0)" ::: "memory"); __builtin_amdgcn_s_barrier(); asm volatile("" ::: "memory");
            return;
        }
        const int col0 = (u.pn & pn_mask) * 256 + wc * 32 + 8 * fq;
#pragma unroll
        for (int ai = 0; ai < 2; ++ai) { if (u.hm != 0 && u.hm != ai + 1) continue;
#pragma unroll
            for (int m = 0; m < 4; ++m) { bf16_t* rowp = O + (size_t)(row0 + ai * 128 + m * 16) * ldc + col0;
#pragma unroll
                for (int bj = 0; bj < 2; ++bj) { const pg8::f32x4 v0 = acc[ai][bj][m][0], v1 = acc[ai][bj][m][1];
                    v4u w; w.x = cvtpk(v0[0], v0[1]); w.y = cvtpk(v0[2], v0[3]); w.z = cvtpk(v1[0], v1[1]); w.w = cvtpk(v1[2], v1[3]);
                    *(v4u*)(rowp + bj * 128) = w; } } }
    }
};
typedef _Float16 hf_t;
typedef _Float16 hf2_t __attribute__((ext_vector_type(2)));
__device__ __forceinline__ unsigned pkh(float a, float b_) { const hf2_t v = {(hf_t)a, (hf_t)b_}; return __builtin_bit_cast(unsigned, v); }
__device__ __forceinline__ float hf_lo(unsigned u) { const hf2_t v = __builtin_bit_cast(hf2_t, u); return (float)v[0]; }
__device__ __forceinline__ float hf_hi(unsigned u) { const hf2_t v = __builtin_bit_cast(hf2_t, u); return (float)v[1]; }
template <bool RH>
struct EpiResid {
    static constexpr bool PERM = true, AFTER_DRAIN = false;
    hf_t* Y; const float* xbase; const float* cbase; const float* modl; f32x2* stats;
    __device__ __forceinline__ void operator()(const pg8::f32x4 (&acc)[2][2][4][2], const pg8::Unit& u, int wr, int wc, int fr_in, int fq_in) const {
        int fr = fr_in, fq = fq_in; asm volatile("" : "+v"(fr), "+v"(fq));
        const int b = u.pm / 9, j = u.pm - b * 9;
        const size_t roff0 = (j == 0) ? (size_t)b * LCT * DM : ((size_t)b * NXT + (size_t)(j - 1) * 256) * DM;
        const float* rb = ((j == 0) ? cbase : xbase) + roff0; const hf_t* rbh = (const hf_t*)xbase + roff0;
        const float* g = modl + (size_t)(j == 0 ? 8 : b) * NMOD + 2048;
        const int col0 = u.pn * 256 + wc * 32 + 8 * fq;
        pg8::f32x4 gv[2][2];
#pragma unroll
        for (int bj = 0; bj < 2; ++bj)
#pragma unroll
            for (int n = 0; n < 2; ++n) gv[bj][n] = *(const pg8::f32x4*)(g + col0 + bj * 128 + n * 4);
#pragma unroll
        for (int ai = 0; ai < 2; ++ai) { if (u.hm != 0 && u.hm != ai + 1) continue;
#pragma unroll
            for (int mh = 0; mh < 2; ++mh) {
            pg8::f32x4 rva[2][2][2]; v4u rvh[2][2];
#pragma unroll
            for (int mm = 0; mm < 2; ++mm) { const size_t ro = (size_t)(ai * 128 + wr * 64 + (2 * mh + mm) * 16 + fr) * DM + col0;
#pragma unroll
                for (int bj = 0; bj < 2; ++bj) {
                    if constexpr (RH) rvh[mm][bj] = *(const v4u*)(rbh + ro + bj * 128);
                    else {
#pragma unroll
                        for (int n = 0; n < 2; ++n) rva[mm][bj][n] = *(const pg8::f32x4*)(rb + ro + bj * 128 + n * 4); } } }
#pragma unroll
            for (int mm = 0; mm < 2; ++mm) { const int m = 2 * mh + mm; const int lr = ai * 128 + wr * 64 + m * 16 + fr;
                hf_t* yrow = Y + ((size_t)u.pm * 256 + lr) * DM + col0;
                float s = 0.f, q = 0.f;
#pragma unroll
                for (int bj = 0; bj < 2; ++bj) {
                    if constexpr (RH) { const v4u h = rvh[mm][bj]; rva[mm][bj][0] = (pg8::f32x4){hf_lo(h.x), hf_hi(h.x), hf_lo(h.y), hf_hi(h.y)}; rva[mm][bj][1] = (pg8::f32x4){hf_lo(h.z), hf_hi(h.z), hf_lo(h.w), hf_hi(h.w)}; }
                    const pg8::f32x4 o0 = rva[mm][bj][0] * ALPHA + gv[bj][0] * acc[ai][bj][m][0], o1 = rva[mm][bj][1] * ALPHA + gv[bj][1] * acc[ai][bj][m][1];
                    s += ((o0[0] + o0[1]) + (o0[2] + o0[3])) + ((o1[0] + o1[1]) + (o1[2] + o1[3]));
                    q += ((o0[0] * o0[0] + o0[1] * o0[1]) + (o0[2] * o0[2] + o0[3] * o0[3])) + ((o1[0] * o1[0] + o1[1] * o1[1]) + (o1[2] * o1[2] + o1[3] * o1[3]));
                    v4u w; w.x = pkh(o0[0], o0[1]); w.y = pkh(o0[2], o0[3]); w.z = pkh(o1[0], o1[1]); w.w = pkh(o1[2], o1[3]);
                    *(v4u*)(yrow + bj * 128) = w; }
                s = xsum<16>(s); q = xsum<16>(q); s = xsum<32>(s); q = xsum<32>(q);
                if (fq == 0) stats[((size_t)u.pm * 256 + lr) * 16 + u.pn * 4 + wc] = (f32x2){s, q}; } } }
    }
};
struct EpiGateUp {
    static constexpr bool PERM = true, AFTER_DRAIN = false;
    bf16_t* ACT; const float* gwof; const LAS int* tbase;
    __device__ __forceinline__ void operator()(const pg8::f32x4 (&acc)[2][2][4][2], const pg8::Unit& u, int wr, int wc, int fr_in, int fq_in) const {
        int fr = fr_in, fq = fq_in; asm volatile("" : "+v"(fr), "+v"(fq));
        const int e = u.pn >> 1; const float* gwe = gwof + (size_t)e * ECAP + (u.pm - tbase[e]) * 256;
        const int lr0 = wr * 64 + fr; const int f0 = (u.pn & 1) * 128 + wc * 32 + 8 * fq;
#pragma unroll
        for (int ai = 0; ai < 2; ++ai) { if (u.hm != 0 && u.hm != ai + 1) continue;
#pragma unroll
            for (int m = 0; m < 4; ++m) { const int lr = lr0 + ai * 128 + m * 16; const float gw = gwe[lr];
                float o[8];
#pragma unroll
                for (int n = 0; n < 2; ++n)
#pragma unroll
                    for (int q = 0; q < 4; ++q) { const float a = acc[ai][0][m][n][q], up = acc[ai][1][m][n][q];
                        o[n * 4 + q] = a * __builtin_amdgcn_rcpf(1.f + __expf(-a)) * up * gw; }
                v4u w; w.x = cvtpk(o[0], o[1]); w.y = cvtpk(o[2], o[3]); w.z = cvtpk(o[4], o[5]); w.w = cvtpk(o[6], o[7]);
                *(v4u*)(ACT + ((size_t)u.pm * 256 + lr) * FH + f0) = w; } }
    }
};

namespace att {
constexpr int KVBLK = 64;
constexpr int SHM_V = KVBLK * 128 * 2, SHM_K = KVBLK * 128 * 2;
constexpr int OFF_WS = 2 * SHM_V + 2 * SHM_K;
constexpr int OFF_XCH = OFF_WS + 8 * 256;
constexpr int LDS_NEED = OFF_XCH + 4 * 16384;
static_assert(LDS_NEED <= MISC_OFF, "attention LDS");
constexpr float THR = 8.f;
#define KSWZ(row, colB) ((row) * 256 + ((colB) ^ (((row) & 7) << 4)))
#define SBAR() __builtin_amdgcn_sched_barrier(0)
__device__ __forceinline__ int crow(int r, int hi) { return (r & 3) + 8 * (r >> 2) + 4 * hi; }

template <bool DIFF> struct Cst { static constexpr float SCALE = DIFF ? 0.125f : 0.088388347648318440f; static constexpr float C = SCALE * 1.4426950408889634f; };

template <bool DIFF>
__device__ __forceinline__ void partialSM(f32x16& p0, f32x16& p1, float& m_reg, float& mn, float& alpha) {
  constexpr float C = Cst<DIFF>::C, SCALE = Cst<DIFF>::SCALE;
  float pmax = p0[0];
#pragma unroll
  for (int r = 1; r < 16; ++r) pmax = fmaxf(pmax, p0[r]);
#pragma unroll
  for (int r = 0; r < 16; ++r) pmax = fmaxf(pmax, p1[r]);
  { auto rr = __builtin_amdgcn_permlane32_swap(__float_as_uint(pmax), __float_as_uint(pmax), false, false);
    pmax = fmaxf(__uint_as_float(rr[0]), __uint_as_float(rr[1])); }
  if (__builtin_expect(__all(pmax - m_reg <= THR / SCALE), 1)) { mn = m_reg; alpha = 1.f; }
  else { mn = fmaxf(m_reg, pmax); alpha = __builtin_amdgcn_exp2f((m_reg - mn) * C); m_reg = mn; }
  float mnC = -mn * C;
#pragma unroll
  for (int r = 0; r < 16; ++r) p0[r] = fmaf(p0[r], C, mnC);
#pragma unroll
  for (int r = 0; r < 16; ++r) p1[r] = fmaf(p1[r], C, mnC);
#pragma unroll
  for (int r = 0; r < 16; ++r) p0[r] = __builtin_amdgcn_exp2f(p0[r]);
}
__device__ __forceinline__ void finishSM(f32x16& p0, f32x16& p1, float alpha, float& l_reg, bf16x8& pa0, bf16x8& pa1, bf16x8& pa2, bf16x8& pa3) {
#pragma unroll
  for (int r = 0; r < 16; ++r) p1[r] = __builtin_amdgcn_exp2f(p1[r]);
  float ps = 0;
#pragma unroll
  for (int r = 0; r < 16; ++r) ps += p0[r];
#pragma unroll
  for (int r = 0; r < 16; ++r) ps += p1[r];
  { auto rr = __builtin_amdgcn_permlane32_swap(__float_as_uint(ps), __float_as_uint(ps), false, false);
    ps = __uint_as_float(rr[0]) + __uint_as_float(rr[1]); }
  l_reg = l_reg * alpha + ps;
#define PK4(P, BASE, OUT) do { unsigned a0 = cvtpk(P[BASE + 0], P[BASE + 1]), a1 = cvtpk(P[BASE + 2], P[BASE + 3]);   \
    unsigned b0 = cvtpk(P[BASE + 4], P[BASE + 5]), b1 = cvtpk(P[BASE + 6], P[BASE + 7]);                              \
    auto r0 = __builtin_amdgcn_permlane32_swap(a0, b0, false, false); auto r1 = __builtin_amdgcn_permlane32_swap(a1, b1, false, false); \
    v4u w = {r0[0], r1[0], r0[1], r1[1]}; OUT = *reinterpret_cast<bf16x8*>(&w); } while (0)
  PK4(p0, 0, pa0); PK4(p0, 8, pa1); PK4(p1, 0, pa2); PK4(p1, 8, pa3);
#undef PK4
}
template <int NQ>
__device__ __forceinline__ void qkt(f32x16& p0, f32x16& p1, const char* Ks, const bf16x8* qr, int r32, int hi, int d0base) {
  p0 = f32x16{}; p1 = f32x16{};
#pragma unroll
  for (int d0 = 0; d0 < NQ; ++d0) { const int cb = ((d0base + d0) * 16 + hi * 8) * 2;
    bf16x8 b0 = *reinterpret_cast<const bf16x8*>(Ks + KSWZ(r32, cb));
    bf16x8 b1 = *reinterpret_cast<const bf16x8*>(Ks + KSWZ(32 + r32, cb));
    p0 = __builtin_amdgcn_mfma_f32_32x32x16_bf16(b0, qr[d0], p0, 0, 0, 0);
    p1 = __builtin_amdgcn_mfma_f32_32x32x16_bf16(b1, qr[d0], p1, 0, 0, 0); }
}
__device__ __forceinline__ int v_st(int k, int c) { const int kk = (k & ~0xC) | ((k & 4) << 1) | ((k & 8) >> 1); return ((kk >> 3) * 4 + (c >> 5)) * 512 + ((kk & 7) * 32 + (c & 31)) * 2; }
__device__ __forceinline__ int v_rd_base(int lane) { return ((lane & 3) << 3) | (((lane >> 2) & 3) << 6) | (((lane >> 4) & 1) << 5) | (((lane >> 5) & 1) << 8); }
constexpr int v_rd_off(int d0, int ks, int half) { return d0 * 512 + ks * 4096 + half * 2048; }
template <int OFF> __device__ __forceinline__ s16x4 tr_read(int vb) {
  s16x4 r; asm volatile("ds_read_b64_tr_b16 %0, %1 offset:%2" : "=&v"(r) : "v"(vb), "i"(OFF) : "memory"); return r;
}
template <int D0> __device__ __forceinline__ void pv_one(f32x16& od, int vb, bf16x8 pa0, bf16x8 pa1, bf16x8 pa2, bf16x8 pa3) {
  const s16x4 l0 = tr_read<v_rd_off(D0, 0, 0)>(vb), h0 = tr_read<v_rd_off(D0, 0, 1)>(vb), l1 = tr_read<v_rd_off(D0, 1, 0)>(vb), h1 = tr_read<v_rd_off(D0, 1, 1)>(vb);
  const s16x4 l2 = tr_read<v_rd_off(D0, 2, 0)>(vb), h2 = tr_read<v_rd_off(D0, 2, 1)>(vb), l3 = tr_read<v_rd_off(D0, 3, 0)>(vb), h3 = tr_read<v_rd_off(D0, 3, 1)>(vb);
  asm volatile("s_waitcnt lgkmcnt(0)" ::: "memory"); SBAR();
#define PK(L, H) (bf16x8){L[0], L[1], L[2], L[3], H[0], H[1], H[2], H[3]}
  od = __builtin_amdgcn_mfma_f32_32x32x16_bf16(pa0, PK(l0, h0), od, 0, 0, 0);
  od = __builtin_amdgcn_mfma_f32_32x32x16_bf16(pa1, PK(l1, h1), od, 0, 0, 0);
  od = __builtin_amdgcn_mfma_f32_32x32x16_bf16(pa2, PK(l2, h2), od, 0, 0, 0);
  od = __builtin_amdgcn_mfma_f32_32x32x16_bf16(pa3, PK(l3, h3), od, 0, 0, 0);
#undef PK
}
__device__ __forceinline__ void pv_d0(f32x16* o, int vb, bf16x8 pa0, bf16x8 pa1, bf16x8 pa2, bf16x8 pa3) {
  pv_one<0>(o[0], vb, pa0, pa1, pa2, pa3); pv_one<1>(o[1], vb, pa0, pa1, pa2, pa3); pv_one<2>(o[2], vb, pa0, pa1, pa2, pa3); pv_one<3>(o[3], vb, pa0, pa1, pa2, pa3);
}

constexpr float THRL = THR * 1.4426950408889634f;
__device__ __forceinline__ void qkt_negm(f32x16& p0, f32x16& p1, const char* Ks, const bf16x8* qr, const f32x16& negm, int r32, int hi, int d0base) {
#pragma unroll
  for (int d0 = 0; d0 < 4; ++d0) { const int cb = ((d0base + d0) * 16 + hi * 8) * 2;
    bf16x8 b0 = *reinterpret_cast<const bf16x8*>(Ks + KSWZ(r32, cb));
    bf16x8 b1 = *reinterpret_cast<const bf16x8*>(Ks + KSWZ(32 + r32, cb));
    if (d0 == 0) { p0 = __builtin_amdgcn_mfma_f32_32x32x16_bf16(b0, qr[0], negm, 0, 0, 0); p1 = __builtin_amdgcn_mfma_f32_32x32x16_bf16(b1, qr[0], negm, 0, 0, 0); }
    else { p0 = __builtin_amdgcn_mfma_f32_32x32x16_bf16(b0, qr[d0], p0, 0, 0, 0); p1 = __builtin_amdgcn_mfma_f32_32x32x16_bf16(b1, qr[d0], p1, 0, 0, 0); } }
}
__device__ __forceinline__ void splat16(f32x16& v, float x) {
#pragma unroll
  for (int r = 0; r < 16; ++r) v[r] = x;
}
__device__ __forceinline__ void partial_first_negm(f32x16& p0, f32x16& p1, float& m_reg, f32x16& negm) {
  float pmax = p0[0];
#pragma unroll
  for (int r = 1; r < 16; ++r) pmax = fmaxf(pmax, p0[r]);
#pragma unroll
  for (int r = 0; r < 16; ++r) pmax = fmaxf(pmax, p1[r]);
  { auto rr = __builtin_amdgcn_permlane32_swap(__float_as_uint(pmax), __float_as_uint(pmax), false, false);
    pmax = fmaxf(__uint_as_float(rr[0]), __uint_as_float(rr[1])); }
  m_reg = pmax; splat16(negm, -pmax);
#pragma unroll
  for (int r = 0; r < 16; ++r) { p0[r] -= pmax; p1[r] -= pmax; }
#pragma unroll
  for (int r = 0; r < 16; ++r) p0[r] = __builtin_amdgcn_exp2f(p0[r]);
}
__device__ __forceinline__ void pv_partial_negm(f32x16* o, int vb, bf16x8 pa0, bf16x8 pa1, bf16x8 pa2, bf16x8 pa3, f32x16& p0, f32x16& p1, float& m_reg, f32x16& negm, float& alpha) {
  pv_one<0>(o[0], vb, pa0, pa1, pa2, pa3);
  float pmax = p0[0];
#pragma unroll
  for (int r = 1; r < 16; ++r) pmax = fmaxf(pmax, p0[r]);
  pv_one<1>(o[1], vb, pa0, pa1, pa2, pa3);
#pragma unroll
  for (int r = 0; r < 16; ++r) pmax = fmaxf(pmax, p1[r]);
  { auto rr = __builtin_amdgcn_permlane32_swap(__float_as_uint(pmax), __float_as_uint(pmax), false, false);
    pmax = fmaxf(__uint_as_float(rr[0]), __uint_as_float(rr[1])); }
  if (__builtin_expect(__all(pmax <= THRL), 1)) { alpha = 1.f; }
  else { const float d = fmaxf(pmax, 0.f); alpha = __builtin_amdgcn_exp2f(-d); m_reg += d; splat16(negm, -m_reg);
#pragma unroll
    for (int r = 0; r < 16; ++r) { p0[r] -= d; p1[r] -= d; } }
  pv_one<2>(o[2], vb, pa0, pa1, pa2, pa3);
  pv_one<3>(o[3], vb, pa0, pa1, pa2, pa3);
#pragma unroll
  for (int r = 0; r < 16; ++r) p0[r] = __builtin_amdgcn_exp2f(p0[r]);
  asm volatile("" : "+v"(p0), "+v"(p1));
  SBAR();
}

template <bool DIFF>
__device__ __forceinline__ void pv_partial(f32x16* o, int vb, bf16x8 pa0, bf16x8 pa1, bf16x8 pa2, bf16x8 pa3, f32x16& p0, f32x16& p1, float& m_reg, float& mn, float& alpha) {
  constexpr float C = Cst<DIFF>::C, SCALE = Cst<DIFF>::SCALE;
  pv_one<0>(o[0], vb, pa0, pa1, pa2, pa3);
  float pmax = p0[0];
#pragma unroll
  for (int r = 1; r < 16; ++r) pmax = fmaxf(pmax, p0[r]);
  pv_one<1>(o[1], vb, pa0, pa1, pa2, pa3);
#pragma unroll
  for (int r = 0; r < 16; ++r) pmax = fmaxf(pmax, p1[r]);
  { auto rr = __builtin_amdgcn_permlane32_swap(__float_as_uint(pmax), __float_as_uint(pmax), false, false);
    pmax = fmaxf(__uint_as_float(rr[0]), __uint_as_float(rr[1])); }
  if (__builtin_expect(__all(pmax - m_reg <= THR / SCALE), 1)) { mn = m_reg; alpha = 1.f; }
  else { mn = fmaxf(m_reg, pmax); alpha = __builtin_amdgcn_exp2f((m_reg - mn) * C); m_reg = mn; }
  pv_one<2>(o[2], vb, pa0, pa1, pa2, pa3);
  const float mnC = -mn * C;
#pragma unroll
  for (int r = 0; r < 16; ++r) p0[r] = fmaf(p0[r], C, mnC);
#pragma unroll
  for (int r = 0; r < 16; ++r) p1[r] = fmaf(p1[r], C, mnC);
  pv_one<3>(o[3], vb, pa0, pa1, pa2, pa3);
#pragma unroll
  for (int r = 0; r < 16; ++r) p0[r] = __builtin_amdgcn_exp2f(p0[r]);
  asm volatile("" : "+v"(p0), "+v"(p1));
  SBAR();
}

template <bool DIFF>
__device__ __forceinline__ void attn_unit(const bf16_t* __restrict__ Qb, int ldq, const bf16_t* __restrict__ Kh, const bf16_t* __restrict__ Vh, int ldk, int seq,
                                          bf16_t* __restrict__ Ob, int ldo, bool rope, int n0, const f32x2* __restrict__ tab,
                                          const float* __restrict__ qg  , const float* __restrict__ subg  , float lam, char* lds, const int wv) {
  constexpr int NQ = DIFF ? 4 : 8;
  const int tid = ltid(wv), wid = wv, lane = tid & 63, r32 = lane & 31, hi = lane >> 5;
  const int qblk = DIFF ? (wid & 3) : wid, map = DIFF ? (wid >> 2) : 0;
  char* V_lds = lds; char* K_lds = lds + 2 * SHM_V;
  float* wsf = (float*)(lds + OFF_WS) + wid * 64; float* li_l = wsf; float* al_l = wsf + 32;
  float m_reg = -1e30f, l_reg = 0; f32x16 o[4] = {}; bf16x8 qr[NQ];
  const int sr = tid >> 4, sc = (tid & 15) * 8, vst0 = v_st(sr, sc), vst1 = v_st(32 + sr, sc);
  const int vb0 = (int)(uintptr_t)V_lds + v_rd_base(lane);
  struct { bf16x8 vs0, vs1, ks0, ks1; } sr_[2] = {};
#define LD8(p) (*reinterpret_cast<const bf16x8*>(p))
#define SLOAD(i, k0) do { sr_[i].vs0 = LD8(&Vh[(size_t)((k0) + sr) * ldk + sc]); sr_[i].vs1 = LD8(&Vh[(size_t)((k0) + 32 + sr) * ldk + sc]); \
    sr_[i].ks0 = LD8(&Kh[(size_t)((k0) + sr) * ldk + sc]); sr_[i].ks1 = LD8(&Kh[(size_t)((k0) + 32 + sr) * ldk + sc]); } while (0)
#define SWRITE(b, i) do { *(bf16x8*)(V_lds + (b) * SHM_V + vst0) = sr_[i].vs0;          \
    *(bf16x8*)(V_lds + (b) * SHM_V + vst1) = sr_[i].vs1; int kc = sc * 2;               \
    *(bf16x8*)(K_lds + (b) * SHM_K + KSWZ(sr, kc)) = sr_[i].ks0;                       \
    *(bf16x8*)(K_lds + (b) * SHM_K + KSWZ(32 + sr, kc)) = sr_[i].ks1; } while (0)
  constexpr int SE = 0, SO = 1;
  SLOAD(SE, 0); SLOAD(SO, KVBLK);
  {
    const bf16_t* Qw = Qb + (size_t)(qblk * 32 + r32) * ldq + map * 64 + hi * 8;
    const int n = n0 + qblk * 32 + r32;
    float qf[NQ][8];
#pragma unroll
    for (int d0 = 0; d0 < NQ; ++d0) { const v4u w = *reinterpret_cast<const v4u*>(Qw + d0 * 16);
      qf[d0][0] = bf_lo(w.x); qf[d0][1] = bf_hi(w.x); qf[d0][2] = bf_lo(w.y); qf[d0][3] = bf_hi(w.y);
      qf[d0][4] = bf_lo(w.z); qf[d0][5] = bf_hi(w.z); qf[d0][6] = bf_lo(w.w); qf[d0][7] = bf_hi(w.w); }
    if constexpr (!DIFF) {
      float ss = 0.f;
#pragma unroll
      for (int d0 = 0; d0 < NQ; ++d0)
#pragma unroll
        for (int j = 0; j < 8; ++j) ss += qf[d0][j] * qf[d0][j];
      ss = xsum<32>(ss);
      const float rs = 1.0f / sqrtf(ss * (1.f / 128.f) + RMS_EPS);
#pragma unroll
      for (int d0 = 0; d0 < NQ; ++d0) { const f32x4 g0 = *(const f32x4*)(qg + d0 * 16 + hi * 8), g1 = *(const f32x4*)(qg + d0 * 16 + hi * 8 + 4);
#pragma unroll
        for (int j = 0; j < 4; ++j) { qf[d0][j] *= rs * g0[j]; qf[d0][4 + j] *= rs * g1[j]; } }
    }
    if (rope) {
      constexpr int NF = DIFF ? 16 : 32;
      constexpr int HB = DIFF ? 1 : 2;
#pragma unroll
      for (int ax = 0; ax < 2; ++ax) { const int pos = ax ? (n & 63) : (n >> 6);
#pragma unroll
        for (int hb = 0; hb < HB; ++hb) { const int dA = ax * 2 * HB + hb, dB = dA + HB;
          const f32x2* tp = tab + pos * NF + hb * 16 + hi * 8;
#pragma unroll
          for (int j = 0; j < 8; ++j) { const f32x2 cs = tp[j]; const float x1 = qf[dA][j], x2 = qf[dB][j];
            qf[dA][j] = x1 * cs.x - x2 * cs.y; qf[dB][j] = x2 * cs.x + x1 * cs.y; } } }
    }
    if constexpr (DIFF) {
#pragma unroll
      for (int d0 = 0; d0 < NQ; ++d0)
#pragma unroll
        for (int j = 0; j < 8; ++j) qf[d0][j] *= Cst<true>::C; }
#pragma unroll
    for (int d0 = 0; d0 < NQ; ++d0) { v4u w = {cvtpk(qf[d0][0], qf[d0][1]), cvtpk(qf[d0][2], qf[d0][3]), cvtpk(qf[d0][4], qf[d0][5]), cvtpk(qf[d0][6], qf[d0][7])};
      qr[d0] = *reinterpret_cast<bf16x8*>(&w); }
  }
#define SWAIT() asm volatile("s_waitcnt vmcnt(4)" ::: "memory")
#define RESC(a) do { if (__any((a) < 1.f)) { if (hi == 0) al_l[r32] = (a); asm volatile("s_waitcnt lgkmcnt(0)" ::: "memory"); \
    _Pragma("unroll") for (int d = 0; d < 4; ++d) _Pragma("unroll") for (int r = 0; r < 16; ++r) o[d][r] *= al_l[crow(r, hi)]; } } while (0)
  f32x16 pA0, pA1, pB0, pB1; float mnA, mnB, alA, alB; bf16x8 pa0, pa1, pa2, pa3; const int NT = seq / KVBLK;
  const int dbase = map * 4;
  f32x16 negm = {};
  if constexpr (DIFF) m_reg = 0.f;
#define QKT(P0, P1, KS) do { if constexpr (DIFF) qkt_negm(P0, P1, KS, qr, negm, r32, hi, dbase); else qkt<NQ>(P0, P1, KS, qr, r32, hi, dbase); } while (0)
#define PVP(VB, P0, P1, MN, AL) do { if constexpr (DIFF) pv_partial_negm(o, VB, pa0, pa1, pa2, pa3, P0, P1, m_reg, negm, AL); else pv_partial<DIFF>(o, VB, pa0, pa1, pa2, pa3, P0, P1, m_reg, MN, AL); } while (0)
  SWAIT(); SWRITE(0, SE); __syncthreads();
  QKT(pA0, pA1, K_lds); if constexpr (DIFF) { partial_first_negm(pA0, pA1, m_reg, negm); alA = 1.f; } else partialSM<DIFF>(pA0, pA1, m_reg, mnA, alA);
  if (2 < NT) SLOAD(SE, 2 * KVBLK);
  SWAIT(); SWRITE(1, SO); __syncthreads();
  for (int j = 1; j + 1 < NT; j += 2) {
    SBAR(); QKT(pB0, pB1, K_lds + SHM_K);
    finishSM(pA0, pA1, alA, l_reg, pa0, pa1, pa2, pa3); SBAR();
    SLOAD(SO, (j + 2) * KVBLK); SBAR();
    PVP(vb0, pB0, pB1, mnB, alB);
    __syncthreads(); SWAIT(); SWRITE(0, SE);
    RESC(alB); __syncthreads();
    SBAR(); QKT(pA0, pA1, K_lds);
    finishSM(pB0, pB1, alB, l_reg, pa0, pa1, pa2, pa3); SBAR();
    if (j + 3 < NT) SLOAD(SE, (j + 3) * KVBLK); SBAR();
    PVP(vb0 + (int)SHM_V, pA0, pA1, mnA, alA);
    __syncthreads(); SWAIT(); SWRITE(1, SO);
    RESC(alA); __syncthreads();
  }
  SBAR(); QKT(pB0, pB1, K_lds + SHM_K);
  finishSM(pA0, pA1, alA, l_reg, pa0, pa1, pa2, pa3); SBAR();
  PVP(vb0, pB0, pB1, mnB, alB);
  __syncthreads(); RESC(alB);
  finishSM(pB0, pB1, alB, l_reg, pa0, pa1, pa2, pa3); SBAR();
  pv_d0(o, vb0 + (int)SHM_V, pa0, pa1, pa2, pa3);
  if (hi == 0) li_l[r32] = l_reg; asm volatile("s_waitcnt lgkmcnt(0)" ::: "memory");
#pragma unroll
  for (int r = 0; r < 16; ++r) { const float rl = __builtin_amdgcn_rcpf(li_l[crow(r, hi)]);
#pragma unroll
    for (int d0 = 0; d0 < 4; ++d0) o[d0][r] *= rl; }
  if constexpr (!DIFF) {
    bf16_t* ost = (bf16_t*)(lds + OFF_XCH) + wid * (32 * 136);
#pragma unroll
    for (int r = 0; r < 16; ++r) { const int orow = crow(r, hi);
#pragma unroll
      for (int d0 = 0; d0 < 4; ++d0) ost[orow * 136 + d0 * 32 + r32] = (bf16_t)(cvtpk(o[d0][r], 0.f) & 0xffffu); }
    asm volatile("s_waitcnt lgkmcnt(0)" ::: "memory");
    bf16_t* Ow = Ob + (size_t)(wid * 32) * ldo;
#pragma unroll
    for (int i = 0; i < 8; ++i) { const int c = i * 64 + lane, orow = c >> 4, ch = c & 15;
      *(v4u*)(Ow + (size_t)orow * ldo + ch * 8) = *(const v4u*)(ost + orow * 136 + ch * 8); }
  } else {
    float* xch = (float*)(lds + OFF_XCH) + qblk * 4096;
    if (map == 1) {
#pragma unroll
      for (int d0 = 0; d0 < 4; ++d0)
#pragma unroll
        for (int r = 0; r < 16; ++r) xch[(d0 * 16 + r) * 64 + lane] = o[d0][r];
    }
    __syncthreads();
    if (map == 0) {
      float ssr[16];
#pragma unroll
      for (int r = 0; r < 16; ++r) { float s = 0.f;
#pragma unroll
        for (int d0 = 0; d0 < 4; ++d0) { const float d = o[d0][r] - lam * xch[(d0 * 16 + r) * 64 + lane]; o[d0][r] = d; s += d * d; }
        ssr[r] = s; }
#pragma unroll
      for (int r = 0; r < 16; ++r) { float s = ssr[r];
        s = sum32(s);
        ssr[r] = (1.0f / sqrtf(s * (1.f / 128.f) + RMS_EPS)) * (1.f - LAMBDA_INIT0); }
      asm volatile("s_waitcnt lgkmcnt(0)" ::: "memory");
      bf16_t* ost = (bf16_t*)xch;
#pragma unroll
      for (int d0 = 0; d0 < 4; ++d0) { const float g = subg[d0 * 32 + r32];
#pragma unroll
        for (int r = 0; r < 16; ++r) ost[crow(r, hi) * 136 + d0 * 32 + r32] = (bf16_t)(cvtpk(o[d0][r] * ssr[r] * g, 0.f) & 0xffffu); }
      asm volatile("s_waitcnt lgkmcnt(0)" ::: "memory");
      bf16_t* Ow = Ob + (size_t)(qblk * 32) * ldo;
#pragma unroll
      for (int i = 0; i < 8; ++i) { const int c = i * 64 + lane, orow = c >> 4, ch = c & 15;
        *(v4u*)(Ow + (size_t)orow * ldo + ch * 8) = *(const v4u*)(ost + orow * 136 + ch * 8); }
    }
  }
#undef QKT
#undef PVP
#undef LD8
#undef SLOAD
#undef SWRITE
#undef SWAIT
#undef RESC
}
#undef KSWZ
#undef SBAR
}

#ifndef REPMASK
#define REPMASK 0
#endif
#ifndef REPN
#define REPN 1
#endif
#ifndef PHMASK
#define PHMASK 0x3ffff
#endif
struct Args { const float* in[28]; float* o_; unsigned char* w_; };
enum { I_X = 0, I_C, I_CTX, I_CCTX, I_WMOD, I_BMOD, I_LNMG, I_LNMB, I_LNFG, I_LNFB, I_DWQKV, I_DWO, I_LQ1, I_LK1, I_LQ2, I_LK2, I_SUBG,
       I_GWQKV, I_GWO, I_GQN, I_GKN, I_WGRP, I_BGRP, I_WRT, I_BRT, I_WGATE, I_WUP, I_WDOWN };

constexpr int PTR_OFF = MISC_OFF + 1024;
__device__ __forceinline__ const float* ldptr(LAS unsigned char* ldsl, int i) {
    int off = PTR_OFF + 8 * i; asm volatile("" : "+v"(off));
    const LAS unsigned* p = (const LAS unsigned*)(ldsl + off);
    const unsigned lo = __builtin_amdgcn_readfirstlane(p[0]), hi = __builtin_amdgcn_readfirstlane(p[1]);
    return (const float*)(GAS const float*)(((unsigned long long)hi << 32) | lo);
}
struct TrItem { const float* W; int N; bf16_t* WT; int KT; int dstrow0; int k0; int n0; int hi_stride; };
__device__ __forceinline__ void transpose_load(const TrItem& I, float (&wv_)[32], int lane) {
    const unsigned vo_ = (unsigned)((lane >> 3) * I.N + (lane & 7) * 4) * 4u;
#pragma unroll
    for (int i = 0; i < 8; ++i) { const f32x4 w = __builtin_nontemporal_load((const f32x4*)((const char*)(I.W + (size_t)(I.k0 + 8 * i) * I.N + I.n0) + vo_));
        wv_[4 * i] = w[0]; wv_[4 * i + 1] = w[1]; wv_[4 * i + 2] = w[2]; wv_[4 * i + 3] = w[3]; }
}
__device__ __forceinline__ void transpose_finish(const TrItem& I, const float (&wv_)[32], LAS float* scr, int lane) {
#pragma unroll
    for (int i = 0; i < 8; ++i)
#pragma unroll
        for (int j = 0; j < 4; ++j) scr[(8 * i + (lane >> 3)) * 33 + (lane & 7) * 4 + j] = wv_[4 * i + j];
    LDS_WAIT(); asm volatile("" ::: "memory");
    const int c = lane & 7;
#pragma unroll
    for (int j = 0; j < 4; ++j) { const int n = (lane >> 3) + 8 * j; const LAS float* s = scr + (8 * c) * 33 + n;
        v4u o; o.x = cvtpk(s[0 * 33], s[1 * 33]); o.y = cvtpk(s[2 * 33], s[3 * 33]); o.z = cvtpk(s[4 * 33], s[5 * 33]); o.w = cvtpk(s[6 * 33], s[7 * 33]);
        *(v4u*)(I.WT + (size_t)(I.dstrow0 + (n & 15) + (n >> 4) * I.hi_stride) * I.KT + I.k0 + 8 * c) = o; }
    LDS_WAIT(); asm volatile("" ::: "memory");
}
__device__ __forceinline__ void transpose_item(const float* __restrict__ W, int N, bf16_t* __restrict__ WT, int KT, int dstrow0, int k0, int n0, LAS float* scr, int lane, int hi_stride = 16) {
    const TrItem I{W, N, WT, KT, dstrow0, k0, n0, hi_stride}; float wv_[32];
    transpose_load(I, wv_, lane); transpose_finish(I, wv_, scr, lane);
}
__device__ __forceinline__ TrItem moe_item_desc(LAS unsigned char* ldsl, int layer, int it, bf16_t* wgu_, bf16_t* wd_) {
    const int e = it / 384, r = it - e * 384;
    const size_t eoff = ((size_t)layer * NEXP + e) * (size_t)DM * FH;
    if (r < 256) {
        const int isup = r >> 7, rr = r & 127, kb = rr >> 3, nb = rr & 7, n0 = nb * 32;
        const float* W = (isup ? ldptr(ldsl, I_WUP) : ldptr(ldsl, I_WGATE)) + eoff;
        return TrItem{W, FH, wgu_, DM, e * 512 + (n0 >> 7) * 256 + isup * 128 + (n0 & 127), kb * 64, n0, 16};
    }
    const int rr = r - 256, kb = rr >> 5, nb = rr & 31;
    return TrItem{ldptr(ldsl, I_WDOWN) + eoff, DM, wd_, FH, e * 1024 + nb * 32, kb * 64, nb * 32, 16};
}
__device__ __forceinline__ void moe_weight_item(LAS unsigned char* ldsl, int layer, int it, bf16_t* wgu_, bf16_t* wd_, LAS float* scr, int lane) {
    const TrItem I = moe_item_desc(ldsl, layer, it, wgu_, wd_); float wv_[32];
    transpose_load(I, wv_, lane); transpose_finish(I, wv_, scr, lane);
}
__device__ __forceinline__ void moe_weight_pair(LAS unsigned char* ldsl, int layer, int ita, int itb, bf16_t* wgu_, bf16_t* wd_, LAS float* scr, int lane) {
    const TrItem A = moe_item_desc(ldsl, layer, ita, wgu_, wd_), B = moe_item_desc(ldsl, layer, itb, wgu_, wd_); float wa_[32], wb_[32];
    transpose_load(A, wa_, lane); transpose_load(B, wb_, lane);
    transpose_finish(A, wa_, scr, lane); transpose_finish(B, wb_, scr, lane);
}
__device__ __forceinline__ int pcol(int lane, int c) { return 8 * lane + 512 * (c >> 1) + 4 * (c & 1); }
__device__ __forceinline__ void store_h_row(const f32x4 (&v)[4], const float* __restrict__ sv, const float* __restrict__ av, bf16_t* __restrict__ hrow, int lane) {
#pragma unroll
    for (int j = 0; j < 2; ++j) { const int col = 8 * lane + 512 * j;
        const f32x4 s0 = *(const f32x4*)(sv + col), s1 = *(const f32x4*)(sv + col + 4), a0 = *(const f32x4*)(av + col), a1 = *(const f32x4*)(av + col + 4);
        const f32x4 h0 = v[2 * j] * (a0 + 1.0f) + s0, h1 = v[2 * j + 1] * (a1 + 1.0f) + s1;
        v4u w; w.x = cvtpk(h0[0], h0[1]); w.y = cvtpk(h0[2], h0[3]); w.z = cvtpk(h1[0], h1[1]); w.w = cvtpk(h1[2], h1[3]); *(v4u*)(hrow + col) = w; }
}
__device__ __forceinline__ void ln_row(f32x4 (&v)[4], const float* __restrict__ g, const float* __restrict__ bb, int lane, float& mean_o, float& rstd_o) {
    float s = 0.f;
#pragma unroll
    for (int j = 0; j < 4; ++j) s += (v[j][0] + v[j][1]) + (v[j][2] + v[j][3]);
    const float mean = wave_sum(s) * (1.f / DM); float s2 = 0.f;
#pragma unroll
    for (int j = 0; j < 4; ++j) { v[j] = v[j] - mean; s2 += (v[j][0] * v[j][0] + v[j][1] * v[j][1]) + (v[j][2] * v[j][2] + v[j][3] * v[j][3]); }
    const float rstd = 1.0f / sqrtf(wave_sum(s2) * (1.f / DM) + LN_EPS);
#pragma unroll
    for (int j = 0; j < 4; ++j) { const int col = pcol(lane, j); const f32x4 gg = *(const f32x4*)(g + col), b4 = *(const f32x4*)(bb + col); v[j] = v[j] * rstd * gg + b4; }
    mean_o = mean; rstd_o = rstd;
}

__device__ __forceinline__ int row_of(int layer, int idx, int per_item, int it, int j) { (void)idx;
    if (layer == 0) return it * per_item + j; const int xi = it * per_item + j; return (xi >> 11) * TT + LCT + (xi & 2047); }
template <int RB>
__device__ __forceinline__ void p8_rows(int idx0, int layer, const int4* __restrict__ tinfo, const LAS int* rowb, const bf16_t* __restrict__ fo, const hf_t* __restrict__ Yp, const f32x2* __restrict__ rst, const float* __restrict__ mg, const float* __restrict__ mb, float* outp, float* xrcp,
                                        const float* __restrict__ modlp, const float* __restrict__ modn, const float* __restrict__ fg, const float* __restrict__ fb, bf16_t* hbp, int lane) {
    f32x4 v[RB][4]; v4u yh[RB][2], fa[RB][2], fc[RB][2]; int rr[RB]; int4 ti[RB];
#pragma unroll
    for (int q = 0; q < RB; ++q) { const int idx = idx0 + q; rr[q] = layer == 0 ? idx : (idx >> 11) * TT + LCT + (idx & 2047); ti[q] = tinfo[rr[q]]; }
    f32x2 st[RB];
#pragma unroll
    for (int q = 0; q < RB; ++q) { const hf_t* xr = Yp + (size_t)rr[q] * DM; st[q] = rst[rr[q]];
        const bf16_t* f1 = fo + (size_t)(rowb[ti[q].x] + ti[q].y) * DM; const bf16_t* f2 = fo + (size_t)(rowb[ti[q].z] + ti[q].w) * DM;
#pragma unroll
        for (int j = 0; j < 2; ++j) yh[q][j] = *(const v4u*)(xr + 8 * lane + 512 * j);
#pragma unroll
        for (int j = 0; j < 2; ++j) { fa[q][j] = *(const v4u*)(f1 + 8 * lane + 512 * j); fc[q][j] = *(const v4u*)(f2 + 8 * lane + 512 * j); } }
#pragma unroll
    for (int q = 0; q < RB; ++q) { const int r = rr[q]; const int b = r / TT, t = r - b * TT; const int cond = t < LCT ? 8 : b;
        const float* gf = modlp + (size_t)cond * NMOD + 5120;
#pragma unroll
        for (int c = 0; c < 4; ++c) { const int col = pcol(lane, c); const v4u a4 = fa[q][c >> 1], c4 = fc[q][c >> 1];
            const unsigned ax = (c & 1) ? a4.z : a4.x, ay = (c & 1) ? a4.w : a4.y, cx = (c & 1) ? c4.z : c4.x, cy = (c & 1) ? c4.w : c4.y;
            const f32x4 f = {bf_lo(ax) + bf_lo(cx), bf_hi(ax) + bf_hi(cx), bf_lo(ay) + bf_lo(cy), bf_hi(ay) + bf_hi(cy)};
            const v4u y4 = yh[q][c >> 1]; const unsigned yx = (c & 1) ? y4.z : y4.x, yy = (c & 1) ? y4.w : y4.y;
            const f32x4 yv = {hf_lo(yx), hf_hi(yx), hf_lo(yy), hf_hi(yy)};
            const f32x4 x1 = (yv - st[q].x) * st[q].y * *(const f32x4*)(mg + col) + *(const f32x4*)(mb + col);
            v[q][c] = x1 * ALPHA + *(const f32x4*)(gf + col) * f; }
        float mean, rstd; ln_row(v[q], fg, fb, lane, mean, rstd); }
#pragma unroll
    for (int q = 0; q < RB; ++q) { const int r = rr[q]; const int b = r / TT, t = r - b * TT; const int cond = t < LCT ? 8 : b;
        if (layer == 0) { if (t >= LCT) { hf_t* xh = (hf_t*)outp + ((size_t)b * NXT + (t - LCT)) * DM;
#pragma unroll
                for (int j = 0; j < 2; ++j) { const f32x4 a = v[q][2 * j], c4 = v[q][2 * j + 1]; v4u w; w.x = pkh(a[0], a[1]); w.y = pkh(a[2], a[3]); w.z = pkh(c4[0], c4[1]); w.w = pkh(c4[2], c4[3]);
                    *(v4u*)(xh + 8 * lane + 512 * j) = w; } } }
        else { float* xr = xr_ptr(outp, xrcp, r);
#pragma unroll
            for (int c = 0; c < 4; ++c) *(f32x4*)(xr + pcol(lane, c)) = v[q][c]; }
        if (layer == 0) { const float* mv = modn + (size_t)cond * NMOD; store_h_row(v[q], mv, mv + 1024, hbp + (size_t)r * DM, lane); } }
}

template <int RB>
__device__ __forceinline__ void h0_rows(int r0, const float* __restrict__ xin, const float* __restrict__ cin, const float* __restrict__ mv0, bf16_t* hb, int lane) {
    f32x4 v[RB][4];
#pragma unroll
    for (int q = 0; q < RB; ++q) { const float* src = in0_ptr(xin, cin, r0 + q);
#pragma unroll
        for (int j = 0; j < 2; ++j) { v[q][2 * j] = *(const f32x4*)(src + 8 * lane + 512 * j); v[q][2 * j + 1] = *(const f32x4*)(src + 8 * lane + 512 * j + 4); } }
#pragma unroll
    for (int q = 0; q < RB; ++q) { const int r = r0 + q; const int b = r / TT, t = r - b * TT; const int cond = t < LCT ? 8 : b;
        const float* sv = mv0 + (size_t)cond * NMOD; const float* av = sv + 1024; bf16_t* hrow = hb + (size_t)r * DM;
#pragma unroll
        for (int j = 0; j < 2; ++j) { const int col = 8 * lane + 512 * j;
            const f32x4 s0 = *(const f32x4*)(sv + col), s1 = *(const f32x4*)(sv + col + 4), a0 = *(const f32x4*)(av + col), a1 = *(const f32x4*)(av + col + 4);
            const f32x4 h0 = v[q][2 * j] * (a0 + 1.0f) + s0, h1 = v[q][2 * j + 1] * (a1 + 1.0f) + s1;
            v4u w; w.x = cvtpk(h0[0], h0[1]); w.y = cvtpk(h0[2], h0[3]); w.z = cvtpk(h1[0], h1[1]); w.w = cvtpk(h1[2], h1[3]); *(v4u*)(hrow + col) = w; } }
}

__global__ void __launch_bounds__(512, 2) fwd_megakernel(Args args) {
    extern __shared__ __attribute__((aligned(16))) unsigned char lds[];
    LAS unsigned char* ldsl = (LAS unsigned char*)lds;
    volatile LAS unsigned* MISC = (volatile LAS unsigned*)(ldsl + MISC_OFF);
    const int G0 = gridDim.x; const int bx0 = blockIdx.x;
    const int vcu0 = (G0 % 8 == 0) ? (bx0 % 8) * (G0 / 8) + bx0 / 8 : bx0;
    const int wv = __builtin_amdgcn_readfirstlane(threadIdx.x >> 6);
#define PHASE_IDS() int G = G0, bx = bx0, vcu = vcu0; asm volatile("" : "+s"(G), "+s"(bx), "+s"(vcu)); const int NGW = G * 8; (void)NGW; (void)bx; int wave = wv; asm volatile("" : "+s"(wave)); const int tid = ltid(wave); (void)tid; const int lane = tid & 63; const int gw = vcu * 8 + wave; (void)gw; (void)lane
#define AIN(i) ldptr(ldsl, (i))
#define WSB ((unsigned char*)ldptr(ldsl, 29))
#define ctl ((gu32*)(WSB + WS_CTL))
#define modv ((float*)(WSB + WS_MOD))
#define tab64 ((f32x2*)(WSB + WS_TAB64))
#define tab128 ((f32x2*)(WSB + WS_TAB128))
#define wrt ((float*)(WSB + WS_WRT))
#define wrs ((bf16_t*)(WSB + WS_WRS))
#define tokinfo ((int4*)(WSB + WS_TOKINFO))
#define tokof ((int*)(WSB + WS_TOKOF))
#define rstats ((f32x2*)(WSB + WS_STATS))
#define gwof ((float*)(WSB + WS_GWOF))
#define ACTB ((bf16_t*)(WSB + WS_QKV))
#define XRC ((float*)(WSB + WS_XRC))
#define wqkv0 ((bf16_t*)(WSB + WS_WQKV0))
#define wo0 ((bf16_t*)(WSB + WS_WO0))
#define wqkv1 ((bf16_t*)(WSB + WS_WQKV1))
#define wo1 ((bf16_t*)(WSB + WS_WO1))
#define wgu ((bf16_t*)(WSB + WS_WGU))
#define wd ((bf16_t*)(WSB + WS_WD))
#define HB ((bf16_t*)(WSB + WS_HBUF))
#define QKV ((bf16_t*)(WSB + WS_QKV))
#define HS QKV
#define Y ((hf_t*)(WSB + WS_YOFF))
#define rowst ((f32x2*)(WSB + WS_ROWST))
#define FO ((bf16_t*)(WSB + WS_Y))
#define out ((float*)ldptr(ldsl, 28))
    for (int u = threadIdx.x; u < (LDS_BYTES - MISC_OFF) / 4; u += 512) ((LAS unsigned*)(ldsl + MISC_OFF))[u] = 0u;
    __syncthreads();
    if (threadIdx.x == 0) { LAS unsigned long long* pt = (LAS unsigned long long*)(ldsl + PTR_OFF);
#pragma unroll
        for (int i = 0; i < 28; ++i) pt[i] = (unsigned long long)args.in[i];
        pt[28] = (unsigned long long)args.o_; pt[29] = (unsigned long long)args.w_; }
    __syncthreads();
    xcd_barrier_post((unsigned*)(ctl + CW_BAR));
#define GRID_BAR() xcd_barrier((unsigned*)(ctl + CW_BAR), MISC + 8, ltid(wv) == 0)

        for (int rep_ = 0; rep_ < ((REPMASK >> 0) & 1) * REPN + 1; ++rep_) {
    if (PHMASK & (1 << 0)) {
        PHASE_IDS();
        for (int it = bx; it < 192; it += G) {
            const int layer = it / 96, col0 = (it % 96) * 64;
            const float* Wm = AIN(I_WMOD) + (size_t)layer * DM * NMOD;
            LAS float* sl = (LAS float*)(ldsl + wave * 8192);
            const int k0 = wave * 128;
            for (int idx = lane; idx < 9 * 128; idx += 64) { const int cond = idx >> 7, kk = idx & 127;
                const float v = cond < 8 ? AIN(I_C)[cond * DM + k0 + kk] : AIN(I_CCTX)[k0 + kk];
                sl[idx] = v / (1.f + expf(-v)); }
            LDS_WAIT(); asm volatile("" ::: "memory");
            const int rg = lane >> 4, c4 = (lane & 15) * 4;
            f32x4 acc[9];
#pragma unroll
            for (int c = 0; c < 9; ++c) acc[c] = (f32x4){0.f, 0.f, 0.f, 0.f};
            const unsigned lofs = (unsigned)(rg * NMOD + c4) * 4u;
#pragma unroll 1
            for (int kb = 0; kb < 128; kb += 64) { f32x4 wv_[16];
#pragma unroll
                for (int i = 0; i < 16; ++i) wv_[i] = __builtin_nontemporal_load((const f32x4*)((const char*)(Wm + (size_t)(k0 + kb + 4 * i) * NMOD + col0) + lofs));
#pragma unroll
                for (int i = 0; i < 16; ++i) {
#pragma unroll
                    for (int c = 0; c < 9; ++c) acc[c] += wv_[i] * sl[c * 128 + kb + 4 * i + rg]; } }
            LAS float* part = (LAS float*)(ldsl + 65536);
#pragma unroll
            for (int c = 0; c < 9; ++c) *(LAS f32x4*)(part + (wave * 4 + rg) * 576 + c * 64 + c4) = acc[c];
            __syncthreads();
            for (int idx = tid; idx < 576; idx += 512) { float s = 0.f;
#pragma unroll
                for (int w = 0; w < 32; ++w) s += part[w * 576 + idx];
                const int cond = idx >> 6, col = col0 + (idx & 63);
                modv[((size_t)layer * 9 + cond) * NMOD + col] = s + AIN(I_BMOD)[layer * NMOD + col]; }
            __syncthreads();
        }
        for (int idx = bx * 512 + tid; idx < 3072 + 2 * 8 * 4 * 3 * 64; idx += G * 512) {
            if (idx < 1024) { const int pos = idx >> 4, f = idx & 15; const float inv = powf(10000.f, -(float)(2 * f) / 32.f); float s, c; sincosf((float)pos * inv, &s, &c); tab64[idx] = (f32x2){c, s}; }
            else if (idx < 3072) { const int i2 = idx - 1024, pos = i2 >> 5, f = i2 & 31; const float inv = powf(10000.f, -(float)(2 * f) / 64.f); float s, c; sincosf((float)pos * inv, &s, &c); tab128[i2] = (f32x2){c, s}; }
            else { const int i2 = idx - 3072, ln = i2 & 63, nb = (i2 >> 6) % 3, s = ((i2 >> 6) / 3) & 3, w = ((i2 >> 6) / 12) & 7, l = (i2 >> 6) / 96;
                const int k0 = 128 * w + 32 * s + 8 * (ln >> 4), o = nb * 16 + (ln & 15); float wv_[8];
#pragma unroll
                for (int j = 0; j < 8; ++j) wv_[j] = o < 4 ? AIN(I_WGRP)[(size_t)l * DM * 4 + (k0 + j) * 4 + o] : (o < 36 ? AIN(I_WRT)[(size_t)l * DM * 32 + (k0 + j) * 32 + (o - 4)] : 0.f);
                unsigned hi_[4], lo_[4];
#pragma unroll
                for (int j = 0; j < 4; ++j) { hi_[j] = cvtpk(wv_[2 * j], wv_[2 * j + 1]); lo_[j] = cvtpk(wv_[2 * j] - bf_lo(hi_[j]), wv_[2 * j + 1] - bf_hi(hi_[j])); }
                bf16_t* dst = wrs + ((size_t)(((l * 8 + w) * 4 + s) * 3 + nb) * 2) * 512 + ln * 8;
                *(v4u*)dst = (v4u){hi_[0], hi_[1], hi_[2], hi_[3]}; *(v4u*)(dst + 512) = (v4u){lo_[0], lo_[1], lo_[2], lo_[3]}; }
        }
        LAS float* scr = (LAS float*)(ldsl + wave * 16384);
        constexpr int S0 = 16 * 96, S1 = 16 * 32, S2 = 16 * 48, S3 = 16 * 32, S4 = NEXP * 384;
        for (int it = gw; it < S0 + S1 + S2 + S3; it += NGW) {
            int r = it;
            if (r < S0) { const int n0 = (r % 96) * 32; const bool kcol = (n0 >= 1024 && n0 < 2048);
                transpose_item(AIN(I_DWQKV), NQKV0, wqkv0, DM, kcol ? (n0 & ~255) + ((n0 >> 6) & 3) * 32 + ((n0 >> 5) & 1) * 16 : n0, (r / 96) * 64, n0, scr, lane, kcol ? 128 : 16); continue; } r -= S0;
            if (r < S1) { transpose_item(AIN(I_DWO), DM, wo0, DM, (r % 32) * 32, (r / 32) * 64, (r % 32) * 32, scr, lane); continue; } r -= S1;
            if (r < S2) { const int n0 = (r % 48) * 32; const bool kcol = (n0 >= 1024 && n0 < 1280);
                transpose_item(AIN(I_GWQKV), NQKV1, wqkv1, DM, kcol ? 1024 + ((n0 >> 5) & 1) * 128 + ((n0 >> 7) & 1) * 64 + ((n0 >> 6) & 1) * 32 : n0, (r / 48) * 64, n0, scr, lane); continue; } r -= S2;
            if (r < S3) { transpose_item(AIN(I_GWO), DM, wo1, DM, (r % 32) * 32, (r / 32) * 64, (r % 32) * 32, scr, lane); continue; }
        }
        { int it = gw; for (; it + NGW < S4; it += 2 * NGW) moe_weight_pair(ldsl, 0, it, it + NGW, wgu, wd, scr, lane);
          if (it < S4) moe_weight_item(ldsl, 0, it, wgu, wd, scr, lane); }
    }
    GRID_BAR(); }
        for (int rep_ = 0; rep_ < ((REPMASK >> 1) & 1) * REPN + 1; ++rep_) {
    if (PHMASK & (1 << 1)) { PHASE_IDS();
    { const float* xin = AIN(I_X); const float* cin = AIN(I_CTX); const float* mv0 = modv; bf16_t* hb = HB;
    const int per = (MALL + NGW - 1) / NGW; int r0 = gw * per; const int r1 = min((int)MALL, r0 + per);
    for (; r0 + 5 <= r1; r0 += 5) h0_rows<5>(r0, xin, cin, mv0, hb, lane);
    for (; r0 + 4 <= r1; r0 += 4) h0_rows<4>(r0, xin, cin, mv0, hb, lane);
    for (; r0 < r1; ++r0) h0_rows<1>(r0, xin, cin, mv0, hb, lane);
    } }
    GRID_BAR(); }

#pragma unroll
    for (int layer = 0; layer < 2; ++layer) {
#define modl (modv + (size_t)layer * 9 * NMOD)
        const int NQ = layer == 0 ? NQKV0 : NQKV1;
        for (int rep_ = 0; rep_ < ((REPMASK >> 2) & 1) * REPN + 1; ++rep_) {
        if (PHMASK & (1 << 2))
        { PHASE_IDS();
            pg8::Gemm g{HB, layer == 0 ? wqkv0 : wqkv1, MALL, NQ, DM};
            SchedRect S; if (layer == 0) S.init(72, NQKV0, G, bx, 0, 0); else S.init(64, NQKV1, G, bx, 1, 16);
            EpiStoreBf16 E{QKV, NQ, 0xffff, layer == 0 ? tab64 : tab128, layer == 0 ? (const float*)nullptr : AIN(I_GKN), (LAS float*)(ldsl + MISC_OFF + 4096)};
            pg8::gemm_phase<EpiStoreBf16, SchedRect, true, true>(ldsl, g, S, E, wave);
        }
        GRID_BAR(); }
        for (int rep_ = 0; rep_ < ((REPMASK >> 4) & 1) * REPN + 1; ++rep_) {
        if (PHMASK & (1 << 4)) {
        if (layer == 0 && (PHMASK & (1 << 16))) { PHASE_IDS();
            float lam;
            { const float s1 = wave_sum(AIN(I_LQ1)[lane] * AIN(I_LK1)[lane]), s2 = wave_sum(AIN(I_LQ2)[lane] * AIN(I_LK2)[lane]);
              lam = expf(s1) - expf(s2) + LAMBDA_INIT0; }
            const int nH = 1024, base = nH / G, rem = nH % G;
            const int u0 = vcu * base + (vcu < rem ? vcu : rem), cnt = base + (vcu < rem ? 1 : 0);
            for (int i = 0; i < cnt; ++i) {
                const int u = u0 + i, bh = u >> 4, qb = u & 15, b = bh >> 3, h = bh & 7;
                const size_t row0 = (size_t)b * TT + LCT + qb * 128;
                const bf16_t* kb = QKV + (size_t)b * TT * NQKV0 + h * 128;
                att::attn_unit<true>(QKV + row0 * NQKV0 + h * 128, NQKV0, kb + 1024, kb + 2048, NQKV0, TT, HB + row0 * DM + h * 128, DM,
                                     true, qb * 128, tab64, nullptr, AIN(I_SUBG), lam, (char*)lds, wave);
            }
            for (int l = vcu; l < 128; l += G) {
                const int bh = l >> 1, qb = l & 1, b = bh >> 3, h = bh & 7;
                const size_t row0 = (size_t)b * TT + qb * 128;
                const bf16_t* kb = QKV + (size_t)b * TT * NQKV0 + h * 128;
                att::attn_unit<true>(QKV + row0 * NQKV0 + h * 128, NQKV0, kb + 1024, kb + 2048, NQKV0, LCT, HB + row0 * DM + h * 128, DM,
                                     false, 0, tab64, nullptr, AIN(I_SUBG), lam, (char*)lds, wave);
            }
        } else if (PHMASK & (1 << 17)) { PHASE_IDS();
            const int nU = 512, base = nU / G, rem = nU % G;
            const int u0 = vcu * base + (vcu < rem ? vcu : rem), cnt = base + (vcu < rem ? 1 : 0);
            for (int i = 0; i < cnt; ++i) {
                const int u = u0 + i, bh = u >> 3, qb = u & 7, b = bh >> 3, h = bh & 7;
                const size_t row0 = (size_t)b * TT + LCT + qb * 256;
                const bf16_t* kb = QKV + (size_t)b * TT * NQKV1 + (h >> 2) * 128;
                att::attn_unit<false>(QKV + row0 * NQKV1 + h * 128, NQKV1, kb + 1024, kb + 1280, NQKV1, TT, HB + row0 * DM + h * 128, DM,
                                      true, qb * 256, tab128, AIN(I_GQN), nullptr, 0.f, (char*)lds, wave);
            }
        } }
        GRID_BAR(); }
        for (int rep_ = 0; rep_ < ((REPMASK >> 5) & 1) * REPN + 1; ++rep_) {
        if (PHMASK & (1 << 5))
        { PHASE_IDS();
            pg8::Gemm g{HB, layer == 0 ? wo0 : wo1, MALL, DM, DM};
            SchedRect S; if (layer == 0) S.init(72, DM, G, bx, 0, 0); else S.init(64, DM, G, bx, 1, 0);
            if (layer == 0) { EpiResid<false> E{Y, AIN(I_X), AIN(I_CTX), modl, rstats}; pg8::gemm_phase<EpiResid<false>, SchedRect, true, true>(ldsl, g, S, E, wave); }
            else { EpiResid<true> E{Y, out, (const float*)nullptr, modl, rstats}; pg8::gemm_phase<EpiResid<true>, SchedRect, true, true>(ldsl, g, S, E, wave); }
        }
        GRID_BAR(); }
        if (PHMASK & (1 << 6))
        { PHASE_IDS();
            const int TR = layer == 0 ? 72 : 64;
            const f32x2* stq = rstats; const hf_t* Yq = Y; float* outq = out; float* xrcq = XRC; const float* modq = modl; bf16_t* hbq = HB;
            const float* lg = AIN(I_LNMG) + layer * DM; const float* lb = AIN(I_LNMB) + layer * DM;
            const bf16_t* wrs_l = wrs + (size_t)layer * 8 * 4 * 3 * 2 * 512;
            LAS float* red = (LAS float*)ldsl;
            LAS float* logits = (LAS float*)(ldsl + 116736);
            LAS float* stats = (LAS float*)(ldsl + 127232);
            LAS int* lcnt = (LAS int*)(ldsl + 127232 + 576);
            LAS int* lbase = lcnt + 32;
            for (int it = bx; it < 256; it += G) {
                v4u ypre[5];
                { const int l15p = lane & 15, kgp = lane >> 4; const hf_t* Yp_ = Y;
#pragma unroll
                  for (int mt = 0; mt < 5; ++mt) { const int j = mt * 16 + l15p; const int r = row_of(layer, 0, TR, it, j < TR ? j : 0); ypre[mt] = *(const v4u*)(Yp_ + (size_t)r * DM + 128 * wave + 8 * kgp); } }
                if (tid < 32) lcnt[tid] = 0;
                if (tid < TR) { const int r = row_of(layer, 0, TR, it, tid); const f32x2* sp = stq + (size_t)r * 16; float S = 0.f, Q = 0.f;
#pragma unroll
                    for (int p = 0; p < 16; ++p) { const f32x2 v = sp[p]; S += v.x; Q += v.y; }
                    const float mean = S * (1.f / DM); const float var = fmaxf(Q * (1.f / DM) - mean * mean, 0.f);
                    const float rstd = 1.0f / sqrtf(var + LN_EPS); stats[2 * tid] = mean; stats[2 * tid + 1] = rstd; rowst[r] = (f32x2){mean, rstd}; }
                __syncthreads();
                {
                    const int l15 = lane & 15, kg = lane >> 4;
                    pg8::f32x4 acc[5][3];
#pragma unroll
                    for (int mt = 0; mt < 5; ++mt)
#pragma unroll
                        for (int nb = 0; nb < 3; ++nb) acc[mt][nb] = (pg8::f32x4){0.f, 0.f, 0.f, 0.f};
                    int rrow[5]; float rmean[5], rrstd[5]; int rcond[5];
#pragma unroll
                    for (int mt = 0; mt < 5; ++mt) { const int j = mt * 16 + l15; const bool ok = j < TR; const int r = ok ? row_of(layer, 0, TR, it, j) : row_of(layer, 0, TR, it, 0);
                        const int bb = r / TT, tt = r - bb * TT; rrow[mt] = ok ? r : -1; rmean[mt] = stats[2 * (ok ? j : 0)]; rrstd[mt] = stats[2 * (ok ? j : 0) + 1];
                        rcond[mt] = tt < LCT ? 8 : bb; }
                    const int rfirst = row_of(layer, 0, TR, it, 0);
#define P4_LOADY(YB, S_) do { const int k0_ = 128 * wave + 32 * (S_) + 8 * kg; _Pragma("unroll") for (int mt = 0; mt < 5; ++mt) YB[mt] = *(const v4u*)(Yq + (size_t)(rrow[mt] >= 0 ? rrow[mt] : rfirst) * DM + k0_); } while (0)
#define P4_STEP(YB, S_) do { const int s = (S_); const int k0 = 128 * wave + 32 * s + 8 * kg; \
                        const f32x4 g0 = *(const f32x4*)(lg + k0), g1 = *(const f32x4*)(lg + k0 + 4), b0 = *(const f32x4*)(lb + k0), b1 = *(const f32x4*)(lb + k0 + 4); \
                        bf16x8 bh[3], bl[3]; \
                        _Pragma("unroll") for (int nb = 0; nb < 3; ++nb) { const bf16_t* bp = wrs_l + ((size_t)((wave * 4 + s) * 3 + nb) * 2) * 512 + lane * 8; bh[nb] = *(const bf16x8*)bp; bl[nb] = *(const bf16x8*)(bp + 512); } \
                        _Pragma("unroll") for (int mt = 0; mt < 5; ++mt) { \
                            int co_ = rcond[mt] * NMOD + k0; asm volatile("" : "+v"(co_)); \
                            const float* mv = modq + co_ - k0; \
                            const f32x4 a0 = *(const f32x4*)(mv + 4096 + k0), a1 = *(const f32x4*)(mv + 4096 + k0 + 4), s0 = *(const f32x4*)(mv + 3072 + k0), s1 = *(const f32x4*)(mv + 3072 + k0 + 4); \
                            const v4u yh = YB[mt]; \
                            const f32x4 y0 = {hf_lo(yh.x), hf_hi(yh.x), hf_lo(yh.y), hf_hi(yh.y)}, y1 = {hf_lo(yh.z), hf_hi(yh.z), hf_lo(yh.w), hf_hi(yh.w)}; \
                            const f32x4 x0 = (y0 - rmean[mt]) * rrstd[mt] * g0 + b0, x1 = (y1 - rmean[mt]) * rrstd[mt] * g1 + b1; \
                            f32x4 h0 = x0 * (a0 + 1.0f) + s0, h1 = x1 * (a1 + 1.0f) + s1; \
                            if (rrow[mt] < 0) { h0 = (f32x4){0.f, 0.f, 0.f, 0.f}; h1 = h0; } \
                            v4u hh; hh.x = cvtpk(h0[0], h0[1]); hh.y = cvtpk(h0[2], h0[3]); hh.z = cvtpk(h1[0], h1[1]); hh.w = cvtpk(h1[2], h1[3]); \
                            v4u hl; hl.x = cvtpk(h0[0] - bf_lo(hh.x), h0[1] - bf_hi(hh.x)); hl.y = cvtpk(h0[2] - bf_lo(hh.y), h0[3] - bf_hi(hh.y)); \
                            hl.z = cvtpk(h1[0] - bf_lo(hh.z), h1[1] - bf_hi(hh.z)); hl.w = cvtpk(h1[2] - bf_lo(hh.w), h1[3] - bf_hi(hh.w)); \
                            if (rrow[mt] >= 0) *(v4u*)(hbq + (size_t)rrow[mt] * DM + k0) = hh; \
                            const bf16x8 ah = *reinterpret_cast<const bf16x8*>(&hh), al = *reinterpret_cast<const bf16x8*>(&hl); \
                            _Pragma("unroll") for (int nb = 0; nb < 3; ++nb) { \
                                acc[mt][nb] = __builtin_amdgcn_mfma_f32_16x16x32_bf16(ah, bh[nb], acc[mt][nb], 0, 0, 0); \
                                acc[mt][nb] = __builtin_amdgcn_mfma_f32_16x16x32_bf16(ah, bl[nb], acc[mt][nb], 0, 0, 0); \
                                acc[mt][nb] = __builtin_amdgcn_mfma_f32_16x16x32_bf16(al, bh[nb], acc[mt][nb], 0, 0, 0); } } } while (0)
                    { v4u ya[5], yb[5];
#pragma unroll
                      for (int mt = 0; mt < 5; ++mt) ya[mt] = ypre[mt];
#pragma unroll 1
                      for (int s2 = 0; s2 < 4; s2 += 2) {
                          P4_LOADY(yb, s2 + 1); __builtin_amdgcn_sched_barrier(0);
                          P4_STEP(ya, s2); __builtin_amdgcn_sched_barrier(0);
                          P4_LOADY(ya, (s2 + 2) & 3); __builtin_amdgcn_sched_barrier(0);
                          P4_STEP(yb, s2 + 1); __builtin_amdgcn_sched_barrier(0); } }
#undef P4_LOADY
#undef P4_STEP
                    const int ln2 = ltid(wave) & 63; const int l15b = ln2 & 15, kgb = ln2 >> 4;
#pragma unroll
                    for (int mt = 0; mt < 5; ++mt)
#pragma unroll
                        for (int nb = 0; nb < 3; ++nb)
#pragma unroll
                            for (int q = 0; q < 4; ++q) { const int row = mt * 16 + kgb * 4 + q, col = nb * 16 + l15b; if (row < 72 && col < 36) red[wave * 2592 + row * 36 + col] = acc[mt][nb][q]; }
                }
                const int tidc = ltid(wave);
                __syncthreads();
                for (int idx = tidc; idx < 2592; idx += 512) { const int o = idx % 36;
                    float s = o < 4 ? AIN(I_BGRP)[layer * 4 + o] : AIN(I_BRT)[layer * 32 + o - 4];
#pragma unroll
                    for (int w = 0; w < 8; ++w) s += red[w * 2592 + idx];
                    logits[idx] = s; }
                __syncthreads();
                int e1 = 0, e2 = 0, rk1 = 0, rk2 = 0; float G1 = 0.f, G2 = 0.f; int rme = 0;
                if (tidc < TR) {
                    const LAS float* lgt = logits + tidc * 36;
                    int gi = 0; float gm = lgt[0];
#pragma unroll
                    for (int g = 1; g < 4; ++g) { const float v = lgt[g]; if (v > gm) { gm = v; gi = g; } }
                    float gs = 0.f;
#pragma unroll
                    for (int g = 0; g < 4; ++g) gs += expf(lgt[g] - gm);
                    const float gtop = 1.0f / gs;
                    const LAS float* el = lgt + 4 + gi * 8;
                    int i1 = 0; float v1 = el[0];
#pragma unroll
                    for (int e = 1; e < 8; ++e) { const float v = el[e]; if (v > v1) { v1 = v; i1 = e; } }
                    int i2 = -1; float v2 = -3.0e38f;
#pragma unroll
                    for (int e = 0; e < 8; ++e) { const float v = el[e]; if (e != i1 && v > v2) { v2 = v; i2 = e; } }
                    const float ex = expf(v2 - v1); const float w1 = 1.0f / (1.0f + ex), w2 = ex / (1.0f + ex);
                    e1 = gi * 8 + i1; e2 = gi * 8 + i2; G1 = gtop * w1; G2 = gtop * w2;
                    rk1 = atomicAdd((int*)(lcnt + e1), 1); rk2 = atomicAdd((int*)(lcnt + e2), 1);
                    if (layer == 0) rme = it * 72 + tidc; else { const int xi = it * 64 + tidc; rme = (xi >> 11) * TT + LCT + (xi & 2047); }
                }
                __syncthreads();
                if (tidc < 32) { const int n = lcnt[tidc]; lbase[tidc] = n ? (int)__hip_atomic_fetch_add((unsigned*)(ctl + CW_CNT + layer * 32 + tidc), (unsigned)n, RLX_AGENT) : 0; }
                __syncthreads();
                if (tidc < TR) { const int q1 = lbase[e1] + rk1, q2 = lbase[e2] + rk2; tokinfo[rme] = make_int4(e1, q1, e2, q2);
                    int* tkf = tokof; float* gwf = gwof; tkf[(size_t)e1 * ECAP + q1] = rme; tkf[(size_t)e2 * ECAP + q2] = rme; gwf[(size_t)e1 * ECAP + q1] = G1; gwf[(size_t)e2 * ECAP + q2] = G2; }
                __syncthreads();
            }
        }
        GRID_BAR();
        for (int rep_ = 0; rep_ < ((REPMASK >> 8) & 1) * REPN + 1; ++rep_) {
        if (PHMASK & (1 << 8))
        {
            PHASE_IDS();
            LAS unsigned char* tile_e = ldsl + TILEE_OFF; LAS int* rowb = (LAS int*)(ldsl + ROWB_OFF); LAS int* cntl = (LAS int*)(ldsl + ROWB_OFF + 128); LAS int* tbase = (LAS int*)(ldsl + ROWB_OFF + 256);
            if (tid == 0) { int tt = 0;
#pragma unroll 1
                for (int e = 0; e < NEXP; ++e) { const int cnt = (int)__hip_atomic_load((unsigned*)(ctl + CW_CNT + layer * 32 + e), RLX_AGENT); rowb[e] = tt * 256; tbase[e] = tt; cntl[e] = cnt; tt += (cnt + 255) >> 8; }
                tbase[NEXP] = tt; MISC[16] = (unsigned)tt; }
            __syncthreads();
            if (tid < 176) { int e = 0;
#pragma unroll 1
                for (int q = 1; q < NEXP; ++q) e += (tbase[q] <= tid) ? 1 : 0;
                tile_e[tid] = (unsigned char)e; }
            __syncthreads();
            const int ntile = (int)MISC[16];
            pg8::Gemm g{HB, wgu, SORT_ROWS, NEXP * 512, DM};
            SchedExp S{ldsl + TILEE_OFF, 2, ntile * 2, G, bx};
            EpiGateUp E{ACTB, gwof, tbase};
            pg8::GatherA GA{tokof, tbase, cntl, 2, ECAP};
            pg8::gemm_phase<EpiGateUp, SchedExp, true, true, true, pg8::GatherA>(ldsl, g, S, E, wave, GA);
        }
        GRID_BAR(); }
        for (int rep_ = 0; rep_ < ((REPMASK >> 9) & 1) * REPN + 1; ++rep_) {
        if (PHMASK & (1 << 9))
        { PHASE_IDS();
            const int ntile = (int)MISC[16];
            int kdn = FH; asm volatile("" : "+s"(kdn));
            pg8::Gemm g{ACTB, wd, SORT_ROWS, NEXP * 1024, kdn};
            SchedExp S{ldsl + TILEE_OFF, 4, ntile * 4, G, bx};
            EpiStoreBf16 E{FO, DM, 3, (const f32x2*)nullptr, (const float*)nullptr, (LAS float*)nullptr};
            pg8::gemm_phase<EpiStoreBf16, SchedExp, true, true>(ldsl, g, S, E, wave);
        }
        GRID_BAR(); }
        if (PHMASK & (1 << 10))
        { PHASE_IDS();
            const float* fg = AIN(I_LNFG) + layer * DM; const float* fb = AIN(I_LNFB) + layer * DM;
            const int nrows = layer == 0 ? MALL : MXR;
            { const hf_t* Yq = Y; const f32x2* rsq = rowst; const float* mg = AIN(I_LNMG) + layer * DM; const float* mb = AIN(I_LNMB) + layer * DM; const int4* tinfo = tokinfo; const LAS int* rowb = (const LAS int*)(ldsl + ROWB_OFF); const bf16_t* fo = FO; float* outq = out; float* xrcq = XRC; const float* modq = modl; const float* modn = modv + (size_t)9 * NMOD; bf16_t* hbq = HB;
              if (layer == 0) {
                  const int per = (nrows + NGW - 1) / NGW; int idx0 = gw * per; const int i1 = min(nrows, idx0 + per);
                  for (; idx0 + 3 <= i1; idx0 += 3) p8_rows<3>(idx0, layer, tinfo, rowb, fo, Yq, rsq, mg, mb, outq, xrcq, modq, modn, fg, fb, hbq, lane);
                  for (; idx0 < i1; ++idx0) p8_rows<1>(idx0, layer, tinfo, rowb, fo, Yq, rsq, mg, mb, outq, xrcq, modq, modn, fg, fb, hbq, lane);
              } else
              for (int idx0 = gw * 4; idx0 < nrows; idx0 += NGW * 4) p8_rows<4>(idx0, layer, tinfo, rowb, fo, Yq, rsq, mg, mb, outq, xrcq, modq, modn, fg, fb, hbq, lane); }
            if (layer == 0) {
                LAS float* scr = (LAS float*)(ldsl + wave * 16384);
                { int it = gw; for (; it + NGW < NEXP * 384; it += 2 * NGW) moe_weight_pair(ldsl, 1, it, it + NGW, wgu, wd, scr, lane);
                  if (it < NEXP * 384) moe_weight_item(ldsl, 1, it, wgu, wd, scr, lane); }
                GRID_BAR();
            }
        }
    }
}

#undef out
#undef Y
#undef HS
#undef QKV
#undef HB
#undef ctl
extern "C" void kernel_launch(void* const* d_in, const int* in_sizes, int n_in, void* d_out, int out_size, void* d_ws, size_t ws_size, hipStream_t stream) {
    static int grid = 0;
    if (grid == 0) {
        if (n_in != 28 || in_sizes[0] != MXR * DM || out_size != MXR * DM || ws_size < WS_END) {
            fprintf(stderr, "kernel_launch: unexpected shapes: n_in %d in0 %d out %d ws %zu (need %zu)\n", n_in, n_in > 0 ? in_sizes[0] : -1, out_size, ws_size, (size_t)WS_END); grid = -1; return; }
        int dev = 0, cus = 0, per_cu = 0;
        if (hipGetDevice(&dev) != hipSuccess || hipDeviceGetAttribute(&cus, hipDeviceAttributeMultiprocessorCount, dev) != hipSuccess) { grid = -1; return; }
        if (hipFuncSetAttribute((const void*)fwd_megakernel, hipFuncAttributeMaxDynamicSharedMemorySize, LDS_BYTES) != hipSuccess) { fprintf(stderr, "kernel_launch: hipFuncSetAttribute failed\n"); grid = -1; return; }
        if (hipOccupancyMaxActiveBlocksPerMultiprocessor(&per_cu, (const void*)fwd_megakernel, 512, LDS_BYTES) != hipSuccess || per_cu < 1) { fprintf(stderr, "kernel_launch: occupancy query reports %d\n", per_cu); (void)hipGetLastError(); per_cu = 1; }
        grid = cus;
        if (grid > 256) grid = 256;
    }
    if (grid < 0) return;
    if (hipMemsetAsync((char*)d_ws + WS_CTL, 0, CTL_ZERO_BYTES, stream) != hipSuccess) { fprintf(stderr, "kernel_launch: memset failed\n"); return; }
    Args a{};
    for (int i = 0; i < 28; ++i) a.in[i] = (const float*)d_in[i];
    a.o_ = (float*)d_out; a.w_ = (unsigned char*)d_ws;
    hipLaunchKernelGGL(fwd_megakernel, dim3(grid), dim3(512), LDS_BYTES, stream, a);
    const hipError_t le = hipPeekAtLastError();
    if (le != hipSuccess) fprintf(stderr, "kernel_launch: launch failed: %s\n", hipGetErrorName(le));
}
```

```cpp
#include <hip/hip_runtime.h>
#include <hip/hip_bf16.h>
#include <cstdio>
#include <cstdint>
__device__ __forceinline__ int ltid(int wv) { int l; asm volatile("v_mbcnt_lo_u32_b32 %0, -1, 0\n\tv_mbcnt_hi_u32_b32 %0, -1, %0" : "=v"(l)); return wv * 64 + l; }
namespace pg8 {
#define PG8_LAS __attribute__((address_space(3)))
typedef unsigned short bf16_t;
typedef short bf16x8 __attribute__((ext_vector_type(8)));
typedef float f32x4 __attribute__((ext_vector_type(4)));
typedef unsigned u32x4 __attribute__((ext_vector_type(4)));
constexpr int BM = 256, BK = 64, HALF = 128, HTB = HALF * BK * 2  , STAGE_BYTES = 8 * HTB, NXCD = 8, WGM = 8;

__host__ __device__ __forceinline__ int lds_byte(int r, int c) { const int st = (r >> 4) * 2 + (c >> 5), rr = r & 15, cc = c & 31, ob = rr * 64 + cc * 2; return st * 1024 + (ob ^ (((ob >> 9) & 1) << 5)); }
__host__ __device__ __forceinline__ void stage_rc(int b, int& R, int& C) { const int st = b / 1024, sb = b % 1024, swz = sb ^ (((sb >> 9) & 1) << 5); R = (st >> 1) * 16 + swz / 64; C = (st & 1) * 32 + (swz % 64) / 2; }
__host__ __device__ __forceinline__ int perm32(int rho) { const int n = rho >> 4, i = rho & 15; return 8 * (i >> 2) + 4 * n + (i & 3); }

struct Unit { int pm, pn, hm; };
struct Gemm { const bf16_t* A; const bf16_t* Bt; int M, N, K; };

struct StaticOrder {
    int nM, nN, nwg, G, c;
    __host__ __device__ void init(int M, int N, int G_, int c_) { nM = M / BM; nN = N / BM; nwg = nM * nN; G = G_; c = c_; }
    __host__ __device__ bool next(int i, Unit& u) const { return at((long)i * G + c, u); }
    __host__ __device__ bool at(const long L, Unit& u) const {
        if (L >= nwg) return false; u.hm = 0;
        int wgid = (int)L; { const int q = nwg / NXCD, r = nwg % NXCD, xcd = wgid % NXCD, off = wgid / NXCD; wgid = (xcd < r ? xcd * (q + 1) : r * (q + 1) + (xcd - r) * q) + off; }
        const int nig = WGM * nN, gid = wgid / nig, fm = gid * WGM, gsz = (nM - fm) < WGM ? (nM - fm) : WGM;
        u.pm = fm + ((wgid % nig) % gsz); u.pn = (wgid % nig) / gsz; return true;
    }
    __device__ __forceinline__ void a_ready(const Unit&) const {}
    __device__ __forceinline__ void done(const Unit&) const {}
};

__device__ __forceinline__ unsigned cvt_pk_bf16(float lo, float hi) { unsigned r; asm volatile("v_cvt_pk_bf16_f32 %0, %1, %2" : "=v"(r) : "v"(lo), "v"(hi)); return r; }
typedef float f32x2 __attribute__((ext_vector_type(2)));
struct NoGather {};
struct GatherA { const int* tok; const PG8_LAS int* tbase; const PG8_LAS int* cnt; int NP, cap; };
template <class Epi, class Sched, bool ALIGN_EPI = false, bool SP2 = false, bool GATHER = false, class GAT = NoGather>
__device__ __forceinline__ void gemm_phase(PG8_LAS unsigned char* lds, const Gemm g, const Sched& S, const Epi& E, const int wv, const GAT& GA = GAT()) {
    static_assert(!GATHER || SP2, "gather staging is written for the SP2 loop");
    const int tid = ltid(wv), wid = wv, lane = tid & 63, wr = wid >> 2, wc = wid & 3, fr = lane & 15, fq = lane >> 4;
    const int K = g.K, nt = K / BK;
    unsigned voffA[2], voffB[2];
#pragma unroll
    for (int i = 0; i < 2; ++i) { int R, C; stage_rc(tid * 16 + i * 8192, R, C); const int Rb = Epi::PERM ? ((R & ~31) + perm32(R & 31)) : R;
        voffA[i] = (unsigned)(R * K + C) * 2u; voffB[i] = (unsigned)(Rb * K + C) * 2u; }
    const size_t kstep = (size_t)(BK * 2);
    const size_t hstep = (size_t)HALF * K * 2;
    const size_t tstep = 2 * hstep;
    const unsigned ldsw = (unsigned)wid * 1024u;
    const int aoff = lds_byte(wr * 64 + fr, fq * 8), boff = lds_byte(wc * 32 + fr, fq * 8);
#define PG8_SA(b, h) (((b) * 2 + (h)) * HTB)
#define PG8_SB(b, h) ((4 + (b) * 2 + (h)) * HTB)
#define PG8_STAGE(bufoff, gbase, voff) do { _Pragma("unroll") for (int _i = 0; _i < 2; ++_i) \
        __builtin_amdgcn_global_load_lds((const unsigned*)((const char*)(gbase) + (voff)[_i]), (PG8_LAS unsigned*)(lds + (bufoff) + ldsw + _i * 8192), 16, 0, 0); } while (0)
#define PG8_STAGE_A(bufoff, ngptr, h, kofs, GV) do { if constexpr (GATHER) { PG8_STAGE(bufoff, (const char*)g.A + (kofs), GV[h]); } else { PG8_STAGE(bufoff, ngptr, voffA); } } while (0)
#define PG8_GOFS(dst, U) do { if constexpr (GATHER) { const int e_ = (U).pn / GA.NP; const int rk0_ = ((U).pm - GA.tbase[e_]) * 256; const int c_ = GA.cnt[e_]; \
        _Pragma("unroll") for (int h_ = 0; h_ < 2; ++h_) _Pragma("unroll") for (int i_ = 0; i_ < 2; ++i_) { int R_, C_; stage_rc(tid * 16 + i_ * 8192, R_, C_); const int rk_ = rk0_ + h_ * 128 + R_; \
            const int tk_ = rk_ < c_ ? GA.tok[(size_t)e_ * GA.cap + rk_] : 0; dst[h_][i_] = (unsigned)(tk_ * K + C_) * 2u; } } } while (0)
#define PG8_LDA(dst, b, h) do { _Pragma("unroll") for (int m = 0; m < 4; ++m) _Pragma("unroll") for (int k = 0; k < 2; ++k) dst[m][k] = *(const PG8_LAS bf16x8*)(lds + PG8_SA(b, h) + aoff + m * 2048 + k * 1024); } while (0)
#define PG8_LDB(dst, b, h) do { _Pragma("unroll") for (int n = 0; n < 2; ++n) _Pragma("unroll") for (int k = 0; k < 2; ++k) dst[n][k] = *(const PG8_LAS bf16x8*)(lds + PG8_SB(b, h) + boff + n * 2048 + k * 1024); } while (0)
#define PG8_MMA(ai, bj, At, Bt) do { if (cur.hm != 0 && cur.hm != (ai) + 1) break; __builtin_amdgcn_s_setprio(1); _Pragma("unroll") for (int m = 0; m < 4; ++m) _Pragma("unroll") for (int n = 0; n < 2; ++n) _Pragma("unroll") for (int k = 0; k < 2; ++k) \
        acc[ai][bj][m][n] = __builtin_amdgcn_mfma_f32_16x16x32_bf16(Bt[n][k], At[m][k], acc[ai][bj][m][n], 0, 0, 0); __builtin_amdgcn_s_setprio(0); } while (0)
#define PG8_WAIT_V(n) asm volatile("s_waitcnt vmcnt(" #n ")" ::: "memory")
#define PG8_WAIT_L(n) asm volatile("s_waitcnt lgkmcnt(" #n ")" ::: "memory")
#define PG8_BAR __builtin_amdgcn_s_barrier()
#define PG8_SCHED __builtin_amdgcn_sched_barrier(0)
    Unit cur, nxt; int ui = 0;
    if (!S.next(0, cur)) return;
    f32x4 acc[2][2][4][2];
#pragma unroll
    for (int a = 0; a < 2; ++a)
#pragma unroll
        for (int b = 0; b < 2; ++b)
#pragma unroll
            for (int m = 0; m < 4; ++m)
#pragma unroll
                for (int n = 0; n < 2; ++n) acc[a][b][m][n] = (f32x4){0.f, 0.f, 0.f, 0.f};
    bf16x8 At[4][2], B0[2][2], B1[2][2];
    const char* cA = (const char*)g.A + (size_t)cur.pm * tstep; const char* cB = (const char*)g.Bt + (size_t)cur.pn * tstep;
    S.a_ready(cur);
    unsigned curG[2][2] = {{0u, 0u}, {0u, 0u}}, nxtG[2][2] = {{0u, 0u}, {0u, 0u}};
    PG8_GOFS(curG, cur); { Unit n0_; if (S.next(1, n0_)) PG8_GOFS(nxtG, n0_); }
    if constexpr (SP2) {
        PG8_STAGE(PG8_SB(0, 0), cB, voffB); PG8_STAGE(PG8_SB(0, 1), cB + hstep, voffB); PG8_STAGE_A(PG8_SA(0, 0), cA, 0, (size_t)0, curG); PG8_STAGE_A(PG8_SA(0, 1), cA + hstep, 1, (size_t)0, curG);
        if (wr == 1) PG8_BAR;
        PG8_WAIT_V(2); PG8_BAR;
        PG8_STAGE(PG8_SB(1, 0), cB + kstep, voffB); PG8_STAGE_A(PG8_SA(1, 0), cA + kstep, 0, kstep, curG); PG8_STAGE(PG8_SB(1, 1), cB + hstep + kstep, voffB);
        PG8_WAIT_V(6); PG8_BAR;
    } else {
        PG8_STAGE(PG8_SB(0, 0), cB, voffB); PG8_STAGE(PG8_SA(0, 0), cA, voffA); PG8_STAGE(PG8_SB(0, 1), cB + hstep, voffB); PG8_STAGE(PG8_SA(0, 1), cA + hstep, voffA);
        if (wr == 1) PG8_BAR;
        PG8_WAIT_V(4); PG8_BAR;
        PG8_STAGE(PG8_SB(1, 0), cB + kstep, voffB); PG8_STAGE(PG8_SA(1, 0), cA + kstep, voffA); PG8_STAGE(PG8_SB(1, 1), cB + hstep + kstep, voffB);
        PG8_WAIT_V(6); PG8_BAR;
    }
    for (;;) {
        const bool has_next = S.next(ui + 1, nxt);
        if (GATHER && has_next && ui >= 1) PG8_GOFS(nxtG, nxt);
        const char* nA = has_next ? (const char*)g.A + (size_t)nxt.pm * tstep : cA; const char* nB = has_next ? (const char*)g.Bt + (size_t)nxt.pn * tstep : cB;
        for (int t = 0; t < nt; t += 2) {
            const bool last = (t == nt - 2);
            const char* a1 = cA + (size_t)(t + 1) * kstep;
            const char* a2 = last ? nA : cA + (size_t)(t + 2) * kstep; const char* b2 = last ? nB : cB + (size_t)(t + 2) * kstep;
            const char* a3 = a2 + kstep; const char* b3 = b2 + kstep;
            if (last && has_next) S.a_ready(nxt);
            const size_t k1o = (size_t)(t + 1) * kstep, k2o = last ? (size_t)0 : (size_t)(t + 2) * kstep; unsigned selG[2][2];
            _Pragma("unroll") for (int h_ = 0; h_ < 2; ++h_) _Pragma("unroll") for (int i_ = 0; i_ < 2; ++i_) selG[h_][i_] = (last && has_next) ? nxtG[h_][i_] : curG[h_][i_];
            if constexpr (SP2) {
            PG8_LDB(B0, 0, 0); PG8_LDB(B1, 0, 1); PG8_SCHED; PG8_LDA(At, 0, 0); PG8_STAGE_A(PG8_SA(1, 1), a1 + hstep, 1, k1o, curG);
            PG8_WAIT_V(8); PG8_WAIT_L(0); PG8_BAR; PG8_MMA(0, 0, At, B0); PG8_MMA(0, 1, At, B1); PG8_BAR; PG8_SCHED;
            PG8_LDA(At, 0, 1); PG8_STAGE(PG8_SB(0, 0), b2, voffB); PG8_STAGE(PG8_SB(0, 1), b2 + hstep, voffB); PG8_STAGE_A(PG8_SA(0, 0), a2, 0, k2o, selG);
            PG8_WAIT_V(8); PG8_WAIT_L(0); PG8_BAR; PG8_MMA(1, 0, At, B0); PG8_MMA(1, 1, At, B1); PG8_BAR; PG8_SCHED;
            PG8_LDB(B0, 1, 0); PG8_LDB(B1, 1, 1); PG8_SCHED; PG8_LDA(At, 1, 0); PG8_STAGE_A(PG8_SA(0, 1), a2 + hstep, 1, k2o, selG);
            PG8_WAIT_V(8); PG8_WAIT_L(0); PG8_BAR; PG8_MMA(0, 0, At, B0); PG8_MMA(0, 1, At, B1); PG8_BAR; PG8_SCHED;
            PG8_LDA(At, 1, 1); PG8_STAGE(PG8_SB(1, 0), b3, voffB); PG8_STAGE(PG8_SB(1, 1), b3 + hstep, voffB); PG8_STAGE_A(PG8_SA(1, 0), a3, 0, k2o + kstep, selG);
            PG8_WAIT_V(8); PG8_WAIT_L(0); PG8_BAR; PG8_MMA(1, 0, At, B0); PG8_MMA(1, 1, At, B1); PG8_BAR; PG8_SCHED;
            } else {
            PG8_LDB(B0, 0, 0); PG8_SCHED; PG8_LDA(At, 0, 0); PG8_STAGE(PG8_SA(1, 1), a1 + hstep, voffA);
            PG8_WAIT_L(8); PG8_BAR; PG8_WAIT_L(0); PG8_MMA(0, 0, At, B0); PG8_BAR; PG8_SCHED;
            PG8_LDB(B1, 0, 1); PG8_STAGE(PG8_SB(0, 0), b2, voffB);
            PG8_BAR; PG8_WAIT_L(0); PG8_MMA(0, 1, At, B1); PG8_BAR;
            PG8_LDA(At, 0, 1); PG8_STAGE(PG8_SA(0, 0), a2, voffA);
            PG8_BAR; PG8_WAIT_L(0); PG8_MMA(1, 0, At, B0); PG8_BAR; PG8_SCHED;
            PG8_STAGE(PG8_SB(0, 1), b2 + hstep, voffB);
            PG8_WAIT_V(6); PG8_BAR; PG8_MMA(1, 1, At, B1); PG8_BAR;
            PG8_LDB(B0, 1, 0); PG8_SCHED; PG8_LDA(At, 1, 0); PG8_STAGE(PG8_SA(0, 1), a2 + hstep, voffA);
            PG8_WAIT_L(8); PG8_BAR; PG8_WAIT_L(0); PG8_MMA(0, 0, At, B0); PG8_BAR; PG8_SCHED;
            PG8_LDB(B1, 1, 1); PG8_STAGE(PG8_SB(1, 0), b3, voffB);
            PG8_BAR; PG8_WAIT_L(0); PG8_MMA(0, 1, At, B1); PG8_BAR;
            PG8_LDA(At, 1, 1); PG8_STAGE(PG8_SA(1, 0), a3, voffA);
            PG8_BAR; PG8_WAIT_L(0); PG8_MMA(1, 0, At, B0); PG8_BAR; PG8_SCHED;
            PG8_STAGE(PG8_SB(1, 1), b3 + hstep, voffB);
            PG8_WAIT_V(6); PG8_BAR; PG8_MMA(1, 1, At, B1); PG8_BAR;
            }
        }
        if constexpr (ALIGN_EPI) { if (wr == 0) PG8_BAR; }
        if constexpr (!Epi::AFTER_DRAIN) { E(acc, cur, wr, wc, fr, fq); S.done(cur); }
        if (!has_next) break;
#pragma unroll
        for (int a = 0; a < 2; ++a)
#pragma unroll
            for (int b = 0; b < 2; ++b)
#pragma unroll
                for (int m = 0; m < 4; ++m)
#pragma unroll
                    for (int n = 0; n < 2; ++n) acc[a][b][m][n] = (f32x4){0.f, 0.f, 0.f, 0.f};
        cur = nxt; cA = nA; cB = nB; ++ui;
        _Pragma("unroll") for (int h_ = 0; h_ < 2; ++h_) _Pragma("unroll") for (int i_ = 0; i_ < 2; ++i_) curG[h_][i_] = nxtG[h_][i_];
        if constexpr (ALIGN_EPI) { if (wr == 1) PG8_BAR; }
    }
    PG8_WAIT_V(0);
    if constexpr (!ALIGN_EPI) { if (wr == 0) PG8_BAR; }
    PG8_BAR;
    if constexpr (Epi::AFTER_DRAIN) { E.fused(acc, cur, wr, wc, fr, fq, lds, wid, lane); S.done(cur); }
#undef PG8_SA
#undef PG8_SB
#undef PG8_STAGE
#undef PG8_LDA
#undef PG8_STAGE_A
#undef PG8_GOFS
#undef PG8_LDB
#undef PG8_MMA
#undef PG8_WAIT_V
#undef PG8_WAIT_L
#undef PG8_BAR
#undef PG8_SCHED
}
}

constexpr int NB = 8, NXT = 2048, LCT = 256, TT = 2304, DM = 1024;
constexpr int MALL = NB * TT;
constexpr int MXR = NB * NXT;
constexpr int NQKV0 = 3072, NQKV1 = 1536;
constexpr int NEXP = 32, FH = 256, NMOD = 6144;
constexpr float ALPHA = 1.41421356237309515f;
constexpr float LAMBDA_INIT0 = 0.2f;
constexpr float LN_EPS = 1e-5f, RMS_EPS = 1e-6f;
constexpr int SORT_ROWS = 45056;

#define GAS __attribute__((address_space(1)))
#define LAS __attribute__((address_space(3)))
typedef unsigned short bf16_t;
typedef unsigned v4u __attribute__((ext_vector_type(4)));
typedef unsigned v2u __attribute__((ext_vector_type(2)));
typedef float f32x4 __attribute__((ext_vector_type(4)));
typedef float f32x2 __attribute__((ext_vector_type(2)));
typedef short bf16x8 __attribute__((ext_vector_type(8)));
typedef short s16x4 __attribute__((ext_vector_type(4)));
typedef float f32x16 __attribute__((ext_vector_type(16)));
typedef GAS unsigned gu32;
#define RLX_AGENT __ATOMIC_RELAXED, __HIP_MEMORY_SCOPE_AGENT
#define LDS_WAIT() asm volatile("s_waitcnt lgkmcnt(0)" ::: "memory")
#define VM_WAIT() asm volatile("s_waitcnt vmcnt(0)" ::: "memory")

constexpr size_t MiB = 1u << 20;
constexpr size_t WS_CTL = 0, CTL_ZERO_BYTES = 1 * MiB;
constexpr size_t WS_MOD = 1 * MiB;
constexpr size_t WS_TAB64 = 1 * MiB + 512 * 1024;
constexpr size_t WS_TAB128 = WS_TAB64 + 8192;
constexpr size_t WS_WRT = WS_TAB64 + 65536;
constexpr size_t WS_TOKINFO = 2 * MiB;
constexpr size_t WS_TOKW = WS_TOKINFO + (size_t)MALL * 16;
constexpr size_t WS_TOKPOS = WS_TOKW + (size_t)MALL * 8;
constexpr size_t WS_GW = 3 * MiB;
constexpr size_t WS_XRC = 4 * MiB;
constexpr size_t WS_WQKV0 = 12 * MiB, WS_WO0 = 18 * MiB, WS_WQKV1 = 20 * MiB, WS_WO1 = 23 * MiB;
constexpr size_t WS_WGU = 26 * MiB;
constexpr size_t WS_WD = 58 * MiB;
constexpr size_t WS_HBUF = 74 * MiB;
constexpr size_t WS_QKV = 110 * MiB;
constexpr size_t WS_Y = 218 * MiB;
constexpr size_t WS_TOKOF = 306 * MiB;
constexpr size_t WS_GWOF = 309 * MiB;
constexpr int ECAP = 18432;
constexpr size_t WS_STATS = 312 * MiB;
constexpr size_t WS_ROWST = 315 * MiB;
constexpr size_t WS_YOFF = WS_QKV + 24 * MiB;
constexpr size_t WS_WRS = 316 * MiB;
constexpr size_t WS_END = 317 * MiB;
static_assert(WS_TOKPOS + (size_t)MALL * 8 <= WS_GW && WS_GW + SORT_ROWS * 4 <= WS_XRC && WS_XRC + 2048 * 4096 <= WS_WQKV0, "ws map");
static_assert(WS_YOFF + (size_t)MALL * DM * 4 <= WS_Y && (size_t)SORT_ROWS * FH * 2 <= 24 * MiB && WS_QKV + (size_t)MALL * 3072 * 2 <= WS_Y && WS_Y + (size_t)SORT_ROWS * 2048 <= WS_END && WS_HBUF + (size_t)MALL * 2048 <= WS_QKV, "ws map");
constexpr int CW_BAR = 4096;
constexpr int CW_CNT = 8192;

constexpr int RING_BYTES = 131072;
constexpr int MISC_OFF = 139264;
constexpr int TILEE_OFF = MISC_OFF + 256;
constexpr int ROWB_OFF = MISC_OFF + 512;
constexpr int LDS_BYTES = 147456;

__device__ __forceinline__ unsigned cvtpk(float lo, float hi) { unsigned r; asm volatile("v_cvt_pk_bf16_f32 %0, %1, %2" : "=v"(r) : "v"(lo), "v"(hi)); return r; }
__device__ __forceinline__ float bf_lo(unsigned u) { return __uint_as_float(u << 16); }
__device__ __forceinline__ float bf_hi(unsigned u) { return __uint_as_float(u & 0xffff0000u); }
template <int M> __device__ __forceinline__ float xsum(float v) {
    if constexpr (M < 32) return v + __int_as_float(__builtin_amdgcn_ds_swizzle(__float_as_int(v), (M << 10) | 0x1f));
    else { auto rr = __builtin_amdgcn_permlane32_swap(__float_as_uint(v), __float_as_uint(v), false, false); return __uint_as_float(rr[0]) + __uint_as_float(rr[1]); }
}
__device__ __forceinline__ float sum32(float v) { v = xsum<1>(v); v = xsum<2>(v); v = xsum<4>(v); v = xsum<8>(v); v = xsum<16>(v); return v; }
__device__ __forceinline__ float wave_sum(float v) { return xsum<32>(sum32(v)); }
__device__ __forceinline__ int row_b(int r) { return r / TT; }
__device__ __forceinline__ float* xr_ptr(float* out, float* xrc, int r) {
    const int b = r / TT, t = r - b * TT;
    return t < LCT ? xrc + ((size_t)b * LCT + t) * DM : out + ((size_t)b * NXT + (t - LCT)) * DM;
}
__device__ __forceinline__ const float* in0_ptr(const float* x, const float* ctx, int r) {
    const int b = r / TT, t = r - b * TT;
    return t < LCT ? ctx + ((size_t)b * LCT + t) * DM : x + ((size_t)b * NXT + (t - LCT)) * DM;
}

#define XB_TMO      128
#define XB_XCNT(j)  (256  + 64 * (j))
#define XB_XSUB(j)  (1280 + 64 * (j))
#define XB_XGEN(j)  (2304 + 64 * (j))
#define XB_TOP      3328
#define XB_TOPGEN   3392
#define XCD_BAR_WORDS 3456
#define XB_SPIN_CAP (1u << 18)
__device__ __forceinline__ unsigned xb_ld(unsigned* p)              { return __hip_atomic_load(p, __ATOMIC_RELAXED, __HIP_MEMORY_SCOPE_AGENT); }
__device__ __forceinline__ unsigned xb_add(unsigned* p, unsigned v) { return __hip_atomic_fetch_add(p, v, __ATOMIC_RELAXED, __HIP_MEMORY_SCOPE_AGENT); }
__device__ __forceinline__ unsigned xb_xcc_id() { return (unsigned)__builtin_amdgcn_s_getreg((3 << 11) | 20) & 0xFu; }
#define XB_SPIN(cond, bar) do { unsigned _sp = 0; while (cond) { __builtin_amdgcn_s_sleep(1); \
    if ((++_sp & 255u) == 0u) { if (xb_ld(&(bar)[XB_TMO])) break; if (_sp > XB_SPIN_CAP) { atomicAdd(&(bar)[XB_TMO], 1u); break; } } } } while (0)
__device__ __forceinline__ void xcd_barrier_post(unsigned* bar) {
    const unsigned x = xb_xcc_id();
    if (threadIdx.x == 0) (void)xb_add(&bar[XB_XCNT(x)], 1u);
}
__device__ __forceinline__ void xcd_barrier_complete(unsigned* bar, unsigned x, unsigned& nloc, unsigned& nx) {
    const unsigned G = gridDim.x * gridDim.y * gridDim.z;
    unsigned sum, cnt, mine, sp = 0u;
    for (;;) {
        sum = 0u; cnt = 0u; mine = 0u;
#pragma unroll
        for (unsigned j = 0; j < 16; ++j) { const unsigned c = xb_ld(&bar[XB_XCNT(j)]); sum += c; cnt += (c > 0u) ? 1u : 0u; mine = (j == x) ? c : mine; }
        if (sum == G) break;
        __builtin_amdgcn_s_sleep(1);
        if ((++sp & 255u) == 0u) { if (xb_ld(&bar[XB_TMO])) break; if (sp > XB_SPIN_CAP) { atomicAdd(&bar[XB_TMO], 1u); break; } }
    }
    nloc = mine > 0u ? mine : 1u; nx = cnt > 0u ? cnt : 1u;
}
__device__ __forceinline__ void xcd_barrier(unsigned* bar_in, volatile LAS unsigned* st, bool leader) {
    asm volatile("s_waitcnt vmcnt(0)" ::: "memory");
    __syncthreads();
    if (leader) {
        unsigned* bar = bar_in;
        unsigned bx_ = xb_xcc_id(); asm volatile("" : "+s"(bx_));
        __builtin_amdgcn_s_waitcnt(0);
        unsigned nloc = st[0], nx = st[1];
        if (nloc == 0u) { xcd_barrier_complete(bar, bx_, nloc, nx); st[0] = nloc; st[1] = nx; }
        const unsigned old = xb_add(&bar[XB_XSUB(bx_)], 1u);
        const unsigned gen = old / nloc;
        if (old + 1u == (gen + 1u) * nloc) {
            __builtin_amdgcn_fence(__ATOMIC_RELEASE, "agent");
            asm volatile("s_waitcnt vmcnt(0)" ::: "memory");
            const unsigned og = xb_add(&bar[XB_TOP], 1u);
            const unsigned tg = og / nx;
            if (og + 1u == (tg + 1u) * nx) xb_add(&bar[XB_TOPGEN], 1u);
            else XB_SPIN(xb_ld(&bar[XB_TOPGEN]) == tg, bar);
            __builtin_amdgcn_fence(__ATOMIC_ACQUIRE, "agent");
            asm volatile("s_waitcnt vmcnt(0)" ::: "memory");
        } else {
            XB_SPIN(xb_ld(&bar[XB_TOPGEN]) == gen, bar);
            __builtin_amdgcn_fence(__ATOMIC_ACQUIRE, "agent");
            asm volatile("s_waitcnt vmcnt(0)" ::: "memory");
        }
    }
    __syncthreads();
}

struct SchedRect {
    pg8::StaticOrder so; int xonly, n_extra, G, c, full, rsplit;
    __device__ void init(int nMt, int N, int G_, int c_, int xonly_, int n_extra_) { so.init(nMt * 256, N, G_, c_); xonly = xonly_; n_extra = n_extra_; G = G_; c = c_;
        const int r = so.nwg % G; full = so.nwg - r; rsplit = (n_extra == 0 && r > 0 && 2 * r <= G) ? r : 0; }
    __device__ bool next(int i, pg8::Unit& u) const {
        const long L = (long)i * G + c;
        if (rsplit && L >= full) { const int j = (int)(L - full); if (j >= 2 * rsplit) return false;
            so.at(full + (j >> 1), u); u.hm = 1 + (j & 1); if (xonly) u.pm = (u.pm >> 3) * 9 + 1 + (u.pm & 7); return true; }
        if (L < so.nwg) { so.at(L, u); if (xonly) u.pm = (u.pm >> 3) * 9 + 1 + (u.pm & 7); return true; }
        const int j = (int)(L - so.nwg); if (j >= n_extra) return false;
        u.pm = (j >> 1) * 9; u.pn = 4 + (j & 1); u.hm = 0; return true;
    }
    __device__ __forceinline__ void a_ready(const pg8::Unit&) const {}
    __device__ __forceinline__ void done(const pg8::Unit&) const {}
};
struct SchedExp {
    const LAS unsigned char* tile_e; int NP, nunits, G, c;
    __device__ bool next(int i, pg8::Unit& u) const {
        long L = (long)i * G + c; int hm = 0;
        const int rr = nunits % G, full = nunits - rr;
        if (rr > 0 && 2 * rr <= G && L >= full) { const int j = (int)(L - full); if (j >= 2 * rr) return false; L = full + (j >> 1); hm = 1 + (j & 1); }
        if (L >= nunits) return false;
        const int q = nunits / 8, r = nunits % 8, xcd = (int)(L % 8), off = (int)(L / 8);
        const int Lr = (xcd < r ? xcd * (q + 1) : r * (q + 1) + (xcd - r) * q) + off;
        const int tm = Lr / NP, pl = Lr % NP;
        u.pm = tm; u.pn = (int)tile_e[tm] * NP + pl; u.hm = hm; return true;
    }
    __device__ __forceinline__ void a_ready(const pg8::Unit&) const {}
    __device__ __forceinline__ void done(const pg8::Unit&) const {}
};

struct EpiStoreBf16 {
    static constexpr bool PERM = true, AFTER_DRAIN = false;
    bf16_t* O; int ldc; int pn_mask; const f32x2* tab; const float* kg; LAS float* xch;
    __device__ __forceinline__ void operator()(const pg8::f32x4 (&acc)[2][2][4][2], const pg8::Unit& u, int wr, int wc, int fr_in, int fq_in) const {
        int fr = fr_in, fq = fq_in; asm volatile("" : "+v"(fr), "+v"(fq));
        const int row0 = u.pm * 256 + wr * 64 + fr;
        if (kg == nullptr && tab != nullptr && u.pn >= 4 && u.pn < 8) {
            const int tj = u.pm % 9; const bool lat = tj != 0; const int nbase = (tj - 1) * 256 + wr * 64 + fr;
            const int ax = fq >> 1, f0 = (fq & 1) * 8; const int col0 = u.pn * 256 + wc * 64 + ax * 32 + f0;
#pragma unroll
            for (int ai = 0; ai < 2; ++ai) { if (u.hm != 0 && u.hm != ai + 1) continue;
#pragma unroll
                for (int m = 0; m < 4; ++m) { bf16_t* rowp = O + (size_t)(row0 + ai * 128 + m * 16) * ldc + col0;
                    float x1[8], x2[8];
#pragma unroll
                    for (int n = 0; n < 2; ++n)
#pragma unroll
                        for (int q = 0; q < 4; ++q) { x1[n * 4 + q] = acc[ai][0][m][n][q]; x2[n * 4 + q] = acc[ai][1][m][n][q]; }
                    if (lat) { const int nr = nbase + ai * 128 + m * 16; const int pos = ax ? (nr & 63) : (nr >> 6);
                        const pg8::f32x4* tp = (const pg8::f32x4*)(tab + pos * 16 + f0);
#pragma unroll
                        for (int q = 0; q < 4; ++q) { const pg8::f32x4 cs = tp[q];
                            const float a0 = x1[2 * q], b0 = x2[2 * q], a1 = x1[2 * q + 1], b1 = x2[2 * q + 1];
                            x1[2 * q] = a0 * cs[0] - b0 * cs[1]; x2[2 * q] = b0 * cs[0] + a0 * cs[1];
                            x1[2 * q + 1] = a1 * cs[2] - b1 * cs[3]; x2[2 * q + 1] = b1 * cs[2] + a1 * cs[3]; } }
                    v4u w; w.x = cvtpk(x1[0], x1[1]); w.y = cvtpk(x1[2], x1[3]); w.z = cvtpk(x1[4], x1[5]); w.w = cvtpk(x1[6], x1[7]);
                    *(v4u*)rowp = w;
                    w.x = cvtpk(x2[0], x2[1]); w.y = cvtpk(x2[2], x2[3]); w.z = cvtpk(x2[4], x2[5]); w.w = cvtpk(x2[6], x2[7]);
                    *(v4u*)(rowp + 16) = w; } }
            return;
        }
        if (kg != nullptr && u.pn == 4) {
            const int tj = u.pm % 9; const bool lat = tj != 0; const int nbase = (tj - 1) * 256 + wr * 64 + fr;
            const int hl = wc >> 1, ax = wc & 1, f0 = 8 * fq; const int col0k = 1024 + hl * 128 + ax * 64 + f0; const int wid = wr * 4 + wc;
            float ssq[2][4];
#pragma unroll
            for (int ai = 0; ai < 2; ++ai)
#pragma unroll
                for (int m = 0; m < 4; ++m) { float s = 0.f;
#pragma unroll
                    for (int bj = 0; bj < 2; ++bj)
#pragma unroll
                        for (int n = 0; n < 2; ++n)
#pragma unroll
                            for (int q = 0; q < 4; ++q) s += acc[ai][bj][m][n][q] * acc[ai][bj][m][n][q];
                    s = xsum<16>(s); s = xsum<32>(s);
                    ssq[ai][m] = s; if (fq == 0) xch[wid * 128 + ai * 64 + m * 16 + fr] = s; }
            asm volatile("s_waitcnt lgkmcnt(0)" ::: "memory"); __builtin_amdgcn_s_barrier(); asm volatile("" ::: "memory");
            const float g00 = 0.f; (void)g00;
            pg8::f32x4 gA[2][2];
#pragma unroll
            for (int bj = 0; bj < 2; ++bj)
#pragma unroll
                for (int n = 0; n < 2; ++n) gA[bj][n] = *(const pg8::f32x4*)(kg + ax * 64 + bj * 32 + f0 + 4 * n);
#pragma unroll
            for (int ai = 0; ai < 2; ++ai) { if (u.hm != 0 && u.hm != ai + 1) continue;
#pragma unroll
                for (int m = 0; m < 4; ++m) { bf16_t* rowp = O + (size_t)(row0 + ai * 128 + m * 16) * ldc + col0k;
                    const float tot = ssq[ai][m] + xch[(wid ^ 1) * 128 + ai * 64 + m * 16 + fr];
                    const float rs = 1.0f / sqrtf(tot * (1.f / 128.f) + RMS_EPS);
                    float x1[8], x2[8];
#pragma unroll
                    for (int n = 0; n < 2; ++n)
#pragma unroll
                        for (int q = 0; q < 4; ++q) { x1[n * 4 + q] = acc[ai][0][m][n][q] * rs * gA[0][n][q]; x2[n * 4 + q] = acc[ai][1][m][n][q] * rs * gA[1][n][q]; }
                    if (lat) { const int nr = nbase + ai * 128 + m * 16; const int pos = ax ? (nr & 63) : (nr >> 6);
                        const pg8::f32x4* tp = (const pg8::f32x4*)(tab + pos * 32 + f0);
#pragma unroll
                        for (int q = 0; q < 4; ++q) { const pg8::f32x4 cs = tp[q];
                            const float a0 = x1[2 * q], b0 = x2[2 * q], a1 = x1[2 * q + 1], b1 = x2[2 * q + 1];
                            x1[2 * q] = a0 * cs[0] - b0 * cs[1]; x2[2 * q] = b0 * cs[0] + a0 * cs[1];
                            x1[2 * q + 1] = a1 * cs[2] - b1 * cs[3]; x2[2 * q + 1] = b1 * cs[2] + a1 * cs[3]; } }
                    v4u w; w.x = cvtpk(x1[0], x1[1]); w.y = cvtpk(x1[2], x1[3]); w.z = cvtpk(x1[4], x1[5]); w.w = cvtpk(x1[6], x1[7]);
                    *(v4u*)rowp = w;
                    w.x = cvtpk(x2[0], x2[1]); w.y = cvtpk(x2[2], x2[3]); w.z = cvtpk(x2[4], x2[5]); w.w = cvtpk(x2[6], x2[7]);
                    *(v4u*)(rowp + 32) = w; } }
            asm volatile("s_waitcnt lgkmcnt(0)" ::: "memory"); __builtin_amdgcn_s_barrier(); asm volatile("" ::: "memory");
            return;
        }
        const int col0 = (u.pn & pn_mask) * 256 + wc * 32 + 8 * fq;
#pragma unroll
        for (int ai = 0; ai < 2; ++ai) { if (u.hm != 0 && u.hm != ai + 1) continue;
#pragma unroll
            for (int m = 0; m < 4; ++m) { bf16_t* rowp = O + (size_t)(row0 + ai * 128 + m * 16) * ldc + col0;
#pragma unroll
                for (int bj = 0; bj < 2; ++bj) { const pg8::f32x4 v0 = acc[ai][bj][m][0], v1 = acc[ai][bj][m][1];
                    v4u w; w.x = cvtpk(v0[0], v0[1]); w.y = cvtpk(v0[2], v0[3]); w.z = cvtpk(v1[0], v1[1]); w.w = cvtpk(v1[2], v1[3]);
                    *(v4u*)(rowp + bj * 128) = w; } } }
    }
};
typedef _Float16 hf_t;
typedef _Float16 hf2_t __attribute__((ext_vector_type(2)));
__device__ __forceinline__ unsigned pkh(float a, float b_) { const hf2_t v = {(hf_t)a, (hf_t)b_}; return __builtin_bit_cast(unsigned, v); }
__device__ __forceinline__ float hf_lo(unsigned u) { const hf2_t v = __builtin_bit_cast(hf2_t, u); return (float)v[0]; }
__device__ __forceinline__ float hf_hi(unsigned u) { const hf2_t v = __builtin_bit_cast(hf2_t, u); return (float)v[1]; }
template <bool RH>
struct EpiResid {
    static constexpr bool PERM = true, AFTER_DRAIN = false;
    hf_t* Y; const float* xbase; const float* cbase; const float* modl; f32x2* stats;
    __device__ __forceinline__ void operator()(const pg8::f32x4 (&acc)[2][2][4][2], const pg8::Unit& u, int wr, int wc, int fr_in, int fq_in) const {
        int fr = fr_in, fq = fq_in; asm volatile("" : "+v"(fr), "+v"(fq));
        const int b = u.pm / 9, j = u.pm - b * 9;
        const size_t roff0 = (j == 0) ? (size_t)b * LCT * DM : ((size_t)b * NXT + (size_t)(j - 1) * 256) * DM;
        const float* rb = ((j == 0) ? cbase : xbase) + roff0; const hf_t* rbh = (const hf_t*)xbase + roff0;
        const float* g = modl + (size_t)(j == 0 ? 8 : b) * NMOD + 2048;
        const int col0 = u.pn * 256 + wc * 32 + 8 * fq;
        pg8::f32x4 gv[2][2];
#pragma unroll
        for (int bj = 0; bj < 2; ++bj)
#pragma unroll
            for (int n = 0; n < 2; ++n) gv[bj][n] = *(const pg8::f32x4*)(g + col0 + bj * 128 + n * 4);
#pragma unroll
        for (int ai = 0; ai < 2; ++ai) { if (u.hm != 0 && u.hm != ai + 1) continue;
#pragma unroll
            for (int mh = 0; mh < 2; ++mh) {
            pg8::f32x4 rva[2][2][2]; v4u rvh[2][2];
#pragma unroll
            for (int mm = 0; mm < 2; ++mm) { const size_t ro = (size_t)(ai * 128 + wr * 64 + (2 * mh + mm) * 16 + fr) * DM + col0;
#pragma unroll
                for (int bj = 0; bj < 2; ++bj) {
                    if constexpr (RH) rvh[mm][bj] = *(const v4u*)(rbh + ro + bj * 128);
                    else {
#pragma unroll
                        for (int n = 0; n < 2; ++n) rva[mm][bj][n] = *(const pg8::f32x4*)(rb + ro + bj * 128 + n * 4); } } }
#pragma unroll
            for (int mm = 0; mm < 2; ++mm) { const int m = 2 * mh + mm; const int lr = ai * 128 + wr * 64 + m * 16 + fr;
                hf_t* yrow = Y + ((size_t)u.pm * 256 + lr) * DM + col0;
                float s = 0.f, q = 0.f;
#pragma unroll
                for (int bj = 0; bj < 2; ++bj) {
                    if constexpr (RH) { const v4u h = rvh[mm][bj]; rva[mm][bj][0] = (pg8::f32x4){hf_lo(h.x), hf_hi(h.x), hf_lo(h.y), hf_hi(h.y)}; rva[mm][bj][1] = (pg8::f32x4){hf_lo(h.z), hf_hi(h.z), hf_lo(h.w), hf_hi(h.w)}; }
                    const pg8::f32x4 o0 = rva[mm][bj][0] * ALPHA + gv[bj][0] * acc[ai][bj][m][0], o1 = rva[mm][bj][1] * ALPHA + gv[bj][1] * acc[ai][bj][m][1];
                    s += ((o0[0] + o0[1]) + (o0[2] + o0[3])) + ((o1[0] + o1[1]) + (o1[2] + o1[3]));
                    q += ((o0[0] * o0[0] + o0[1] * o0[1]) + (o0[2] * o0[2] + o0[3] * o0[3])) + ((o1[0] * o1[0] + o1[1] * o1[1]) + (o1[2] * o1[2] + o1[3] * o1[3]));
                    v4u w; w.x = pkh(o0[0], o0[1]); w.y = pkh(o0[2], o0[3]); w.z = pkh(o1[0], o1[1]); w.w = pkh(o1[2], o1[3]);
                    *(v4u*)(yrow + bj * 128) = w; }
                s = xsum<16>(s); q = xsum<16>(q); s = xsum<32>(s); q = xsum<32>(q);
                if (fq == 0) stats[((size_t)u.pm * 256 + lr) * 16 + u.pn * 4 + wc] = (f32x2){s, q}; } } }
    }
};
struct EpiGateUp {
    static constexpr bool PERM = true, AFTER_DRAIN = false;
    bf16_t* ACT; const float* gwof; const LAS int* tbase;
    __device__ __forceinline__ void operator()(const pg8::f32x4 (&acc)[2][2][4][2], const pg8::Unit& u, int wr, int wc, int fr_in, int fq_in) const {
        int fr = fr_in, fq = fq_in; asm volatile("" : "+v"(fr), "+v"(fq));
        const int e = u.pn >> 1; const float* gwe = gwof + (size_t)e * ECAP + (u.pm - tbase[e]) * 256;
        const int lr0 = wr * 64 + fr; const int f0 = (u.pn & 1) * 128 + wc * 32 + 8 * fq;
#pragma unroll
        for (int ai = 0; ai < 2; ++ai) { if (u.hm != 0 && u.hm != ai + 1) continue;
#pragma unroll
            for (int m = 0; m < 4; ++m) { const int lr = lr0 + ai * 128 + m * 16; const float gw = gwe[lr];
                float o[8];
#pragma unroll
                for (int n = 0; n < 2; ++n)
#pragma unroll
                    for (int q = 0; q < 4; ++q) { const float a = acc[ai][0][m][n][q], up = acc[ai][1][m][n][q];
                        o[n * 4 + q] = a * __builtin_amdgcn_rcpf(1.f + __expf(-a)) * up * gw; }
                v4u w; w.x = cvtpk(o[0], o[1]); w.y = cvtpk(o[2], o[3]); w.z = cvtpk(o[4], o[5]); w.w = cvtpk(o[6], o[7]);
                *(v4u*)(ACT + ((size_t)u.pm * 256 + lr) * FH + f0) = w; } }
    }
};

namespace att {
constexpr int KVBLK = 64;
constexpr int SHM_V = KVBLK * 128 * 2, SHM_K = KVBLK * 128 * 2;
constexpr int OFF_WS = 2 * SHM_V + 2 * SHM_K;
constexpr int OFF_XCH = OFF_WS + 8 * 256;
constexpr int LDS_NEED = OFF_XCH + 4 * 16384;
static_assert(LDS_NEED <= MISC_OFF, "attention LDS");
constexpr float THR = 8.f;
#define KSWZ(row, colB) ((row) * 256 + ((colB) ^ (((row) & 7) << 4)))
#define SBAR() __builtin_amdgcn_sched_barrier(0)
__device__ __forceinline__ int crow(int r, int hi) { return (r & 3) + 8 * (r >> 2) + 4 * hi; }

template <bool DIFF> struct Cst { static constexpr float SCALE = DIFF ? 0.125f : 0.088388347648318440f; static constexpr float C = SCALE * 1.4426950408889634f; };

template <bool DIFF>
__device__ __forceinline__ void partialSM(f32x16& p0, f32x16& p1, float& m_reg, float& mn, float& alpha) {
  constexpr float C = Cst<DIFF>::C, SCALE = Cst<DIFF>::SCALE;
  float pmax = p0[0];
#pragma unroll
  for (int r = 1; r < 16; ++r) pmax = fmaxf(pmax, p0[r]);
#pragma unroll
  for (int r = 0; r < 16; ++r) pmax = fmaxf(pmax, p1[r]);
  { auto rr = __builtin_amdgcn_permlane32_swap(__float_as_uint(pmax), __float_as_uint(pmax), false, false);
    pmax = fmaxf(__uint_as_float(rr[0]), __uint_as_float(rr[1])); }
  if (__builtin_expect(__all(pmax - m_reg <= THR / SCALE), 1)) { mn = m_reg; alpha = 1.f; }
  else { mn = fmaxf(m_reg, pmax); alpha = __builtin_amdgcn_exp2f((m_reg - mn) * C); m_reg = mn; }
  float mnC = -mn * C;
#pragma unroll
  for (int r = 0; r < 16; ++r) p0[r] = fmaf(p0[r], C, mnC);
#pragma unroll
  for (int r = 0; r < 16; ++r) p1[r] = fmaf(p1[r], C, mnC);
#pragma unroll
  for (int r = 0; r < 16; ++r) p0[r] = __builtin_amdgcn_exp2f(p0[r]);
}
__device__ __forceinline__ void finishSM(f32x16& p0, f32x16& p1, float alpha, float& l_reg, bf16x8& pa0, bf16x8& pa1, bf16x8& pa2, bf16x8& pa3) {
#pragma unroll
  for (int r = 0; r < 16; ++r) p1[r] = __builtin_amdgcn_exp2f(p1[r]);
  float ps = 0;
#pragma unroll
  for (int r = 0; r < 16; ++r) ps += p0[r];
#pragma unroll
  for (int r = 0; r < 16; ++r) ps += p1[r];
  { auto rr = __builtin_amdgcn_permlane32_swap(__float_as_uint(ps), __float_as_uint(ps), false, false);
    ps = __uint_as_float(rr[0]) + __uint_as_float(rr[1]); }
  l_reg = l_reg * alpha + ps;
#define PK4(P, BASE, OUT) do { unsigned a0 = cvtpk(P[BASE + 0], P[BASE + 1]), a1 = cvtpk(P[BASE + 2], P[BASE + 3]);   \
    unsigned b0 = cvtpk(P[BASE + 4], P[BASE + 5]), b1 = cvtpk(P[BASE + 6], P[BASE + 7]);                              \
    auto r0 = __builtin_amdgcn_permlane32_swap(a0, b0, false, false); auto r1 = __builtin_amdgcn_permlane32_swap(a1, b1, false, false); \
    v4u w = {r0[0], r1[0], r0[1], r1[1]}; OUT = *reinterpret_cast<bf16x8*>(&w); } while (0)
  PK4(p0, 0, pa0); PK4(p0, 8, pa1); PK4(p1, 0, pa2); PK4(p1, 8, pa3);
#undef PK4
}
template <int NQ>
__device__ __forceinline__ void qkt(f32x16& p0, f32x16& p1, const char* Ks, const bf16x8* qr, int r32, int hi, int d0base) {
  p0 = f32x16{}; p1 = f32x16{};
#pragma unroll
  for (int d0 = 0; d0 < NQ; ++d0) { const int cb = ((d0base + d0) * 16 + hi * 8) * 2;
    bf16x8 b0 = *reinterpret_cast<const bf16x8*>(Ks + KSWZ(r32, cb));
    bf16x8 b1 = *reinterpret_cast<const bf16x8*>(Ks + KSWZ(32 + r32, cb));
    p0 = __builtin_amdgcn_mfma_f32_32x32x16_bf16(b0, qr[d0], p0, 0, 0, 0);
    p1 = __builtin_amdgcn_mfma_f32_32x32x16_bf16(b1, qr[d0], p1, 0, 0, 0); }
}
__device__ __forceinline__ int v_st(int k, int c) { const int kk = (k & ~0xC) | ((k & 4) << 1) | ((k & 8) >> 1); return ((kk >> 3) * 4 + (c >> 5)) * 512 + ((kk & 7) * 32 + (c & 31)) * 2; }
__device__ __forceinline__ int v_rd_base(int lane) { return ((lane & 3) << 3) | (((lane >> 2) & 3) << 6) | (((lane >> 4) & 1) << 5) | (((lane >> 5) & 1) << 8); }
constexpr int v_rd_off(int d0, int ks, int half) { return d0 * 512 + ks * 4096 + half * 2048; }
template <int OFF> __device__ __forceinline__ s16x4 tr_read(int vb) {
  s16x4 r; asm volatile("ds_read_b64_tr_b16 %0, %1 offset:%2" : "=&v"(r) : "v"(vb), "i"(OFF) : "memory"); return r;
}
template <int D0> __device__ __forceinline__ void pv_one(f32x16& od, int vb, bf16x8 pa0, bf16x8 pa1, bf16x8 pa2, bf16x8 pa3) {
  const s16x4 l0 = tr_read<v_rd_off(D0, 0, 0)>(vb), h0 = tr_read<v_rd_off(D0, 0, 1)>(vb), l1 = tr_read<v_rd_off(D0, 1, 0)>(vb), h1 = tr_read<v_rd_off(D0, 1, 1)>(vb);
  const s16x4 l2 = tr_read<v_rd_off(D0, 2, 0)>(vb), h2 = tr_read<v_rd_off(D0, 2, 1)>(vb), l3 = tr_read<v_rd_off(D0, 3, 0)>(vb), h3 = tr_read<v_rd_off(D0, 3, 1)>(vb);
  asm volatile("s_waitcnt lgkmcnt(0)" ::: "memory"); SBAR();
#define PK(L, H) (bf16x8){L[0], L[1], L[2], L[3], H[0], H[1], H[2], H[3]}
  od = __builtin_amdgcn_mfma_f32_32x32x16_bf16(pa0, PK(l0, h0), od, 0, 0, 0);
  od = __builtin_amdgcn_mfma_f32_32x32x16_bf16(pa1, PK(l1, h1), od, 0, 0, 0);
  od = __builtin_amdgcn_mfma_f32_32x32x16_bf16(pa2, PK(l2, h2), od, 0, 0, 0);
  od = __builtin_amdgcn_mfma_f32_32x32x16_bf16(pa3, PK(l3, h3), od, 0, 0, 0);
#undef PK
}
__device__ __forceinline__ void pv_d0(f32x16* o, int vb, bf16x8 pa0, bf16x8 pa1, bf16x8 pa2, bf16x8 pa3) {
  pv_one<0>(o[0], vb, pa0, pa1, pa2, pa3); pv_one<1>(o[1], vb, pa0, pa1, pa2, pa3); pv_one<2>(o[2], vb, pa0, pa1, pa2, pa3); pv_one<3>(o[3], vb, pa0, pa1, pa2, pa3);
}

constexpr float THRL = THR * 1.4426950408889634f;
__device__ __forceinline__ void qkt_negm(f32x16& p0, f32x16& p1, const char* Ks, const bf16x8* qr, const f32x16& negm, int r32, int hi, int d0base) {
#pragma unroll
  for (int d0 = 0; d0 < 4; ++d0) { const int cb = ((d0base + d0) * 16 + hi * 8) * 2;
    bf16x8 b0 = *reinterpret_cast<const bf16x8*>(Ks + KSWZ(r32, cb));
    bf16x8 b1 = *reinterpret_cast<const bf16x8*>(Ks + KSWZ(32 + r32, cb));
    if (d0 == 0) { p0 = __builtin_amdgcn_mfma_f32_32x32x16_bf16(b0, qr[0], negm, 0, 0, 0); p1 = __builtin_amdgcn_mfma_f32_32x32x16_bf16(b1, qr[0], negm, 0, 0, 0); }
    else { p0 = __builtin_amdgcn_mfma_f32_32x32x16_bf16(b0, qr[d0], p0, 0, 0, 0); p1 = __builtin_amdgcn_mfma_f32_32x32x16_bf16(b1, qr[d0], p1, 0, 0, 0); } }
}
__device__ __forceinline__ void splat16(f32x16& v, float x) {
#pragma unroll
  for (int r = 0; r < 16; ++r) v[r] = x;
}
__device__ __forceinline__ void partial_first_negm(f32x16& p0, f32x16& p1, float& m_reg, f32x16& negm) {
  float pmax = p0[0];
#pragma unroll
  for (int r = 1; r < 16; ++r) pmax = fmaxf(pmax, p0[r]);
#pragma unroll
  for (int r = 0; r < 16; ++r) pmax = fmaxf(pmax, p1[r]);
  { auto rr = __builtin_amdgcn_permlane32_swap(__float_as_uint(pmax), __float_as_uint(pmax), false, false);
    pmax = fmaxf(__uint_as_float(rr[0]), __uint_as_float(rr[1])); }
  m_reg = pmax; splat16(negm, -pmax);
#pragma unroll
  for (int r = 0; r < 16; ++r) { p0[r] -= pmax; p1[r] -= pmax; }
#pragma unroll
  for (int r = 0; r < 16; ++r) p0[r] = __builtin_amdgcn_exp2f(p0[r]);
}
__device__ __forceinline__ void pv_partial_negm(f32x16* o, int vb, bf16x8 pa0, bf16x8 pa1, bf16x8 pa2, bf16x8 pa3, f32x16& p0, f32x16& p1, float& m_reg, f32x16& negm, float& alpha) {
  pv_one<0>(o[0], vb, pa0, pa1, pa2, pa3);
  float pmax = p0[0];
#pragma unroll
  for (int r = 1; r < 16; ++r) pmax = fmaxf(pmax, p0[r]);
  pv_one<1>(o[1], vb, pa0, pa1, pa2, pa3);
#pragma unroll
  for (int r = 0; r < 16; ++r) pmax = fmaxf(pmax, p1[r]);
  { auto rr = __builtin_amdgcn_permlane32_swap(__float_as_uint(pmax), __float_as_uint(pmax), false, false);
    pmax = fmaxf(__uint_as_float(rr[0]), __uint_as_float(rr[1])); }
  if (__builtin_expect(__all(pmax <= THRL), 1)) { alpha = 1.f; }
  else { const float d = fmaxf(pmax, 0.f); alpha = __builtin_amdgcn_exp2f(-d); m_reg += d; splat16(negm, -m_reg);
#pragma unroll
    for (int r = 0; r < 16; ++r) { p0[r] -= d; p1[r] -= d; } }
  pv_one<2>(o[2], vb, pa0, pa1, pa2, pa3);
  pv_one<3>(o[3], vb, pa0, pa1, pa2, pa3);
#pragma unroll
  for (int r = 0; r < 16; ++r) p0[r] = __builtin_amdgcn_exp2f(p0[r]);
  asm volatile("" : "+v"(p0), "+v"(p1));
  SBAR();
}

template <bool DIFF>
__device__ __forceinline__ void pv_partial(f32x16* o, int vb, bf16x8 pa0, bf16x8 pa1, bf16x8 pa2, bf16x8 pa3, f32x16& p0, f32x16& p1, float& m_reg, float& mn, float& alpha) {
  constexpr float C = Cst<DIFF>::C, SCALE = Cst<DIFF>::SCALE;
  pv_one<0>(o[0], vb, pa0, pa1, pa2, pa3);
  float pmax = p0[0];
#pragma unroll
  for (int r = 1; r < 16; ++r) pmax = fmaxf(pmax, p0[r]);
  pv_one<1>(o[1], vb, pa0, pa1, pa2, pa3);
#pragma unroll
  for (int r = 0; r < 16; ++r) pmax = fmaxf(pmax, p1[r]);
  { auto rr = __builtin_amdgcn_permlane32_swap(__float_as_uint(pmax), __float_as_uint(pmax), false, false);
    pmax = fmaxf(__uint_as_float(rr[0]), __uint_as_float(rr[1])); }
  if (__builtin_expect(__all(pmax - m_reg <= THR / SCALE), 1)) { mn = m_reg; alpha = 1.f; }
  else { mn = fmaxf(m_reg, pmax); alpha = __builtin_amdgcn_exp2f((m_reg - mn) * C); m_reg = mn; }
  pv_one<2>(o[2], vb, pa0, pa1, pa2, pa3);
  const float mnC = -mn * C;
#pragma unroll
  for (int r = 0; r < 16; ++r) p0[r] = fmaf(p0[r], C, mnC);
#pragma unroll
  for (int r = 0; r < 16; ++r) p1[r] = fmaf(p1[r], C, mnC);
  pv_one<3>(o[3], vb, pa0, pa1, pa2, pa3);
#pragma unroll
  for (int r = 0; r < 16; ++r) p0[r] = __builtin_amdgcn_exp2f(p0[r]);
  asm volatile("" : "+v"(p0), "+v"(p1));
  SBAR();
}

template <bool DIFF>
__device__ __forceinline__ void attn_unit(const bf16_t* __restrict__ Qb, int ldq, const bf16_t* __restrict__ Kh, const bf16_t* __restrict__ Vh, int ldk, int seq,
                                          bf16_t* __restrict__ Ob, int ldo, bool rope, int n0, const f32x2* __restrict__ tab,
                                          const float* __restrict__ qg  , const float* __restrict__ subg  , float lam, char* lds, const int wv) {
  constexpr int NQ = DIFF ? 4 : 8;
  const int tid = ltid(wv), wid = wv, lane = tid & 63, r32 = lane & 31, hi = lane >> 5;
  const int qblk = DIFF ? (wid & 3) : wid, map = DIFF ? (wid >> 2) : 0;
  char* V_lds = lds; char* K_lds = lds + 2 * SHM_V;
  float* wsf = (float*)(lds + OFF_WS) + wid * 64; float* li_l = wsf; float* al_l = wsf + 32;
  float m_reg = -1e30f, l_reg = 0; f32x16 o[4] = {}; bf16x8 qr[NQ];
  const int sr = tid >> 4, sc = (tid & 15) * 8, vst0 = v_st(sr, sc), vst1 = v_st(32 + sr, sc);
  const int vb0 = (int)(uintptr_t)V_lds + v_rd_base(lane);
  struct { bf16x8 vs0, vs1, ks0, ks1; } sr_[2] = {};
#define LD8(p) (*reinterpret_cast<const bf16x8*>(p))
#define SLOAD(i, k0) do { sr_[i].vs0 = LD8(&Vh[(size_t)((k0) + sr) * ldk + sc]); sr_[i].vs1 = LD8(&Vh[(size_t)((k0) + 32 + sr) * ldk + sc]); \
    sr_[i].ks0 = LD8(&Kh[(size_t)((k0) + sr) * ldk + sc]); sr_[i].ks1 = LD8(&Kh[(size_t)((k0) + 32 + sr) * ldk + sc]); } while (0)
#define SWRITE(b, i) do { *(bf16x8*)(V_lds + (b) * SHM_V + vst0) = sr_[i].vs0;          \
    *(bf16x8*)(V_lds + (b) * SHM_V + vst1) = sr_[i].vs1; int kc = sc * 2;               \
    *(bf16x8*)(K_lds + (b) * SHM_K + KSWZ(sr, kc)) = sr_[i].ks0;                       \
    *(bf16x8*)(K_lds + (b) * SHM_K + KSWZ(32 + sr, kc)) = sr_[i].ks1; } while (0)
  constexpr int SE = 0, SO = 1;
  SLOAD(SE, 0); SLOAD(SO, KVBLK);
  {
    const bf16_t* Qw = Qb + (size_t)(qblk * 32 + r32) * ldq + map * 64 + hi * 8;
    const int n = n0 + qblk * 32 + r32;
    float qf[NQ][8];
#pragma unroll
    for (int d0 = 0; d0 < NQ; ++d0) { const v4u w = *reinterpret_cast<const v4u*>(Qw + d0 * 16);
      qf[d0][0] = bf_lo(w.x); qf[d0][1] = bf_hi(w.x); qf[d0][2] = bf_lo(w.y); qf[d0][3] = bf_hi(w.y);
      qf[d0][4] = bf_lo(w.z); qf[d0][5] = bf_hi(w.z); qf[d0][6] = bf_lo(w.w); qf[d0][7] = bf_hi(w.w); }
    if constexpr (!DIFF) {
      float ss = 0.f;
#pragma unroll
      for (int d0 = 0; d0 < NQ; ++d0)
#pragma unroll
        for (int j = 0; j < 8; ++j) ss += qf[d0][j] * qf[d0][j];
      ss = xsum<32>(ss);
      const float rs = 1.0f / sqrtf(ss * (1.f / 128.f) + RMS_EPS);
#pragma unroll
      for (int d0 = 0; d0 < NQ; ++d0) { const f32x4 g0 = *(const f32x4*)(qg + d0 * 16 + hi * 8), g1 = *(const f32x4*)(qg + d0 * 16 + hi * 8 + 4);
#pragma unroll
        for (int j = 0; j < 4; ++j) { qf[d0][j] *= rs * g0[j]; qf[d0][4 + j] *= rs * g1[j]; } }
    }
    if (rope) {
      constexpr int NF = DIFF ? 16 : 32;
      constexpr int HB = DIFF ? 1 : 2;
#pragma unroll
      for (int ax = 0; ax < 2; ++ax) { const int pos = ax ? (n & 63) : (n >> 6);
#pragma unroll
        for (int hb = 0; hb < HB; ++hb) { const int dA = ax * 2 * HB + hb, dB = dA + HB;
          const f32x2* tp = tab + pos * NF + hb * 16 + hi * 8;
#pragma unroll
          for (int j = 0; j < 8; ++j) { const f32x2 cs = tp[j]; const float x1 = qf[dA][j], x2 = qf[dB][j];
            qf[dA][j] = x1 * cs.x - x2 * cs.y; qf[dB][j] = x2 * cs.x + x1 * cs.y; } } }
    }
    if constexpr (DIFF) {
#pragma unroll
      for (int d0 = 0; d0 < NQ; ++d0)
#pragma unroll
        for (int j = 0; j < 8; ++j) qf[d0][j] *= Cst<true>::C; }
#pragma unroll
    for (int d0 = 0; d0 < NQ; ++d0) { v4u w = {cvtpk(qf[d0][0], qf[d0][1]), cvtpk(qf[d0][2], qf[d0][3]), cvtpk(qf[d0][4], qf[d0][5]), cvtpk(qf[d0][6], qf[d0][7])};
      qr[d0] = *reinterpret_cast<bf16x8*>(&w); }
  }
#define SWAIT() asm volatile("s_waitcnt vmcnt(4)" ::: "memory")
#define RESC(a) do { if (__any((a) < 1.f)) { if (hi == 0) al_l[r32] = (a); asm volatile("s_waitcnt lgkmcnt(0)" ::: "memory"); \
    _Pragma("unroll") for (int d = 0; d < 4; ++d) _Pragma("unroll") for (int r = 0; r < 16; ++r) o[d][r] *= al_l[crow(r, hi)]; } } while (0)
  f32x16 pA0, pA1, pB0, pB1; float mnA, mnB, alA, alB; bf16x8 pa0, pa1, pa2, pa3; const int NT = seq / KVBLK;
  const int dbase = map * 4;
  f32x16 negm = {};
  if constexpr (DIFF) m_reg = 0.f;
#define QKT(P0, P1, KS) do { if constexpr (DIFF) qkt_negm(P0, P1, KS, qr, negm, r32, hi, dbase); else qkt<NQ>(P0, P1, KS, qr, r32, hi, dbase); } while (0)
#define PVP(VB, P0, P1, MN, AL) do { if constexpr (DIFF) pv_partial_negm(o, VB, pa0, pa1, pa2, pa3, P0, P1, m_reg, negm, AL); else pv_partial<DIFF>(o, VB, pa0, pa1, pa2, pa3, P0, P1, m_reg, MN, AL); } while (0)
  SWAIT(); SWRITE(0, SE); __syncthreads();
  QKT(pA0, pA1, K_lds); if constexpr (DIFF) { partial_first_negm(pA0, pA1, m_reg, negm); alA = 1.f; } else partialSM<DIFF>(pA0, pA1, m_reg, mnA, alA);
  if (2 < NT) SLOAD(SE, 2 * KVBLK);
  SWAIT(); SWRITE(1, SO); __syncthreads();
  for (int j = 1; j + 1 < NT; j += 2) {
    SBAR(); QKT(pB0, pB1, K_lds + SHM_K);
    finishSM(pA0, pA1, alA, l_reg, pa0, pa1, pa2, pa3); SBAR();
    SLOAD(SO, (j + 2) * KVBLK); SBAR();
    PVP(vb0, pB0, pB1, mnB, alB);
    __syncthreads(); SWAIT(); SWRITE(0, SE);
    RESC(alB); __syncthreads();
    SBAR(); QKT(pA0, pA1, K_lds);
    finishSM(pB0, pB1, alB, l_reg, pa0, pa1, pa2, pa3); SBAR();
    if (j + 3 < NT) SLOAD(SE, (j + 3) * KVBLK); SBAR();
    PVP(vb0 + (int)SHM_V, pA0, pA1, mnA, alA);
    __syncthreads(); SWAIT(); SWRITE(1, SO);
    RESC(alA); __syncthreads();
  }
  SBAR(); QKT(pB0, pB1, K_lds + SHM_K);
  finishSM(pA0, pA1, alA, l_reg, pa0, pa1, pa2, pa3); SBAR();
  PVP(vb0, pB0, pB1, mnB, alB);
  __syncthreads(); RESC(alB);
  finishSM(pB0, pB1, alB, l_reg, pa0, pa1, pa2, pa3); SBAR();
  pv_d0(o, vb0 + (int)SHM_V, pa0, pa1, pa2, pa3);
  if (hi == 0) li_l[r32] = l_reg; asm volatile("s_waitcnt lgkmcnt(0)" ::: "memory");
#pragma unroll
  for (int r = 0; r < 16; ++r) { const float rl = __builtin_amdgcn_rcpf(li_l[crow(r, hi)]);
#pragma unroll
    for (int d0 = 0; d0 < 4; ++d0) o[d0][r] *= rl; }
  if constexpr (!DIFF) {
    bf16_t* ost = (bf16_t*)(lds + OFF_XCH) + wid * (32 * 136);
#pragma unroll
    for (int r = 0; r < 16; ++r) { const int orow = crow(r, hi);
#pragma unroll
      for (int d0 = 0; d0 < 4; ++d0) ost[orow * 136 + d0 * 32 + r32] = (bf16_t)(cvtpk(o[d0][r], 0.f) & 0xffffu); }
    asm volatile("s_waitcnt lgkmcnt(0)" ::: "memory");
    bf16_t* Ow = Ob + (size_t)(wid * 32) * ldo;
#pragma unroll
    for (int i = 0; i < 8; ++i) { const int c = i * 64 + lane, orow = c >> 4, ch = c & 15;
      *(v4u*)(Ow + (size_t)orow * ldo + ch * 8) = *(const v4u*)(ost + orow * 136 + ch * 8); }
  } else {
    float* xch = (float*)(lds + OFF_XCH) + qblk * 4096;
    if (map == 1) {
#pragma unroll
      for (int d0 = 0; d0 < 4; ++d0)
#pragma unroll
        for (int r = 0; r < 16; ++r) xch[(d0 * 16 + r) * 64 + lane] = o[d0][r];
    }
    __syncthreads();
    if (map == 0) {
      float ssr[16];
#pragma unroll
      for (int r = 0; r < 16; ++r) { float s = 0.f;
#pragma unroll
        for (int d0 = 0; d0 < 4; ++d0) { const float d = o[d0][r] - lam * xch[(d0 * 16 + r) * 64 + lane]; o[d0][r] = d; s += d * d; }
        ssr[r] = s; }
#pragma unroll
      for (int r = 0; r < 16; ++r) { float s = ssr[r];
        s = sum32(s);
        ssr[r] = (1.0f / sqrtf(s * (1.f / 128.f) + RMS_EPS)) * (1.f - LAMBDA_INIT0); }
      asm volatile("s_waitcnt lgkmcnt(0)" ::: "memory");
      bf16_t* ost = (bf16_t*)xch;
#pragma unroll
      for (int d0 = 0; d0 < 4; ++d0) { const float g = subg[d0 * 32 + r32];
#pragma unroll
        for (int r = 0; r < 16; ++r) ost[crow(r, hi) * 136 + d0 * 32 + r32] = (bf16_t)(cvtpk(o[d0][r] * ssr[r] * g, 0.f) & 0xffffu); }
      asm volatile("s_waitcnt lgkmcnt(0)" ::: "memory");
      bf16_t* Ow = Ob + (size_t)(qblk * 32) * ldo;
#pragma unroll
      for (int i = 0; i < 8; ++i) { const int c = i * 64 + lane, orow = c >> 4, ch = c & 15;
        *(v4u*)(Ow + (size_t)orow * ldo + ch * 8) = *(const v4u*)(ost + orow * 136 + ch * 8); }
    }
  }
#undef QKT
#undef PVP
#undef LD8
#undef SLOAD
#undef SWRITE
#undef SWAIT
#undef RESC
}
#undef KSWZ
#undef SBAR
}

#ifndef REPMASK
#define REPMASK 0
#endif
#ifndef REPN
#define REPN 1
#endif
#ifndef PHMASK
#define PHMASK 0x3ffff
#endif
struct Args { const float* in[28]; float* o_; unsigned char* w_; };
enum { I_X = 0, I_C, I_CTX, I_CCTX, I_WMOD, I_BMOD, I_LNMG, I_LNMB, I_LNFG, I_LNFB, I_DWQKV, I_DWO, I_LQ1, I_LK1, I_LQ2, I_LK2, I_SUBG,
       I_GWQKV, I_GWO, I_GQN, I_GKN, I_WGRP, I_BGRP, I_WRT, I_BRT, I_WGATE, I_WUP, I_WDOWN };

constexpr int PTR_OFF = MISC_OFF + 1024;
__device__ __forceinline__ const float* ldptr(LAS unsigned char* ldsl, int i) {
    int off = PTR_OFF + 8 * i; asm volatile("" : "+v"(off));
    const LAS unsigned* p = (const LAS unsigned*)(ldsl + off);
    const unsigned lo = __builtin_amdgcn_readfirstlane(p[0]), hi = __builtin_amdgcn_readfirstlane(p[1]);
    return (const float*)(GAS const float*)(((unsigned long long)hi << 32) | lo);
}
struct TrItem { const float* W; int N; bf16_t* WT; int KT; int dstrow0; int k0; int n0; int hi_stride; };
__device__ __forceinline__ void transpose_load(const TrItem& I, float (&wv_)[32], int lane) {
    const unsigned vo_ = (unsigned)((lane >> 3) * I.N + (lane & 7) * 4) * 4u;
#pragma unroll
    for (int i = 0; i < 8; ++i) { const f32x4 w = __builtin_nontemporal_load((const f32x4*)((const char*)(I.W + (size_t)(I.k0 + 8 * i) * I.N + I.n0) + vo_));
        wv_[4 * i] = w[0]; wv_[4 * i + 1] = w[1]; wv_[4 * i + 2] = w[2]; wv_[4 * i + 3] = w[3]; }
}
__device__ __forceinline__ void transpose_finish(const TrItem& I, const float (&wv_)[32], LAS float* scr, int lane) {
#pragma unroll
    for (int i = 0; i < 8; ++i)
#pragma unroll
        for (int j = 0; j < 4; ++j) scr[(8 * i + (lane >> 3)) * 33 + (lane & 7) * 4 + j] = wv_[4 * i + j];
    LDS_WAIT(); asm volatile("" ::: "memory");
    const int c = lane & 7;
#pragma unroll
    for (int j = 0; j < 4; ++j) { const int n = (lane >> 3) + 8 * j; const LAS float* s = scr + (8 * c) * 33 + n;
        v4u o; o.x = cvtpk(s[0 * 33], s[1 * 33]); o.y = cvtpk(s[2 * 33], s[3 * 33]); o.z = cvtpk(s[4 * 33], s[5 * 33]); o.w = cvtpk(s[6 * 33], s[7 * 33]);
        *(v4u*)(I.WT + (size_t)(I.dstrow0 + (n & 15) + (n >> 4) * I.hi_stride) * I.KT + I.k0 + 8 * c) = o; }
    LDS_WAIT(); asm volatile("" ::: "memory");
}
__device__ __forceinline__ void transpose_item(const float* __restrict__ W, int N, bf16_t* __restrict__ WT, int KT, int dstrow0, int k0, int n0, LAS float* scr, int lane, int hi_stride = 16) {
    const TrItem I{W, N, WT, KT, dstrow0, k0, n0, hi_stride}; float wv_[32];
    transpose_load(I, wv_, lane); transpose_finish(I, wv_, scr, lane);
}
__device__ __forceinline__ TrItem moe_item_desc(LAS unsigned char* ldsl, int layer, int it, bf16_t* wgu_, bf16_t* wd_) {
    const int e = it / 384, r = it - e * 384;
    const size_t eoff = ((size_t)layer * NEXP + e) * (size_t)DM * FH;
    if (r < 256) {
        const int isup = r >> 7, rr = r & 127, kb = rr >> 3, nb = rr & 7, n0 = nb * 32;
        const float* W = (isup ? ldptr(ldsl, I_WUP) : ldptr(ldsl, I_WGATE)) + eoff;
        return TrItem{W, FH, wgu_, DM, e * 512 + (n0 >> 7) * 256 + isup * 128 + (n0 & 127), kb * 64, n0, 16};
    }
    const int rr = r - 256, kb = rr >> 5, nb = rr & 31;
    return TrItem{ldptr(ldsl, I_WDOWN) + eoff, DM, wd_, FH, e * 1024 + nb * 32, kb * 64, nb * 32, 16};
}
__device__ __forceinline__ void moe_weight_item(LAS unsigned char* ldsl, int layer, int it, bf16_t* wgu_, bf16_t* wd_, LAS float* scr, int lane) {
    const TrItem I = moe_item_desc(ldsl, layer, it, wgu_, wd_); float wv_[32];
    transpose_load(I, wv_, lane); transpose_finish(I, wv_, scr, lane);
}
__device__ __forceinline__ void moe_weight_pair(LAS unsigned char* ldsl, int layer, int ita, int itb, bf16_t* wgu_, bf16_t* wd_, LAS float* scr, int lane) {
    const TrItem A = moe_item_desc(ldsl, layer, ita, wgu_, wd_), B = moe_item_desc(ldsl, layer, itb, wgu_, wd_); float wa_[32], wb_[32];
    transpose_load(A, wa_, lane); transpose_load(B, wb_, lane);
    transpose_finish(A, wa_, scr, lane); transpose_finish(B, wb_, scr, lane);
}
__device__ __forceinline__ int pcol(int lane, int c) { return 8 * lane + 512 * (c >> 1) + 4 * (c & 1); }
__device__ __forceinline__ void store_h_row(const f32x4 (&v)[4], const float* __restrict__ sv, const float* __restrict__ av, bf16_t* __restrict__ hrow, int lane) {
#pragma unroll
    for (int j = 0; j < 2; ++j) { const int col = 8 * lane + 512 * j;
        const f32x4 s0 = *(const f32x4*)(sv + col), s1 = *(const f32x4*)(sv + col + 4), a0 = *(const f32x4*)(av + col), a1 = *(const f32x4*)(av + col + 4);
        const f32x4 h0 = v[2 * j] * (a0 + 1.0f) + s0, h1 = v[2 * j + 1] * (a1 + 1.0f) + s1;
        v4u w; w.x = cvtpk(h0[0], h0[1]); w.y = cvtpk(h0[2], h0[3]); w.z = cvtpk(h1[0], h1[1]); w.w = cvtpk(h1[2], h1[3]); *(v4u*)(hrow + col) = w; }
}
__device__ __forceinline__ void ln_row(f32x4 (&v)[4], const float* __restrict__ g, const float* __restrict__ bb, int lane, float& mean_o, float& rstd_o) {
    float s = 0.f;
#pragma unroll
    for (int j = 0; j < 4; ++j) s += (v[j][0] + v[j][1]) + (v[j][2] + v[j][3]);
    const float mean = wave_sum(s) * (1.f / DM); float s2 = 0.f;
#pragma unroll
    for (int j = 0; j < 4; ++j) { v[j] = v[j] - mean; s2 += (v[j][0] * v[j][0] + v[j][1] * v[j][1]) + (v[j][2] * v[j][2] + v[j][3] * v[j][3]); }
    const float rstd = 1.0f / sqrtf(wave_sum(s2) * (1.f / DM) + LN_EPS);
#pragma unroll
    for (int j = 0; j < 4; ++j) { const int col = pcol(lane, j); const f32x4 gg = *(const f32x4*)(g + col), b4 = *(const f32x4*)(bb + col); v[j] = v[j] * rstd * gg + b4; }
    mean_o = mean; rstd_o = rstd;
}

__device__ __forceinline__ int row_of(int layer, int idx, int per_item, int it, int j) { (void)idx;
    if (layer == 0) return it * per_item + j; const int xi = it * per_item + j; return (xi >> 11) * TT + LCT + (xi & 2047); }
template <int RB>
__device__ __forceinline__ void p8_rows(int idx0, int layer, const int4* __restrict__ tinfo, const LAS int* rowb, const bf16_t* __restrict__ fo, const hf_t* __restrict__ Yp, const f32x2* __restrict__ rst, const float* __restrict__ mg, const float* __restrict__ mb, float* outp, float* xrcp,
                                        const float* __restrict__ modlp, const float* __restrict__ modn, const float* __restrict__ fg, const float* __restrict__ fb, bf16_t* hbp, int lane) {
    f32x4 v[RB][4]; v4u yh[RB][2], fa[RB][2], fc[RB][2]; int rr[RB]; int4 ti[RB];
#pragma unroll
    for (int q = 0; q < RB; ++q) { const int idx = idx0 + q; rr[q] = layer == 0 ? idx : (idx >> 11) * TT + LCT + (idx & 2047); ti[q] = tinfo[rr[q]]; }
    f32x2 st[RB];
#pragma unroll
    for (int q = 0; q < RB; ++q) { const hf_t* xr = Yp + (size_t)rr[q] * DM; st[q] = rst[rr[q]];
        const bf16_t* f1 = fo + (size_t)(rowb[ti[q].x] + ti[q].y) * DM; const bf16_t* f2 = fo + (size_t)(rowb[ti[q].z] + ti[q].w) * DM;
#pragma unroll
        for (int j = 0; j < 2; ++j) yh[q][j] = *(const v4u*)(xr + 8 * lane + 512 * j);
#pragma unroll
        for (int j = 0; j < 2; ++j) { fa[q][j] = *(const v4u*)(f1 + 8 * lane + 512 * j); fc[q][j] = *(const v4u*)(f2 + 8 * lane + 512 * j); } }
#pragma unroll
    for (int q = 0; q < RB; ++q) { const int r = rr[q]; const int b = r / TT, t = r - b * TT; const int cond = t < LCT ? 8 : b;
        const float* gf = modlp + (size_t)cond * NMOD + 5120;
#pragma unroll
        for (int c = 0; c < 4; ++c) { const int col = pcol(lane, c); const v4u a4 = fa[q][c >> 1], c4 = fc[q][c >> 1];
            const unsigned ax = (c & 1) ? a4.z : a4.x, ay = (c & 1) ? a4.w : a4.y, cx = (c & 1) ? c4.z : c4.x, cy = (c & 1) ? c4.w : c4.y;
            const f32x4 f = {bf_lo(ax) + bf_lo(cx), bf_hi(ax) + bf_hi(cx), bf_lo(ay) + bf_lo(cy), bf_hi(ay) + bf_hi(cy)};
            const v4u y4 = yh[q][c >> 1]; const unsigned yx = (c & 1) ? y4.z : y4.x, yy = (c & 1) ? y4.w : y4.y;
            const f32x4 yv = {hf_lo(yx), hf_hi(yx), hf_lo(yy), hf_hi(yy)};
            const f32x4 x1 = (yv - st[q].x) * st[q].y * *(const f32x4*)(mg + col) + *(const f32x4*)(mb + col);
            v[q][c] = x1 * ALPHA + *(const f32x4*)(gf + col) * f; }
        float mean, rstd; ln_row(v[q], fg, fb, lane, mean, rstd); }
#pragma unroll
    for (int q = 0; q < RB; ++q) { const int r = rr[q]; const int b = r / TT, t = r - b * TT; const int cond = t < LCT ? 8 : b;
        if (layer == 0) { if (t >= LCT) { hf_t* xh = (hf_t*)outp + ((size_t)b * NXT + (t - LCT)) * DM;
#pragma unroll
                for (int j = 0; j < 2; ++j) { const f32x4 a = v[q][2 * j], c4 = v[q][2 * j + 1]; v4u w; w.x = pkh(a[0], a[1]); w.y = pkh(a[2], a[3]); w.z = pkh(c4[0], c4[1]); w.w = pkh(c4[2], c4[3]);
                    *(v4u*)(xh + 8 * lane + 512 * j) = w; } } }
        else { float* xr = xr_ptr(outp, xrcp, r);
#pragma unroll
            for (int c = 0; c < 4; ++c) *(f32x4*)(xr + pcol(lane, c)) = v[q][c]; }
        if (layer == 0) { const float* mv = modn + (size_t)cond * NMOD; store_h_row(v[q], mv, mv + 1024, hbp + (size_t)r * DM, lane); } }
}

template <int RB>
__device__ __forceinline__ void h0_rows(int r0, const float* __restrict__ xin, const float* __restrict__ cin, const float* __restrict__ mv0, bf16_t* hb, int lane) {
    f32x4 v[RB][4];
#pragma unroll
    for (int q = 0; q < RB; ++q) { const float* src = in0_ptr(xin, cin, r0 + q);
#pragma unroll
        for (int j = 0; j < 2; ++j) { v[q][2 * j] = *(const f32x4*)(src + 8 * lane + 512 * j); v[q][2 * j + 1] = *(const f32x4*)(src + 8 * lane + 512 * j + 4); } }
#pragma unroll
    for (int q = 0; q < RB; ++q) { const int r = r0 + q; const int b = r / TT, t = r - b * TT; const int cond = t < LCT ? 8 : b;
        const float* sv = mv0 + (size_t)cond * NMOD; const float* av = sv + 1024; bf16_t* hrow = hb + (size_t)r * DM;
#pragma unroll
        for (int j = 0; j < 2; ++j) { const int col = 8 * lane + 512 * j;
            const f32x4 s0 = *(const f32x4*)(sv + col), s1 = *(const f32x4*)(sv + col + 4), a0 = *(const f32x4*)(av + col), a1 = *(const f32x4*)(av + col + 4);
            const f32x4 h0 = v[q][2 * j] * (a0 + 1.0f) + s0, h1 = v[q][2 * j + 1] * (a1 + 1.0f) + s1;
            v4u w; w.x = cvtpk(h0[0], h0[1]); w.y = cvtpk(h0[2], h0[3]); w.z = cvtpk(h1[0], h1[1]); w.w = cvtpk(h1[2], h1[3]); *(v4u*)(hrow + col) = w; } }
}

__global__ void __launch_bounds__(512, 2) fwd_megakernel(Args args) {
    extern __shared__ __attribute__((aligned(16))) unsigned char lds[];
    LAS unsigned char* ldsl = (LAS unsigned char*)lds;
    volatile LAS unsigned* MISC = (volatile LAS unsigned*)(ldsl + MISC_OFF);
    const int G0 = gridDim.x; const int bx0 = blockIdx.x;
    const int vcu0 = (G0 % 8 == 0) ? (bx0 % 8) * (G0 / 8) + bx0 / 8 : bx0;
    const int wv = __builtin_amdgcn_readfirstlane(threadIdx.x >> 6);
#define PHASE_IDS() int G = G0, bx = bx0, vcu = vcu0; asm volatile("" : "+s"(G), "+s"(bx), "+s"(vcu)); const int NGW = G * 8; (void)NGW; (void)bx; int wave = wv; asm volatile("" : "+s"(wave)); const int tid = ltid(wave); (void)tid; const int lane = tid & 63; const int gw = vcu * 8 + wave; (void)gw; (void)lane
#define AIN(i) ldptr(ldsl, (i))
#define WSB ((unsigned char*)ldptr(ldsl, 29))
#define ctl ((gu32*)(WSB + WS_CTL))
#define modv ((float*)(WSB + WS_MOD))
#define tab64 ((f32x2*)(WSB + WS_TAB64))
#define tab128 ((f32x2*)(WSB + WS_TAB128))
#define wrt ((float*)(WSB + WS_WRT))
#define wrs ((bf16_t*)(WSB + WS_WRS))
#define tokinfo ((int4*)(WSB + WS_TOKINFO))
#define tokof ((int*)(WSB + WS_TOKOF))
#define rstats ((f32x2*)(WSB + WS_STATS))
#define gwof ((float*)(WSB + WS_GWOF))
#define ACTB ((bf16_t*)(WSB + WS_QKV))
#define XRC ((float*)(WSB + WS_XRC))
#define wqkv0 ((bf16_t*)(WSB + WS_WQKV0))
#define wo0 ((bf16_t*)(WSB + WS_WO0))
#define wqkv1 ((bf16_t*)(WSB + WS_WQKV1))
#define wo1 ((bf16_t*)(WSB + WS_WO1))
#define wgu ((bf16_t*)(WSB + WS_WGU))
#define wd ((bf16_t*)(WSB + WS_WD))
#define HB ((bf16_t*)(WSB + WS_HBUF))
#define QKV ((bf16_t*)(WSB + WS_QKV))
#define HS QKV
#define Y ((hf_t*)(WSB + WS_YOFF))
#define rowst ((f32x2*)(WSB + WS_ROWST))
#define FO ((bf16_t*)(WSB + WS_Y))
#define out ((float*)ldptr(ldsl, 28))
    for (int u = threadIdx.x; u < (LDS_BYTES - MISC_OFF) / 4; u += 512) ((LAS unsigned*)(ldsl + MISC_OFF))[u] = 0u;
    __syncthreads();
    if (threadIdx.x == 0) { LAS unsigned long long* pt = (LAS unsigned long long*)(ldsl + PTR_OFF);
#pragma unroll
        for (int i = 0; i < 28; ++i) pt[i] = (unsigned long long)args.in[i];
        pt[28] = (unsigned long long)args.o_; pt[29] = (unsigned long long)args.w_; }
    __syncthreads();
    xcd_barrier_post((unsigned*)(ctl + CW_BAR));
#define GRID_BAR() xcd_barrier((unsigned*)(ctl + CW_BAR), MISC + 8, ltid(wv) == 0)

        for (int rep_ = 0; rep_ < ((REPMASK >> 0) & 1) * REPN + 1; ++rep_) {
    if (PHMASK & (1 << 0)) {
        PHASE_IDS();
        for (int it = bx; it < 192; it += G) {
            const int layer = it / 96, col0 = (it % 96) * 64;
            const float* Wm = AIN(I_WMOD) + (size_t)layer * DM * NMOD;
            LAS float* sl = (LAS float*)(ldsl + wave * 8192);
            const int k0 = wave * 128;
            for (int idx = lane; idx < 9 * 128; idx += 64) { const int cond = idx >> 7, kk = idx & 127;
                const float v = cond < 8 ? AIN(I_C)[cond * DM + k0 + kk] : AIN(I_CCTX)[k0 + kk];
                sl[idx] = v / (1.f + expf(-v)); }
            LDS_WAIT(); asm volatile("" ::: "memory");
            const int rg = lane >> 4, c4 = (lane & 15) * 4;
            f32x4 acc[9];
#pragma unroll
            for (int c = 0; c < 9; ++c) acc[c] = (f32x4){0.f, 0.f, 0.f, 0.f};
            const unsigned lofs = (unsigned)(rg * NMOD + c4) * 4u;
#pragma unroll 1
            for (int kb = 0; kb < 128; kb += 64) { f32x4 wv_[16];
#pragma unroll
                for (int i = 0; i < 16; ++i) wv_[i] = __builtin_nontemporal_load((const f32x4*)((const char*)(Wm + (size_t)(k0 + kb + 4 * i) * NMOD + col0) + lofs));
#pragma unroll
                for (int i = 0; i < 16; ++i) {
#pragma unroll
                    for (int c = 0; c < 9; ++c) acc[c] += wv_[i] * sl[c * 128 + kb + 4 * i + rg]; } }
            LAS float* part = (LAS float*)(ldsl + 65536);
#pragma unroll
            for (int c = 0; c < 9; ++c) *(LAS f32x4*)(part + (wave * 4 + rg) * 576 + c * 64 + c4) = acc[c];
            __syncthreads();
            for (int idx = tid; idx < 576; idx += 512) { float s = 0.f;
#pragma unroll
                for (int w = 0; w < 32; ++w) s += part[w * 576 + idx];
                const int cond = idx >> 6, col = col0 + (idx & 63);
                modv[((size_t)layer * 9 + cond) * NMOD + col] = s + AIN(I_BMOD)[layer * NMOD + col]; }
            __syncthreads();
        }
        for (int idx = bx * 512 + tid; idx < 3072 + 2 * 8 * 4 * 3 * 64; idx += G * 512) {
            if (idx < 1024) { const int pos = idx >> 4, f = idx & 15; const float inv = powf(10000.f, -(float)(2 * f) / 32.f); float s, c; sincosf((float)pos * inv, &s, &c); tab64[idx] = (f32x2){c, s}; }
            else if (idx < 3072) { const int i2 = idx - 1024, pos = i2 >> 5, f = i2 & 31; const float inv = powf(10000.f, -(float)(2 * f) / 64.f); float s, c; sincosf((float)pos * inv, &s, &c); tab128[i2] = (f32x2){c, s}; }
            else { const int i2 = idx - 3072, ln = i2 & 63, nb = (i2 >> 6) % 3, s = ((i2 >> 6) / 3) & 3, w = ((i2 >> 6) / 12) & 7, l = (i2 >> 6) / 96;
                const int k0 = 128 * w + 32 * s + 8 * (ln >> 4), o = nb * 16 + (ln & 15); float wv_[8];
#pragma unroll
                for (int j = 0; j < 8; ++j) wv_[j] = o < 4 ? AIN(I_WGRP)[(size_t)l * DM * 4 + (k0 + j) * 4 + o] : (o < 36 ? AIN(I_WRT)[(size_t)l * DM * 32 + (k0 + j) * 32 + (o - 4)] : 0.f);
                unsigned hi_[4], lo_[4];
#pragma unroll
                for (int j = 0; j < 4; ++j) { hi_[j] = cvtpk(wv_[2 * j], wv_[2 * j + 1]); lo_[j] = cvtpk(wv_[2 * j] - bf_lo(hi_[j]), wv_[2 * j + 1] - bf_hi(hi_[j])); }
                bf16_t* dst = wrs + ((size_t)(((l * 8 + w) * 4 + s) * 3 + nb) * 2) * 512 + ln * 8;
                *(v4u*)dst = (v4u){hi_[0], hi_[1], hi_[2], hi_[3]}; *(v4u*)(dst + 512) = (v4u){lo_[0], lo_[1], lo_[2], lo_[3]}; }
        }
        LAS float* scr = (LAS float*)(ldsl + wave * 16384);
        constexpr int S0 = 16 * 96, S1 = 16 * 32, S2 = 16 * 48, S3 = 16 * 32, S4 = NEXP * 384;
        for (int it = gw; it < S0 + S1 + S2 + S3; it += NGW) {
            int r = it;
            if (r < S0) { const int n0 = (r % 96) * 32; const bool kcol = (n0 >= 1024 && n0 < 2048);
                transpose_item(AIN(I_DWQKV), NQKV0, wqkv0, DM, kcol ? (n0 & ~255) + ((n0 >> 6) & 3) * 32 + ((n0 >> 5) & 1) * 16 : n0, (r / 96) * 64, n0, scr, lane, kcol ? 128 : 16); continue; } r -= S0;
            if (r < S1) { transpose_item(AIN(I_DWO), DM, wo0, DM, (r % 32) * 32, (r / 32) * 64, (r % 32) * 32, scr, lane); continue; } r -= S1;
            if (r < S2) { const int n0 = (r % 48) * 32; const bool kcol = (n0 >= 1024 && n0 < 1280);
                transpose_item(AIN(I_GWQKV), NQKV1, wqkv1, DM, kcol ? 1024 + ((n0 >> 5) & 1) * 128 + ((n0 >> 7) & 1) * 64 + ((n0 >> 6) & 1) * 32 : n0, (r / 48) * 64, n0, scr, lane); continue; } r -= S2;
            if (r < S3) { transpose_item(AIN(I_GWO), DM, wo1, DM, (r % 32) * 32, (r / 32) * 64, (r % 32) * 32, scr, lane); continue; }
        }
        { int it = gw; for (; it + NGW < S4; it += 2 * NGW) moe_weight_pair(ldsl, 0, it, it + NGW, wgu, wd, scr, lane);
          if (it < S4) moe_weight_item(ldsl, 0, it, wgu, wd, scr, lane); }
    }
    GRID_BAR(); }
        for (int rep_ = 0; rep_ < ((REPMASK >> 1) & 1) * REPN + 1; ++rep_) {
    if (PHMASK & (1 << 1)) { PHASE_IDS();
    { const float* xin = AIN(I_X); const float* cin = AIN(I_CTX); const float* mv0 = modv; bf16_t* hb = HB;
    const int per = (MALL + NGW - 1) / NGW; int r0 = gw * per; const int r1 = min((int)MALL, r0 + per);
    for (; r0 + 5 <= r1; r0 += 5) h0_rows<5>(r0, xin, cin, mv0, hb, lane);
    for (; r0 + 4 <= r1; r0 += 4) h0_rows<4>(r0, xin, cin, mv0, hb, lane);
    for (; r0 < r1; ++r0) h0_rows<1>(r0, xin, cin, mv0, hb, lane);
    } }
    GRID_BAR(); }

#pragma unroll
    for (int layer = 0; layer < 2; ++layer) {
#define modl (modv + (size_t)layer * 9 * NMOD)
        const int NQ = layer == 0 ? NQKV0 : NQKV1;
        for (int rep_ = 0; rep_ < ((REPMASK >> 2) & 1) * REPN + 1; ++rep_) {
        if (PHMASK & (1 << 2))
        { PHASE_IDS();
            pg8::Gemm g{HB, layer == 0 ? wqkv0 : wqkv1, MALL, NQ, DM};
            SchedRect S; if (layer == 0) S.init(72, NQKV0, G, bx, 0, 0); else S.init(64, NQKV1, G, bx, 1, 16);
            EpiStoreBf16 E{QKV, NQ, 0xffff, layer == 0 ? tab64 : tab128, layer == 0 ? (const float*)nullptr : AIN(I_GKN), (LAS float*)(ldsl + MISC_OFF + 4096)};
            pg8::gemm_phase<EpiStoreBf16, SchedRect, true, true>(ldsl, g, S, E, wave);
        }
        GRID_BAR(); }
        for (int rep_ = 0; rep_ < ((REPMASK >> 4) & 1) * REPN + 1; ++rep_) {
        if (PHMASK & (1 << 4)) {
        if (layer == 0 && (PHMASK & (1 << 16))) { PHASE_IDS();
            float lam;
            { const float s1 = wave_sum(AIN(I_LQ1)[lane] * AIN(I_LK1)[lane]), s2 = wave_sum(AIN(I_LQ2)[lane] * AIN(I_LK2)[lane]);
              lam = expf(s1) - expf(s2) + LAMBDA_INIT0; }
            const int nH = 1024, base = nH / G, rem = nH % G;
            const int u0 = vcu * base + (vcu < rem ? vcu : rem), cnt = base + (vcu < rem ? 1 : 0);
            for (int i = 0; i < cnt; ++i) {
                const int u = u0 + i, bh = u >> 4, qb = u & 15, b = bh >> 3, h = bh & 7;
                const size_t row0 = (size_t)b * TT + LCT + qb * 128;
                const bf16_t* kb = QKV + (size_t)b * TT * NQKV0 + h * 128;
                att::attn_unit<true>(QKV + row0 * NQKV0 + h * 128, NQKV0, kb + 1024, kb + 2048, NQKV0, TT, HB + row0 * DM + h * 128, DM,
                                     true, qb * 128, tab64, nullptr, AIN(I_SUBG), lam, (char*)lds, wave);
            }
            for (int l = vcu; l < 128; l += G) {
                const int bh = l >> 1, qb = l & 1, b = bh >> 3, h = bh & 7;
                const size_t row0 = (size_t)b * TT + qb * 128;
                const bf16_t* kb = QKV + (size_t)b * TT * NQKV0 + h * 128;
                att::attn_unit<true>(QKV + row0 * NQKV0 + h * 128, NQKV0, kb + 1024, kb + 2048, NQKV0, LCT, HB + row0 * DM + h * 128, DM,
                                     false, 0, tab64, nullptr, AIN(I_SUBG), lam, (char*)lds, wave);
            }
        } else if (PHMASK & (1 << 17)) { PHASE_IDS();
            const int nU = 512, base = nU / G, rem = nU % G;
            const int u0 = vcu * base + (vcu < rem ? vcu : rem), cnt = base + (vcu < rem ? 1 : 0);
            for (int i = 0; i < cnt; ++i) {
                const int u = u0 + i, bh = u >> 3, qb = u & 7, b = bh >> 3, h = bh & 7;
                const size_t row0 = (size_t)b * TT + LCT + qb * 256;
                const bf16_t* kb = QKV + (size_t)b * TT * NQKV1 + (h >> 2) * 128;
                att::attn_unit<false>(QKV + row0 * NQKV1 + h * 128, NQKV1, kb + 1024, kb + 1280, NQKV1, TT, HB + row0 * DM + h * 128, DM,
                                      true, qb * 256, tab128, AIN(I_GQN), nullptr, 0.f, (char*)lds, wave);
            }
        } }
        GRID_BAR(); }
        for (int rep_ = 0; rep_ < ((REPMASK >> 5) & 1) * REPN + 1; ++rep_) {
        if (PHMASK & (1 << 5))
        { PHASE_IDS();
            pg8::Gemm g{HB, layer == 0 ? wo0 : wo1, MALL, DM, DM};
            SchedRect S; if (layer == 0) S.init(72, DM, G, bx, 0, 0); else S.init(64, DM, G, bx, 1, 0);
            if (layer == 0) { EpiResid<false> E{Y, AIN(I_X), AIN(I_CTX), modl, rstats}; pg8::gemm_phase<EpiResid<false>, SchedRect, true, true>(ldsl, g, S, E, wave); }
            else { EpiResid<true> E{Y, out, (const float*)nullptr, modl, rstats}; pg8::gemm_phase<EpiResid<true>, SchedRect, true, true>(ldsl, g, S, E, wave); }
        }
        GRID_BAR(); }
        if (PHMASK & (1 << 6))
        { PHASE_IDS();
            const int TR = layer == 0 ? 72 : 64;
            const f32x2* stq = rstats; const hf_t* Yq = Y; float* outq = out; float* xrcq = XRC; const float* modq = modl; bf16_t* hbq = HB;
            const float* lg = AIN(I_LNMG) + layer * DM; const float* lb = AIN(I_LNMB) + layer * DM;
            const bf16_t* wrs_l = wrs + (size_t)layer * 8 * 4 * 3 * 2 * 512;
            LAS float* red = (LAS float*)ldsl;
            LAS float* logits = (LAS float*)(ldsl + 116736);
            LAS float* stats = (LAS float*)(ldsl + 127232);
            LAS int* lcnt = (LAS int*)(ldsl + 127232 + 576);
            LAS int* lbase = lcnt + 32;
            for (int it = bx; it < 256; it += G) {
                LAS float* mods = (LAS float*)(ldsl + 82944);
                LAS float* lnv = mods + 4096;
                { const int b0i = row_of(layer, 0, TR, it, 0) / TT;
                  for (int i = tid; i < 1536; i += 512) { f32x4 v;
                      if (i < 1024) { const int slot = i >> 9, w = (i >> 8) & 1, c = (i & 255) * 4; v = *(const f32x4*)(modq + (size_t)(slot ? 8 : b0i) * NMOD + (w ? 4096 : 3072) + c); }
                      else { const int w = (i - 1024) >> 8, c = ((i - 1024) & 255) * 4; v = *(const f32x4*)((w ? lb : lg) + c); }
                      *(LAS f32x4*)(mods + i * 4) = v; } }
                v4u ypre[5];
                { const int l15p = lane & 15, kgp = lane >> 4; const hf_t* Yp_ = Y;
#pragma unroll
                  for (int mt = 0; mt < 5; ++mt) { const int j = mt * 16 + l15p; const int r = row_of(layer, 0, TR, it, j < TR ? j : 0); ypre[mt] = *(const v4u*)(Yp_ + (size_t)r * DM + 128 * wave + 8 * kgp); } }
                if (tid < 32) lcnt[tid] = 0;
                if (tid < TR) { const int r = row_of(layer, 0, TR, it, tid); const f32x2* sp = stq + (size_t)r * 16; float S = 0.f, Q = 0.f;
#pragma unroll
                    for (int p = 0; p < 16; ++p) { const f32x2 v = sp[p]; S += v.x; Q += v.y; }
                    const float mean = S * (1.f / DM); const float var = fmaxf(Q * (1.f / DM) - mean * mean, 0.f);
                    const float rstd = 1.0f / sqrtf(var + LN_EPS); stats[2 * tid] = mean; stats[2 * tid + 1] = rstd; rowst[r] = (f32x2){mean, rstd}; }
                __syncthreads();
                {
                    const int l15 = lane & 15, kg = lane >> 4;
                    pg8::f32x4 acc[5][3];
#pragma unroll
                    for (int mt = 0; mt < 5; ++mt)
#pragma unroll
                        for (int nb = 0; nb < 3; ++nb) acc[mt][nb] = (pg8::f32x4){0.f, 0.f, 0.f, 0.f};
                    int rrow[5]; float rmean[5], rrstd[5]; int rcond[5];
#pragma unroll
                    for (int mt = 0; mt < 5; ++mt) { const int j = mt * 16 + l15; const bool ok = j < TR; const int r = ok ? row_of(layer, 0, TR, it, j) : row_of(layer, 0, TR, it, 0);
                        const int bb = r / TT, tt = r - bb * TT; rrow[mt] = ok ? r : -1; rmean[mt] = stats[2 * (ok ? j : 0)]; rrstd[mt] = stats[2 * (ok ? j : 0) + 1];
                        rcond[mt] = tt < LCT ? 8 : bb; }
                    const int rfirst = row_of(layer, 0, TR, it, 0);
#define P4_LOADY(YB, S_) do { const int k0_ = 128 * wave + 32 * (S_) + 8 * kg; _Pragma("unroll") for (int mt = 0; mt < 5; ++mt) YB[mt] = *(const v4u*)(Yq + (size_t)(rrow[mt] >= 0 ? rrow[mt] : rfirst) * DM + k0_); } while (0)
#define P4_STEP(YB, S_) do { const int s = (S_); const int k0 = 128 * wave + 32 * s + 8 * kg; \
                        const f32x4 g0 = *(const LAS f32x4*)(lnv + k0), g1 = *(const LAS f32x4*)(lnv + k0 + 4), b0 = *(const LAS f32x4*)(lnv + 1024 + k0), b1 = *(const LAS f32x4*)(lnv + 1024 + k0 + 4); \
                        bf16x8 bh[3], bl[3]; \
                        _Pragma("unroll") for (int nb = 0; nb < 3; ++nb) { const bf16_t* bp = wrs_l + ((size_t)((wave * 4 + s) * 3 + nb) * 2) * 512 + lane * 8; bh[nb] = *(const bf16x8*)bp; bl[nb] = *(const bf16x8*)(bp + 512); } \
                        _Pragma("unroll") for (int mt = 0; mt < 5; ++mt) { \
                            int mo_ = (rcond[mt] == 8 ? 2048 : 0) + k0; asm volatile("" : "+v"(mo_)); \
                            const LAS float* mv = mods + mo_; \
                            const f32x4 s0 = *(const LAS f32x4*)(mv), s1 = *(const LAS f32x4*)(mv + 4), a0 = *(const LAS f32x4*)(mv + 1024), a1 = *(const LAS f32x4*)(mv + 1028); \
                            const v4u yh = YB[mt]; \
                            const f32x4 y0 = {hf_lo(yh.x), hf_hi(yh.x), hf_lo(yh.y), hf_hi(yh.y)}, y1 = {hf_lo(yh.z), hf_hi(yh.z), hf_lo(yh.w), hf_hi(yh.w)}; \
                            const f32x4 x0 = (y0 - rmean[mt]) * rrstd[mt] * g0 + b0, x1 = (y1 - rmean[mt]) * rrstd[mt] * g1 + b1; \
                            f32x4 h0 = x0 * (a0 + 1.0f) + s0, h1 = x1 * (a1 + 1.0f) + s1; \
                            if (rrow[mt] < 0) { h0 = (f32x4){0.f, 0.f, 0.f, 0.f}; h1 = h0; } \
                            v4u hh; hh.x = cvtpk(h0[0], h0[1]); hh.y = cvtpk(h0[2], h0[3]); hh.z = cvtpk(h1[0], h1[1]); hh.w = cvtpk(h1[2], h1[3]); \
                            v4u hl; hl.x = cvtpk(h0[0] - bf_lo(hh.x), h0[1] - bf_hi(hh.x)); hl.y = cvtpk(h0[2] - bf_lo(hh.y), h0[3] - bf_hi(hh.y)); \
                            hl.z = cvtpk(h1[0] - bf_lo(hh.z), h1[1] - bf_hi(hh.z)); hl.w = cvtpk(h1[2] - bf_lo(hh.w), h1[3] - bf_hi(hh.w)); \
                            if (rrow[mt] >= 0) *(v4u*)(hbq + (size_t)rrow[mt] * DM + k0) = hh; \
                            const bf16x8 ah = *reinterpret_cast<const bf16x8*>(&hh), al = *reinterpret_cast<const bf16x8*>(&hl); \
                            _Pragma("unroll") for (int nb = 0; nb < 3; ++nb) { \
                                acc[mt][nb] = __builtin_amdgcn_mfma_f32_16x16x32_bf16(ah, bh[nb], acc[mt][nb], 0, 0, 0); \
                                acc[mt][nb] = __builtin_amdgcn_mfma_f32_16x16x32_bf16(ah, bl[nb], acc[mt][nb], 0, 0, 0); \
                                acc[mt][nb] = __builtin_amdgcn_mfma_f32_16x16x32_bf16(al, bh[nb], acc[mt][nb], 0, 0, 0); } } } while (0)
                    { v4u ya[5], yb[5];
#pragma unroll
                      for (int mt = 0; mt < 5; ++mt) ya[mt] = ypre[mt];
#pragma unroll 1
                      for (int s2 = 0; s2 < 4; s2 += 2) {
                          P4_LOADY(yb, s2 + 1); __builtin_amdgcn_sched_barrier(0);
                          P4_STEP(ya, s2); __builtin_amdgcn_sched_barrier(0);
                          P4_LOADY(ya, (s2 + 2) & 3); __builtin_amdgcn_sched_barrier(0);
                          P4_STEP(yb, s2 + 1); __builtin_amdgcn_sched_barrier(0); } }
#undef P4_LOADY
#undef P4_STEP
                    const int ln2 = ltid(wave) & 63; const int l15b = ln2 & 15, kgb = ln2 >> 4;
#pragma unroll
                    for (int mt = 0; mt < 5; ++mt)
#pragma unroll
                        for (int nb = 0; nb < 3; ++nb)
#pragma unroll
                            for (int q = 0; q < 4; ++q) { const int row = mt * 16 + kgb * 4 + q, col = nb * 16 + l15b; if (row < 72 && col < 36) red[wave * 2592 + row * 36 + col] = acc[mt][nb][q]; }
                }
                const int tidc = ltid(wave);
                __syncthreads();
                for (int idx = tidc; idx < 2592; idx += 512) { const int o = idx % 36;
                    float s = o < 4 ? AIN(I_BGRP)[layer * 4 + o] : AIN(I_BRT)[layer * 32 + o - 4];
#pragma unroll
                    for (int w = 0; w < 8; ++w) s += red[w * 2592 + idx];
                    logits[idx] = s; }
                __syncthreads();
                int e1 = 0, e2 = 0, rk1 = 0, rk2 = 0; float G1 = 0.f, G2 = 0.f; int rme = 0;
                if (tidc < TR) {
                    const LAS float* lgt = logits + tidc * 36;
                    int gi = 0; float gm = lgt[0];
#pragma unroll
                    for (int g = 1; g < 4; ++g) { const float v = lgt[g]; if (v > gm) { gm = v; gi = g; } }
                    float gs = 0.f;
#pragma unroll
                    for (int g = 0; g < 4; ++g) gs += expf(lgt[g] - gm);
                    const float gtop = 1.0f / gs;
                    const LAS float* el = lgt + 4 + gi * 8;
                    int i1 = 0; float v1 = el[0];
#pragma unroll
                    for (int e = 1; e < 8; ++e) { const float v = el[e]; if (v > v1) { v1 = v; i1 = e; } }
                    int i2 = -1; float v2 = -3.0e38f;
#pragma unroll
                    for (int e = 0; e < 8; ++e) { const float v = el[e]; if (e != i1 && v > v2) { v2 = v; i2 = e; } }
                    const float ex = expf(v2 - v1); const float w1 = 1.0f / (1.0f + ex), w2 = ex / (1.0f + ex);
                    e1 = gi * 8 + i1; e2 = gi * 8 + i2; G1 = gtop * w1; G2 = gtop * w2;
                    rk1 = atomicAdd((int*)(lcnt + e1), 1); rk2 = atomicAdd((int*)(lcnt + e2), 1);
                    if (layer == 0) rme = it * 72 + tidc; else { const int xi = it * 64 + tidc; rme = (xi >> 11) * TT + LCT + (xi & 2047); }
                }
                __syncthreads();
                if (tidc < 32) { const int n = lcnt[tidc]; lbase[tidc] = n ? (int)__hip_atomic_fetch_add((unsigned*)(ctl + CW_CNT + layer * 32 + tidc), (unsigned)n, RLX_AGENT) : 0; }
                __syncthreads();
                if (tidc < TR) { const int q1 = lbase[e1] + rk1, q2 = lbase[e2] + rk2; tokinfo[rme] = make_int4(e1, q1, e2, q2);
                    int* tkf = tokof; float* gwf = gwof; tkf[(size_t)e1 * ECAP + q1] = rme; tkf[(size_t)e2 * ECAP + q2] = rme; gwf[(size_t)e1 * ECAP + q1] = G1; gwf[(size_t)e2 * ECAP + q2] = G2; }
                __syncthreads();
            }
        }
        GRID_BAR();
        for (int rep_ = 0; rep_ < ((REPMASK >> 8) & 1) * REPN + 1; ++rep_) {
        if (PHMASK & (1 << 8))
        {
            PHASE_IDS();
            LAS unsigned char* tile_e = ldsl + TILEE_OFF; LAS int* rowb = (LAS int*)(ldsl + ROWB_OFF); LAS int* cntl = (LAS int*)(ldsl + ROWB_OFF + 128); LAS int* tbase = (LAS int*)(ldsl + ROWB_OFF + 256);
            if (tid == 0) { int tt = 0;
#pragma unroll 1
                for (int e = 0; e < NEXP; ++e) { const int cnt = (int)__hip_atomic_load((unsigned*)(ctl + CW_CNT + layer * 32 + e), RLX_AGENT); rowb[e] = tt * 256; tbase[e] = tt; cntl[e] = cnt; tt += (cnt + 255) >> 8; }
                tbase[NEXP] = tt; MISC[16] = (unsigned)tt; }
            __syncthreads();
            if (tid < 176) { int e = 0;
#pragma unroll 1
                for (int q = 1; q < NEXP; ++q) e += (tbase[q] <= tid) ? 1 : 0;
                tile_e[tid] = (unsigned char)e; }
            __syncthreads();
            const int ntile = (int)MISC[16];
            pg8::Gemm g{HB, wgu, SORT_ROWS, NEXP * 512, DM};
            SchedExp S{ldsl + TILEE_OFF, 2, ntile * 2, G, bx};
            EpiGateUp E{ACTB, gwof, tbase};
            pg8::GatherA GA{tokof, tbase, cntl, 2, ECAP};
            pg8::gemm_phase<EpiGateUp, SchedExp, true, true, true, pg8::GatherA>(ldsl, g, S, E, wave, GA);
        }
        GRID_BAR(); }
        for (int rep_ = 0; rep_ < ((REPMASK >> 9) & 1) * REPN + 1; ++rep_) {
        if (PHMASK & (1 << 9))
        { PHASE_IDS();
            const int ntile = (int)MISC[16];
            int kdn = FH; asm volatile("" : "+s"(kdn));
            pg8::Gemm g{ACTB, wd, SORT_ROWS, NEXP * 1024, kdn};
            SchedExp S{ldsl + TILEE_OFF, 4, ntile * 4, G, bx};
            EpiStoreBf16 E{FO, DM, 3, (const f32x2*)nullptr, (const float*)nullptr, (LAS float*)nullptr};
            pg8::gemm_phase<EpiStoreBf16, SchedExp, true, true>(ldsl, g, S, E, wave);
        }
        GRID_BAR(); }
        if (PHMASK & (1 << 10))
        { PHASE_IDS();
            const float* fg = AIN(I_LNFG) + layer * DM; const float* fb = AIN(I_LNFB) + layer * DM;
            const int nrows = layer == 0 ? MALL : MXR;
            { const hf_t* Yq = Y; const f32x2* rsq = rowst; const float* mg = AIN(I_LNMG) + layer * DM; const float* mb = AIN(I_LNMB) + layer * DM; const int4* tinfo = tokinfo; const LAS int* rowb = (const LAS int*)(ldsl + ROWB_OFF); const bf16_t* fo = FO; float* outq = out; float* xrcq = XRC; const float* modq = modl; const float* modn = modv + (size_t)9 * NMOD; bf16_t* hbq = HB;
              if (layer == 0) {
                  const int per = (nrows + NGW - 1) / NGW; int idx0 = gw * per; const int i1 = min(nrows, idx0 + per);
                  for (; idx0 + 3 <= i1; idx0 += 3) p8_rows<3>(idx0, layer, tinfo, rowb, fo, Yq, rsq, mg, mb, outq, xrcq, modq, modn, fg, fb, hbq, lane);
                  for (; idx0 < i1; ++idx0) p8_rows<1>(idx0, layer, tinfo, rowb, fo, Yq, rsq, mg, mb, outq, xrcq, modq, modn, fg, fb, hbq, lane);
              } else
              for (int idx0 = gw * 4; idx0 < nrows; idx0 += NGW * 4) p8_rows<4>(idx0, layer, tinfo, rowb, fo, Yq, rsq, mg, mb, outq, xrcq, modq, modn, fg, fb, hbq, lane); }
            if (layer == 0) {
                LAS float* scr = (LAS float*)(ldsl + wave * 16384);
                { int it = gw; for (; it + NGW < NEXP * 384; it += 2 * NGW) moe_weight_pair(ldsl, 1, it, it + NGW, wgu, wd, scr, lane);
                  if (it < NEXP * 384) moe_weight_item(ldsl, 1, it, wgu, wd, scr, lane); }
                GRID_BAR();
            }
        }
    }
}

#undef out
#undef Y
#undef HS
#undef QKV
#undef HB
#undef ctl
extern "C" void kernel_launch(void* const* d_in, const int* in_sizes, int n_in, void* d_out, int out_size, void* d_ws, size_t ws_size, hipStream_t stream) {
    static int grid = 0;
    if (grid == 0) {
        if (n_in != 28 || in_sizes[0] != MXR * DM || out_size != MXR * DM || ws_size < WS_END) {
            fprintf(stderr, "kernel_launch: unexpected shapes: n_in %d in0 %d out %d ws %zu (need %zu)\n", n_in, n_in > 0 ? in_sizes[0] : -1, out_size, ws_size, (size_t)WS_END); grid = -1; return; }
        int dev = 0, cus = 0, per_cu = 0;
        if (hipGetDevice(&dev) != hipSuccess || hipDeviceGetAttribute(&cus, hipDeviceAttributeMultiprocessorCount, dev) != hipSuccess) { grid = -1; return; }
        if (hipFuncSetAttribute((const void*)fwd_megakernel, hipFuncAttributeMaxDynamicSharedMemorySize, LDS_BYTES) != hipSuccess) { fprintf(stderr, "kernel_launch: hipFuncSetAttribute failed\n"); grid = -1; return; }
        if (hipOccupancyMaxActiveBlocksPerMultiprocessor(&per_cu, (const void*)fwd_megakernel, 512, LDS_BYTES) != hipSuccess || per_cu < 1) { fprintf(stderr, "kernel_launch: occupancy query reports %d\n", per_cu); (void)hipGetLastError(); per_cu = 1; }
        grid = cus;
        if (grid > 256) grid = 256;
    }
    if (grid < 0) return;
    if (hipMemsetAsync((char*)d_ws + WS_CTL, 0, CTL_ZERO_BYTES, stream) != hipSuccess) { fprintf(stderr, "kernel_launch: memset failed\n"); return; }
    Args a{};
    for (int i = 0; i < 28; ++i) a.in[i] = (const float*)d_in[i];
    a.o_ = (float*)d_out; a.w_ = (unsigned char*)d_ws;
    hipLaunchKernelGGL(fwd_megakernel, dim3(grid), dim3(512), LDS_BYTES, stream, a);
    const hipError_t le = hipPeekAtLastError();
    if (le != hipSuccess) fprintf(stderr, "kernel_launch: launch failed: %s\n", hipGetErrorName(le));
}
```

```cpp
#include <hip/hip_runtime.h>
#include <hip/hip_bf16.h>
#include <cstdio>
#include <cstdint>
__device__ __forceinline__ int ltid(int wv) { int l; asm volatile("v_mbcnt_lo_u32_b32 %0, -1, 0\n\tv_mbcnt_hi_u32_b32 %0, -1, %0" : "=v"(l)); return wv * 64 + l; }
namespace pg8 {
#define PG8_LAS __attribute__((address_space(3)))
typedef unsigned short bf16_t;
typedef short bf16x8 __attribute__((ext_vector_type(8)));
typedef float f32x4 __attribute__((ext_vector_type(4)));
typedef unsigned u32x4 __attribute__((ext_vector_type(4)));
constexpr int BM = 256, BK = 64, HALF = 128, HTB = HALF * BK * 2  , STAGE_BYTES = 8 * HTB, NXCD = 8, WGM = 8;

__host__ __device__ __forceinline__ int lds_byte(int r, int c) { const int st = (r >> 4) * 2 + (c >> 5), rr = r & 15, cc = c & 31, ob = rr * 64 + cc * 2; return st * 1024 + (ob ^ (((ob >> 9) & 1) << 5)); }
__host__ __device__ __forceinline__ void stage_rc(int b, int& R, int& C) { const int st = b / 1024, sb = b % 1024, swz = sb ^ (((sb >> 9) & 1) << 5); R = (st >> 1) * 16 + swz / 64; C = (st & 1) * 32 + (swz % 64) / 2; }
__host__ __device__ __forceinline__ int perm32(int rho) { const int n = rho >> 4, i = rho & 15; return 8 * (i >> 2) + 4 * n + (i & 3); }

struct Unit { int pm, pn, hm; };
struct Gemm { const bf16_t* A; const bf16_t* Bt; int M, N, K; };

struct StaticOrder {
    int nM, nN, nwg, G, c;
    __host__ __device__ void init(int M, int N, int G_, int c_) { nM = M / BM; nN = N / BM; nwg = nM * nN; G = G_; c = c_; }
    __host__ __device__ bool next(int i, Unit& u) const { return at((long)i * G + c, u); }
    __host__ __device__ bool at(const long L, Unit& u) const {
        if (L >= nwg) return false; u.hm = 0;
        int wgid = (int)L; { const int q = nwg / NXCD, r = nwg % NXCD, xcd = wgid % NXCD, off = wgid / NXCD; wgid = (xcd < r ? xcd * (q + 1) : r * (q + 1) + (xcd - r) * q) + off; }
        const int nig = WGM * nN, gid = wgid / nig, fm = gid * WGM, gsz = (nM - fm) < WGM ? (nM - fm) : WGM;
        u.pm = fm + ((wgid % nig) % gsz); u.pn = (wgid % nig) / gsz; return true;
    }
    __device__ __forceinline__ void a_ready(const Unit&) const {}
    __device__ __forceinline__ void done(const Unit&) const {}
};

__device__ __forceinline__ unsigned cvt_pk_bf16(float lo, float hi) { unsigned r; asm volatile("v_cvt_pk_bf16_f32 %0, %1, %2" : "=v"(r) : "v"(lo), "v"(hi)); return r; }
typedef float f32x2 __attribute__((ext_vector_type(2)));
struct NoGather {};
struct GatherA { const int* tok; const PG8_LAS int* tbase; const PG8_LAS int* cnt; int NP, cap; };
template <class Epi, class Sched, bool ALIGN_EPI = false, bool SP2 = false, bool GATHER = false, class GAT = NoGather>
__device__ __forceinline__ void gemm_phase(PG8_LAS unsigned char* lds, const Gemm g, const Sched& S, const Epi& E, const int wv, const GAT& GA = GAT()) {
    static_assert(!GATHER || SP2, "gather staging is written for the SP2 loop");
    const int tid = ltid(wv), wid = wv, lane = tid & 63, wr = wid >> 2, wc = wid & 3, fr = lane & 15, fq = lane >> 4;
    const int K = g.K, nt = K / BK;
    unsigned voffA[2], voffB[2];
#pragma unroll
    for (int i = 0; i < 2; ++i) { int R, C; stage_rc(tid * 16 + i * 8192, R, C); const int Rb = Epi::PERM ? ((R & ~31) + perm32(R & 31)) : R;
        voffA[i] = (unsigned)(R * K + C) * 2u; voffB[i] = (unsigned)(Rb * K + C) * 2u; }
    const size_t kstep = (size_t)(BK * 2);
    const size_t hstep = (size_t)HALF * K * 2;
    const size_t tstep = 2 * hstep;
    const unsigned ldsw = (unsigned)wid * 1024u;
    const int aoff = lds_byte(wr * 64 + fr, fq * 8), boff = lds_byte(wc * 32 + fr, fq * 8);
#define PG8_SA(b, h) (((b) * 2 + (h)) * HTB)
#define PG8_SB(b, h) ((4 + (b) * 2 + (h)) * HTB)
#define PG8_STAGE(bufoff, gbase, voff) do { _Pragma("unroll") for (int _i = 0; _i < 2; ++_i) \
        __builtin_amdgcn_global_load_lds((const unsigned*)((const char*)(gbase) + (voff)[_i]), (PG8_LAS unsigned*)(lds + (bufoff) + ldsw + _i * 8192), 16, 0, 0); } while (0)
#define PG8_STAGE_A(bufoff, ngptr, h, kofs, GV) do { if constexpr (GATHER) { PG8_STAGE(bufoff, (const char*)g.A + (kofs), GV[h]); } else { PG8_STAGE(bufoff, ngptr, voffA); } } while (0)
#define PG8_GOFS(dst, U) do { if constexpr (GATHER) { const int e_ = (U).pn / GA.NP; const int rk0_ = ((U).pm - GA.tbase[e_]) * 256; const int c_ = GA.cnt[e_]; \
        _Pragma("unroll") for (int h_ = 0; h_ < 2; ++h_) _Pragma("unroll") for (int i_ = 0; i_ < 2; ++i_) { int R_, C_; stage_rc(tid * 16 + i_ * 8192, R_, C_); const int rk_ = rk0_ + h_ * 128 + R_; \
            const int tk_ = rk_ < c_ ? GA.tok[(size_t)e_ * GA.cap + rk_] : 0; dst[h_][i_] = (unsigned)(tk_ * K + C_) * 2u; } } } while (0)
#define PG8_LDA(dst, b, h) do { _Pragma("unroll") for (int m = 0; m < 4; ++m) _Pragma("unroll") for (int k = 0; k < 2; ++k) dst[m][k] = *(const PG8_LAS bf16x8*)(lds + PG8_SA(b, h) + aoff + m * 2048 + k * 1024); } while (0)
#define PG8_LDB(dst, b, h) do { _Pragma("unroll") for (int n = 0; n < 2; ++n) _Pragma("unroll") for (int k = 0; k < 2; ++k) dst[n][k] = *(const PG8_LAS bf16x8*)(lds + PG8_SB(b, h) + boff + n * 2048 + k * 1024); } while (0)
#define PG8_MMA(ai, bj, At, Bt) do { if (cur.hm != 0 && cur.hm != (ai) + 1) break; __builtin_amdgcn_s_setprio(1); _Pragma("unroll") for (int m = 0; m < 4; ++m) _Pragma("unroll") for (int n = 0; n < 2; ++n) _Pragma("unroll") for (int k = 0; k < 2; ++k) \
        acc[ai][bj][m][n] = __builtin_amdgcn_mfma_f32_16x16x32_bf16(Bt[n][k], At[m][k], acc[ai][bj][m][n], 0, 0, 0); __builtin_amdgcn_s_setprio(0); } while (0)
#define PG8_WAIT_V(n) asm volatile("s_waitcnt vmcnt(" #n ")" ::: "memory")
#define PG8_WAIT_L(n) asm volatile("s_waitcnt lgkmcnt(" #n ")" ::: "memory")
#define PG8_BAR __builtin_amdgcn_s_barrier()
#define PG8_SCHED __builtin_amdgcn_sched_barrier(0)
    Unit cur, nxt; int ui = 0;
    if (!S.next(0, cur)) return;
    f32x4 acc[2][2][4][2];
#pragma unroll
    for (int a = 0; a < 2; ++a)
#pragma unroll
        for (int b = 0; b < 2; ++b)
#pragma unroll
            for (int m = 0; m < 4; ++m)
#pragma unroll
                for (int n = 0; n < 2; ++n) acc[a][b][m][n] = (f32x4){0.f, 0.f, 0.f, 0.f};
    bf16x8 At[4][2], B0[2][2], B1[2][2];
    const char* cA = (const char*)g.A + (size_t)cur.pm * tstep; const char* cB = (const char*)g.Bt + (size_t)cur.pn * tstep;
    S.a_ready(cur);
    unsigned curG[2][2] = {{0u, 0u}, {0u, 0u}}, nxtG[2][2] = {{0u, 0u}, {0u, 0u}};
    PG8_GOFS(curG, cur); { Unit n0_; if (S.next(1, n0_)) PG8_GOFS(nxtG, n0_); }
    if constexpr (SP2) {
        PG8_STAGE(PG8_SB(0, 0), cB, voffB); PG8_STAGE(PG8_SB(0, 1), cB + hstep, voffB); PG8_STAGE_A(PG8_SA(0, 0), cA, 0, (size_t)0, curG); PG8_STAGE_A(PG8_SA(0, 1), cA + hstep, 1, (size_t)0, curG);
        if (wr == 1) PG8_BAR;
        PG8_WAIT_V(2); PG8_BAR;
        PG8_STAGE(PG8_SB(1, 0), cB + kstep, voffB); PG8_STAGE_A(PG8_SA(1, 0), cA + kstep, 0, kstep, curG); PG8_STAGE(PG8_SB(1, 1), cB + hstep + kstep, voffB);
        PG8_WAIT_V(6); PG8_BAR;
    } else {
        PG8_STAGE(PG8_SB(0, 0), cB, voffB); PG8_STAGE(PG8_SA(0, 0), cA, voffA); PG8_STAGE(PG8_SB(0, 1), cB + hstep, voffB); PG8_STAGE(PG8_SA(0, 1), cA + hstep, voffA);
        if (wr == 1) PG8_BAR;
        PG8_WAIT_V(4); PG8_BAR;
        PG8_STAGE(PG8_SB(1, 0), cB + kstep, voffB); PG8_STAGE(PG8_SA(1, 0), cA + kstep, voffA); PG8_STAGE(PG8_SB(1, 1), cB + hstep + kstep, voffB);
        PG8_WAIT_V(6); PG8_BAR;
    }
    for (;;) {
        const bool has_next = S.next(ui + 1, nxt);
        if (GATHER && has_next && ui >= 1) PG8_GOFS(nxtG, nxt);
        const char* nA = has_next ? (const char*)g.A + (size_t)nxt.pm * tstep : cA; const char* nB = has_next ? (const char*)g.Bt + (size_t)nxt.pn * tstep : cB;
        for (int t = 0; t < nt; t += 2) {
            const bool last = (t == nt - 2);
            const char* a1 = cA + (size_t)(t + 1) * kstep;
            const char* a2 = last ? nA : cA + (size_t)(t + 2) * kstep; const char* b2 = last ? nB : cB + (size_t)(t + 2) * kstep;
            const char* a3 = a2 + kstep; const char* b3 = b2 + kstep;
            if (last && has_next) S.a_ready(nxt);
            const size_t k1o = (size_t)(t + 1) * kstep, k2o = last ? (size_t)0 : (size_t)(t + 2) * kstep; unsigned selG[2][2];
            _Pragma("unroll") for (int h_ = 0; h_ < 2; ++h_) _Pragma("unroll") for (int i_ = 0; i_ < 2; ++i_) selG[h_][i_] = (last && has_next) ? nxtG[h_][i_] : curG[h_][i_];
            if constexpr (SP2) {
            PG8_LDB(B0, 0, 0); PG8_LDB(B1, 0, 1); PG8_SCHED; PG8_LDA(At, 0, 0); PG8_STAGE_A(PG8_SA(1, 1), a1 + hstep, 1, k1o, curG);
            PG8_WAIT_V(8); PG8_WAIT_L(0); PG8_BAR; PG8_MMA(0, 0, At, B0); PG8_MMA(0, 1, At, B1); PG8_BAR; PG8_SCHED;
            PG8_LDA(At, 0, 1); PG8_STAGE(PG8_SB(0, 0), b2, voffB); PG8_STAGE(PG8_SB(0, 1), b2 + hstep, voffB); PG8_STAGE_A(PG8_SA(0, 0), a2, 0, k2o, selG);
            PG8_WAIT_V(8); PG8_WAIT_L(0); PG8_BAR; PG8_MMA(1, 0, At, B0); PG8_MMA(1, 1, At, B1); PG8_BAR; PG8_SCHED;
            PG8_LDB(B0, 1, 0); PG8_LDB(B1, 1, 1); PG8_SCHED; PG8_LDA(At, 1, 0); PG8_STAGE_A(PG8_SA(0, 1), a2 + hstep, 1, k2o, selG);
            PG8_WAIT_V(8); PG8_WAIT_L(0); PG8_BAR; PG8_MMA(0, 0, At, B0); PG8_MMA(0, 1, At, B1); PG8_BAR; PG8_SCHED;
            PG8_LDA(At, 1, 1); PG8_STAGE(PG8_SB(1, 0), b3, voffB); PG8_STAGE(PG8_SB(1, 1), b3 + hstep, voffB); PG8_STAGE_A(PG8_SA(1, 0), a3, 0, k2o + kstep, selG);
            PG8_WAIT_V(8); PG8_WAIT_L(0); PG8_BAR; PG8_MMA(1, 0, At, B0); PG8_MMA(1, 1, At, B1); PG8_BAR; PG8_SCHED;
            } else {
            PG8_LDB(B0, 0, 0); PG8_SCHED; PG8_LDA(At, 0, 0); PG8_STAGE(PG8_SA(1, 1), a1 + hstep, voffA);
            PG8_WAIT_L(8); PG8_BAR; PG8_WAIT_L(0); PG8_MMA(0, 0, At, B0); PG8_BAR; PG8_SCHED;
            PG8_LDB(B1, 0, 1); PG8_STAGE(PG8_SB(0, 0), b2, voffB);
            PG8_BAR; PG8_WAIT_L(0); PG8_MMA(0, 1, At, B1); PG8_BAR;
            PG8_LDA(At, 0, 1); PG8_STAGE(PG8_SA(0, 0), a2, voffA);
            PG8_BAR; PG8_WAIT_L(0); PG8_MMA(1, 0, At, B0); PG8_BAR; PG8_SCHED;
            PG8_STAGE(PG8_SB(0, 1), b2 + hstep, voffB);
            PG8_WAIT_V(6); PG8_BAR; PG8_MMA(1, 1, At, B1); PG8_BAR;
            PG8_LDB(B0, 1, 0); PG8_SCHED; PG8_LDA(At, 1, 0); PG8_STAGE(PG8_SA(0, 1), a2 + hstep, voffA);
            PG8_WAIT_L(8); PG8_BAR; PG8_WAIT_L(0); PG8_MMA(0, 0, At, B0); PG8_BAR; PG8_SCHED;
            PG8_LDB(B1, 1, 1); PG8_STAGE(PG8_SB(1, 0), b3, voffB);
            PG8_BAR; PG8_WAIT_L(0); PG8_MMA(0, 1, At, B1); PG8_BAR;
            PG8_LDA(At, 1, 1); PG8_STAGE(PG8_SA(1, 0), a3, voffA);
            PG8_BAR; PG8_WAIT_L(0); PG8_MMA(1, 0, At, B0); PG8_BAR; PG8_SCHED;
            PG8_STAGE(PG8_SB(1, 1), b3 + hstep, voffB);
            PG8_WAIT_V(6); PG8_BAR; PG8_MMA(1, 1, At, B1); PG8_BAR;
            }
        }
        if constexpr (ALIGN_EPI) { if (wr == 0) PG8_BAR; }
        if constexpr (!Epi::AFTER_DRAIN) { E(acc, cur, wr, wc, fr, fq); S.done(cur); }
        if (!has_next) break;
#pragma unroll
        for (int a = 0; a < 2; ++a)
#pragma unroll
            for (int b = 0; b < 2; ++b)
#pragma unroll
                for (int m = 0; m < 4; ++m)
#pragma unroll
                    for (int n = 0; n < 2; ++n) acc[a][b][m][n] = (f32x4){0.f, 0.f, 0.f, 0.f};
        cur = nxt; cA = nA; cB = nB; ++ui;
        _Pragma("unroll") for (int h_ = 0; h_ < 2; ++h_) _Pragma("unroll") for (int i_ = 0; i_ < 2; ++i_) curG[h_][i_] = nxtG[h_][i_];
        if constexpr (ALIGN_EPI) { if (wr == 1) PG8_BAR; }
    }
    PG8_WAIT_V(0);
    if constexpr (!ALIGN_EPI) { if (wr == 0) PG8_BAR; }
    PG8_BAR;
    if constexpr (Epi::AFTER_DRAIN) { E.fused(acc, cur, wr, wc, fr, fq, lds, wid, lane); S.done(cur); }
#undef PG8_SA
#undef PG8_SB
#undef PG8_STAGE
#undef PG8_LDA
#undef PG8_STAGE_A
#undef PG8_GOFS
#undef PG8_LDB
#undef PG8_MMA
#undef PG8_WAIT_V
#undef PG8_WAIT_L
#undef PG8_BAR
#undef PG8_SCHED
}
}

constexpr int NB = 8, NXT = 2048, LCT = 256, TT = 2304, DM = 1024;
constexpr int MALL = NB * TT;
constexpr int MXR = NB * NXT;
constexpr int NQKV0 = 3072, NQKV1 = 1536;
constexpr int NEXP = 32, FH = 256, NMOD = 6144;
constexpr float ALPHA = 1.41421356237309515f;
constexpr float LAMBDA_INIT0 = 0.2f;
constexpr float LN_EPS = 1e-5f, RMS_EPS = 1e-6f;
constexpr int SORT_ROWS = 45056;

#define GAS __attribute__((address_space(1)))
#define LAS __attribute__((address_space(3)))
typedef unsigned short bf16_t;
typedef unsigned v4u __attribute__((ext_vector_type(4)));
typedef unsigned v2u __attribute__((ext_vector_type(2)));
typedef float f32x4 __attribute__((ext_vector_type(4)));
typedef float f32x2 __attribute__((ext_vector_type(2)));
typedef short bf16x8 __attribute__((ext_vector_type(8)));
typedef short s16x4 __attribute__((ext_vector_type(4)));
typedef float f32x16 __attribute__((ext_vector_type(16)));
typedef GAS unsigned gu32;
#define RLX_AGENT __ATOMIC_RELAXED, __HIP_MEMORY_SCOPE_AGENT
#define LDS_WAIT() asm volatile("s_waitcnt lgkmcnt(0)" ::: "memory")
#define VM_WAIT() asm volatile("s_waitcnt vmcnt(0)" ::: "memory")

constexpr size_t MiB = 1u << 20;
constexpr size_t WS_CTL = 0, CTL_ZERO_BYTES = 1 * MiB;
constexpr size_t WS_MOD = 1 * MiB;
constexpr size_t WS_TAB64 = 1 * MiB + 512 * 1024;
constexpr size_t WS_TAB128 = WS_TAB64 + 8192;
constexpr size_t WS_WRT = WS_TAB64 + 65536;
constexpr size_t WS_TOKINFO = 2 * MiB;
constexpr size_t WS_TOKW = WS_TOKINFO + (size_t)MALL * 16;
constexpr size_t WS_TOKPOS = WS_TOKW + (size_t)MALL * 8;
constexpr size_t WS_GW = 3 * MiB;
constexpr size_t WS_XRC = 4 * MiB;
constexpr size_t WS_WQKV0 = 12 * MiB, WS_WO0 = 18 * MiB, WS_WQKV1 = 20 * MiB, WS_WO1 = 23 * MiB;
constexpr size_t WS_WGU = 26 * MiB;
constexpr size_t WS_WD = 58 * MiB;
constexpr size_t WS_HBUF = 74 * MiB;
constexpr size_t WS_QKV = 110 * MiB;
constexpr size_t WS_R1 = WS_QKV + 66 * MiB;
constexpr size_t WS_Y = 218 * MiB;
constexpr size_t WS_TOKOF = 306 * MiB;
constexpr size_t WS_GWOF = 309 * MiB;
constexpr int ECAP = 18432;
constexpr size_t WS_STATS = 312 * MiB;
constexpr size_t WS_ROWST = 315 * MiB;
constexpr size_t WS_YOFF = WS_QKV + 24 * MiB;
constexpr size_t WS_WRS = 316 * MiB;
constexpr size_t WS_END = 317 * MiB;
static_assert(WS_TOKPOS + (size_t)MALL * 8 <= WS_GW && WS_GW + SORT_ROWS * 4 <= WS_XRC && WS_XRC + 2048 * 4096 <= WS_WQKV0, "ws map");
static_assert(WS_YOFF + (size_t)MALL * DM * 4 <= WS_Y && (size_t)SORT_ROWS * FH * 2 <= 24 * MiB && WS_QKV + (size_t)MALL * 3072 * 2 <= WS_Y && WS_Y + (size_t)SORT_ROWS * 2048 <= WS_END && WS_HBUF + (size_t)MALL * 2048 <= WS_QKV, "ws map");
constexpr int CW_BAR = 4096;
constexpr int CW_CNT = 8192;

constexpr int RING_BYTES = 131072;
constexpr int MISC_OFF = 139264;
constexpr int TILEE_OFF = MISC_OFF + 256;
constexpr int ROWB_OFF = MISC_OFF + 512;
constexpr int LDS_BYTES = 147456;

__device__ __forceinline__ unsigned cvtpk(float lo, float hi) { unsigned r; asm volatile("v_cvt_pk_bf16_f32 %0, %1, %2" : "=v"(r) : "v"(lo), "v"(hi)); return r; }
__device__ __forceinline__ float bf_lo(unsigned u) { return __uint_as_float(u << 16); }
__device__ __forceinline__ float bf_hi(unsigned u) { return __uint_as_float(u & 0xffff0000u); }
template <int M> __device__ __forceinline__ float xsum(float v) {
    if constexpr (M < 32) return v + __int_as_float(__builtin_amdgcn_ds_swizzle(__float_as_int(v), (M << 10) | 0x1f));
    else { auto rr = __builtin_amdgcn_permlane32_swap(__float_as_uint(v), __float_as_uint(v), false, false); return __uint_as_float(rr[0]) + __uint_as_float(rr[1]); }
}
__device__ __forceinline__ float sum32(float v) { v = xsum<1>(v); v = xsum<2>(v); v = xsum<4>(v); v = xsum<8>(v); v = xsum<16>(v); return v; }
__device__ __forceinline__ float wave_sum(float v) { return xsum<32>(sum32(v)); }
__device__ __forceinline__ int row_b(int r) { return r / TT; }
__device__ __forceinline__ float* xr_ptr(float* out, float* xrc, int r) {
    const int b = r / TT, t = r - b * TT;
    return t < LCT ? xrc + ((size_t)b * LCT + t) * DM : out + ((size_t)b * NXT + (t - LCT)) * DM;
}
__device__ __forceinline__ const float* in0_ptr(const float* x, const float* ctx, int r) {
    const int b = r / TT, t = r - b * TT;
    return t < LCT ? ctx + ((size_t)b * LCT + t) * DM : x + ((size_t)b * NXT + (t - LCT)) * DM;
}

#define XB_TMO      128
#define XB_XCNT(j)  (256  + 64 * (j))
#define XB_XSUB(j)  (1280 + 64 * (j))
#define XB_XGEN(j)  (2304 + 64 * (j))
#define XB_TOP      3328
#define XB_TOPGEN   3392
#define XCD_BAR_WORDS 3456
#define XB_SPIN_CAP (1u << 18)
__device__ __forceinline__ unsigned xb_ld(unsigned* p)              { return __hip_atomic_load(p, __ATOMIC_RELAXED, __HIP_MEMORY_SCOPE_AGENT); }
__device__ __forceinline__ unsigned xb_add(unsigned* p, unsigned v) { return __hip_atomic_fetch_add(p, v, __ATOMIC_RELAXED, __HIP_MEMORY_SCOPE_AGENT); }
__device__ __forceinline__ unsigned xb_xcc_id() { return (unsigned)__builtin_amdgcn_s_getreg((3 << 11) | 20) & 0xFu; }
#define XB_SPIN(cond, bar) do { unsigned _sp = 0; while (cond) { __builtin_amdgcn_s_sleep(1); \
    if ((++_sp & 255u) == 0u) { if (xb_ld(&(bar)[XB_TMO])) break; if (_sp > XB_SPIN_CAP) { atomicAdd(&(bar)[XB_TMO], 1u); break; } } } } while (0)
__device__ __forceinline__ void xcd_barrier_post(unsigned* bar) {
    const unsigned x = xb_xcc_id();
    if (threadIdx.x == 0) (void)xb_add(&bar[XB_XCNT(x)], 1u);
}
__device__ __forceinline__ void xcd_barrier_complete(unsigned* bar, unsigned x, unsigned& nloc, unsigned& nx) {
    const unsigned G = gridDim.x * gridDim.y * gridDim.z;
    unsigned sum, cnt, mine, sp = 0u;
    for (;;) {
        sum = 0u; cnt = 0u; mine = 0u;
#pragma unroll
        for (unsigned j = 0; j < 16; ++j) { const unsigned c = xb_ld(&bar[XB_XCNT(j)]); sum += c; cnt += (c > 0u) ? 1u : 0u; mine = (j == x) ? c : mine; }
        if (sum == G) break;
        __builtin_amdgcn_s_sleep(1);
        if ((++sp & 255u) == 0u) { if (xb_ld(&bar[XB_TMO])) break; if (sp > XB_SPIN_CAP) { atomicAdd(&bar[XB_TMO], 1u); break; } }
    }
    nloc = mine > 0u ? mine : 1u; nx = cnt > 0u ? cnt : 1u;
}
__device__ __forceinline__ void xcd_barrier(unsigned* bar_in, volatile LAS unsigned* st, bool leader) {
    asm volatile("s_waitcnt vmcnt(0)" ::: "memory");
    __syncthreads();
    if (leader) {
        unsigned* bar = bar_in;
        unsigned bx_ = xb_xcc_id(); asm volatile("" : "+s"(bx_));
        __builtin_amdgcn_s_waitcnt(0);
        unsigned nloc = st[0], nx = st[1];
        if (nloc == 0u) { xcd_barrier_complete(bar, bx_, nloc, nx); st[0] = nloc; st[1] = nx; }
        const unsigned old = xb_add(&bar[XB_XSUB(bx_)], 1u);
        const unsigned gen = old / nloc;
        if (old + 1u == (gen + 1u) * nloc) {
            __builtin_amdgcn_fence(__ATOMIC_RELEASE, "agent");
            asm volatile("s_waitcnt vmcnt(0)" ::: "memory");
            const unsigned og = xb_add(&bar[XB_TOP], 1u);
            const unsigned tg = og / nx;
            if (og + 1u == (tg + 1u) * nx) xb_add(&bar[XB_TOPGEN], 1u);
            else XB_SPIN(xb_ld(&bar[XB_TOPGEN]) == tg, bar);
            __builtin_amdgcn_fence(__ATOMIC_ACQUIRE, "agent");
            asm volatile("s_waitcnt vmcnt(0)" ::: "memory");
        } else {
            XB_SPIN(xb_ld(&bar[XB_TOPGEN]) == gen, bar);
            __builtin_amdgcn_fence(__ATOMIC_ACQUIRE, "agent");
            asm volatile("s_waitcnt vmcnt(0)" ::: "memory");
        }
    }
    __syncthreads();
}

struct SchedRect {
    pg8::StaticOrder so; int xonly, n_extra, G, c, full, rsplit;
    __device__ void init(int nMt, int N, int G_, int c_, int xonly_, int n_extra_) { so.init(nMt * 256, N, G_, c_); xonly = xonly_; n_extra = n_extra_; G = G_; c = c_;
        const int r = so.nwg % G; full = so.nwg - r; rsplit = (n_extra == 0 && r > 0 && 2 * r <= G) ? r : 0; }
    __device__ bool next(int i, pg8::Unit& u) const {
        const long L = (long)i * G + c;
        if (rsplit && L >= full) { const int j = (int)(L - full); if (j >= 2 * rsplit) return false;
            so.at(full + (j >> 1), u); u.hm = 1 + (j & 1); if (xonly) u.pm = (u.pm >> 3) * 9 + 1 + (u.pm & 7); return true; }
        if (L < so.nwg) { so.at(L, u); if (xonly) u.pm = (u.pm >> 3) * 9 + 1 + (u.pm & 7); return true; }
        const int j = (int)(L - so.nwg); if (j >= n_extra) return false;
        u.pm = (j >> 1) * 9; u.pn = 4 + (j & 1); u.hm = 0; return true;
    }
    __device__ __forceinline__ void a_ready(const pg8::Unit&) const {}
    __device__ __forceinline__ void done(const pg8::Unit&) const {}
};
struct SchedExp {
    const LAS unsigned char* tile_e; int NP, nunits, G, c;
    __device__ bool next(int i, pg8::Unit& u) const {
        long L = (long)i * G + c; int hm = 0;
        const int rr = nunits % G, full = nunits - rr;
        if (rr > 0 && 2 * rr <= G && L >= full) { const int j = (int)(L - full); if (j >= 2 * rr) return false; L = full + (j >> 1); hm = 1 + (j & 1); }
        if (L >= nunits) return false;
        const int q = nunits / 8, r = nunits % 8, xcd = (int)(L % 8), off = (int)(L / 8);
        const int Lr = (xcd < r ? xcd * (q + 1) : r * (q + 1) + (xcd - r) * q) + off;
        const int tm = Lr / NP, pl = Lr % NP;
        u.pm = tm; u.pn = (int)tile_e[tm] * NP + pl; u.hm = hm; return true;
    }
    __device__ __forceinline__ void a_ready(const pg8::Unit&) const {}
    __device__ __forceinline__ void done(const pg8::Unit&) const {}
};

struct EpiStoreBf16 {
    static constexpr bool PERM = true, AFTER_DRAIN = false;
    bf16_t* O; int ldc; int pn_mask; const f32x2* tab; const float* kg; LAS float* xch;
    __device__ __forceinline__ void operator()(const pg8::f32x4 (&acc)[2][2][4][2], const pg8::Unit& u, int wr, int wc, int fr_in, int fq_in) const {
        int fr = fr_in, fq = fq_in; asm volatile("" : "+v"(fr), "+v"(fq));
        const int row0 = u.pm * 256 + wr * 64 + fr;
        if (kg == nullptr && tab != nullptr && u.pn >= 4 && u.pn < 8) {
            const int tj = u.pm % 9; const bool lat = tj != 0; const int nbase = (tj - 1) * 256 + wr * 64 + fr;
            const int ax = fq >> 1, f0 = (fq & 1) * 8; const int col0 = u.pn * 256 + wc * 64 + ax * 32 + f0;
#pragma unroll
            for (int ai = 0; ai < 2; ++ai) { if (u.hm != 0 && u.hm != ai + 1) continue;
#pragma unroll
                for (int m = 0; m < 4; ++m) { bf16_t* rowp = O + (size_t)(row0 + ai * 128 + m * 16) * ldc + col0;
                    float x1[8], x2[8];
#pragma unroll
                    for (int n = 0; n < 2; ++n)
#pragma unroll
                        for (int q = 0; q < 4; ++q) { x1[n * 4 + q] = acc[ai][0][m][n][q]; x2[n * 4 + q] = acc[ai][1][m][n][q]; }
                    if (lat) { const int nr = nbase + ai * 128 + m * 16; const int pos = ax ? (nr & 63) : (nr >> 6);
                        const pg8::f32x4* tp = (const pg8::f32x4*)(tab + pos * 16 + f0);
#pragma unroll
                        for (int q = 0; q < 4; ++q) { const pg8::f32x4 cs = tp[q];
                            const float a0 = x1[2 * q], b0 = x2[2 * q], a1 = x1[2 * q + 1], b1 = x2[2 * q + 1];
                            x1[2 * q] = a0 * cs[0] - b0 * cs[1]; x2[2 * q] = b0 * cs[0] + a0 * cs[1];
                            x1[2 * q + 1] = a1 * cs[2] - b1 * cs[3]; x2[2 * q + 1] = b1 * cs[2] + a1 * cs[3]; } }
                    v4u w; w.x = cvtpk(x1[0], x1[1]); w.y = cvtpk(x1[2], x1[3]); w.z = cvtpk(x1[4], x1[5]); w.w = cvtpk(x1[6], x1[7]);
                    *(v4u*)rowp = w;
                    w.x = cvtpk(x2[0], x2[1]); w.y = cvtpk(x2[2], x2[3]); w.z = cvtpk(x2[4], x2[5]); w.w = cvtpk(x2[6], x2[7]);
                    *(v4u*)(rowp + 16) = w; } }
            return;
        }
        if (kg != nullptr && u.pn == 4) {
            const int tj = u.pm % 9; const bool lat = tj != 0; const int nbase = (tj - 1) * 256 + wr * 64 + fr;
            const int hl = wc >> 1, ax = wc & 1, f0 = 8 * fq; const int col0k = 1024 + hl * 128 + ax * 64 + f0; const int wid = wr * 4 + wc;
            float ssq[2][4];
#pragma unroll
            for (int ai = 0; ai < 2; ++ai)
#pragma unroll
                for (int m = 0; m < 4; ++m) { float s = 0.f;
#pragma unroll
                    for (int bj = 0; bj < 2; ++bj)
#pragma unroll
                        for (int n = 0; n < 2; ++n)
#pragma unroll
                            for (int q = 0; q < 4; ++q) s += acc[ai][bj][m][n][q] * acc[ai][bj][m][n][q];
                    s = xsum<16>(s); s = xsum<32>(s);
                    ssq[ai][m] = s; if (fq == 0) xch[wid * 128 + ai * 64 + m * 16 + fr] = s; }
            asm volatile("s_waitcnt lgkmcnt(0)" ::: "memory"); __builtin_amdgcn_s_barrier(); asm volatile("" ::: "memory");
            const float g00 = 0.f; (void)g00;
            pg8::f32x4 gA[2][2];
#pragma unroll
            for (int bj = 0; bj < 2; ++bj)
#pragma unroll
                for (int n = 0; n < 2; ++n) gA[bj][n] = *(const pg8::f32x4*)(kg + ax * 64 + bj * 32 + f0 + 4 * n);
#pragma unroll
            for (int ai = 0; ai < 2; ++ai) { if (u.hm != 0 && u.hm != ai + 1) continue;
#pragma unroll
                for (int m = 0; m < 4; ++m) { bf16_t* rowp = O + (size_t)(row0 + ai * 128 + m * 16) * ldc + col0k;
                    const float tot = ssq[ai][m] + xch[(wid ^ 1) * 128 + ai * 64 + m * 16 + fr];
                    const float rs = 1.0f / sqrtf(tot * (1.f / 128.f) + RMS_EPS);
                    float x1[8], x2[8];
#pragma unroll
                    for (int n = 0; n < 2; ++n)
#pragma unroll
                        for (int q = 0; q < 4; ++q) { x1[n * 4 + q] = acc[ai][0][m][n][q] * rs * gA[0][n][q]; x2[n * 4 + q] = acc[ai][1][m][n][q] * rs * gA[1][n][q]; }
                    if (lat) { const int nr = nbase + ai * 128 + m * 16; const int pos = ax ? (nr & 63) : (nr >> 6);
                        const pg8::f32x4* tp = (const pg8::f32x4*)(tab + pos * 32 + f0);
#pragma unroll
                        for (int q = 0; q < 4; ++q) { const pg8::f32x4 cs = tp[q];
                            const float a0 = x1[2 * q], b0 = x2[2 * q], a1 = x1[2 * q + 1], b1 = x2[2 * q + 1];
                            x1[2 * q] = a0 * cs[0] - b0 * cs[1]; x2[2 * q] = b0 * cs[0] + a0 * cs[1];
                            x1[2 * q + 1] = a1 * cs[2] - b1 * cs[3]; x2[2 * q + 1] = b1 * cs[2] + a1 * cs[3]; } }
                    v4u w; w.x = cvtpk(x1[0], x1[1]); w.y = cvtpk(x1[2], x1[3]); w.z = cvtpk(x1[4], x1[5]); w.w = cvtpk(x1[6], x1[7]);
                    *(v4u*)rowp = w;
                    w.x = cvtpk(x2[0], x2[1]); w.y = cvtpk(x2[2], x2[3]); w.z = cvtpk(x2[4], x2[5]); w.w = cvtpk(x2[6], x2[7]);
                    *(v4u*)(rowp + 32) = w; } }
            asm volatile("s_waitcnt lgkmcnt(0)" ::: "memory"); __builtin_amdgcn_s_barrier(); asm volatile("" ::: "memory");
            return;
        }
        const int col0 = (u.pn & pn_mask) * 256 + wc * 32 + 8 * fq;
#pragma unroll
        for (int ai = 0; ai < 2; ++ai) { if (u.hm != 0 && u.hm != ai + 1) continue;
#pragma unroll
            for (int m = 0; m < 4; ++m) { bf16_t* rowp = O + (size_t)(row0 + ai * 128 + m * 16) * ldc + col0;
#pragma unroll
                for (int bj = 0; bj < 2; ++bj) { const pg8::f32x4 v0 = acc[ai][bj][m][0], v1 = acc[ai][bj][m][1];
                    v4u w; w.x = cvtpk(v0[0], v0[1]); w.y = cvtpk(v0[2], v0[3]); w.z = cvtpk(v1[0], v1[1]); w.w = cvtpk(v1[2], v1[3]);
                    *(v4u*)(rowp + bj * 128) = w; } } }
    }
};
typedef _Float16 hf_t;
typedef _Float16 hf2_t __attribute__((ext_vector_type(2)));
__device__ __forceinline__ unsigned pkh(float a, float b_) { const hf2_t v = {(hf_t)a, (hf_t)b_}; return __builtin_bit_cast(unsigned, v); }
__device__ __forceinline__ float hf_lo(unsigned u) { const hf2_t v = __builtin_bit_cast(hf2_t, u); return (float)v[0]; }
__device__ __forceinline__ float hf_hi(unsigned u) { const hf2_t v = __builtin_bit_cast(hf2_t, u); return (float)v[1]; }
template <int RH>
struct EpiResid {
    static constexpr bool PERM = true, AFTER_DRAIN = false;
    hf_t* Y; const float* xbase; const float* cbase; const float* modl; f32x2* stats;
    __device__ __forceinline__ void operator()(const pg8::f32x4 (&acc)[2][2][4][2], const pg8::Unit& u, int wr, int wc, int fr_in, int fq_in) const {
        int fr = fr_in, fq = fq_in; asm volatile("" : "+v"(fr), "+v"(fq));
        const int b = u.pm / 9, j = u.pm - b * 9;
        const size_t roff0 = (j == 0) ? (size_t)b * LCT * DM : ((size_t)b * NXT + (size_t)(j - 1) * 256) * DM;
        const float* rb = ((j == 0) ? cbase : xbase) + roff0; const hf_t* rbh = (const hf_t*)xbase + (RH == 2 ? (size_t)u.pm * 256 * DM : roff0);
        const float* g = modl + (size_t)(j == 0 ? 8 : b) * NMOD + 2048;
        const int col0 = u.pn * 256 + wc * 32 + 8 * fq;
        pg8::f32x4 gv[2][2];
#pragma unroll
        for (int bj = 0; bj < 2; ++bj)
#pragma unroll
            for (int n = 0; n < 2; ++n) gv[bj][n] = *(const pg8::f32x4*)(g + col0 + bj * 128 + n * 4);
#pragma unroll
        for (int ai = 0; ai < 2; ++ai) { if (u.hm != 0 && u.hm != ai + 1) continue;
            v4u rvh4[4][2];
            if constexpr (RH != 0) {
#pragma unroll
                for (int m4 = 0; m4 < 4; ++m4)
#pragma unroll
                    for (int bj = 0; bj < 2; ++bj) rvh4[m4][bj] = *(const v4u*)(rbh + (size_t)(ai * 128 + wr * 64 + m4 * 16 + fr) * DM + col0 + bj * 128); }
#pragma unroll
            for (int mh = 0; mh < 2; ++mh) {
            pg8::f32x4 rva[2][2][2];
            if constexpr (RH == 0) {
#pragma unroll
            for (int mm = 0; mm < 2; ++mm) { const size_t ro = (size_t)(ai * 128 + wr * 64 + (2 * mh + mm) * 16 + fr) * DM + col0;
#pragma unroll
                for (int bj = 0; bj < 2; ++bj)
#pragma unroll
                    for (int n = 0; n < 2; ++n) rva[mm][bj][n] = *(const pg8::f32x4*)(rb + ro + bj * 128 + n * 4); } }
#pragma unroll
            for (int mm = 0; mm < 2; ++mm) { const int m = 2 * mh + mm; const int lr = ai * 128 + wr * 64 + m * 16 + fr;
                hf_t* yrow = Y + ((size_t)u.pm * 256 + lr) * DM + col0;
                float s = 0.f, q = 0.f;
#pragma unroll
                for (int bj = 0; bj < 2; ++bj) {
                    if constexpr (RH != 0) { const v4u h = rvh4[m][bj]; rva[mm][bj][0] = (pg8::f32x4){hf_lo(h.x), hf_hi(h.x), hf_lo(h.y), hf_hi(h.y)}; rva[mm][bj][1] = (pg8::f32x4){hf_lo(h.z), hf_hi(h.z), hf_lo(h.w), hf_hi(h.w)}; }
                    const pg8::f32x4 o0 = rva[mm][bj][0] * ALPHA + gv[bj][0] * acc[ai][bj][m][0], o1 = rva[mm][bj][1] * ALPHA + gv[bj][1] * acc[ai][bj][m][1];
                    s += ((o0[0] + o0[1]) + (o0[2] + o0[3])) + ((o1[0] + o1[1]) + (o1[2] + o1[3]));
                    q += ((o0[0] * o0[0] + o0[1] * o0[1]) + (o0[2] * o0[2] + o0[3] * o0[3])) + ((o1[0] * o1[0] + o1[1] * o1[1]) + (o1[2] * o1[2] + o1[3] * o1[3]));
                    v4u w; w.x = pkh(o0[0], o0[1]); w.y = pkh(o0[2], o0[3]); w.z = pkh(o1[0], o1[1]); w.w = pkh(o1[2], o1[3]);
                    *(v4u*)(yrow + bj * 128) = w; }
                s = xsum<16>(s); q = xsum<16>(q); s = xsum<32>(s); q = xsum<32>(q);
                if (fq == 0) stats[((size_t)u.pm * 256 + lr) * 16 + u.pn * 4 + wc] = (f32x2){s, q}; } } }
    }
};
struct EpiGateUp {
    static constexpr bool PERM = true, AFTER_DRAIN = false;
    bf16_t* ACT; const float* gwof; const LAS int* tbase;
    __device__ __forceinline__ void operator()(const pg8::f32x4 (&acc)[2][2][4][2], const pg8::Unit& u, int wr, int wc, int fr_in, int fq_in) const {
        int fr = fr_in, fq = fq_in; asm volatile("" : "+v"(fr), "+v"(fq));
        const int e = u.pn >> 1; const float* gwe = gwof + (size_t)e * ECAP + (u.pm - tbase[e]) * 256;
        const int lr0 = wr * 64 + fr; const int f0 = (u.pn & 1) * 128 + wc * 32 + 8 * fq;
#pragma unroll
        for (int ai = 0; ai < 2; ++ai) { if (u.hm != 0 && u.hm != ai + 1) continue;
#pragma unroll
            for (int m = 0; m < 4; ++m) { const int lr = lr0 + ai * 128 + m * 16; const float gw = gwe[lr];
                float o[8];
#pragma unroll
                for (int n = 0; n < 2; ++n)
#pragma unroll
                    for (int q = 0; q < 4; ++q) { const float a = acc[ai][0][m][n][q], up = acc[ai][1][m][n][q];
                        o[n * 4 + q] = a * __builtin_amdgcn_rcpf(1.f + __expf(-a)) * up * gw; }
                v4u w; w.x = cvtpk(o[0], o[1]); w.y = cvtpk(o[2], o[3]); w.z = cvtpk(o[4], o[5]); w.w = cvtpk(o[6], o[7]);
                *(v4u*)(ACT + ((size_t)u.pm * 256 + lr) * FH + f0) = w; } }
    }
};

namespace att {
constexpr int KVBLK = 64;
constexpr int SHM_V = KVBLK * 128 * 2, SHM_K = KVBLK * 128 * 2;
constexpr int OFF_WS = 2 * SHM_V + 2 * SHM_K;
constexpr int OFF_XCH = OFF_WS + 8 * 256;
constexpr int LDS_NEED = OFF_XCH + 4 * 16384;
static_assert(LDS_NEED <= MISC_OFF, "attention LDS");
constexpr float THR = 8.f;
#define KSWZ(row, colB) ((row) * 256 + ((colB) ^ (((row) & 7) << 4)))
#define SBAR() __builtin_amdgcn_sched_barrier(0)
__device__ __forceinline__ int crow(int r, int hi) { return (r & 3) + 8 * (r >> 2) + 4 * hi; }

template <bool DIFF> struct Cst { static constexpr float SCALE = DIFF ? 0.125f : 0.088388347648318440f; static constexpr float C = SCALE * 1.4426950408889634f; };

template <bool DIFF>
__device__ __forceinline__ void partialSM(f32x16& p0, f32x16& p1, float& m_reg, float& mn, float& alpha) {
  constexpr float C = Cst<DIFF>::C, SCALE = Cst<DIFF>::SCALE;
  float pmax = p0[0];
#pragma unroll
  for (int r = 1; r < 16; ++r) pmax = fmaxf(pmax, p0[r]);
#pragma unroll
  for (int r = 0; r < 16; ++r) pmax = fmaxf(pmax, p1[r]);
  { auto rr = __builtin_amdgcn_permlane32_swap(__float_as_uint(pmax), __float_as_uint(pmax), false, false);
    pmax = fmaxf(__uint_as_float(rr[0]), __uint_as_float(rr[1])); }
  if (__builtin_expect(__all(pmax - m_reg <= THR / SCALE), 1)) { mn = m_reg; alpha = 1.f; }
  else { mn = fmaxf(m_reg, pmax); alpha = __builtin_amdgcn_exp2f((m_reg - mn) * C); m_reg = mn; }
  float mnC = -mn * C;
#pragma unroll
  for (int r = 0; r < 16; ++r) p0[r] = fmaf(p0[r], C, mnC);
#pragma unroll
  for (int r = 0; r < 16; ++r) p1[r] = fmaf(p1[r], C, mnC);
#pragma unroll
  for (int r = 0; r < 16; ++r) p0[r] = __builtin_amdgcn_exp2f(p0[r]);
}
__device__ __forceinline__ void finishSM(f32x16& p0, f32x16& p1, float alpha, float& l_reg, bf16x8& pa0, bf16x8& pa1, bf16x8& pa2, bf16x8& pa3) {
#pragma unroll
  for (int r = 0; r < 16; ++r) p1[r] = __builtin_amdgcn_exp2f(p1[r]);
  float ps = 0;
#pragma unroll
  for (int r = 0; r < 16; ++r) ps += p0[r];
#pragma unroll
  for (int r = 0; r < 16; ++r) ps += p1[r];
  { auto rr = __builtin_amdgcn_permlane32_swap(__float_as_uint(ps), __float_as_uint(ps), false, false);
    ps = __uint_as_float(rr[0]) + __uint_as_float(rr[1]); }
  l_reg = l_reg * alpha + ps;
#define PK4(P, BASE, OUT) do { unsigned a0 = cvtpk(P[BASE + 0], P[BASE + 1]), a1 = cvtpk(P[BASE + 2], P[BASE + 3]);   \
    unsigned b0 = cvtpk(P[BASE + 4], P[BASE + 5]), b1 = cvtpk(P[BASE + 6], P[BASE + 7]);                              \
    auto r0 = __builtin_amdgcn_permlane32_swap(a0, b0, false, false); auto r1 = __builtin_amdgcn_permlane32_swap(a1, b1, false, false); \
    v4u w = {r0[0], r1[0], r0[1], r1[1]}; OUT = *reinterpret_cast<bf16x8*>(&w); } while (0)
  PK4(p0, 0, pa0); PK4(p0, 8, pa1); PK4(p1, 0, pa2); PK4(p1, 8, pa3);
#undef PK4
}
template <int NQ>
__device__ __forceinline__ void qkt(f32x16& p0, f32x16& p1, const char* Ks, const bf16x8* qr, int r32, int hi, int d0base) {
  p0 = f32x16{}; p1 = f32x16{};
#pragma unroll
  for (int d0 = 0; d0 < NQ; ++d0) { const int cb = ((d0base + d0) * 16 + hi * 8) * 2;
    bf16x8 b0 = *reinterpret_cast<const bf16x8*>(Ks + KSWZ(r32, cb));
    bf16x8 b1 = *reinterpret_cast<const bf16x8*>(Ks + KSWZ(32 + r32, cb));
    p0 = __builtin_amdgcn_mfma_f32_32x32x16_bf16(b0, qr[d0], p0, 0, 0, 0);
    p1 = __builtin_amdgcn_mfma_f32_32x32x16_bf16(b1, qr[d0], p1, 0, 0, 0); }
}
__device__ __forceinline__ int v_st(int k, int c) { const int kk = (k & ~0xC) | ((k & 4) << 1) | ((k & 8) >> 1); return ((kk >> 3) * 4 + (c >> 5)) * 512 + ((kk & 7) * 32 + (c & 31)) * 2; }
__device__ __forceinline__ int v_rd_base(int lane) { return ((lane & 3) << 3) | (((lane >> 2) & 3) << 6) | (((lane >> 4) & 1) << 5) | (((lane >> 5) & 1) << 8); }
constexpr int v_rd_off(int d0, int ks, int half) { return d0 * 512 + ks * 4096 + half * 2048; }
template <int OFF> __device__ __forceinline__ s16x4 tr_read(int vb) {
  s16x4 r; asm volatile("ds_read_b64_tr_b16 %0, %1 offset:%2" : "=&v"(r) : "v"(vb), "i"(OFF) : "memory"); return r;
}
template <int D0> __device__ __forceinline__ void pv_one(f32x16& od, int vb, bf16x8 pa0, bf16x8 pa1, bf16x8 pa2, bf16x8 pa3) {
  const s16x4 l0 = tr_read<v_rd_off(D0, 0, 0)>(vb), h0 = tr_read<v_rd_off(D0, 0, 1)>(vb), l1 = tr_read<v_rd_off(D0, 1, 0)>(vb), h1 = tr_read<v_rd_off(D0, 1, 1)>(vb);
  const s16x4 l2 = tr_read<v_rd_off(D0, 2, 0)>(vb), h2 = tr_read<v_rd_off(D0, 2, 1)>(vb), l3 = tr_read<v_rd_off(D0, 3, 0)>(vb), h3 = tr_read<v_rd_off(D0, 3, 1)>(vb);
  asm volatile("s_waitcnt lgkmcnt(0)" ::: "memory"); SBAR();
#define PK(L, H) (bf16x8){L[0], L[1], L[2], L[3], H[0], H[1], H[2], H[3]}
  od = __builtin_amdgcn_mfma_f32_32x32x16_bf16(pa0, PK(l0, h0), od, 0, 0, 0);
  od = __builtin_amdgcn_mfma_f32_32x32x16_bf16(pa1, PK(l1, h1), od, 0, 0, 0);
  od = __builtin_amdgcn_mfma_f32_32x32x16_bf16(pa2, PK(l2, h2), od, 0, 0, 0);
  od = __builtin_amdgcn_mfma_f32_32x32x16_bf16(pa3, PK(l3, h3), od, 0, 0, 0);
#undef PK
}
__device__ __forceinline__ void pv_d0(f32x16* o, int vb, bf16x8 pa0, bf16x8 pa1, bf16x8 pa2, bf16x8 pa3) {
  pv_one<0>(o[0], vb, pa0, pa1, pa2, pa3); pv_one<1>(o[1], vb, pa0, pa1, pa2, pa3); pv_one<2>(o[2], vb, pa0, pa1, pa2, pa3); pv_one<3>(o[3], vb, pa0, pa1, pa2, pa3);
}

constexpr float THRL = THR * 1.4426950408889634f;
__device__ __forceinline__ void qkt_negm(f32x16& p0, f32x16& p1, const char* Ks, const bf16x8* qr, const f32x16& negm, int r32, int hi, int d0base) {
#pragma unroll
  for (int d0 = 0; d0 < 4; ++d0) { const int cb = ((d0base + d0) * 16 + hi * 8) * 2;
    bf16x8 b0 = *reinterpret_cast<const bf16x8*>(Ks + KSWZ(r32, cb));
    bf16x8 b1 = *reinterpret_cast<const bf16x8*>(Ks + KSWZ(32 + r32, cb));
    if (d0 == 0) { p0 = __builtin_amdgcn_mfma_f32_32x32x16_bf16(b0, qr[0], negm, 0, 0, 0); p1 = __builtin_amdgcn_mfma_f32_32x32x16_bf16(b1, qr[0], negm, 0, 0, 0); }
    else { p0 = __builtin_amdgcn_mfma_f32_32x32x16_bf16(b0, qr[d0], p0, 0, 0, 0); p1 = __builtin_amdgcn_mfma_f32_32x32x16_bf16(b1, qr[d0], p1, 0, 0, 0); } }
}
__device__ __forceinline__ void splat16(f32x16& v, float x) {
#pragma unroll
  for (int r = 0; r < 16; ++r) v[r] = x;
}
__device__ __forceinline__ void partial_first_negm(f32x16& p0, f32x16& p1, float& m_reg, f32x16& negm) {
  float pmax = p0[0];
#pragma unroll
  for (int r = 1; r < 16; ++r) pmax = fmaxf(pmax, p0[r]);
#pragma unroll
  for (int r = 0; r < 16; ++r) pmax = fmaxf(pmax, p1[r]);
  { auto rr = __builtin_amdgcn_permlane32_swap(__float_as_uint(pmax), __float_as_uint(pmax), false, false);
    pmax = fmaxf(__uint_as_float(rr[0]), __uint_as_float(rr[1])); }
  m_reg = pmax; splat16(negm, -pmax);
#pragma unroll
  for (int r = 0; r < 16; ++r) { p0[r] -= pmax; p1[r] -= pmax; }
#pragma unroll
  for (int r = 0; r < 16; ++r) p0[r] = __builtin_amdgcn_exp2f(p0[r]);
}
__device__ __forceinline__ void pv_partial_negm(f32x16* o, int vb, bf16x8 pa0, bf16x8 pa1, bf16x8 pa2, bf16x8 pa3, f32x16& p0, f32x16& p1, float& m_reg, f32x16& negm, float& alpha) {
  pv_one<0>(o[0], vb, pa0, pa1, pa2, pa3);
  float pmax = p0[0];
#pragma unroll
  for (int r = 1; r < 16; ++r) pmax = fmaxf(pmax, p0[r]);
  pv_one<1>(o[1], vb, pa0, pa1, pa2, pa3);
#pragma unroll
  for (int r = 0; r < 16; ++r) pmax = fmaxf(pmax, p1[r]);
  { auto rr = __builtin_amdgcn_permlane32_swap(__float_as_uint(pmax), __float_as_uint(pmax), false, false);
    pmax = fmaxf(__uint_as_float(rr[0]), __uint_as_float(rr[1])); }
  if (__builtin_expect(__all(pmax <= THRL), 1)) { alpha = 1.f; }
  else { const float d = fmaxf(pmax, 0.f); alpha = __builtin_amdgcn_exp2f(-d); m_reg += d; splat16(negm, -m_reg);
#pragma unroll
    for (int r = 0; r < 16; ++r) { p0[r] -= d; p1[r] -= d; } }
  pv_one<2>(o[2], vb, pa0, pa1, pa2, pa3);
  pv_one<3>(o[3], vb, pa0, pa1, pa2, pa3);
#pragma unroll
  for (int r = 0; r < 16; ++r) p0[r] = __builtin_amdgcn_exp2f(p0[r]);
  asm volatile("" : "+v"(p0), "+v"(p1));
  SBAR();
}

template <bool DIFF>
__device__ __forceinline__ void pv_partial(f32x16* o, int vb, bf16x8 pa0, bf16x8 pa1, bf16x8 pa2, bf16x8 pa3, f32x16& p0, f32x16& p1, float& m_reg, float& mn, float& alpha) {
  constexpr float C = Cst<DIFF>::C, SCALE = Cst<DIFF>::SCALE;
  pv_one<0>(o[0], vb, pa0, pa1, pa2, pa3);
  float pmax = p0[0];
#pragma unroll
  for (int r = 1; r < 16; ++r) pmax = fmaxf(pmax, p0[r]);
  pv_one<1>(o[1], vb, pa0, pa1, pa2, pa3);
#pragma unroll
  for (int r = 0; r < 16; ++r) pmax = fmaxf(pmax, p1[r]);
  { auto rr = __builtin_amdgcn_permlane32_swap(__float_as_uint(pmax), __float_as_uint(pmax), false, false);
    pmax = fmaxf(__uint_as_float(rr[0]), __uint_as_float(rr[1])); }
  if (__builtin_expect(__all(pmax - m_reg <= THR / SCALE), 1)) { mn = m_reg; alpha = 1.f; }
  else { mn = fmaxf(m_reg, pmax); alpha = __builtin_amdgcn_exp2f((m_reg - mn) * C); m_reg = mn; }
  pv_one<2>(o[2], vb, pa0, pa1, pa2, pa3);
  const float mnC = -mn * C;
#pragma unroll
  for (int r = 0; r < 16; ++r) p0[r] = fmaf(p0[r], C, mnC);
#pragma unroll
  for (int r = 0; r < 16; ++r) p1[r] = fmaf(p1[r], C, mnC);
  pv_one<3>(o[3], vb, pa0, pa1, pa2, pa3);
#pragma unroll
  for (int r = 0; r < 16; ++r) p0[r] = __builtin_amdgcn_exp2f(p0[r]);
  asm volatile("" : "+v"(p0), "+v"(p1));
  SBAR();
}

template <bool DIFF>
__device__ __forceinline__ void attn_unit(const bf16_t* __restrict__ Qb, int ldq, const bf16_t* __restrict__ Kh, const bf16_t* __restrict__ Vh, int ldk, int seq,
                                          bf16_t* __restrict__ Ob, int ldo, bool rope, int n0, const f32x2* __restrict__ tab,
                                          const float* __restrict__ qg  , const float* __restrict__ subg  , float lam, char* lds, const int wv) {
  constexpr int NQ = DIFF ? 4 : 8;
  const int tid = ltid(wv), wid = wv, lane = tid & 63, r32 = lane & 31, hi = lane >> 5;
  const int qblk = DIFF ? (wid & 3) : wid, map = DIFF ? (wid >> 2) : 0;
  char* V_lds = lds; char* K_lds = lds + 2 * SHM_V;
  float* wsf = (float*)(lds + OFF_WS) + wid * 64; float* li_l = wsf; float* al_l = wsf + 32;
  float m_reg = -1e30f, l_reg = 0; f32x16 o[4] = {}; bf16x8 qr[NQ];
  const int sr = tid >> 4, sc = (tid & 15) * 8, vst0 = v_st(sr, sc), vst1 = v_st(32 + sr, sc);
  const int vb0 = (int)(uintptr_t)V_lds + v_rd_base(lane);
  struct { bf16x8 vs0, vs1, ks0, ks1; } sr_[2] = {};
#define LD8(p) (*reinterpret_cast<const bf16x8*>(p))
#define SLOAD(i, k0) do { sr_[i].vs0 = LD8(&Vh[(size_t)((k0) + sr) * ldk + sc]); sr_[i].vs1 = LD8(&Vh[(size_t)((k0) + 32 + sr) * ldk + sc]); \
    sr_[i].ks0 = LD8(&Kh[(size_t)((k0) + sr) * ldk + sc]); sr_[i].ks1 = LD8(&Kh[(size_t)((k0) + 32 + sr) * ldk + sc]); } while (0)
#define SWRITE(b, i) do { *(bf16x8*)(V_lds + (b) * SHM_V + vst0) = sr_[i].vs0;          \
    *(bf16x8*)(V_lds + (b) * SHM_V + vst1) = sr_[i].vs1; int kc = sc * 2;               \
    *(bf16x8*)(K_lds + (b) * SHM_K + KSWZ(sr, kc)) = sr_[i].ks0;                       \
    *(bf16x8*)(K_lds + (b) * SHM_K + KSWZ(32 + sr, kc)) = sr_[i].ks1; } while (0)
  constexpr int SE = 0, SO = 1;
  SLOAD(SE, 0); SLOAD(SO, KVBLK);
  {
    const bf16_t* Qw = Qb + (size_t)(qblk * 32 + r32) * ldq + map * 64 + hi * 8;
    const int n = n0 + qblk * 32 + r32;
    float qf[NQ][8];
#pragma unroll
    for (int d0 = 0; d0 < NQ; ++d0) { const v4u w = *reinterpret_cast<const v4u*>(Qw + d0 * 16);
      qf[d0][0] = bf_lo(w.x); qf[d0][1] = bf_hi(w.x); qf[d0][2] = bf_lo(w.y); qf[d0][3] = bf_hi(w.y);
      qf[d0][4] = bf_lo(w.z); qf[d0][5] = bf_hi(w.z); qf[d0][6] = bf_lo(w.w); qf[d0][7] = bf_hi(w.w); }
    if constexpr (!DIFF) {
      float ss = 0.f;
#pragma unroll
      for (int d0 = 0; d0 < NQ; ++d0)
#pragma unroll
        for (int j = 0; j < 8; ++j) ss += qf[d0][j] * qf[d0][j];
      ss = xsum<32>(ss);
      const float rs = 1.0f / sqrtf(ss * (1.f / 128.f) + RMS_EPS);
#pragma unroll
      for (int d0 = 0; d0 < NQ; ++d0) { const f32x4 g0 = *(const f32x4*)(qg + d0 * 16 + hi * 8), g1 = *(const f32x4*)(qg + d0 * 16 + hi * 8 + 4);
#pragma unroll
        for (int j = 0; j < 4; ++j) { qf[d0][j] *= rs * g0[j]; qf[d0][4 + j] *= rs * g1[j]; } }
    }
    if (rope) {
      constexpr int NF = DIFF ? 16 : 32;
      constexpr int HB = DIFF ? 1 : 2;
#pragma unroll
      for (int ax = 0; ax < 2; ++ax) { const int pos = ax ? (n & 63) : (n >> 6);
#pragma unroll
        for (int hb = 0; hb < HB; ++hb) { const int dA = ax * 2 * HB + hb, dB = dA + HB;
          const f32x2* tp = tab + pos * NF + hb * 16 + hi * 8;
#pragma unroll
          for (int j = 0; j < 8; ++j) { const f32x2 cs = tp[j]; const float x1 = qf[dA][j], x2 = qf[dB][j];
            qf[dA][j] = x1 * cs.x - x2 * cs.y; qf[dB][j] = x2 * cs.x + x1 * cs.y; } } }
    }
    if constexpr (DIFF) {
#pragma unroll
      for (int d0 = 0; d0 < NQ; ++d0)
#pragma unroll
        for (int j = 0; j < 8; ++j) qf[d0][j] *= Cst<true>::C; }
#pragma unroll
    for (int d0 = 0; d0 < NQ; ++d0) { v4u w = {cvtpk(qf[d0][0], qf[d0][1]), cvtpk(qf[d0][2], qf[d0][3]), cvtpk(qf[d0][4], qf[d0][5]), cvtpk(qf[d0][6], qf[d0][7])};
      qr[d0] = *reinterpret_cast<bf16x8*>(&w); }
  }
#define SWAIT() asm volatile("s_waitcnt vmcnt(4)" ::: "memory")
#define RESC(a) do { if (__any((a) < 1.f)) { if (hi == 0) al_l[r32] = (a); asm volatile("s_waitcnt lgkmcnt(0)" ::: "memory"); \
    _Pragma("unroll") for (int d = 0; d < 4; ++d) _Pragma("unroll") for (int r = 0; r < 16; ++r) o[d][r] *= al_l[crow(r, hi)]; } } while (0)
  f32x16 pA0, pA1, pB0, pB1; float mnA, mnB, alA, alB; bf16x8 pa0, pa1, pa2, pa3; const int NT = seq / KVBLK;
  const int dbase = map * 4;
  f32x16 negm = {};
  if constexpr (DIFF) m_reg = 0.f;
#define QKT(P0, P1, KS) do { if constexpr (DIFF) qkt_negm(P0, P1, KS, qr, negm, r32, hi, dbase); else qkt<NQ>(P0, P1, KS, qr, r32, hi, dbase); } while (0)
#define PVP(VB, P0, P1, MN, AL) do { if constexpr (DIFF) pv_partial_negm(o, VB, pa0, pa1, pa2, pa3, P0, P1, m_reg, negm, AL); else pv_partial<DIFF>(o, VB, pa0, pa1, pa2, pa3, P0, P1, m_reg, MN, AL); } while (0)
  SWAIT(); SWRITE(0, SE); __syncthreads();
  QKT(pA0, pA1, K_lds); if constexpr (DIFF) { partial_first_negm(pA0, pA1, m_reg, negm); alA = 1.f; } else partialSM<DIFF>(pA0, pA1, m_reg, mnA, alA);
  if (2 < NT) SLOAD(SE, 2 * KVBLK);
  SWAIT(); SWRITE(1, SO); __syncthreads();
  for (int j = 1; j + 1 < NT; j += 2) {
    SBAR(); QKT(pB0, pB1, K_lds + SHM_K);
    finishSM(pA0, pA1, alA, l_reg, pa0, pa1, pa2, pa3); SBAR();
    SLOAD(SO, (j + 2) * KVBLK); SBAR();
    PVP(vb0, pB0, pB1, mnB, alB);
    __syncthreads(); SWAIT(); SWRITE(0, SE);
    RESC(alB); __syncthreads();
    SBAR(); QKT(pA0, pA1, K_lds);
    finishSM(pB0, pB1, alB, l_reg, pa0, pa1, pa2, pa3); SBAR();
    if (j + 3 < NT) SLOAD(SE, (j + 3) * KVBLK); SBAR();
    PVP(vb0 + (int)SHM_V, pA0, pA1, mnA, alA);
    __syncthreads(); SWAIT(); SWRITE(1, SO);
    RESC(alA); __syncthreads();
  }
  SBAR(); QKT(pB0, pB1, K_lds + SHM_K);
  finishSM(pA0, pA1, alA, l_reg, pa0, pa1, pa2, pa3); SBAR();
  PVP(vb0, pB0, pB1, mnB, alB);
  __syncthreads(); RESC(alB);
  finishSM(pB0, pB1, alB, l_reg, pa0, pa1, pa2, pa3); SBAR();
  pv_d0(o, vb0 + (int)SHM_V, pa0, pa1, pa2, pa3);
  if (hi == 0) li_l[r32] = l_reg; asm volatile("s_waitcnt lgkmcnt(0)" ::: "memory");
#pragma unroll
  for (int r = 0; r < 16; ++r) { const float rl = __builtin_amdgcn_rcpf(li_l[crow(r, hi)]);
#pragma unroll
    for (int d0 = 0; d0 < 4; ++d0) o[d0][r] *= rl; }
  if constexpr (!DIFF) {
    bf16_t* ost = (bf16_t*)(lds + OFF_XCH) + wid * (32 * 136);
#pragma unroll
    for (int r = 0; r < 16; ++r) { const int orow = crow(r, hi);
#pragma unroll
      for (int d0 = 0; d0 < 4; ++d0) ost[orow * 136 + d0 * 32 + r32] = (bf16_t)(cvtpk(o[d0][r], 0.f) & 0xffffu); }
    asm volatile("s_waitcnt lgkmcnt(0)" ::: "memory");
    bf16_t* Ow = Ob + (size_t)(wid * 32) * ldo;
#pragma unroll
    for (int i = 0; i < 8; ++i) { const int c = i * 64 + lane, orow = c >> 4, ch = c & 15;
      *(v4u*)(Ow + (size_t)orow * ldo + ch * 8) = *(const v4u*)(ost + orow * 136 + ch * 8); }
  } else {
    float* xch = (float*)(lds + OFF_XCH) + qblk * 4096;
    if (map == 1) {
#pragma unroll
      for (int d0 = 0; d0 < 4; ++d0)
#pragma unroll
        for (int r = 0; r < 16; ++r) xch[(d0 * 16 + r) * 64 + lane] = o[d0][r];
    }
    __syncthreads();
    if (map == 0) {
      float ssr[16];
#pragma unroll
      for (int r = 0; r < 16; ++r) { float s = 0.f;
#pragma unroll
        for (int d0 = 0; d0 < 4; ++d0) { const float d = o[d0][r] - lam * xch[(d0 * 16 + r) * 64 + lane]; o[d0][r] = d; s += d * d; }
        ssr[r] = s; }
#pragma unroll
      for (int r = 0; r < 16; ++r) { float s = ssr[r];
        s = sum32(s);
        ssr[r] = (1.0f / sqrtf(s * (1.f / 128.f) + RMS_EPS)) * (1.f - LAMBDA_INIT0); }
      asm volatile("s_waitcnt lgkmcnt(0)" ::: "memory");
      bf16_t* ost = (bf16_t*)xch;
#pragma unroll
      for (int d0 = 0; d0 < 4; ++d0) { const float g = subg[d0 * 32 + r32];
#pragma unroll
        for (int r = 0; r < 16; ++r) ost[crow(r, hi) * 136 + d0 * 32 + r32] = (bf16_t)(cvtpk(o[d0][r] * ssr[r] * g, 0.f) & 0xffffu); }
      asm volatile("s_waitcnt lgkmcnt(0)" ::: "memory");
      bf16_t* Ow = Ob + (size_t)(qblk * 32) * ldo;
#pragma unroll
      for (int i = 0; i < 8; ++i) { const int c = i * 64 + lane, orow = c >> 4, ch = c & 15;
        *(v4u*)(Ow + (size_t)orow * ldo + ch * 8) = *(const v4u*)(ost + orow * 136 + ch * 8); }
    }
  }
#undef QKT
#undef PVP
#undef LD8
#undef SLOAD
#undef SWRITE
#undef SWAIT
#undef RESC
}
#undef KSWZ
#undef SBAR
}

#ifndef REPMASK
#define REPMASK 0
#endif
#ifndef REPN
#define REPN 1
#endif
#ifndef PHMASK
#define PHMASK 0x3ffff
#endif
struct Args { const float* in[28]; float* o_; unsigned char* w_; };
enum { I_X = 0, I_C, I_CTX, I_CCTX, I_WMOD, I_BMOD, I_LNMG, I_LNMB, I_LNFG, I_LNFB, I_DWQKV, I_DWO, I_LQ1, I_LK1, I_LQ2, I_LK2, I_SUBG,
       I_GWQKV, I_GWO, I_GQN, I_GKN, I_WGRP, I_BGRP, I_WRT, I_BRT, I_WGATE, I_WUP, I_WDOWN };

constexpr int PTR_OFF = MISC_OFF + 1024;
__device__ __forceinline__ const float* ldptr(LAS unsigned char* ldsl, int i) {
    int off = PTR_OFF + 8 * i; asm volatile("" : "+v"(off));
    const LAS unsigned* p = (const LAS unsigned*)(ldsl + off);
    const unsigned lo = __builtin_amdgcn_readfirstlane(p[0]), hi = __builtin_amdgcn_readfirstlane(p[1]);
    return (const float*)(GAS const float*)(((unsigned long long)hi << 32) | lo);
}
struct TrItem { const float* W; int N; bf16_t* WT; int KT; int dstrow0; int k0; int n0; int hi_stride; };
__device__ __forceinline__ void transpose_load(const TrItem& I, float (&wv_)[32], int lane) {
    const unsigned vo_ = (unsigned)((lane >> 3) * I.N + (lane & 7) * 4) * 4u;
#pragma unroll
    for (int i = 0; i < 8; ++i) { const f32x4 w = __builtin_nontemporal_load((const f32x4*)((const char*)(I.W + (size_t)(I.k0 + 8 * i) * I.N + I.n0) + vo_));
        wv_[4 * i] = w[0]; wv_[4 * i + 1] = w[1]; wv_[4 * i + 2] = w[2]; wv_[4 * i + 3] = w[3]; }
}
__device__ __forceinline__ void transpose_finish(const TrItem& I, const float (&wv_)[32], LAS float* scr, int lane) {
#pragma unroll
    for (int i = 0; i < 8; ++i)
#pragma unroll
        for (int j = 0; j < 4; ++j) scr[(8 * i + (lane >> 3)) * 33 + (lane & 7) * 4 + j] = wv_[4 * i + j];
    LDS_WAIT(); asm volatile("" ::: "memory");
    const int c = lane & 7;
#pragma unroll
    for (int j = 0; j < 4; ++j) { const int n = (lane >> 3) + 8 * j; const LAS float* s = scr + (8 * c) * 33 + n;
        v4u o; o.x = cvtpk(s[0 * 33], s[1 * 33]); o.y = cvtpk(s[2 * 33], s[3 * 33]); o.z = cvtpk(s[4 * 33], s[5 * 33]); o.w = cvtpk(s[6 * 33], s[7 * 33]);
        *(v4u*)(I.WT + (size_t)(I.dstrow0 + (n & 15) + (n >> 4) * I.hi_stride) * I.KT + I.k0 + 8 * c) = o; }
    LDS_WAIT(); asm volatile("" ::: "memory");
}
__device__ __forceinline__ void transpose_item(const float* __restrict__ W, int N, bf16_t* __restrict__ WT, int KT, int dstrow0, int k0, int n0, LAS float* scr, int lane, int hi_stride = 16) {
    const TrItem I{W, N, WT, KT, dstrow0, k0, n0, hi_stride}; float wv_[32];
    transpose_load(I, wv_, lane); transpose_finish(I, wv_, scr, lane);
}
__device__ __forceinline__ TrItem moe_item_desc(LAS unsigned char* ldsl, int layer, int it, bf16_t* wgu_, bf16_t* wd_) {
    const int e = it / 384, r = it - e * 384;
    const size_t eoff = ((size_t)layer * NEXP + e) * (size_t)DM * FH;
    if (r < 256) {
        const int isup = r >> 7, rr = r & 127, kb = rr >> 3, nb = rr & 7, n0 = nb * 32;
        const float* W = (isup ? ldptr(ldsl, I_WUP) : ldptr(ldsl, I_WGATE)) + eoff;
        return TrItem{W, FH, wgu_, DM, e * 512 + (n0 >> 7) * 256 + isup * 128 + (n0 & 127), kb * 64, n0, 16};
    }
    const int rr = r - 256, kb = rr >> 5, nb = rr & 31;
    return TrItem{ldptr(ldsl, I_WDOWN) + eoff, DM, wd_, FH, e * 1024 + nb * 32, kb * 64, nb * 32, 16};
}
__device__ __forceinline__ void moe_weight_item(LAS unsigned char* ldsl, int layer, int it, bf16_t* wgu_, bf16_t* wd_, LAS float* scr, int lane) {
    const TrItem I = moe_item_desc(ldsl, layer, it, wgu_, wd_); float wv_[32];
    transpose_load(I, wv_, lane); transpose_finish(I, wv_, scr, lane);
}
__device__ __forceinline__ void moe_weight_pair(LAS unsigned char* ldsl, int layer, int ita, int itb, bf16_t* wgu_, bf16_t* wd_, LAS float* scr, int lane) {
    const TrItem A = moe_item_desc(ldsl, layer, ita, wgu_, wd_), B = moe_item_desc(ldsl, layer, itb, wgu_, wd_); float wa_[32], wb_[32];
    transpose_load(A, wa_, lane); transpose_load(B, wb_, lane);
    transpose_finish(A, wa_, scr, lane); transpose_finish(B, wb_, scr, lane);
}
__device__ __forceinline__ int pcol(int lane, int c) { return 8 * lane + 512 * (c >> 1) + 4 * (c & 1); }
__device__ __forceinline__ void store_h_row(const f32x4 (&v)[4], const float* __restrict__ sv, const float* __restrict__ av, bf16_t* __restrict__ hrow, int lane) {
#pragma unroll
    for (int j = 0; j < 2; ++j) { const int col = 8 * lane + 512 * j;
        const f32x4 s0 = *(const f32x4*)(sv + col), s1 = *(const f32x4*)(sv + col + 4), a0 = *(const f32x4*)(av + col), a1 = *(const f32x4*)(av + col + 4);
        const f32x4 h0 = v[2 * j] * (a0 + 1.0f) + s0, h1 = v[2 * j + 1] * (a1 + 1.0f) + s1;
        v4u w; w.x = cvtpk(h0[0], h0[1]); w.y = cvtpk(h0[2], h0[3]); w.z = cvtpk(h1[0], h1[1]); w.w = cvtpk(h1[2], h1[3]); *(v4u*)(hrow + col) = w; }
}
__device__ __forceinline__ void ln_row(f32x4 (&v)[4], const float* __restrict__ g, const float* __restrict__ bb, int lane, float& mean_o, float& rstd_o) {
    float s = 0.f;
#pragma unroll
    for (int j = 0; j < 4; ++j) s += (v[j][0] + v[j][1]) + (v[j][2] + v[j][3]);
    const float mean = wave_sum(s) * (1.f / DM); float s2 = 0.f;
#pragma unroll
    for (int j = 0; j < 4; ++j) { v[j] = v[j] - mean; s2 += (v[j][0] * v[j][0] + v[j][1] * v[j][1]) + (v[j][2] * v[j][2] + v[j][3] * v[j][3]); }
    const float rstd = 1.0f / sqrtf(wave_sum(s2) * (1.f / DM) + LN_EPS);
#pragma unroll
    for (int j = 0; j < 4; ++j) { const int col = pcol(lane, j); const f32x4 gg = *(const f32x4*)(g + col), b4 = *(const f32x4*)(bb + col); v[j] = v[j] * rstd * gg + b4; }
    mean_o = mean; rstd_o = rstd;
}

__device__ __forceinline__ int row_of(int layer, int idx, int per_item, int it, int j) { (void)idx;
    if (layer == 0) return it * per_item + j; const int xi = it * per_item + j; return (xi >> 11) * TT + LCT + (xi & 2047); }
template <int RB>
__device__ __forceinline__ void p8_rows(int idx0, int layer, const int4* __restrict__ tinfo, const LAS int* rowb, const bf16_t* __restrict__ fo, const hf_t* __restrict__ Yp, const f32x2* __restrict__ rst, const float* __restrict__ mg, const float* __restrict__ mb, float* outp, float* xrcp,
                                        const float* __restrict__ modlp, const float* __restrict__ modn, const float* __restrict__ fg, const float* __restrict__ fb, bf16_t* hbp, hf_t* r1p, int lane) {
    f32x4 v[RB][4]; v4u yh[RB][2], fa[RB][2], fc[RB][2]; int rr[RB]; int4 ti[RB];
#pragma unroll
    for (int q = 0; q < RB; ++q) { const int idx = idx0 + q; rr[q] = layer == 0 ? idx : (idx >> 11) * TT + LCT + (idx & 2047); ti[q] = tinfo[rr[q]]; }
    f32x2 st[RB];
#pragma unroll
    for (int q = 0; q < RB; ++q) { const hf_t* xr = Yp + (size_t)rr[q] * DM; st[q] = rst[rr[q]];
        const bf16_t* f1 = fo + (size_t)(rowb[ti[q].x] + ti[q].y) * DM; const bf16_t* f2 = fo + (size_t)(rowb[ti[q].z] + ti[q].w) * DM;
#pragma unroll
        for (int j = 0; j < 2; ++j) yh[q][j] = *(const v4u*)(xr + 8 * lane + 512 * j);
#pragma unroll
        for (int j = 0; j < 2; ++j) { fa[q][j] = *(const v4u*)(f1 + 8 * lane + 512 * j); fc[q][j] = *(const v4u*)(f2 + 8 * lane + 512 * j); } }
#pragma unroll
    for (int q = 0; q < RB; ++q) { const int r = rr[q]; const int b = r / TT, t = r - b * TT; const int cond = t < LCT ? 8 : b;
        const float* gf = modlp + (size_t)cond * NMOD + 5120;
#pragma unroll
        for (int c = 0; c < 4; ++c) { const int col = pcol(lane, c); const v4u a4 = fa[q][c >> 1], c4 = fc[q][c >> 1];
            const unsigned ax = (c & 1) ? a4.z : a4.x, ay = (c & 1) ? a4.w : a4.y, cx = (c & 1) ? c4.z : c4.x, cy = (c & 1) ? c4.w : c4.y;
            const f32x4 f = {bf_lo(ax) + bf_lo(cx), bf_hi(ax) + bf_hi(cx), bf_lo(ay) + bf_lo(cy), bf_hi(ay) + bf_hi(cy)};
            const v4u y4 = yh[q][c >> 1]; const unsigned yx = (c & 1) ? y4.z : y4.x, yy = (c & 1) ? y4.w : y4.y;
            const f32x4 yv = {hf_lo(yx), hf_hi(yx), hf_lo(yy), hf_hi(yy)};
            const f32x4 x1 = (yv - st[q].x) * st[q].y * *(const f32x4*)(mg + col) + *(const f32x4*)(mb + col);
            v[q][c] = x1 * ALPHA + *(const f32x4*)(gf + col) * f; }
        float mean, rstd; ln_row(v[q], fg, fb, lane, mean, rstd); }
#pragma unroll
    for (int q = 0; q < RB; ++q) { const int r = rr[q]; const int b = r / TT, t = r - b * TT; const int cond = t < LCT ? 8 : b;
        if (layer == 0) { if (t >= LCT) { hf_t* xh = r1p + ((size_t)b * NXT + (t - LCT)) * DM;
#pragma unroll
                for (int j = 0; j < 2; ++j) { const f32x4 a = v[q][2 * j], c4 = v[q][2 * j + 1]; v4u w; w.x = pkh(a[0], a[1]); w.y = pkh(a[2], a[3]); w.z = pkh(c4[0], c4[1]); w.w = pkh(c4[2], c4[3]);
                    *(v4u*)(xh + 8 * lane + 512 * j) = w; } } }
        else { float* xr = xr_ptr(outp, xrcp, r);
#pragma unroll
            for (int c = 0; c < 4; ++c) *(f32x4*)(xr + pcol(lane, c)) = v[q][c]; }
        if (layer == 0) { const float* mv = modn + (size_t)cond * NMOD; store_h_row(v[q], mv, mv + 1024, hbp + (size_t)r * DM, lane); } }
}

template <int RB>
__device__ __forceinline__ void h0_rows(int r0, const float* __restrict__ xin, const float* __restrict__ cin, const float* __restrict__ mv0, bf16_t* hb, hf_t* xh, int lane) {
    f32x4 v[RB][4];
#pragma unroll
    for (int q = 0; q < RB; ++q) { const float* src = in0_ptr(xin, cin, r0 + q);
#pragma unroll
        for (int j = 0; j < 2; ++j) { v[q][2 * j] = *(const f32x4*)(src + 8 * lane + 512 * j); v[q][2 * j + 1] = *(const f32x4*)(src + 8 * lane + 512 * j + 4); } }
#pragma unroll
    for (int q = 0; q < RB; ++q) { const int r = r0 + q; const int b = r / TT, t = r - b * TT; const int cond = t < LCT ? 8 : b;
        const float* sv = mv0 + (size_t)cond * NMOD; const float* av = sv + 1024; bf16_t* hrow = hb + (size_t)r * DM;
#pragma unroll
        for (int j = 0; j < 2; ++j) { const int col = 8 * lane + 512 * j;
            const f32x4 s0 = *(const f32x4*)(sv + col), s1 = *(const f32x4*)(sv + col + 4), a0 = *(const f32x4*)(av + col), a1 = *(const f32x4*)(av + col + 4);
            const f32x4 h0 = v[q][2 * j] * (a0 + 1.0f) + s0, h1 = v[q][2 * j + 1] * (a1 + 1.0f) + s1;
            v4u w; w.x = cvtpk(h0[0], h0[1]); w.y = cvtpk(h0[2], h0[3]); w.z = cvtpk(h1[0], h1[1]); w.w = cvtpk(h1[2], h1[3]); *(v4u*)(hrow + col) = w;
            const f32x4 x0 = v[q][2 * j], x1 = v[q][2 * j + 1];
            v4u xw; xw.x = pkh(x0[0], x0[1]); xw.y = pkh(x0[2], x0[3]); xw.z = pkh(x1[0], x1[1]); xw.w = pkh(x1[2], x1[3]); *(v4u*)(xh + (size_t)r * DM + col) = xw; } }
}

__global__ void __launch_bounds__(512, 2) fwd_megakernel(Args args) {
    extern __shared__ __attribute__((aligned(16))) unsigned char lds[];
    LAS unsigned char* ldsl = (LAS unsigned char*)lds;
    volatile LAS unsigned* MISC = (volatile LAS unsigned*)(ldsl + MISC_OFF);
    const int G0 = gridDim.x; const int bx0 = blockIdx.x;
    const int vcu0 = (G0 % 8 == 0) ? (bx0 % 8) * (G0 / 8) + bx0 / 8 : bx0;
    const int wv = __builtin_amdgcn_readfirstlane(threadIdx.x >> 6);
#define PHASE_IDS() int G = G0, bx = bx0, vcu = vcu0; asm volatile("" : "+s"(G), "+s"(bx), "+s"(vcu)); const int NGW = G * 8; (void)NGW; (void)bx; int wave = wv; asm volatile("" : "+s"(wave)); const int tid = ltid(wave); (void)tid; const int lane = tid & 63; const int gw = vcu * 8 + wave; (void)gw; (void)lane
#define AIN(i) ldptr(ldsl, (i))
#define WSB ((unsigned char*)ldptr(ldsl, 29))
#define ctl ((gu32*)(WSB + WS_CTL))
#define modv ((float*)(WSB + WS_MOD))
#define tab64 ((f32x2*)(WSB + WS_TAB64))
#define tab128 ((f32x2*)(WSB + WS_TAB128))
#define wrt ((float*)(WSB + WS_WRT))
#define wrs ((bf16_t*)(WSB + WS_WRS))
#define tokinfo ((int4*)(WSB + WS_TOKINFO))
#define tokof ((int*)(WSB + WS_TOKOF))
#define rstats ((f32x2*)(WSB + WS_STATS))
#define gwof ((float*)(WSB + WS_GWOF))
#define ACTB ((bf16_t*)(WSB + WS_QKV))
#define XRC ((float*)(WSB + WS_XRC))
#define wqkv0 ((bf16_t*)(WSB + WS_WQKV0))
#define wo0 ((bf16_t*)(WSB + WS_WO0))
#define wqkv1 ((bf16_t*)(WSB + WS_WQKV1))
#define wo1 ((bf16_t*)(WSB + WS_WO1))
#define wgu ((bf16_t*)(WSB + WS_WGU))
#define wd ((bf16_t*)(WSB + WS_WD))
#define HB ((bf16_t*)(WSB + WS_HBUF))
#define QKV ((bf16_t*)(WSB + WS_QKV))
#define HS QKV
#define Y ((hf_t*)(WSB + WS_YOFF))
#define rowst ((f32x2*)(WSB + WS_ROWST))
#define FO ((bf16_t*)(WSB + WS_Y))
#define out ((float*)ldptr(ldsl, 28))
    for (int u = threadIdx.x; u < (LDS_BYTES - MISC_OFF) / 4; u += 512) ((LAS unsigned*)(ldsl + MISC_OFF))[u] = 0u;
    __syncthreads();
    if (threadIdx.x == 0) { LAS unsigned long long* pt = (LAS unsigned long long*)(ldsl + PTR_OFF);
#pragma unroll
        for (int i = 0; i < 28; ++i) pt[i] = (unsigned long long)args.in[i];
        pt[28] = (unsigned long long)args.o_; pt[29] = (unsigned long long)args.w_; }
    __syncthreads();
    xcd_barrier_post((unsigned*)(ctl + CW_BAR));
#define GRID_BAR() xcd_barrier((unsigned*)(ctl + CW_BAR), MISC + 8, ltid(wv) == 0)

        for (int rep_ = 0; rep_ < ((REPMASK >> 0) & 1) * REPN + 1; ++rep_) {
    if (PHMASK & (1 << 0)) {
        PHASE_IDS();
        for (int it = bx; it < 192; it += G) {
            const int layer = it / 96, col0 = (it % 96) * 64;
            const float* Wm = AIN(I_WMOD) + (size_t)layer * DM * NMOD;
            LAS float* sl = (LAS float*)(ldsl + wave * 8192);
            const int k0 = wave * 128;
            for (int idx = lane; idx < 9 * 128; idx += 64) { const int cond = idx >> 7, kk = idx & 127;
                const float v = cond < 8 ? AIN(I_C)[cond * DM + k0 + kk] : AIN(I_CCTX)[k0 + kk];
                sl[idx] = v / (1.f + expf(-v)); }
            LDS_WAIT(); asm volatile("" ::: "memory");
            const int rg = lane >> 4, c4 = (lane & 15) * 4;
            f32x4 acc[9];
#pragma unroll
            for (int c = 0; c < 9; ++c) acc[c] = (f32x4){0.f, 0.f, 0.f, 0.f};
            const unsigned lofs = (unsigned)(rg * NMOD + c4) * 4u;
#pragma unroll 1
            for (int kb = 0; kb < 128; kb += 64) { f32x4 wv_[16];
#pragma unroll
                for (int i = 0; i < 16; ++i) wv_[i] = __builtin_nontemporal_load((const f32x4*)((const char*)(Wm + (size_t)(k0 + kb + 4 * i) * NMOD + col0) + lofs));
#pragma unroll
                for (int i = 0; i < 16; ++i) {
#pragma unroll
                    for (int c = 0; c < 9; ++c) acc[c] += wv_[i] * sl[c * 128 + kb + 4 * i + rg]; } }
            LAS float* part = (LAS float*)(ldsl + 65536);
#pragma unroll
            for (int c = 0; c < 9; ++c) *(LAS f32x4*)(part + (wave * 4 + rg) * 576 + c * 64 + c4) = acc[c];
            __syncthreads();
            for (int idx = tid; idx < 576; idx += 512) { float s = 0.f;
#pragma unroll
                for (int w = 0; w < 32; ++w) s += part[w * 576 + idx];
                const int cond = idx >> 6, col = col0 + (idx & 63);
                modv[((size_t)layer * 9 + cond) * NMOD + col] = s + AIN(I_BMOD)[layer * NMOD + col]; }
            __syncthreads();
        }
        for (int idx = bx * 512 + tid; idx < 3072 + 2 * 8 * 4 * 3 * 64; idx += G * 512) {
            if (idx < 1024) { const int pos = idx >> 4, f = idx & 15; const float inv = powf(10000.f, -(float)(2 * f) / 32.f); float s, c; sincosf((float)pos * inv, &s, &c); tab64[idx] = (f32x2){c, s}; }
            else if (idx < 3072) { const int i2 = idx - 1024, pos = i2 >> 5, f = i2 & 31; const float inv = powf(10000.f, -(float)(2 * f) / 64.f); float s, c; sincosf((float)pos * inv, &s, &c); tab128[i2] = (f32x2){c, s}; }
            else { const int i2 = idx - 3072, ln = i2 & 63, nb = (i2 >> 6) % 3, s = ((i2 >> 6) / 3) & 3, w = ((i2 >> 6) / 12) & 7, l = (i2 >> 6) / 96;
                const int k0 = 128 * w + 32 * s + 8 * (ln >> 4), o = nb * 16 + (ln & 15); float wv_[8];
#pragma unroll
                for (int j = 0; j < 8; ++j) wv_[j] = o < 4 ? AIN(I_WGRP)[(size_t)l * DM * 4 + (k0 + j) * 4 + o] : (o < 36 ? AIN(I_WRT)[(size_t)l * DM * 32 + (k0 + j) * 32 + (o - 4)] : 0.f);
                unsigned hi_[4], lo_[4];
#pragma unroll
                for (int j = 0; j < 4; ++j) { hi_[j] = cvtpk(wv_[2 * j], wv_[2 * j + 1]); lo_[j] = cvtpk(wv_[2 * j] - bf_lo(hi_[j]), wv_[2 * j + 1] - bf_hi(hi_[j])); }
                bf16_t* dst = wrs + ((size_t)(((l * 8 + w) * 4 + s) * 3 + nb) * 2) * 512 + ln * 8;
                *(v4u*)dst = (v4u){hi_[0], hi_[1], hi_[2], hi_[3]}; *(v4u*)(dst + 512) = (v4u){lo_[0], lo_[1], lo_[2], lo_[3]}; }
        }
        LAS float* scr = (LAS float*)(ldsl + wave * 16384);
        constexpr int S0 = 16 * 96, S1 = 16 * 32, S2 = 16 * 48, S3 = 16 * 32, S4 = NEXP * 384;
        for (int it = gw; it < S0 + S1 + S2 + S3; it += NGW) {
            int r = it;
            if (r < S0) { const int n0 = (r % 96) * 32; const bool kcol = (n0 >= 1024 && n0 < 2048);
                transpose_item(AIN(I_DWQKV), NQKV0, wqkv0, DM, kcol ? (n0 & ~255) + ((n0 >> 6) & 3) * 32 + ((n0 >> 5) & 1) * 16 : n0, (r / 96) * 64, n0, scr, lane, kcol ? 128 : 16); continue; } r -= S0;
            if (r < S1) { transpose_item(AIN(I_DWO), DM, wo0, DM, (r % 32) * 32, (r / 32) * 64, (r % 32) * 32, scr, lane); continue; } r -= S1;
            if (r < S2) { const int n0 = (r % 48) * 32; const bool kcol = (n0 >= 1024 && n0 < 1280);
                transpose_item(AIN(I_GWQKV), NQKV1, wqkv1, DM, kcol ? 1024 + ((n0 >> 5) & 1) * 128 + ((n0 >> 7) & 1) * 64 + ((n0 >> 6) & 1) * 32 : n0, (r / 48) * 64, n0, scr, lane); continue; } r -= S2;
            if (r < S3) { transpose_item(AIN(I_GWO), DM, wo1, DM, (r % 32) * 32, (r / 32) * 64, (r % 32) * 32, scr, lane); continue; }
        }
        { int it = gw; for (; it + NGW < S4; it += 2 * NGW) moe_weight_pair(ldsl, 0, it, it + NGW, wgu, wd, scr, lane);
          if (it < S4) moe_weight_item(ldsl, 0, it, wgu, wd, scr, lane); }
    }
    GRID_BAR(); }
        for (int rep_ = 0; rep_ < ((REPMASK >> 1) & 1) * REPN + 1; ++rep_) {
    if (PHMASK & (1 << 1)) { PHASE_IDS();
    { const float* xin = AIN(I_X); const float* cin = AIN(I_CTX); const float* mv0 = modv; bf16_t* hb = HB;
    const int per = (MALL + NGW - 1) / NGW; int r0 = gw * per; const int r1 = min((int)MALL, r0 + per);
    hf_t* xh = (hf_t*)(WSB + WS_Y);
    for (; r0 + 5 <= r1; r0 += 5) h0_rows<5>(r0, xin, cin, mv0, hb, xh, lane);
    for (; r0 + 4 <= r1; r0 += 4) h0_rows<4>(r0, xin, cin, mv0, hb, xh, lane);
    for (; r0 < r1; ++r0) h0_rows<1>(r0, xin, cin, mv0, hb, xh, lane);
    } }
    GRID_BAR(); }

#pragma unroll
    for (int layer = 0; layer < 2; ++layer) {
#define modl (modv + (size_t)layer * 9 * NMOD)
        const int NQ = layer == 0 ? NQKV0 : NQKV1;
        for (int rep_ = 0; rep_ < ((REPMASK >> 2) & 1) * REPN + 1; ++rep_) {
        if (PHMASK & (1 << 2))
        { PHASE_IDS();
            pg8::Gemm g{HB, layer == 0 ? wqkv0 : wqkv1, MALL, NQ, DM};
            SchedRect S; if (layer == 0) S.init(72, NQKV0, G, bx, 0, 0); else S.init(64, NQKV1, G, bx, 1, 16);
            EpiStoreBf16 E{QKV, NQ, 0xffff, layer == 0 ? tab64 : tab128, layer == 0 ? (const float*)nullptr : AIN(I_GKN), (LAS float*)(ldsl + MISC_OFF + 4096)};
            pg8::gemm_phase<EpiStoreBf16, SchedRect, true, true>(ldsl, g, S, E, wave);
        }
        GRID_BAR(); }
        for (int rep_ = 0; rep_ < ((REPMASK >> 4) & 1) * REPN + 1; ++rep_) {
        if (PHMASK & (1 << 4)) {
        if (layer == 0 && (PHMASK & (1 << 16))) { PHASE_IDS();
            float lam;
            { const float s1 = wave_sum(AIN(I_LQ1)[lane] * AIN(I_LK1)[lane]), s2 = wave_sum(AIN(I_LQ2)[lane] * AIN(I_LK2)[lane]);
              lam = expf(s1) - expf(s2) + LAMBDA_INIT0; }
            const int nH = 1024, base = nH / G, rem = nH % G;
            const int u0 = vcu * base + (vcu < rem ? vcu : rem), cnt = base + (vcu < rem ? 1 : 0);
            for (int i = 0; i < cnt; ++i) {
                const int u = u0 + i, bh = u >> 4, qb = u & 15, b = bh >> 3, h = bh & 7;
                const size_t row0 = (size_t)b * TT + LCT + qb * 128;
                const bf16_t* kb = QKV + (size_t)b * TT * NQKV0 + h * 128;
                att::attn_unit<true>(QKV + row0 * NQKV0 + h * 128, NQKV0, kb + 1024, kb + 2048, NQKV0, TT, HB + row0 * DM + h * 128, DM,
                                     true, qb * 128, tab64, nullptr, AIN(I_SUBG), lam, (char*)lds, wave);
            }
            for (int l = vcu; l < 128; l += G) {
                const int bh = l >> 1, qb = l & 1, b = bh >> 3, h = bh & 7;
                const size_t row0 = (size_t)b * TT + qb * 128;
                const bf16_t* kb = QKV + (size_t)b * TT * NQKV0 + h * 128;
                att::attn_unit<true>(QKV + row0 * NQKV0 + h * 128, NQKV0, kb + 1024, kb + 2048, NQKV0, LCT, HB + row0 * DM + h * 128, DM,
                                     false, 0, tab64, nullptr, AIN(I_SUBG), lam, (char*)lds, wave);
            }
        } else if (PHMASK & (1 << 17)) { PHASE_IDS();
            const int nU = 512, base = nU / G, rem = nU % G;
            const int u0 = vcu * base + (vcu < rem ? vcu : rem), cnt = base + (vcu < rem ? 1 : 0);
            for (int i = 0; i < cnt; ++i) {
                const int u = u0 + i, bh = u >> 3, qb = u & 7, b = bh >> 3, h = bh & 7;
                const size_t row0 = (size_t)b * TT + LCT + qb * 256;
                const bf16_t* kb = QKV + (size_t)b * TT * NQKV1 + (h >> 2) * 128;
                att::attn_unit<false>(QKV + row0 * NQKV1 + h * 128, NQKV1, kb + 1024, kb + 1280, NQKV1, TT, HB + row0 * DM + h * 128, DM,
                                      true, qb * 256, tab128, AIN(I_GQN), nullptr, 0.f, (char*)lds, wave);
            }
        } }
        GRID_BAR(); }
        for (int rep_ = 0; rep_ < ((REPMASK >> 5) & 1) * REPN + 1; ++rep_) {
        if (PHMASK & (1 << 5))
        { PHASE_IDS();
            pg8::Gemm g{HB, layer == 0 ? wo0 : wo1, MALL, DM, DM};
            SchedRect S; if (layer == 0) S.init(72, DM, G, bx, 0, 0); else S.init(64, DM, G, bx, 1, 0);
            if (layer == 0) { EpiResid<2> E{Y, (const float*)(WSB + WS_Y), (const float*)nullptr, modl, rstats}; pg8::gemm_phase<EpiResid<2>, SchedRect, true, true>(ldsl, g, S, E, wave); }
            else { EpiResid<1> E{Y, (const float*)(WSB + WS_R1), (const float*)nullptr, modl, rstats}; pg8::gemm_phase<EpiResid<1>, SchedRect, true, true>(ldsl, g, S, E, wave); }
        }
        GRID_BAR(); }
        if (PHMASK & (1 << 6))
        { PHASE_IDS();
            const int TR = layer == 0 ? 72 : 64;
            const f32x2* stq = rstats; const hf_t* Yq = Y; float* outq = out; float* xrcq = XRC; const float* modq = modl; bf16_t* hbq = HB;
            const float* lg = AIN(I_LNMG) + layer * DM; const float* lb = AIN(I_LNMB) + layer * DM;
            const bf16_t* wrs_l = wrs + (size_t)layer * 8 * 4 * 3 * 2 * 512;
            LAS float* red = (LAS float*)ldsl;
            LAS float* logits = (LAS float*)(ldsl + 116736);
            LAS float* stats = (LAS float*)(ldsl + 127232);
            LAS int* lcnt = (LAS int*)(ldsl + 127232 + 576);
            LAS int* lbase = lcnt + 32;
            for (int it = bx; it < 256; it += G) {
                LAS float* mods = (LAS float*)(ldsl + 82944);
                LAS float* lnv = mods + 4096;
                { const int b0i = row_of(layer, 0, TR, it, 0) / TT;
                  for (int i = tid; i < 1536; i += 512) { f32x4 v;
                      if (i < 1024) { const int slot = i >> 9, w = (i >> 8) & 1, c = (i & 255) * 4; v = *(const f32x4*)(modq + (size_t)(slot ? 8 : b0i) * NMOD + (w ? 4096 : 3072) + c); }
                      else { const int w = (i - 1024) >> 8, c = ((i - 1024) & 255) * 4; v = *(const f32x4*)((w ? lb : lg) + c); }
                      *(LAS f32x4*)(mods + i * 4) = v; } }
                v4u ypre[5];
                { const int l15p = lane & 15, kgp = lane >> 4; const hf_t* Yp_ = Y;
#pragma unroll
                  for (int mt = 0; mt < 5; ++mt) { const int j = mt * 16 + l15p; const int r = row_of(layer, 0, TR, it, j < TR ? j : 0); ypre[mt] = *(const v4u*)(Yp_ + (size_t)r * DM + 128 * wave + 8 * kgp); } }
                if (tid < 32) lcnt[tid] = 0;
                if (tid < TR) { const int r = row_of(layer, 0, TR, it, tid); const f32x2* sp = stq + (size_t)r * 16; float S = 0.f, Q = 0.f;
#pragma unroll
                    for (int p = 0; p < 16; ++p) { const f32x2 v = sp[p]; S += v.x; Q += v.y; }
                    const float mean = S * (1.f / DM); const float var = fmaxf(Q * (1.f / DM) - mean * mean, 0.f);
                    const float rstd = 1.0f / sqrtf(var + LN_EPS); stats[2 * tid] = mean; stats[2 * tid + 1] = rstd; rowst[r] = (f32x2){mean, rstd}; }
                __syncthreads();
                {
                    const int l15 = lane & 15, kg = lane >> 4;
                    pg8::f32x4 acc[5][3];
#pragma unroll
                    for (int mt = 0; mt < 5; ++mt)
#pragma unroll
                        for (int nb = 0; nb < 3; ++nb) acc[mt][nb] = (pg8::f32x4){0.f, 0.f, 0.f, 0.f};
                    int rrow[5]; float rmean[5], rrstd[5]; int rcond[5];
#pragma unroll
                    for (int mt = 0; mt < 5; ++mt) { const int j = mt * 16 + l15; const bool ok = j < TR; const int r = ok ? row_of(layer, 0, TR, it, j) : row_of(layer, 0, TR, it, 0);
                        const int bb = r / TT, tt = r - bb * TT; rrow[mt] = ok ? r : -1; rmean[mt] = stats[2 * (ok ? j : 0)]; rrstd[mt] = stats[2 * (ok ? j : 0) + 1];
                        rcond[mt] = tt < LCT ? 8 : bb; }
                    const int rfirst = row_of(layer, 0, TR, it, 0);
#define P4_LOADY(YB, S_) do { const int k0_ = 128 * wave + 32 * (S_) + 8 * kg; _Pragma("unroll") for (int mt = 0; mt < 5; ++mt) YB[mt] = *(const v4u*)(Yq + (size_t)(rrow[mt] >= 0 ? rrow[mt] : rfirst) * DM + k0_); } while (0)
#define P4_STEP(YB, S_) do { const int s = (S_); const int k0 = 128 * wave + 32 * s + 8 * kg; \
                        const f32x4 g0 = *(const LAS f32x4*)(lnv + k0), g1 = *(const LAS f32x4*)(lnv + k0 + 4), b0 = *(const LAS f32x4*)(lnv + 1024 + k0), b1 = *(const LAS f32x4*)(lnv + 1024 + k0 + 4); \
                        bf16x8 bh[3], bl[3]; \
                        _Pragma("unroll") for (int nb = 0; nb < 3; ++nb) { const bf16_t* bp = wrs_l + ((size_t)((wave * 4 + s) * 3 + nb) * 2) * 512 + lane * 8; bh[nb] = *(const bf16x8*)bp; bl[nb] = *(const bf16x8*)(bp + 512); } \
                        _Pragma("unroll") for (int mt = 0; mt < 5; ++mt) { \
                            int mo_ = (rcond[mt] == 8 ? 2048 : 0) + k0; asm volatile("" : "+v"(mo_)); \
                            const LAS float* mv = mods + mo_; \
                            const f32x4 s0 = *(const LAS f32x4*)(mv), s1 = *(const LAS f32x4*)(mv + 4), a0 = *(const LAS f32x4*)(mv + 1024), a1 = *(const LAS f32x4*)(mv + 1028); \
                            const v4u yh = YB[mt]; \
                            const f32x4 y0 = {hf_lo(yh.x), hf_hi(yh.x), hf_lo(yh.y), hf_hi(yh.y)}, y1 = {hf_lo(yh.z), hf_hi(yh.z), hf_lo(yh.w), hf_hi(yh.w)}; \
                            const f32x4 x0 = (y0 - rmean[mt]) * rrstd[mt] * g0 + b0, x1 = (y1 - rmean[mt]) * rrstd[mt] * g1 + b1; \
                            f32x4 h0 = x0 * (a0 + 1.0f) + s0, h1 = x1 * (a1 + 1.0f) + s1; \
                            if (rrow[mt] < 0) { h0 = (f32x4){0.f, 0.f, 0.f, 0.f}; h1 = h0; } \
                            v4u hh; hh.x = cvtpk(h0[0], h0[1]); hh.y = cvtpk(h0[2], h0[3]); hh.z = cvtpk(h1[0], h1[1]); hh.w = cvtpk(h1[2], h1[3]); \
                            v4u hl; hl.x = cvtpk(h0[0] - bf_lo(hh.x), h0[1] - bf_hi(hh.x)); hl.y = cvtpk(h0[2] - bf_lo(hh.y), h0[3] - bf_hi(hh.y)); \
                            hl.z = cvtpk(h1[0] - bf_lo(hh.z), h1[1] - bf_hi(hh.z)); hl.w = cvtpk(h1[2] - bf_lo(hh.w), h1[3] - bf_hi(hh.w)); \
                            if (rrow[mt] >= 0) *(v4u*)(hbq + (size_t)rrow[mt] * DM + k0) = hh; \
                            const bf16x8 ah = *reinterpret_cast<const bf16x8*>(&hh), al = *reinterpret_cast<const bf16x8*>(&hl); \
                            _Pragma("unroll") for (int nb = 0; nb < 3; ++nb) { \
                                acc[mt][nb] = __builtin_amdgcn_mfma_f32_16x16x32_bf16(ah, bh[nb], acc[mt][nb], 0, 0, 0); \
                                acc[mt][nb] = __builtin_amdgcn_mfma_f32_16x16x32_bf16(ah, bl[nb], acc[mt][nb], 0, 0, 0); \
                                acc[mt][nb] = __builtin_amdgcn_mfma_f32_16x16x32_bf16(al, bh[nb], acc[mt][nb], 0, 0, 0); } } } while (0)
                    { v4u ya[5], yb[5];
#pragma unroll
                      for (int mt = 0; mt < 5; ++mt) ya[mt] = ypre[mt];
#pragma unroll 1
                      for (int s2 = 0; s2 < 4; s2 += 2) {
                          P4_LOADY(yb, s2 + 1); __builtin_amdgcn_sched_barrier(0);
                          P4_STEP(ya, s2); __builtin_amdgcn_sched_barrier(0);
                          P4_LOADY(ya, (s2 + 2) & 3); __builtin_amdgcn_sched_barrier(0);
                          P4_STEP(yb, s2 + 1); __builtin_amdgcn_sched_barrier(0); } }
#undef P4_LOADY
#undef P4_STEP
                    const int ln2 = ltid(wave) & 63; const int l15b = ln2 & 15, kgb = ln2 >> 4;
#pragma unroll
                    for (int mt = 0; mt < 5; ++mt)
#pragma unroll
                        for (int nb = 0; nb < 3; ++nb)
#pragma unroll
                            for (int q = 0; q < 4; ++q) { const int row = mt * 16 + kgb * 4 + q, col = nb * 16 + l15b; if (row < 72 && col < 36) red[wave * 2592 + row * 36 + col] = acc[mt][nb][q]; }
                }
                const int tidc = ltid(wave);
                __syncthreads();
                for (int idx = tidc; idx < 2592; idx += 512) { const int o = idx % 36;
                    float s = o < 4 ? AIN(I_BGRP)[layer * 4 + o] : AIN(I_BRT)[layer * 32 + o - 4];
#pragma unroll
                    for (int w = 0; w < 8; ++w) s += red[w * 2592 + idx];
                    logits[idx] = s; }
                __syncthreads();
                int e1 = 0, e2 = 0, rk1 = 0, rk2 = 0; float G1 = 0.f, G2 = 0.f; int rme = 0;
                if (tidc < TR) {
                    const LAS float* lgt = logits + tidc * 36;
                    int gi = 0; float gm = lgt[0];
#pragma unroll
                    for (int g = 1; g < 4; ++g) { const float v = lgt[g]; if (v > gm) { gm = v; gi = g; } }
                    float gs = 0.f;
#pragma unroll
                    for (int g = 0; g < 4; ++g) gs += expf(lgt[g] - gm);
                    const float gtop = 1.0f / gs;
                    const LAS float* el = lgt + 4 + gi * 8;
                    int i1 = 0; float v1 = el[0];
#pragma unroll
                    for (int e = 1; e < 8; ++e) { const float v = el[e]; if (v > v1) { v1 = v; i1 = e; } }
                    int i2 = -1; float v2 = -3.0e38f;
#pragma unroll
                    for (int e = 0; e < 8; ++e) { const float v = el[e]; if (e != i1 && v > v2) { v2 = v; i2 = e; } }
                    const float ex = expf(v2 - v1); const float w1 = 1.0f / (1.0f + ex), w2 = ex / (1.0f + ex);
                    e1 = gi * 8 + i1; e2 = gi * 8 + i2; G1 = gtop * w1; G2 = gtop * w2;
                    rk1 = atomicAdd((int*)(lcnt + e1), 1); rk2 = atomicAdd((int*)(lcnt + e2), 1);
                    if (layer == 0) rme = it * 72 + tidc; else { const int xi = it * 64 + tidc; rme = (xi >> 11) * TT + LCT + (xi & 2047); }
                }
                __syncthreads();
                if (tidc < 32) { const int n = lcnt[tidc]; lbase[tidc] = n ? (int)__hip_atomic_fetch_add((unsigned*)(ctl + CW_CNT + layer * 32 + tidc), (unsigned)n, RLX_AGENT) : 0; }
                __syncthreads();
                if (tidc < TR) { const int q1 = lbase[e1] + rk1, q2 = lbase[e2] + rk2; tokinfo[rme] = make_int4(e1, q1, e2, q2);
                    int* tkf = tokof; float* gwf = gwof; tkf[(size_t)e1 * ECAP + q1] = rme; tkf[(size_t)e2 * ECAP + q2] = rme; gwf[(size_t)e1 * ECAP + q1] = G1; gwf[(size_t)e2 * ECAP + q2] = G2; }
                __syncthreads();
            }
        }
        GRID_BAR();
        for (int rep_ = 0; rep_ < ((REPMASK >> 8) & 1) * REPN + 1; ++rep_) {
        if (PHMASK & (1 << 8))
        {
            PHASE_IDS();
            LAS unsigned char* tile_e = ldsl + TILEE_OFF; LAS int* rowb = (LAS int*)(ldsl + ROWB_OFF); LAS int* cntl = (LAS int*)(ldsl + ROWB_OFF + 128); LAS int* tbase = (LAS int*)(ldsl + ROWB_OFF + 256);
            if (tid == 0) { int tt = 0;
#pragma unroll 1
                for (int e = 0; e < NEXP; ++e) { const int cnt = (int)__hip_atomic_load((unsigned*)(ctl + CW_CNT + layer * 32 + e), RLX_AGENT); rowb[e] = tt * 256; tbase[e] = tt; cntl[e] = cnt; tt += (cnt + 255) >> 8; }
                tbase[NEXP] = tt; MISC[16] = (unsigned)tt; }
            __syncthreads();
            if (tid < 176) { int e = 0;
#pragma unroll 1
                for (int q = 1; q < NEXP; ++q) e += (tbase[q] <= tid) ? 1 : 0;
                tile_e[tid] = (unsigned char)e; }
            __syncthreads();
            const int ntile = (int)MISC[16];
            pg8::Gemm g{HB, wgu, SORT_ROWS, NEXP * 512, DM};
            SchedExp S{ldsl + TILEE_OFF, 2, ntile * 2, G, bx};
            EpiGateUp E{ACTB, gwof, tbase};
            pg8::GatherA GA{tokof, tbase, cntl, 2, ECAP};
            pg8::gemm_phase<EpiGateUp, SchedExp, true, true, true, pg8::GatherA>(ldsl, g, S, E, wave, GA);
        }
        GRID_BAR(); }
        for (int rep_ = 0; rep_ < ((REPMASK >> 9) & 1) * REPN + 1; ++rep_) {
        if (PHMASK & (1 << 9))
        { PHASE_IDS();
            const int ntile = (int)MISC[16];
            int kdn = FH; asm volatile("" : "+s"(kdn));
            pg8::Gemm g{ACTB, wd, SORT_ROWS, NEXP * 1024, kdn};
            SchedExp S{ldsl + TILEE_OFF, 4, ntile * 4, G, bx};
            EpiStoreBf16 E{FO, DM, 3, (const f32x2*)nullptr, (const float*)nullptr, (LAS float*)nullptr};
            pg8::gemm_phase<EpiStoreBf16, SchedExp, true, true>(ldsl, g, S, E, wave);
        }
        GRID_BAR(); }
        if (PHMASK & (1 << 10))
        { PHASE_IDS();
            const float* fg = AIN(I_LNFG) + layer * DM; const float* fb = AIN(I_LNFB) + layer * DM;
            const int nrows = layer == 0 ? MALL : MXR;
            { const hf_t* Yq = Y; const f32x2* rsq = rowst; const float* mg = AIN(I_LNMG) + layer * DM; const float* mb = AIN(I_LNMB) + layer * DM; const int4* tinfo = tokinfo; const LAS int* rowb = (const LAS int*)(ldsl + ROWB_OFF); const bf16_t* fo = FO; float* outq = out; float* xrcq = XRC; const float* modq = modl; const float* modn = modv + (size_t)9 * NMOD; bf16_t* hbq = HB;
              if (layer == 0) {
                  const int per = (nrows + NGW - 1) / NGW; int idx0 = gw * per; const int i1 = min(nrows, idx0 + per);
                  for (; idx0 + 3 <= i1; idx0 += 3) p8_rows<3>(idx0, layer, tinfo, rowb, fo, Yq, rsq, mg, mb, outq, xrcq, modq, modn, fg, fb, hbq, (hf_t*)(WSB + WS_R1), lane);
                  for (; idx0 < i1; ++idx0) p8_rows<1>(idx0, layer, tinfo, rowb, fo, Yq, rsq, mg, mb, outq, xrcq, modq, modn, fg, fb, hbq, (hf_t*)(WSB + WS_R1), lane);
              } else
              for (int idx0 = gw * 4; idx0 < nrows; idx0 += NGW * 4) p8_rows<4>(idx0, layer, tinfo, rowb, fo, Yq, rsq, mg, mb, outq, xrcq, modq, modn, fg, fb, hbq, (hf_t*)(WSB + WS_R1), lane); }
            if (layer == 0) {
                LAS float* scr = (LAS float*)(ldsl + wave * 16384);
                { int it = gw; for (; it + NGW < NEXP * 384; it += 2 * NGW) moe_weight_pair(ldsl, 1, it, it + NGW, wgu, wd, scr, lane);
                  if (it < NEXP * 384) moe_weight_item(ldsl, 1, it, wgu, wd, scr, lane); }
                GRID_BAR();
            }
        }
    }
}

#undef out
#undef Y
#undef HS
#undef QKV
#undef HB
#undef ctl
extern "C" void kernel_launch(void* const* d_in, const int* in_sizes, int n_in, void* d_out, int out_size, void* d_ws, size_t ws_size, hipStream_t stream) {
    static int grid = 0;
    if (grid == 0) {
        if (n_in != 28 || in_sizes[0] != MXR * DM || out_size != MXR * DM || ws_size < WS_END) {
            fprintf(stderr, "kernel_launch: unexpected shapes: n_in %d in0 %d out %d ws %zu (need %zu)\n", n_in, n_in > 0 ? in_sizes[0] : -1, out_size, ws_size, (size_t)WS_END); grid = -1; return; }
        int dev = 0, cus = 0, per_cu = 0;
        if (hipGetDevice(&dev) != hipSuccess || hipDeviceGetAttribute(&cus, hipDeviceAttributeMultiprocessorCount, dev) != hipSuccess) { grid = -1; return; }
        if (hipFuncSetAttribute((const void*)fwd_megakernel, hipFuncAttributeMaxDynamicSharedMemorySize, LDS_BYTES) != hipSuccess) { fprintf(stderr, "kernel_launch: hipFuncSetAttribute failed\n"); grid = -1; return; }
        if (hipOccupancyMaxActiveBlocksPerMultiprocessor(&per_cu, (const void*)fwd_megakernel, 512, LDS_BYTES) != hipSuccess || per_cu < 1) { fprintf(stderr, "kernel_launch: occupancy query reports %d\n", per_cu); (void)hipGetLastError(); per_cu = 1; }
        grid = cus;
        if (grid > 256) grid = 256;
    }
    if (grid < 0) return;
    if (hipMemsetAsync((char*)d_ws + WS_CTL, 0, CTL_ZERO_BYTES, stream) != hipSuccess) { fprintf(stderr, "kernel_launch: memset failed\n"); return; }
    Args a{};
    for (int i = 0; i < 28; ++i) a.in[i] = (const float*)d_in[i];
    a.o_ = (float*)d_out; a.w_ = (unsigned char*)d_ws;
    hipLaunchKernelGGL(fwd_megakernel, dim3(grid), dim3(512), LDS_BYTES, stream, a);
    const hipError_t le = hipPeekAtLastError();
    if (le != hipSuccess) fprintf(stderr, "kernel_launch: launch failed: %s\n", hipGetErrorName(le));
}
```

```cpp
#include <hip/hip_runtime.h>
#include <hip/hip_bf16.h>
#include <cstdio>
#include <cstdint>
__device__ __forceinline__ int ltid(int wv) { int l; asm volatile("v_mbcnt_lo_u32_b32 %0, -1, 0\n\tv_mbcnt_hi_u32_b32 %0, -1, %0" : "=v"(l)); return wv * 64 + l; }
namespace pg8 {
#define PG8_LAS __attribute__((address_space(3)))
typedef unsigned short bf16_t;
typedef short bf16x8 __attribute__((ext_vector_type(8)));
typedef float f32x4 __attribute__((ext_vector_type(4)));
typedef unsigned u32x4 __attribute__((ext_vector_type(4)));
constexpr int BM = 256, BK = 64, HALF = 128, HTB = HALF * BK * 2  , STAGE_BYTES = 8 * HTB, NXCD = 8, WGM = 8;

__host__ __device__ __forceinline__ int lds_byte(int r, int c) { const int st = (r >> 4) * 2 + (c >> 5), rr = r & 15, cc = c & 31, ob = rr * 64 + cc * 2; return st * 1024 + (ob ^ (((ob >> 9) & 1) << 5)); }
__host__ __device__ __forceinline__ void stage_rc(int b, int& R, int& C) { const int st = b / 1024, sb = b % 1024, swz = sb ^ (((sb >> 9) & 1) << 5); R = (st >> 1) * 16 + swz / 64; C = (st & 1) * 32 + (swz % 64) / 2; }
__host__ __device__ __forceinline__ int perm32(int rho) { const int n = rho >> 4, i = rho & 15; return 8 * (i >> 2) + 4 * n + (i & 3); }

struct Unit { int pm, pn, hm; };
struct Gemm { const bf16_t* A; const bf16_t* Bt; int M, N, K; };

struct StaticOrder {
    int nM, nN, nwg, G, c;
    __host__ __device__ void init(int M, int N, int G_, int c_) { nM = M / BM; nN = N / BM; nwg = nM * nN; G = G_; c = c_; }
    __host__ __device__ bool next(int i, Unit& u) const { return at((long)i * G + c, u); }
    __host__ __device__ bool at(const long L, Unit& u) const {
        if (L >= nwg) return false; u.hm = 0;
        int wgid = (int)L; { const int q = nwg / NXCD, r = nwg % NXCD, xcd = wgid % NXCD, off = wgid / NXCD; wgid = (xcd < r ? xcd * (q + 1) : r * (q + 1) + (xcd - r) * q) + off; }
        const int nig = WGM * nN, gid = wgid / nig, fm = gid * WGM, gsz = (nM - fm) < WGM ? (nM - fm) : WGM;
        u.pm = fm + ((wgid % nig) % gsz); u.pn = (wgid % nig) / gsz; return true;
    }
    __device__ __forceinline__ void a_ready(const Unit&) const {}
    __device__ __forceinline__ void done(const Unit&) const {}
};

__device__ __forceinline__ unsigned cvt_pk_bf16(float lo, float hi) { unsigned r; asm volatile("v_cvt_pk_bf16_f32 %0, %1, %2" : "=v"(r) : "v"(lo), "v"(hi)); return r; }
typedef float f32x2 __attribute__((ext_vector_type(2)));
struct NoGather {};
struct GatherA { const int* tok; const PG8_LAS int* tbase; const PG8_LAS int* cnt; int NP, cap; };
template <class Epi, class Sched, bool ALIGN_EPI = false, bool SP2 = false, bool GATHER = false, class GAT = NoGather>
__device__ __forceinline__ void gemm_phase(PG8_LAS unsigned char* lds, const Gemm g, const Sched& S, const Epi& E, const int wv, const GAT& GA = GAT()) {
    static_assert(!GATHER || SP2, "gather staging is written for the SP2 loop");
    const int tid = ltid(wv), wid = wv, lane = tid & 63, wr = wid >> 2, wc = wid & 3, fr = lane & 15, fq = lane >> 4;
    const int K = g.K, nt = K / BK;
    unsigned voffA[2], voffB[2];
#pragma unroll
    for (int i = 0; i < 2; ++i) { int R, C; stage_rc(tid * 16 + i * 8192, R, C); const int Rb = Epi::PERM ? ((R & ~31) + perm32(R & 31)) : R;
        voffA[i] = (unsigned)(R * K + C) * 2u; voffB[i] = (unsigned)(Rb * K + C) * 2u; }
    const size_t kstep = (size_t)(BK * 2);
    const size_t hstep = (size_t)HALF * K * 2;
    const size_t tstep = 2 * hstep;
    const unsigned ldsw = (unsigned)wid * 1024u;
    const int aoff = lds_byte(wr * 64 + fr, fq * 8), boff = lds_byte(wc * 32 + fr, fq * 8);
#define PG8_SA(b, h) (((b) * 2 + (h)) * HTB)
#define PG8_SB(b, h) ((4 + (b) * 2 + (h)) * HTB)
#define PG8_STAGE(bufoff, gbase, voff) do { _Pragma("unroll") for (int _i = 0; _i < 2; ++_i) \
        __builtin_amdgcn_global_load_lds((const unsigned*)((const char*)(gbase) + (voff)[_i]), (PG8_LAS unsigned*)(lds + (bufoff) + ldsw + _i * 8192), 16, 0, 0); } while (0)
#define PG8_STAGE_A(bufoff, ngptr, h, kofs, GV) do { if constexpr (GATHER) { PG8_STAGE(bufoff, (const char*)g.A + (kofs), GV[h]); } else { PG8_STAGE(bufoff, ngptr, voffA); } } while (0)
#define PG8_GOFS(dst, U) do { if constexpr (GATHER) { const int e_ = (U).pn / GA.NP; const int rk0_ = ((U).pm - GA.tbase[e_]) * 256; const int c_ = GA.cnt[e_]; \
        _Pragma("unroll") for (int h_ = 0; h_ < 2; ++h_) _Pragma("unroll") for (int i_ = 0; i_ < 2; ++i_) { int R_, C_; stage_rc(tid * 16 + i_ * 8192, R_, C_); const int rk_ = rk0_ + h_ * 128 + R_; \
            const int tk_ = rk_ < c_ ? GA.tok[(size_t)e_ * GA.cap + rk_] : 0; dst[h_][i_] = (unsigned)(tk_ * K + C_) * 2u; } } } while (0)
#define PG8_LDA(dst, b, h) do { _Pragma("unroll") for (int m = 0; m < 4; ++m) _Pragma("unroll") for (int k = 0; k < 2; ++k) dst[m][k] = *(const PG8_LAS bf16x8*)(lds + PG8_SA(b, h) + aoff + m * 2048 + k * 1024); } while (0)
#define PG8_LDB(dst, b, h) do { _Pragma("unroll") for (int n = 0; n < 2; ++n) _Pragma("unroll") for (int k = 0; k < 2; ++k) dst[n][k] = *(const PG8_LAS bf16x8*)(lds + PG8_SB(b, h) + boff + n * 2048 + k * 1024); } while (0)
#define PG8_MMA(ai, bj, At, Bt) do { if (cur.hm != 0 && cur.hm != (ai) + 1) break; __builtin_amdgcn_s_setprio(1); _Pragma("unroll") for (int m = 0; m < 4; ++m) _Pragma("unroll") for (int n = 0; n < 2; ++n) _Pragma("unroll") for (int k = 0; k < 2; ++k) \
        acc[ai][bj][m][n] = __builtin_amdgcn_mfma_f32_16x16x32_bf16(Bt[n][k], At[m][k], acc[ai][bj][m][n], 0, 0, 0); __builtin_amdgcn_s_setprio(0); } while (0)
#define PG8_WAIT_V(n) asm volatile("s_waitcnt vmcnt(" #n ")" ::: "memory")
#define PG8_WAIT_L(n) asm volatile("s_waitcnt lgkmcnt(" #n ")" ::: "memory")
#define PG8_BAR __builtin_amdgcn_s_barrier()
#define PG8_SCHED __builtin_amdgcn_sched_barrier(0)
    Unit cur, nxt; int ui = 0;
    if (!S.next(0, cur)) return;
    f32x4 acc[2][2][4][2];
#pragma unroll
    for (int a = 0; a < 2; ++a)
#pragma unroll
        for (int b = 0; b < 2; ++b)
#pragma unroll
            for (int m = 0; m < 4; ++m)
#pragma unroll
                for (int n = 0; n < 2; ++n) acc[a][b][m][n] = (f32x4){0.f, 0.f, 0.f, 0.f};
    bf16x8 At[4][2], B0[2][2], B1[2][2];
    const char* cA = (const char*)g.A + (size_t)cur.pm * tstep; const char* cB = (const char*)g.Bt + (size_t)cur.pn * tstep;
    S.a_ready(cur);
    unsigned curG[2][2] = {{0u, 0u}, {0u, 0u}}, nxtG[2][2] = {{0u, 0u}, {0u, 0u}};
    PG8_GOFS(curG, cur); { Unit n0_; if (S.next(1, n0_)) PG8_GOFS(nxtG, n0_); }
    if constexpr (SP2) {
        PG8_STAGE(PG8_SB(0, 0), cB, voffB); PG8_STAGE(PG8_SB(0, 1), cB + hstep, voffB); PG8_STAGE_A(PG8_SA(0, 0), cA, 0, (size_t)0, curG); PG8_STAGE_A(PG8_SA(0, 1), cA + hstep, 1, (size_t)0, curG);
        if (wr == 1) PG8_BAR;
        PG8_WAIT_V(2); PG8_BAR;
        PG8_STAGE(PG8_SB(1, 0), cB + kstep, voffB); PG8_STAGE_A(PG8_SA(1, 0), cA + kstep, 0, kstep, curG); PG8_STAGE(PG8_SB(1, 1), cB + hstep + kstep, voffB);
        PG8_WAIT_V(6); PG8_BAR;
    } else {
        PG8_STAGE(PG8_SB(0, 0), cB, voffB); PG8_STAGE(PG8_SA(0, 0), cA, voffA); PG8_STAGE(PG8_SB(0, 1), cB + hstep, voffB); PG8_STAGE(PG8_SA(0, 1), cA + hstep, voffA);
        if (wr == 1) PG8_BAR;
        PG8_WAIT_V(4); PG8_BAR;
        PG8_STAGE(PG8_SB(1, 0), cB + kstep, voffB); PG8_STAGE(PG8_SA(1, 0), cA + kstep, voffA); PG8_STAGE(PG8_SB(1, 1), cB + hstep + kstep, voffB);
        PG8_WAIT_V(6); PG8_BAR;
    }
    for (;;) {
        const bool has_next = S.next(ui + 1, nxt);
        if (GATHER && has_next && ui >= 1) PG8_GOFS(nxtG, nxt);
        const char* nA = has_next ? (const char*)g.A + (size_t)nxt.pm * tstep : cA; const char* nB = has_next ? (const char*)g.Bt + (size_t)nxt.pn * tstep : cB;
        for (int t = 0; t < nt; t += 2) {
            const bool last = (t == nt - 2);
            const char* a1 = cA + (size_t)(t + 1) * kstep;
            const char* a2 = last ? nA : cA + (size_t)(t + 2) * kstep; const char* b2 = last ? nB : cB + (size_t)(t + 2) * kstep;
            const char* a3 = a2 + kstep; const char* b3 = b2 + kstep;
            if (last && has_next) S.a_ready(nxt);
            const size_t k1o = (size_t)(t + 1) * kstep, k2o = last ? (size_t)0 : (size_t)(t + 2) * kstep; unsigned selG[2][2];
            _Pragma("unroll") for (int h_ = 0; h_ < 2; ++h_) _Pragma("unroll") for (int i_ = 0; i_ < 2; ++i_) selG[h_][i_] = (last && has_next) ? nxtG[h_][i_] : curG[h_][i_];
            if constexpr (SP2) {
            PG8_LDB(B0, 0, 0); PG8_LDB(B1, 0, 1); PG8_SCHED; PG8_LDA(At, 0, 0); PG8_STAGE_A(PG8_SA(1, 1), a1 + hstep, 1, k1o, curG);
            PG8_WAIT_V(8); PG8_WAIT_L(0); PG8_BAR; PG8_MMA(0, 0, At, B0); PG8_MMA(0, 1, At, B1); PG8_BAR; PG8_SCHED;
            PG8_LDA(At, 0, 1); PG8_STAGE(PG8_SB(0, 0), b2, voffB); PG8_STAGE(PG8_SB(0, 1), b2 + hstep, voffB); PG8_STAGE_A(PG8_SA(0, 0), a2, 0, k2o, selG);
            PG8_WAIT_V(8); PG8_WAIT_L(0); PG8_BAR; PG8_MMA(1, 0, At, B0); PG8_MMA(1, 1, At, B1); PG8_BAR; PG8_SCHED;
            PG8_LDB(B0, 1, 0); PG8_LDB(B1, 1, 1); PG8_SCHED; PG8_LDA(At, 1, 0); PG8_STAGE_A(PG8_SA(0, 1), a2 + hstep, 1, k2o, selG);
            PG8_WAIT_V(8); PG8_WAIT_L(0); PG8_BAR; PG8_MMA(0, 0, At, B0); PG8_MMA(0, 1, At, B1); PG8_BAR; PG8_SCHED;
            PG8_LDA(At, 1, 1); PG8_STAGE(PG8_SB(1, 0), b3, voffB); PG8_STAGE(PG8_SB(1, 1), b3 + hstep, voffB); PG8_STAGE_A(PG8_SA(1, 0), a3, 0, k2o + kstep, selG);
            PG8_WAIT_V(8); PG8_WAIT_L(0); PG8_BAR; PG8_MMA(1, 0, At, B0); PG8_MMA(1, 1, At, B1); PG8_BAR; PG8_SCHED;
            } else {
            PG8_LDB(B0, 0, 0); PG8_SCHED; PG8_LDA(At, 0, 0); PG8_STAGE(PG8_SA(1, 1), a1 + hstep, voffA);
            PG8_WAIT_L(8); PG8_BAR; PG8_WAIT_L(0); PG8_MMA(0, 0, At, B0); PG8_BAR; PG8_SCHED;
            PG8_LDB(B1, 0, 1); PG8_STAGE(PG8_SB(0, 0), b2, voffB);
            PG8_BAR; PG8_WAIT_L(0); PG8_MMA(0, 1, At, B1); PG8_BAR;
            PG8_LDA(At, 0, 1); PG8_STAGE(PG8_SA(0, 0), a2, voffA);
            PG8_BAR; PG8_WAIT_L(0); PG8_MMA(1, 0, At, B0); PG8_BAR; PG8_SCHED;
            PG8_STAGE(PG8_SB(0, 1), b2 + hstep, voffB);
            PG8_WAIT_V(6); PG8_BAR; PG8_MMA(1, 1, At, B1); PG8_BAR;
            PG8_LDB(B0, 1, 0); PG8_SCHED; PG8_LDA(At, 1, 0); PG8_STAGE(PG8_SA(0, 1), a2 + hstep, voffA);
            PG8_WAIT_L(8); PG8_BAR; PG8_WAIT_L(0); PG8_MMA(0, 0, At, B0); PG8_BAR; PG8_SCHED;
            PG8_LDB(B1, 1, 1); PG8_STAGE(PG8_SB(1, 0), b3, voffB);
            PG8_BAR; PG8_WAIT_L(0); PG8_MMA(0, 1, At, B1); PG8_BAR;
            PG8_LDA(At, 1, 1); PG8_STAGE(PG8_SA(1, 0), a3, voffA);
            PG8_BAR; PG8_WAIT_L(0); PG8_MMA(1, 0, At, B0); PG8_BAR; PG8_SCHED;
            PG8_STAGE(PG8_SB(1, 1), b3 + hstep, voffB);
            PG8_WAIT_V(6); PG8_BAR; PG8_MMA(1, 1, At, B1); PG8_BAR;
            }
        }
        if constexpr (ALIGN_EPI) { if (wr == 0) PG8_BAR; }
        if constexpr (!Epi::AFTER_DRAIN) { E(acc, cur, wr, wc, fr, fq); S.done(cur); }
        if (!has_next) break;
#pragma unroll
        for (int a = 0; a < 2; ++a)
#pragma unroll
            for (int b = 0; b < 2; ++b)
#pragma unroll
                for (int m = 0; m < 4; ++m)
#pragma unroll
                    for (int n = 0; n < 2; ++n) acc[a][b][m][n] = (f32x4){0.f, 0.f, 0.f, 0.f};
        cur = nxt; cA = nA; cB = nB; ++ui;
        _Pragma("unroll") for (int h_ = 0; h_ < 2; ++h_) _Pragma("unroll") for (int i_ = 0; i_ < 2; ++i_) curG[h_][i_] = nxtG[h_][i_];
        if constexpr (ALIGN_EPI) { if (wr == 1) PG8_BAR; }
    }
    PG8_WAIT_V(0);
    if constexpr (!ALIGN_EPI) { if (wr == 0) PG8_BAR; }
    PG8_BAR;
    if constexpr (Epi::AFTER_DRAIN) { E.fused(acc, cur, wr, wc, fr, fq, lds, wid, lane); S.done(cur); }
#undef PG8_SA
#undef PG8_SB
#undef PG8_STAGE
#undef PG8_LDA
#undef PG8_STAGE_A
#undef PG8_GOFS
#undef PG8_LDB
#undef PG8_MMA
#undef PG8_WAIT_V
#undef PG8_WAIT_L
#undef PG8_BAR
#undef PG8_SCHED
}
}

constexpr int NB = 8, NXT = 2048, LCT = 256, TT = 2304, DM = 1024;
constexpr int MALL = NB * TT;
constexpr int MXR = NB * NXT;
constexpr int NQKV0 = 3072, NQKV1 = 1536;
constexpr int NEXP = 32, FH = 256, NMOD = 6144;
constexpr float ALPHA = 1.41421356237309515f;
constexpr float LAMBDA_INIT0 = 0.2f;
constexpr float LN_EPS = 1e-5f, RMS_EPS = 1e-6f;
constexpr int SORT_ROWS = 45056;

#define GAS __attribute__((address_space(1)))
#define LAS __attribute__((address_space(3)))
typedef unsigned short bf16_t;
typedef unsigned v4u __attribute__((ext_vector_type(4)));
typedef unsigned v2u __attribute__((ext_vector_type(2)));
typedef float f32x4 __attribute__((ext_vector_type(4)));
typedef float f32x2 __attribute__((ext_vector_type(2)));
typedef short bf16x8 __attribute__((ext_vector_type(8)));
typedef short s16x4 __attribute__((ext_vector_type(4)));
typedef float f32x16 __attribute__((ext_vector_type(16)));
typedef GAS unsigned gu32;
#define RLX_AGENT __ATOMIC_RELAXED, __HIP_MEMORY_SCOPE_AGENT
#define LDS_WAIT() asm volatile("s_waitcnt lgkmcnt(0)" ::: "memory")
#define VM_WAIT() asm volatile("s_waitcnt vmcnt(0)" ::: "memory")

constexpr size_t MiB = 1u << 20;
constexpr size_t WS_CTL = 0, CTL_ZERO_BYTES = 1 * MiB;
constexpr size_t WS_MOD = 1 * MiB;
constexpr size_t WS_TAB64 = 1 * MiB + 512 * 1024;
constexpr size_t WS_TAB128 = WS_TAB64 + 8192;
constexpr size_t WS_WRT = WS_TAB64 + 65536;
constexpr size_t WS_TOKINFO = 2 * MiB;
constexpr size_t WS_TOKW = WS_TOKINFO + (size_t)MALL * 16;
constexpr size_t WS_TOKPOS = WS_TOKW + (size_t)MALL * 8;
constexpr size_t WS_GW = 3 * MiB;
constexpr size_t WS_XRC = 4 * MiB;
constexpr size_t WS_WQKV0 = 12 * MiB, WS_WO0 = 18 * MiB, WS_WQKV1 = 20 * MiB, WS_WO1 = 23 * MiB;
constexpr size_t WS_WGU = 26 * MiB;
constexpr size_t WS_WD = 58 * MiB;
constexpr size_t WS_HBUF = 74 * MiB;
constexpr size_t WS_QKV = 110 * MiB;
constexpr size_t WS_R1 = WS_QKV + 66 * MiB;
constexpr size_t WS_Y = 218 * MiB;
constexpr size_t WS_TOKOF = 306 * MiB;
constexpr size_t WS_GWOF = 309 * MiB;
constexpr int ECAP = 18432;
constexpr size_t WS_STATS = 312 * MiB;
constexpr size_t WS_ROWST = 315 * MiB;
constexpr size_t WS_YOFF = WS_QKV + 24 * MiB;
constexpr size_t WS_WRS = 316 * MiB;
constexpr size_t WS_END = 317 * MiB;
static_assert(WS_TOKPOS + (size_t)MALL * 8 <= WS_GW && WS_GW + SORT_ROWS * 4 <= WS_XRC && WS_XRC + 2048 * 4096 <= WS_WQKV0, "ws map");
static_assert(WS_YOFF + (size_t)MALL * DM * 4 <= WS_Y && (size_t)SORT_ROWS * FH * 2 <= 24 * MiB && WS_QKV + (size_t)MALL * 3072 * 2 <= WS_Y && WS_Y + (size_t)SORT_ROWS * 2048 <= WS_END && WS_HBUF + (size_t)MALL * 2048 <= WS_QKV, "ws map");
constexpr int CW_BAR = 4096;
constexpr int CW_CNT = 8192;

constexpr int RING_BYTES = 131072;
constexpr int MISC_OFF = 139264;
constexpr int TILEE_OFF = MISC_OFF + 256;
constexpr int ROWB_OFF = MISC_OFF + 512;
constexpr int LDS_BYTES = 147456;

__device__ __forceinline__ unsigned cvtpk(float lo, float hi) { unsigned r; asm volatile("v_cvt_pk_bf16_f32 %0, %1, %2" : "=v"(r) : "v"(lo), "v"(hi)); return r; }
__device__ __forceinline__ float bf_lo(unsigned u) { return __uint_as_float(u << 16); }
__device__ __forceinline__ float bf_hi(unsigned u) { return __uint_as_float(u & 0xffff0000u); }
template <int M> __device__ __forceinline__ float xsum(float v) {
    if constexpr (M < 32) return v + __int_as_float(__builtin_amdgcn_ds_swizzle(__float_as_int(v), (M << 10) | 0x1f));
    else { auto rr = __builtin_amdgcn_permlane32_swap(__float_as_uint(v), __float_as_uint(v), false, false); return __uint_as_float(rr[0]) + __uint_as_float(rr[1]); }
}
__device__ __forceinline__ float sum32(float v) { v = xsum<1>(v); v = xsum<2>(v); v = xsum<4>(v); v = xsum<8>(v); v = xsum<16>(v); return v; }
__device__ __forceinline__ float wave_sum(float v) { return xsum<32>(sum32(v)); }
__device__ __forceinline__ int row_b(int r) { return r / TT; }
__device__ __forceinline__ float* xr_ptr(float* out, float* xrc, int r) {
    const int b = r / TT, t = r - b * TT;
    return t < LCT ? xrc + ((size_t)b * LCT + t) * DM : out + ((size_t)b * NXT + (t - LCT)) * DM;
}
__device__ __forceinline__ const float* in0_ptr(const float* x, const float* ctx, int r) {
    const int b = r / TT, t = r - b * TT;
    return t < LCT ? ctx + ((size_t)b * LCT + t) * DM : x + ((size_t)b * NXT + (t - LCT)) * DM;
}

#define XB_TMO      128
#define XB_XCNT(j)  (256  + 64 * (j))
#define XB_XSUB(j)  (1280 + 64 * (j))
#define XB_XGEN(j)  (2304 + 64 * (j))
#define XB_TOP      3328
#define XB_TOPGEN   3392
#define XCD_BAR_WORDS 3456
#define XB_SPIN_CAP (1u << 18)
__device__ __forceinline__ unsigned xb_ld(unsigned* p)              { return __hip_atomic_load(p, __ATOMIC_RELAXED, __HIP_MEMORY_SCOPE_AGENT); }
__device__ __forceinline__ unsigned xb_add(unsigned* p, unsigned v) { return __hip_atomic_fetch_add(p, v, __ATOMIC_RELAXED, __HIP_MEMORY_SCOPE_AGENT); }
__device__ __forceinline__ unsigned xb_xcc_id() { return (unsigned)__builtin_amdgcn_s_getreg((3 << 11) | 20) & 0xFu; }
#define XB_SPIN(cond, bar) do { unsigned _sp = 0; while (cond) { __builtin_amdgcn_s_sleep(1); \
    if ((++_sp & 255u) == 0u) { if (xb_ld(&(bar)[XB_TMO])) break; if (_sp > XB_SPIN_CAP) { atomicAdd(&(bar)[XB_TMO], 1u); break; } } } } while (0)
__device__ __forceinline__ void xcd_barrier_post(unsigned* bar) {
    const unsigned x = xb_xcc_id();
    if (threadIdx.x == 0) (void)xb_add(&bar[XB_XCNT(x)], 1u);
}
__device__ __forceinline__ void xcd_barrier_complete(unsigned* bar, unsigned x, unsigned& nloc, unsigned& nx) {
    const unsigned G = gridDim.x * gridDim.y * gridDim.z;
    unsigned sum, cnt, mine, sp = 0u;
    for (;;) {
        sum = 0u; cnt = 0u; mine = 0u;
#pragma unroll
        for (unsigned j = 0; j < 16; ++j) { const unsigned c = xb_ld(&bar[XB_XCNT(j)]); sum += c; cnt += (c > 0u) ? 1u : 0u; mine = (j == x) ? c : mine; }
        if (sum == G) break;
        __builtin_amdgcn_s_sleep(1);
        if ((++sp & 255u) == 0u) { if (xb_ld(&bar[XB_TMO])) break; if (sp > XB_SPIN_CAP) { atomicAdd(&bar[XB_TMO], 1u); break; } }
    }
    nloc = mine > 0u ? mine : 1u; nx = cnt > 0u ? cnt : 1u;
}
__device__ __forceinline__ void xcd_barrier(unsigned* bar_in, volatile LAS unsigned* st, bool leader) {
    asm volatile("s_waitcnt vmcnt(0)" ::: "memory");
    __syncthreads();
    if (leader) {
        unsigned* bar = bar_in;
        unsigned bx_ = xb_xcc_id(); asm volatile("" : "+s"(bx_));
        __builtin_amdgcn_s_waitcnt(0);
        unsigned nloc = st[0], nx = st[1];
        if (nloc == 0u) { xcd_barrier_complete(bar, bx_, nloc, nx); st[0] = nloc; st[1] = nx; }
        const unsigned old = xb_add(&bar[XB_XSUB(bx_)], 1u);
        const unsigned gen = old / nloc;
        if (old + 1u == (gen + 1u) * nloc) {
            __builtin_amdgcn_fence(__ATOMIC_RELEASE, "agent");
            asm volatile("s_waitcnt vmcnt(0)" ::: "memory");
            const unsigned og = xb_add(&bar[XB_TOP], 1u);
            const unsigned tg = og / nx;
            if (og + 1u == (tg + 1u) * nx) xb_add(&bar[XB_TOPGEN], 1u);
            else XB_SPIN(xb_ld(&bar[XB_TOPGEN]) == tg, bar);
            __builtin_amdgcn_fence(__ATOMIC_ACQUIRE, "agent");
            asm volatile("s_waitcnt vmcnt(0)" ::: "memory");
        } else {
            XB_SPIN(xb_ld(&bar[XB_TOPGEN]) == gen, bar);
            __builtin_amdgcn_fence(__ATOMIC_ACQUIRE, "agent");
            asm volatile("s_waitcnt vmcnt(0)" ::: "memory");
        }
    }
    __syncthreads();
}

struct SchedRect {
    pg8::StaticOrder so; int xonly, n_extra, G, c, full, rsplit;
    __device__ void init(int nMt, int N, int G_, int c_, int xonly_, int n_extra_) { so.init(nMt * 256, N, G_, c_); xonly = xonly_; n_extra = n_extra_; G = G_; c = c_;
        const int r = so.nwg % G; full = so.nwg - r; rsplit = (n_extra == 0 && r > 0 && 2 * r <= G) ? r : 0; }
    __device__ bool next(int i, pg8::Unit& u) const {
        const long L = (long)i * G + c;
        if (rsplit && L >= full) { const int j = (int)(L - full); if (j >= 2 * rsplit) return false;
            so.at(full + (j >> 1), u); u.hm = 1 + (j & 1); if (xonly) u.pm = (u.pm >> 3) * 9 + 1 + (u.pm & 7); return true; }
        if (L < so.nwg) { so.at(L, u); if (xonly) u.pm = (u.pm >> 3) * 9 + 1 + (u.pm & 7); return true; }
        const int j = (int)(L - so.nwg); if (j >= n_extra) return false;
        u.pm = (j >> 1) * 9; u.pn = 4 + (j & 1); u.hm = 0; return true;
    }
    __device__ __forceinline__ void a_ready(const pg8::Unit&) const {}
    __device__ __forceinline__ void done(const pg8::Unit&) const {}
};
struct SchedExp {
    const LAS unsigned char* tile_e; int NP, nunits, G, c;
    __device__ bool next(int i, pg8::Unit& u) const {
        long L = (long)i * G + c; int hm = 0;
        const int rr = nunits % G, full = nunits - rr;
        if (rr > 0 && 2 * rr <= G && L >= full) { const int j = (int)(L - full); if (j >= 2 * rr) return false; L = full + (j >> 1); hm = 1 + (j & 1); }
        if (L >= nunits) return false;
        const int q = nunits / 8, r = nunits % 8, xcd = (int)(L % 8), off = (int)(L / 8);
        const int Lr = (xcd < r ? xcd * (q + 1) : r * (q + 1) + (xcd - r) * q) + off;
        const int tm = Lr / NP, pl = Lr % NP;
        u.pm = tm; u.pn = (int)tile_e[tm] * NP + pl; u.hm = hm; return true;
    }
    __device__ __forceinline__ void a_ready(const pg8::Unit&) const {}
    __device__ __forceinline__ void done(const pg8::Unit&) const {}
};

struct EpiStoreBf16 {
    static constexpr bool PERM = true, AFTER_DRAIN = false;
    bf16_t* O; int ldc; int pn_mask; const f32x2* tab; const float* kg; LAS float* xch;
    __device__ __forceinline__ void operator()(const pg8::f32x4 (&acc)[2][2][4][2], const pg8::Unit& u, int wr, int wc, int fr_in, int fq_in) const {
        int fr = fr_in, fq = fq_in; asm volatile("" : "+v"(fr), "+v"(fq));
        const int row0 = u.pm * 256 + wr * 64 + fr;
        if (kg == nullptr && tab != nullptr && u.pn >= 4 && u.pn < 8) {
            const int tj = u.pm % 9; const bool lat = tj != 0; const int nbase = (tj - 1) * 256 + wr * 64 + fr;
            const int ax = fq >> 1, f0 = (fq & 1) * 8; const int col0 = u.pn * 256 + wc * 64 + ax * 32 + f0;
#pragma unroll
            for (int ai = 0; ai < 2; ++ai) { if (u.hm != 0 && u.hm != ai + 1) continue;
#pragma unroll
                for (int m = 0; m < 4; ++m) { bf16_t* rowp = O + (size_t)(row0 + ai * 128 + m * 16) * ldc + col0;
                    float x1[8], x2[8];
#pragma unroll
                    for (int n = 0; n < 2; ++n)
#pragma unroll
                        for (int q = 0; q < 4; ++q) { x1[n * 4 + q] = acc[ai][0][m][n][q]; x2[n * 4 + q] = acc[ai][1][m][n][q]; }
                    if (lat) { const int nr = nbase + ai * 128 + m * 16; const int pos = ax ? (nr & 63) : (nr >> 6);
                        const pg8::f32x4* tp = (const pg8::f32x4*)(tab + pos * 16 + f0);
#pragma unroll
                        for (int q = 0; q < 4; ++q) { const pg8::f32x4 cs = tp[q];
                            const float a0 = x1[2 * q], b0 = x2[2 * q], a1 = x1[2 * q + 1], b1 = x2[2 * q + 1];
                            x1[2 * q] = a0 * cs[0] - b0 * cs[1]; x2[2 * q] = b0 * cs[0] + a0 * cs[1];
                            x1[2 * q + 1] = a1 * cs[2] - b1 * cs[3]; x2[2 * q + 1] = b1 * cs[2] + a1 * cs[3]; } }
                    v4u w; w.x = cvtpk(x1[0], x1[1]); w.y = cvtpk(x1[2], x1[3]); w.z = cvtpk(x1[4], x1[5]); w.w = cvtpk(x1[6], x1[7]);
                    *(v4u*)rowp = w;
                    w.x = cvtpk(x2[0], x2[1]); w.y = cvtpk(x2[2], x2[3]); w.z = cvtpk(x2[4], x2[5]); w.w = cvtpk(x2[6], x2[7]);
                    *(v4u*)(rowp + 16) = w; } }
            return;
        }
        if (kg != nullptr && u.pn == 4) {
            const int tj = u.pm % 9; const bool lat = tj != 0; const int nbase = (tj - 1) * 256 + wr * 64 + fr;
            const int hl = wc >> 1, ax = wc & 1, f0 = 8 * fq; const int col0k = 1024 + hl * 128 + ax * 64 + f0; const int wid = wr * 4 + wc;
            float ssq[2][4];
#pragma unroll
            for (int ai = 0; ai < 2; ++ai)
#pragma unroll
                for (int m = 0; m < 4; ++m) { float s = 0.f;
#pragma unroll
                    for (int bj = 0; bj < 2; ++bj)
#pragma unroll
                        for (int n = 0; n < 2; ++n)
#pragma unroll
                            for (int q = 0; q < 4; ++q) s += acc[ai][bj][m][n][q] * acc[ai][bj][m][n][q];
                    s = xsum<16>(s); s = xsum<32>(s);
                    ssq[ai][m] = s; if (fq == 0) xch[wid * 128 + ai * 64 + m * 16 + fr] = s; }
            asm volatile("s_waitcnt lgkmcnt(0)" ::: "memory"); __builtin_amdgcn_s_barrier(); asm volatile("" ::: "memory");
            const float g00 = 0.f; (void)g00;
            pg8::f32x4 gA[2][2];
#pragma unroll
            for (int bj = 0; bj < 2; ++bj)
#pragma unroll
                for (int n = 0; n < 2; ++n) gA[bj][n] = *(const pg8::f32x4*)(kg + ax * 64 + bj * 32 + f0 + 4 * n);
#pragma unroll
            for (int ai = 0; ai < 2; ++ai) { if (u.hm != 0 && u.hm != ai + 1) continue;
#pragma unroll
                for (int m = 0; m < 4; ++m) { bf16_t* rowp = O + (size_t)(row0 + ai * 128 + m * 16) * ldc + col0k;
                    const float tot = ssq[ai][m] + xch[(wid ^ 1) * 128 + ai * 64 + m * 16 + fr];
                    const float rs = 1.0f / sqrtf(tot * (1.f / 128.f) + RMS_EPS);
                    float x1[8], x2[8];
#pragma unroll
                    for (int n = 0; n < 2; ++n)
#pragma unroll
                        for (int q = 0; q < 4; ++q) { x1[n * 4 + q] = acc[ai][0][m][n][q] * rs * gA[0][n][q]; x2[n * 4 + q] = acc[ai][1][m][n][q] * rs * gA[1][n][q]; }
                    if (lat) { const int nr = nbase + ai * 128 + m * 16; const int pos = ax ? (nr & 63) : (nr >> 6);
                        const pg8::f32x4* tp = (const pg8::f32x4*)(tab + pos * 32 + f0);
#pragma unroll
                        for (int q = 0; q < 4; ++q) { const pg8::f32x4 cs = tp[q];
                            const float a0 = x1[2 * q], b0 = x2[2 * q], a1 = x1[2 * q + 1], b1 = x2[2 * q + 1];
                            x1[2 * q] = a0 * cs[0] - b0 * cs[1]; x2[2 * q] = b0 * cs[0] + a0 * cs[1];
                            x1[2 * q + 1] = a1 * cs[2] - b1 * cs[3]; x2[2 * q + 1] = b1 * cs[2] + a1 * cs[3]; } }
                    v4u w; w.x = cvtpk(x1[0], x1[1]); w.y = cvtpk(x1[2], x1[3]); w.z = cvtpk(x1[4], x1[5]); w.w = cvtpk(x1[6], x1[7]);
                    *(v4u*)rowp = w;
                    w.x = cvtpk(x2[0], x2[1]); w.y = cvtpk(x2[2], x2[3]); w.z = cvtpk(x2[4], x2[5]); w.w = cvtpk(x2[6], x2[7]);
                    *(v4u*)(rowp + 32) = w; } }
            asm volatile("s_waitcnt lgkmcnt(0)" ::: "memory"); __builtin_amdgcn_s_barrier(); asm volatile("" ::: "memory");
            return;
        }
        const int col0 = (u.pn & pn_mask) * 256 + wc * 32 + 8 * fq;
#pragma unroll
        for (int ai = 0; ai < 2; ++ai) { if (u.hm != 0 && u.hm != ai + 1) continue;
#pragma unroll
            for (int m = 0; m < 4; ++m) { bf16_t* rowp = O + (size_t)(row0 + ai * 128 + m * 16) * ldc + col0;
#pragma unroll
                for (int bj = 0; bj < 2; ++bj) { const pg8::f32x4 v0 = acc[ai][bj][m][0], v1 = acc[ai][bj][m][1];
                    v4u w; w.x = cvtpk(v0[0], v0[1]); w.y = cvtpk(v0[2], v0[3]); w.z = cvtpk(v1[0], v1[1]); w.w = cvtpk(v1[2], v1[3]);
                    *(v4u*)(rowp + bj * 128) = w; } } }
    }
};
typedef _Float16 hf_t;
typedef _Float16 hf2_t __attribute__((ext_vector_type(2)));
__device__ __forceinline__ unsigned pkh(float a, float b_) { const hf2_t v = {(hf_t)a, (hf_t)b_}; return __builtin_bit_cast(unsigned, v); }
__device__ __forceinline__ float hf_lo(unsigned u) { const hf2_t v = __builtin_bit_cast(hf2_t, u); return (float)v[0]; }
__device__ __forceinline__ float hf_hi(unsigned u) { const hf2_t v = __builtin_bit_cast(hf2_t, u); return (float)v[1]; }
template <int RH>
struct EpiResid {
    static constexpr bool PERM = true, AFTER_DRAIN = false;
    hf_t* Y; const float* xbase; const float* cbase; const float* modl; f32x2* stats;
    __device__ __forceinline__ void operator()(const pg8::f32x4 (&acc)[2][2][4][2], const pg8::Unit& u, int wr, int wc, int fr_in, int fq_in) const {
        int fr = fr_in, fq = fq_in; asm volatile("" : "+v"(fr), "+v"(fq));
        const int b = u.pm / 9, j = u.pm - b * 9;
        const size_t roff0 = (j == 0) ? (size_t)b * LCT * DM : ((size_t)b * NXT + (size_t)(j - 1) * 256) * DM;
        const float* rb = ((j == 0) ? cbase : xbase) + roff0; const hf_t* rbh = (const hf_t*)xbase + (RH == 2 ? (size_t)u.pm * 256 * DM : roff0);
        const float* g = modl + (size_t)(j == 0 ? 8 : b) * NMOD + 2048;
        const int col0 = u.pn * 256 + wc * 32 + 8 * fq;
        pg8::f32x4 gv[2][2];
#pragma unroll
        for (int bj = 0; bj < 2; ++bj)
#pragma unroll
            for (int n = 0; n < 2; ++n) gv[bj][n] = *(const pg8::f32x4*)(g + col0 + bj * 128 + n * 4);
#pragma unroll
        for (int ai = 0; ai < 2; ++ai) { if (u.hm != 0 && u.hm != ai + 1) continue;
            v4u rvh4[4][2];
            if constexpr (RH != 0) {
#pragma unroll
                for (int m4 = 0; m4 < 4; ++m4)
#pragma unroll
                    for (int bj = 0; bj < 2; ++bj) rvh4[m4][bj] = *(const v4u*)(rbh + (size_t)(ai * 128 + wr * 64 + m4 * 16 + fr) * DM + col0 + bj * 128); }
#pragma unroll
            for (int mh = 0; mh < 2; ++mh) {
            pg8::f32x4 rva[2][2][2];
            if constexpr (RH == 0) {
#pragma unroll
            for (int mm = 0; mm < 2; ++mm) { const size_t ro = (size_t)(ai * 128 + wr * 64 + (2 * mh + mm) * 16 + fr) * DM + col0;
#pragma unroll
                for (int bj = 0; bj < 2; ++bj)
#pragma unroll
                    for (int n = 0; n < 2; ++n) rva[mm][bj][n] = *(const pg8::f32x4*)(rb + ro + bj * 128 + n * 4); } }
#pragma unroll
            for (int mm = 0; mm < 2; ++mm) { const int m = 2 * mh + mm; const int lr = ai * 128 + wr * 64 + m * 16 + fr;
                hf_t* yrow = Y + ((size_t)u.pm * 256 + lr) * DM + col0;
                float s = 0.f, q = 0.f;
#pragma unroll
                for (int bj = 0; bj < 2; ++bj) {
                    if constexpr (RH != 0) { const v4u h = rvh4[m][bj]; rva[mm][bj][0] = (pg8::f32x4){hf_lo(h.x), hf_hi(h.x), hf_lo(h.y), hf_hi(h.y)}; rva[mm][bj][1] = (pg8::f32x4){hf_lo(h.z), hf_hi(h.z), hf_lo(h.w), hf_hi(h.w)}; }
                    const pg8::f32x4 o0 = rva[mm][bj][0] * ALPHA + gv[bj][0] * acc[ai][bj][m][0], o1 = rva[mm][bj][1] * ALPHA + gv[bj][1] * acc[ai][bj][m][1];
                    s += ((o0[0] + o0[1]) + (o0[2] + o0[3])) + ((o1[0] + o1[1]) + (o1[2] + o1[3]));
                    q += ((o0[0] * o0[0] + o0[1] * o0[1]) + (o0[2] * o0[2] + o0[3] * o0[3])) + ((o1[0] * o1[0] + o1[1] * o1[1]) + (o1[2] * o1[2] + o1[3] * o1[3]));
                    v4u w; w.x = pkh(o0[0], o0[1]); w.y = pkh(o0[2], o0[3]); w.z = pkh(o1[0], o1[1]); w.w = pkh(o1[2], o1[3]);
                    *(v4u*)(yrow + bj * 128) = w; }
                s = xsum<16>(s); q = xsum<16>(q); s = xsum<32>(s); q = xsum<32>(q);
                if (fq == 0) stats[((size_t)u.pm * 256 + lr) * 16 + u.pn * 4 + wc] = (f32x2){s, q}; } } }
    }
};
struct EpiGateUp {
    static constexpr bool PERM = true, AFTER_DRAIN = false;
    bf16_t* ACT; const float* gwof; const LAS int* tbase;
    __device__ __forceinline__ void operator()(const pg8::f32x4 (&acc)[2][2][4][2], const pg8::Unit& u, int wr, int wc, int fr_in, int fq_in) const {
        int fr = fr_in, fq = fq_in; asm volatile("" : "+v"(fr), "+v"(fq));
        const int e = u.pn >> 1; const float* gwe = gwof + (size_t)e * ECAP + (u.pm - tbase[e]) * 256;
        const int lr0 = wr * 64 + fr; const int f0 = (u.pn & 1) * 128 + wc * 32 + 8 * fq;
#pragma unroll
        for (int ai = 0; ai < 2; ++ai) { if (u.hm != 0 && u.hm != ai + 1) continue;
#pragma unroll
            for (int m = 0; m < 4; ++m) { const int lr = lr0 + ai * 128 + m * 16; const float gw = gwe[lr];
                float o[8];
#pragma unroll
                for (int n = 0; n < 2; ++n)
#pragma unroll
                    for (int q = 0; q < 4; ++q) { const float a = acc[ai][0][m][n][q], up = acc[ai][1][m][n][q];
                        o[n * 4 + q] = a * __builtin_amdgcn_rcpf(1.f + __expf(-a)) * up * gw; }
                v4u w; w.x = cvtpk(o[0], o[1]); w.y = cvtpk(o[2], o[3]); w.z = cvtpk(o[4], o[5]); w.w = cvtpk(o[6], o[7]);
                *(v4u*)(ACT + ((size_t)u.pm * 256 + lr) * FH + f0) = w; } }
    }
};

namespace att {
constexpr int KVBLK = 64;
constexpr int SHM_V = KVBLK * 128 * 2, SHM_K = KVBLK * 128 * 2;
constexpr int OFF_WS = 2 * SHM_V + 2 * SHM_K;
constexpr int OFF_XCH = OFF_WS + 8 * 256;
constexpr int LDS_NEED = OFF_XCH + 4 * 16384;
static_assert(LDS_NEED <= MISC_OFF, "attention LDS");
constexpr float THR = 8.f;
#define KSWZ(row, colB) ((row) * 256 + ((colB) ^ (((row) & 7) << 4)))
#define SBAR() __builtin_amdgcn_sched_barrier(0)
__device__ __forceinline__ int crow(int r, int hi) { return (r & 3) + 8 * (r >> 2) + 4 * hi; }

template <bool DIFF> struct Cst { static constexpr float SCALE = DIFF ? 0.125f : 0.088388347648318440f; static constexpr float C = SCALE * 1.4426950408889634f; };

template <bool DIFF>
__device__ __forceinline__ void partialSM(f32x16& p0, f32x16& p1, float& m_reg, float& mn, float& alpha) {
  constexpr float C = Cst<DIFF>::C, SCALE = Cst<DIFF>::SCALE;
  float pmax = p0[0];
#pragma unroll
  for (int r = 1; r < 16; ++r) pmax = fmaxf(pmax, p0[r]);
#pragma unroll
  for (int r = 0; r < 16; ++r) pmax = fmaxf(pmax, p1[r]);
  { auto rr = __builtin_amdgcn_permlane32_swap(__float_as_uint(pmax), __float_as_uint(pmax), false, false);
    pmax = fmaxf(__uint_as_float(rr[0]), __uint_as_float(rr[1])); }
  if (__builtin_expect(__all(pmax - m_reg <= THR / SCALE), 1)) { mn = m_reg; alpha = 1.f; }
  else { mn = fmaxf(m_reg, pmax); alpha = __builtin_amdgcn_exp2f((m_reg - mn) * C); m_reg = mn; }
  float mnC = -mn * C;
#pragma unroll
  for (int r = 0; r < 16; ++r) p0[r] = fmaf(p0[r], C, mnC);
#pragma unroll
  for (int r = 0; r < 16; ++r) p1[r] = fmaf(p1[r], C, mnC);
#pragma unroll
  for (int r = 0; r < 16; ++r) p0[r] = __builtin_amdgcn_exp2f(p0[r]);
}
__device__ __forceinline__ void finishSM(f32x16& p0, f32x16& p1, float alpha, float& l_reg, bf16x8& pa0, bf16x8& pa1, bf16x8& pa2, bf16x8& pa3) {
#pragma unroll
  for (int r = 0; r < 16; ++r) p1[r] = __builtin_amdgcn_exp2f(p1[r]);
  float ps = 0;
#pragma unroll
  for (int r = 0; r < 16; ++r) ps += p0[r];
#pragma unroll
  for (int r = 0; r < 16; ++r) ps += p1[r];
  { auto rr = __builtin_amdgcn_permlane32_swap(__float_as_uint(ps), __float_as_uint(ps), false, false);
    ps = __uint_as_float(rr[0]) + __uint_as_float(rr[1]); }
  l_reg = l_reg * alpha + ps;
#define PK4(P, BASE, OUT) do { unsigned a0 = cvtpk(P[BASE + 0], P[BASE + 1]), a1 = cvtpk(P[BASE + 2], P[BASE + 3]);   \
    unsigned b0 = cvtpk(P[BASE + 4], P[BASE + 5]), b1 = cvtpk(P[BASE + 6], P[BASE + 7]);                              \
    auto r0 = __builtin_amdgcn_permlane32_swap(a0, b0, false, false); auto r1 = __builtin_amdgcn_permlane32_swap(a1, b1, false, false); \
    v4u w = {r0[0], r1[0], r0[1], r1[1]}; OUT = *reinterpret_cast<bf16x8*>(&w); } while (0)
  PK4(p0, 0, pa0); PK4(p0, 8, pa1); PK4(p1, 0, pa2); PK4(p1, 8, pa3);
#undef PK4
}
template <int NQ>
__device__ __forceinline__ void qkt(f32x16& p0, f32x16& p1, const char* Ks, const bf16x8* qr, int r32, int hi, int d0base) {
  p0 = f32x16{}; p1 = f32x16{};
#pragma unroll
  for (int d0 = 0; d0 < NQ; ++d0) { const int cb = ((d0base + d0) * 16 + hi * 8) * 2;
    bf16x8 b0 = *reinterpret_cast<const bf16x8*>(Ks + KSWZ(r32, cb));
    bf16x8 b1 = *reinterpret_cast<const bf16x8*>(Ks + KSWZ(32 + r32, cb));
    p0 = __builtin_amdgcn_mfma_f32_32x32x16_bf16(b0, qr[d0], p0, 0, 0, 0);
    p1 = __builtin_amdgcn_mfma_f32_32x32x16_bf16(b1, qr[d0], p1, 0, 0, 0); }
}
__device__ __forceinline__ int v_st(int k, int c) { const int kk = (k & ~0xC) | ((k & 4) << 1) | ((k & 8) >> 1); return ((kk >> 3) * 4 + (c >> 5)) * 512 + ((kk & 7) * 32 + (c & 31)) * 2; }
__device__ __forceinline__ int v_rd_base(int lane) { return ((lane & 3) << 3) | (((lane >> 2) & 3) << 6) | (((lane >> 4) & 1) << 5) | (((lane >> 5) & 1) << 8); }
constexpr int v_rd_off(int d0, int ks, int half) { return d0 * 512 + ks * 4096 + half * 2048; }
template <int OFF> __device__ __forceinline__ s16x4 tr_read(int vb) {
  s16x4 r; asm volatile("ds_read_b64_tr_b16 %0, %1 offset:%2" : "=&v"(r) : "v"(vb), "i"(OFF) : "memory"); return r;
}
template <int D0> __device__ __forceinline__ void pv_one(f32x16& od, int vb, bf16x8 pa0, bf16x8 pa1, bf16x8 pa2, bf16x8 pa3) {
  const s16x4 l0 = tr_read<v_rd_off(D0, 0, 0)>(vb), h0 = tr_read<v_rd_off(D0, 0, 1)>(vb), l1 = tr_read<v_rd_off(D0, 1, 0)>(vb), h1 = tr_read<v_rd_off(D0, 1, 1)>(vb);
  const s16x4 l2 = tr_read<v_rd_off(D0, 2, 0)>(vb), h2 = tr_read<v_rd_off(D0, 2, 1)>(vb), l3 = tr_read<v_rd_off(D0, 3, 0)>(vb), h3 = tr_read<v_rd_off(D0, 3, 1)>(vb);
  asm volatile("s_waitcnt lgkmcnt(0)" ::: "memory"); SBAR();
#define PK(L, H) (bf16x8){L[0], L[1], L[2], L[3], H[0], H[1], H[2], H[3]}
  od = __builtin_amdgcn_mfma_f32_32x32x16_bf16(pa0, PK(l0, h0), od, 0, 0, 0);
  od = __builtin_amdgcn_mfma_f32_32x32x16_bf16(pa1, PK(l1, h1), od, 0, 0, 0);
  od = __builtin_amdgcn_mfma_f32_32x32x16_bf16(pa2, PK(l2, h2), od, 0, 0, 0);
  od = __builtin_amdgcn_mfma_f32_32x32x16_bf16(pa3, PK(l3, h3), od, 0, 0, 0);
#undef PK
}
__device__ __forceinline__ void pv_d0(f32x16* o, int vb, bf16x8 pa0, bf16x8 pa1, bf16x8 pa2, bf16x8 pa3) {
  pv_one<0>(o[0], vb, pa0, pa1, pa2, pa3); pv_one<1>(o[1], vb, pa0, pa1, pa2, pa3); pv_one<2>(o[2], vb, pa0, pa1, pa2, pa3); pv_one<3>(o[3], vb, pa0, pa1, pa2, pa3);
}

constexpr float THRL = THR * 1.4426950408889634f;
__device__ __forceinline__ void qkt_negm(f32x16& p0, f32x16& p1, const char* Ks, const bf16x8* qr, const f32x16& negm, int r32, int hi, int d0base) {
#pragma unroll
  for (int d0 = 0; d0 < 4; ++d0) { const int cb = ((d0base + d0) * 16 + hi * 8) * 2;
    bf16x8 b0 = *reinterpret_cast<const bf16x8*>(Ks + KSWZ(r32, cb));
    bf16x8 b1 = *reinterpret_cast<const bf16x8*>(Ks + KSWZ(32 + r32, cb));
    if (d0 == 0) { p0 = __builtin_amdgcn_mfma_f32_32x32x16_bf16(b0, qr[0], negm, 0, 0, 0); p1 = __builtin_amdgcn_mfma_f32_32x32x16_bf16(b1, qr[0], negm, 0, 0, 0); }
    else { p0 = __builtin_amdgcn_mfma_f32_32x32x16_bf16(b0, qr[d0], p0, 0, 0, 0); p1 = __builtin_amdgcn_mfma_f32_32x32x16_bf16(b1, qr[d0], p1, 0, 0, 0); } }
}
__device__ __forceinline__ void splat16(f32x16& v, float x) {
#pragma unroll
  for (int r = 0; r < 16; ++r) v[r] = x;
}
__device__ __forceinline__ void partial_first_negm(f32x16& p0, f32x16& p1, float& m_reg, f32x16& negm) {
  float pmax = p0[0];
#pragma unroll
  for (int r = 1; r < 16; ++r) pmax = fmaxf(pmax, p0[r]);
#pragma unroll
  for (int r = 0; r < 16; ++r) pmax = fmaxf(pmax, p1[r]);
  { auto rr = __builtin_amdgcn_permlane32_swap(__float_as_uint(pmax), __float_as_uint(pmax), false, false);
    pmax = fmaxf(__uint_as_float(rr[0]), __uint_as_float(rr[1])); }
  m_reg = pmax; splat16(negm, -pmax);
#pragma unroll
  for (int r = 0; r < 16; ++r) { p0[r] -= pmax; p1[r] -= pmax; }
#pragma unroll
  for (int r = 0; r < 16; ++r) p0[r] = __builtin_amdgcn_exp2f(p0[r]);
}
__device__ __forceinline__ void pv_partial_negm(f32x16* o, int vb, bf16x8 pa0, bf16x8 pa1, bf16x8 pa2, bf16x8 pa3, f32x16& p0, f32x16& p1, float& m_reg, f32x16& negm, float& alpha) {
  pv_one<0>(o[0], vb, pa0, pa1, pa2, pa3);
  float pmax = p0[0];
#pragma unroll
  for (int r = 1; r < 16; ++r) pmax = fmaxf(pmax, p0[r]);
  pv_one<1>(o[1], vb, pa0, pa1, pa2, pa3);
#pragma unroll
  for (int r = 0; r < 16; ++r) pmax = fmaxf(pmax, p1[r]);
  { auto rr = __builtin_amdgcn_permlane32_swap(__float_as_uint(pmax), __float_as_uint(pmax), false, false);
    pmax = fmaxf(__uint_as_float(rr[0]), __uint_as_float(rr[1])); }
  if (__builtin_expect(__all(pmax <= THRL), 1)) { alpha = 1.f; }
  else { const float d = fmaxf(pmax, 0.f); alpha = __builtin_amdgcn_exp2f(-d); m_reg += d; splat16(negm, -m_reg);
#pragma unroll
    for (int r = 0; r < 16; ++r) { p0[r] -= d; p1[r] -= d; } }
  pv_one<2>(o[2], vb, pa0, pa1, pa2, pa3);
  pv_one<3>(o[3], vb, pa0, pa1, pa2, pa3);
#pragma unroll
  for (int r = 0; r < 16; ++r) p0[r] = __builtin_amdgcn_exp2f(p0[r]);
  asm volatile("" : "+v"(p0), "+v"(p1));
  SBAR();
}

template <bool DIFF>
__device__ __forceinline__ void pv_partial(f32x16* o, int vb, bf16x8 pa0, bf16x8 pa1, bf16x8 pa2, bf16x8 pa3, f32x16& p0, f32x16& p1, float& m_reg, float& mn, float& alpha) {
  constexpr float C = Cst<DIFF>::C, SCALE = Cst<DIFF>::SCALE;
  pv_one<0>(o[0], vb, pa0, pa1, pa2, pa3);
  float pmax = p0[0];
#pragma unroll
  for (int r = 1; r < 16; ++r) pmax = fmaxf(pmax, p0[r]);
  pv_one<1>(o[1], vb, pa0, pa1, pa2, pa3);
#pragma unroll
  for (int r = 0; r < 16; ++r) pmax = fmaxf(pmax, p1[r]);
  { auto rr = __builtin_amdgcn_permlane32_swap(__float_as_uint(pmax), __float_as_uint(pmax), false, false);
    pmax = fmaxf(__uint_as_float(rr[0]), __uint_as_float(rr[1])); }
  if (__builtin_expect(__all(pmax - m_reg <= THR / SCALE), 1)) { mn = m_reg; alpha = 1.f; }
  else { mn = fmaxf(m_reg, pmax); alpha = __builtin_amdgcn_exp2f((m_reg - mn) * C); m_reg = mn; }
  pv_one<2>(o[2], vb, pa0, pa1, pa2, pa3);
  const float mnC = -mn * C;
#pragma unroll
  for (int r = 0; r < 16; ++r) p0[r] = fmaf(p0[r], C, mnC);
#pragma unroll
  for (int r = 0; r < 16; ++r) p1[r] = fmaf(p1[r], C, mnC);
  pv_one<3>(o[3], vb, pa0, pa1, pa2, pa3);
#pragma unroll
  for (int r = 0; r < 16; ++r) p0[r] = __builtin_amdgcn_exp2f(p0[r]);
  asm volatile("" : "+v"(p0), "+v"(p1));
  SBAR();
}

template <bool DIFF>
__device__ __forceinline__ void attn_unit(const bf16_t* __restrict__ Qb, int ldq, const bf16_t* __restrict__ Kh, const bf16_t* __restrict__ Vh, int ldk, int seq,
                                          bf16_t* __restrict__ Ob, int ldo, bool rope, int n0, const f32x2* __restrict__ tab,
                                          const float* __restrict__ qg  , const float* __restrict__ subg  , float lam, char* lds, const int wv) {
  constexpr int NQ = DIFF ? 4 : 8;
  const int tid = ltid(wv), wid = wv, lane = tid & 63, r32 = lane & 31, hi = lane >> 5;
  const int qblk = DIFF ? (wid & 3) : wid, map = DIFF ? (wid >> 2) : 0;
  char* V_lds = lds; char* K_lds = lds + 2 * SHM_V;
  float* wsf = (float*)(lds + OFF_WS) + wid * 64; float* li_l = wsf; float* al_l = wsf + 32;
  float m_reg = -1e30f, l_reg = 0; f32x16 o[4] = {}; bf16x8 qr[NQ];
  const int sr = tid >> 4, sc = (tid & 15) * 8, vst0 = v_st(sr, sc), vst1 = v_st(32 + sr, sc);
  const int vb0 = (int)(uintptr_t)V_lds + v_rd_base(lane);
  struct { bf16x8 vs0, vs1, ks0, ks1; } sr_[2] = {};
#define LD8(p) (*reinterpret_cast<const bf16x8*>(p))
#define SLOAD(i, k0) do { sr_[i].vs0 = LD8(&Vh[(size_t)((k0) + sr) * ldk + sc]); sr_[i].vs1 = LD8(&Vh[(size_t)((k0) + 32 + sr) * ldk + sc]); \
    sr_[i].ks0 = LD8(&Kh[(size_t)((k0) + sr) * ldk + sc]); sr_[i].ks1 = LD8(&Kh[(size_t)((k0) + 32 + sr) * ldk + sc]); } while (0)
#define SWRITE(b, i) do { *(bf16x8*)(V_lds + (b) * SHM_V + vst0) = sr_[i].vs0;          \
    *(bf16x8*)(V_lds + (b) * SHM_V + vst1) = sr_[i].vs1; int kc = sc * 2;               \
    *(bf16x8*)(K_lds + (b) * SHM_K + KSWZ(sr, kc)) = sr_[i].ks0;                       \
    *(bf16x8*)(K_lds + (b) * SHM_K + KSWZ(32 + sr, kc)) = sr_[i].ks1; } while (0)
  constexpr int SE = 0, SO = 1;
  SLOAD(SE, 0); SLOAD(SO, KVBLK);
  {
    const bf16_t* Qw = Qb + (size_t)(qblk * 32 + r32) * ldq + map * 64 + hi * 8;
    const int n = n0 + qblk * 32 + r32;
    float qf[NQ][8];
#pragma unroll
    for (int d0 = 0; d0 < NQ; ++d0) { const v4u w = *reinterpret_cast<const v4u*>(Qw + d0 * 16);
      qf[d0][0] = bf_lo(w.x); qf[d0][1] = bf_hi(w.x); qf[d0][2] = bf_lo(w.y); qf[d0][3] = bf_hi(w.y);
      qf[d0][4] = bf_lo(w.z); qf[d0][5] = bf_hi(w.z); qf[d0][6] = bf_lo(w.w); qf[d0][7] = bf_hi(w.w); }
    if constexpr (!DIFF) {
      float ss = 0.f;
#pragma unroll
      for (int d0 = 0; d0 < NQ; ++d0)
#pragma unroll
        for (int j = 0; j < 8; ++j) ss += qf[d0][j] * qf[d0][j];
      ss = xsum<32>(ss);
      const float rs = 1.0f / sqrtf(ss * (1.f / 128.f) + RMS_EPS);
#pragma unroll
      for (int d0 = 0; d0 < NQ; ++d0) { const f32x4 g0 = *(const f32x4*)(qg + d0 * 16 + hi * 8), g1 = *(const f32x4*)(qg + d0 * 16 + hi * 8 + 4);
#pragma unroll
        for (int j = 0; j < 4; ++j) { qf[d0][j] *= rs * g0[j]; qf[d0][4 + j] *= rs * g1[j]; } }
    }
    if (rope) {
      constexpr int NF = DIFF ? 16 : 32;
      constexpr int HB = DIFF ? 1 : 2;
#pragma unroll
      for (int ax = 0; ax < 2; ++ax) { const int pos = ax ? (n & 63) : (n >> 6);
#pragma unroll
        for (int hb = 0; hb < HB; ++hb) { const int dA = ax * 2 * HB + hb, dB = dA + HB;
          const f32x2* tp = tab + pos * NF + hb * 16 + hi * 8;
#pragma unroll
          for (int j = 0; j < 8; ++j) { const f32x2 cs = tp[j]; const float x1 = qf[dA][j], x2 = qf[dB][j];
            qf[dA][j] = x1 * cs.x - x2 * cs.y; qf[dB][j] = x2 * cs.x + x1 * cs.y; } } }
    }
    if constexpr (DIFF) {
#pragma unroll
      for (int d0 = 0; d0 < NQ; ++d0)
#pragma unroll
        for (int j = 0; j < 8; ++j) qf[d0][j] *= Cst<true>::C; }
#pragma unroll
    for (int d0 = 0; d0 < NQ; ++d0) { v4u w = {cvtpk(qf[d0][0], qf[d0][1]), cvtpk(qf[d0][2], qf[d0][3]), cvtpk(qf[d0][4], qf[d0][5]), cvtpk(qf[d0][6], qf[d0][7])};
      qr[d0] = *reinterpret_cast<bf16x8*>(&w); }
  }
#define SWAIT() asm volatile("s_waitcnt vmcnt(4)" ::: "memory")
#define RESC(a) do { if (__any((a) < 1.f)) { if (hi == 0) al_l[r32] = (a); asm volatile("s_waitcnt lgkmcnt(0)" ::: "memory"); \
    _Pragma("unroll") for (int d = 0; d < 4; ++d) _Pragma("unroll") for (int r = 0; r < 16; ++r) o[d][r] *= al_l[crow(r, hi)]; } } while (0)
  f32x16 pA0, pA1, pB0, pB1; float mnA, mnB, alA, alB; bf16x8 pa0, pa1, pa2, pa3; const int NT = seq / KVBLK;
  const int dbase = map * 4;
  f32x16 negm = {};
  if constexpr (DIFF) m_reg = 0.f;
#define QKT(P0, P1, KS) do { if constexpr (DIFF) qkt_negm(P0, P1, KS, qr, negm, r32, hi, dbase); else qkt<NQ>(P0, P1, KS, qr, r32, hi, dbase); } while (0)
#define PVP(VB, P0, P1, MN, AL) do { if constexpr (DIFF) pv_partial_negm(o, VB, pa0, pa1, pa2, pa3, P0, P1, m_reg, negm, AL); else pv_partial<DIFF>(o, VB, pa0, pa1, pa2, pa3, P0, P1, m_reg, MN, AL); } while (0)
  SWAIT(); SWRITE(0, SE); __syncthreads();
  QKT(pA0, pA1, K_lds); if constexpr (DIFF) { partial_first_negm(pA0, pA1, m_reg, negm); alA = 1.f; } else partialSM<DIFF>(pA0, pA1, m_reg, mnA, alA);
  if (2 < NT) SLOAD(SE, 2 * KVBLK);
  SWAIT(); SWRITE(1, SO); __syncthreads();
  for (int j = 1; j + 1 < NT; j += 2) {
    SBAR(); QKT(pB0, pB1, K_lds + SHM_K);
    finishSM(pA0, pA1, alA, l_reg, pa0, pa1, pa2, pa3); SBAR();
    SLOAD(SO, (j + 2) * KVBLK); SBAR();
    PVP(vb0, pB0, pB1, mnB, alB);
    __syncthreads(); SWAIT(); SWRITE(0, SE);
    RESC(alB); __syncthreads();
    SBAR(); QKT(pA0, pA1, K_lds);
    finishSM(pB0, pB1, alB, l_reg, pa0, pa1, pa2, pa3); SBAR();
    if (j + 3 < NT) SLOAD(SE, (j + 3) * KVBLK); SBAR();
    PVP(vb0 + (int)SHM_V, pA0, pA1, mnA, alA);
    __syncthreads(); SWAIT(); SWRITE(1, SO);
    RESC(alA); __syncthreads();
  }
  SBAR(); QKT(pB0, pB1, K_lds + SHM_K);
  finishSM(pA0, pA1, alA, l_reg, pa0, pa1, pa2, pa3); SBAR();
  PVP(vb0, pB0, pB1, mnB, alB);
  __syncthreads(); RESC(alB);
  finishSM(pB0, pB1, alB, l_reg, pa0, pa1, pa2, pa3); SBAR();
  pv_d0(o, vb0 + (int)SHM_V, pa0, pa1, pa2, pa3);
  if (hi == 0) li_l[r32] = l_reg; asm volatile("s_waitcnt lgkmcnt(0)" ::: "memory");
#pragma unroll
  for (int r = 0; r < 16; ++r) { const float rl = __builtin_amdgcn_rcpf(li_l[crow(r, hi)]);
#pragma unroll
    for (int d0 = 0; d0 < 4; ++d0) o[d0][r] *= rl; }
  if constexpr (!DIFF) {
    bf16_t* ost = (bf16_t*)(lds + OFF_XCH) + wid * (32 * 136);
#pragma unroll
    for (int r = 0; r < 16; ++r) { const int orow = crow(r, hi);
#pragma unroll
      for (int d0 = 0; d0 < 4; ++d0) ost[orow * 136 + d0 * 32 + r32] = (bf16_t)(cvtpk(o[d0][r], 0.f) & 0xffffu); }
    asm volatile("s_waitcnt lgkmcnt(0)" ::: "memory");
    bf16_t* Ow = Ob + (size_t)(wid * 32) * ldo;
#pragma unroll
    for (int i = 0; i < 8; ++i) { const int c = i * 64 + lane, orow = c >> 4, ch = c & 15;
      *(v4u*)(Ow + (size_t)orow * ldo + ch * 8) = *(const v4u*)(ost + orow * 136 + ch * 8); }
  } else {
    float* xch = (float*)(lds + OFF_XCH) + qblk * 4096;
    if (map == 1) {
#pragma unroll
      for (int d0 = 0; d0 < 4; ++d0)
#pragma unroll
        for (int r = 0; r < 16; ++r) xch[(d0 * 16 + r) * 64 + lane] = o[d0][r];
    }
    __syncthreads();
    if (map == 0) {
      float ssr[16];
#pragma unroll
      for (int r = 0; r < 16; ++r) { float s = 0.f;
#pragma unroll
        for (int d0 = 0; d0 < 4; ++d0) { const float d = o[d0][r] - lam * xch[(d0 * 16 + r) * 64 + lane]; o[d0][r] = d; s += d * d; }
        ssr[r] = s; }
#pragma unroll
      for (int r = 0; r < 16; ++r) { float s = ssr[r];
        s = sum32(s);
        ssr[r] = (1.0f / sqrtf(s * (1.f / 128.f) + RMS_EPS)) * (1.f - LAMBDA_INIT0); }
      asm volatile("s_waitcnt lgkmcnt(0)" ::: "memory");
      bf16_t* ost = (bf16_t*)xch;
#pragma unroll
      for (int d0 = 0; d0 < 4; ++d0) { const float g = subg[d0 * 32 + r32];
#pragma unroll
        for (int r = 0; r < 16; ++r) ost[crow(r, hi) * 136 + d0 * 32 + r32] = (bf16_t)(cvtpk(o[d0][r] * ssr[r] * g, 0.f) & 0xffffu); }
      asm volatile("s_waitcnt lgkmcnt(0)" ::: "memory");
      bf16_t* Ow = Ob + (size_t)(qblk * 32) * ldo;
#pragma unroll
      for (int i = 0; i < 8; ++i) { const int c = i * 64 + lane, orow = c >> 4, ch = c & 15;
        *(v4u*)(Ow + (size_t)orow * ldo + ch * 8) = *(const v4u*)(ost + orow * 136 + ch * 8); }
    }
  }
#undef QKT
#undef PVP
#undef LD8
#undef SLOAD
#undef SWRITE
#undef SWAIT
#undef RESC
}
#undef KSWZ
#undef SBAR
}

#ifndef REPMASK
#define REPMASK 0
#endif
#ifndef REPN
#define REPN 1
#endif
#ifndef PHMASK
#define PHMASK 0x3ffff
#endif
struct Args { const float* in[28]; float* o_; unsigned char* w_; };
enum { I_X = 0, I_C, I_CTX, I_CCTX, I_WMOD, I_BMOD, I_LNMG, I_LNMB, I_LNFG, I_LNFB, I_DWQKV, I_DWO, I_LQ1, I_LK1, I_LQ2, I_LK2, I_SUBG,
       I_GWQKV, I_GWO, I_GQN, I_GKN, I_WGRP, I_BGRP, I_WRT, I_BRT, I_WGATE, I_WUP, I_WDOWN };

constexpr int PTR_OFF = MISC_OFF + 1024;
__device__ __forceinline__ const float* ldptr(LAS unsigned char* ldsl, int i) {
    int off = PTR_OFF + 8 * i; asm volatile("" : "+v"(off));
    const LAS unsigned* p = (const LAS unsigned*)(ldsl + off);
    const unsigned lo = __builtin_amdgcn_readfirstlane(p[0]), hi = __builtin_amdgcn_readfirstlane(p[1]);
    return (const float*)(GAS const float*)(((unsigned long long)hi << 32) | lo);
}
struct TrItem { const float* W; int N; bf16_t* WT; int KT; int dstrow0; int k0; int n0; int hi_stride; };
__device__ __forceinline__ void transpose_load(const TrItem& I, float (&wv_)[32], int lane) {
    const unsigned vo_ = (unsigned)((lane >> 3) * I.N + (lane & 7) * 4) * 4u;
#pragma unroll
    for (int i = 0; i < 8; ++i) { const f32x4 w = __builtin_nontemporal_load((const f32x4*)((const char*)(I.W + (size_t)(I.k0 + 8 * i) * I.N + I.n0) + vo_));
        wv_[4 * i] = w[0]; wv_[4 * i + 1] = w[1]; wv_[4 * i + 2] = w[2]; wv_[4 * i + 3] = w[3]; }
}
__device__ __forceinline__ void transpose_finish(const TrItem& I, const float (&wv_)[32], LAS float* scr, int lane) {
#pragma unroll
    for (int i = 0; i < 8; ++i)
#pragma unroll
        for (int j = 0; j < 4; ++j) scr[(8 * i + (lane >> 3)) * 33 + (lane & 7) * 4 + j] = wv_[4 * i + j];
    LDS_WAIT(); asm volatile("" ::: "memory");
    const int c = lane & 7;
#pragma unroll
    for (int j = 0; j < 4; ++j) { const int n = (lane >> 3) + 8 * j; const LAS float* s = scr + (8 * c) * 33 + n;
        v4u o; o.x = cvtpk(s[0 * 33], s[1 * 33]); o.y = cvtpk(s[2 * 33], s[3 * 33]); o.z = cvtpk(s[4 * 33], s[5 * 33]); o.w = cvtpk(s[6 * 33], s[7 * 33]);
        *(v4u*)(I.WT + (size_t)(I.dstrow0 + (n & 15) + (n >> 4) * I.hi_stride) * I.KT + I.k0 + 8 * c) = o; }
    LDS_WAIT(); asm volatile("" ::: "memory");
}
__device__ __forceinline__ void transpose_item(const float* __restrict__ W, int N, bf16_t* __restrict__ WT, int KT, int dstrow0, int k0, int n0, LAS float* scr, int lane, int hi_stride = 16) {
    const TrItem I{W, N, WT, KT, dstrow0, k0, n0, hi_stride}; float wv_[32];
    transpose_load(I, wv_, lane); transpose_finish(I, wv_, scr, lane);
}
__device__ __forceinline__ TrItem moe_item_desc(LAS unsigned char* ldsl, int layer, int it, bf16_t* wgu_, bf16_t* wd_) {
    const int e = it / 384, r = it - e * 384;
    const size_t eoff = ((size_t)layer * NEXP + e) * (size_t)DM * FH;
    if (r < 256) {
        const int isup = r >> 7, rr = r & 127, kb = rr >> 3, nb = rr & 7, n0 = nb * 32;
        const float* W = (isup ? ldptr(ldsl, I_WUP) : ldptr(ldsl, I_WGATE)) + eoff;
        return TrItem{W, FH, wgu_, DM, e * 512 + (n0 >> 7) * 256 + isup * 128 + (n0 & 127), kb * 64, n0, 16};
    }
    const int rr = r - 256, kb = rr >> 5, nb = rr & 31;
    return TrItem{ldptr(ldsl, I_WDOWN) + eoff, DM, wd_, FH, e * 1024 + nb * 32, kb * 64, nb * 32, 16};
}
__device__ __forceinline__ void moe_weight_item(LAS unsigned char* ldsl, int layer, int it, bf16_t* wgu_, bf16_t* wd_, LAS float* scr, int lane) {
    const TrItem I = moe_item_desc(ldsl, layer, it, wgu_, wd_); float wv_[32];
    transpose_load(I, wv_, lane); transpose_finish(I, wv_, scr, lane);
}
__device__ __forceinline__ void moe_weight_pair(LAS unsigned char* ldsl, int layer, int ita, int itb, bf16_t* wgu_, bf16_t* wd_, LAS float* scr, int lane) {
    const TrItem A = moe_item_desc(ldsl, layer, ita, wgu_, wd_), B = moe_item_desc(ldsl, layer, itb, wgu_, wd_); float wa_[32], wb_[32];
    transpose_load(A, wa_, lane); transpose_load(B, wb_, lane);
    transpose_finish(A, wa_, scr, lane); transpose_finish(B, wb_, scr, lane);
}
__device__ __forceinline__ int pcol(int lane, int c) { return 8 * lane + 512 * (c >> 1) + 4 * (c & 1); }
__device__ __forceinline__ void store_h_row(const f32x4 (&v)[4], const float* __restrict__ sv, const float* __restrict__ av, bf16_t* __restrict__ hrow, int lane) {
#pragma unroll
    for (int j = 0; j < 2; ++j) { const int col = 8 * lane + 512 * j;
        const f32x4 s0 = *(const f32x4*)(sv + col), s1 = *(const f32x4*)(sv + col + 4), a0 = *(const f32x4*)(av + col), a1 = *(const f32x4*)(av + col + 4);
        const f32x4 h0 = v[2 * j] * (a0 + 1.0f) + s0, h1 = v[2 * j + 1] * (a1 + 1.0f) + s1;
        v4u w; w.x = cvtpk(h0[0], h0[1]); w.y = cvtpk(h0[2], h0[3]); w.z = cvtpk(h1[0], h1[1]); w.w = cvtpk(h1[2], h1[3]); *(v4u*)(hrow + col) = w; }
}
__device__ __forceinline__ void ln_row(f32x4 (&v)[4], const float* __restrict__ g, const float* __restrict__ bb, int lane, float& mean_o, float& rstd_o) {
    float s = 0.f;
#pragma unroll
    for (int j = 0; j < 4; ++j) s += (v[j][0] + v[j][1]) + (v[j][2] + v[j][3]);
    const float mean = wave_sum(s) * (1.f / DM); float s2 = 0.f;
#pragma unroll
    for (int j = 0; j < 4; ++j) { v[j] = v[j] - mean; s2 += (v[j][0] * v[j][0] + v[j][1] * v[j][1]) + (v[j][2] * v[j][2] + v[j][3] * v[j][3]); }
    const float rstd = 1.0f / sqrtf(wave_sum(s2) * (1.f / DM) + LN_EPS);
#pragma unroll
    for (int j = 0; j < 4; ++j) { const int col = pcol(lane, j); const f32x4 gg = *(const f32x4*)(g + col), b4 = *(const f32x4*)(bb + col); v[j] = v[j] * rstd * gg + b4; }
    mean_o = mean; rstd_o = rstd;
}

__device__ __forceinline__ int row_of(int layer, int idx, int per_item, int it, int j) { (void)idx;
    if (layer == 0) return it * per_item + j; const int xi = it * per_item + j; return (xi >> 11) * TT + LCT + (xi & 2047); }
template <int RB>
__device__ __forceinline__ void p8_rows(int idx0, int layer, const int4* __restrict__ tinfo, const LAS int* rowb, const bf16_t* __restrict__ fo, const hf_t* __restrict__ Yp, const f32x2* __restrict__ rst, const float* __restrict__ mg, const float* __restrict__ mb, float* outp, float* xrcp,
                                        const float* __restrict__ modlp, const float* __restrict__ modn, const float* __restrict__ fg, const float* __restrict__ fb, bf16_t* hbp, hf_t* r1p, int lane) {
    f32x4 v[RB][4]; v4u yh[RB][2], fa[RB][2], fc[RB][2]; int rr[RB]; int4 ti[RB];
#pragma unroll
    for (int q = 0; q < RB; ++q) { const int idx = idx0 + q; rr[q] = layer == 0 ? idx : (idx >> 11) * TT + LCT + (idx & 2047); ti[q] = tinfo[rr[q]]; }
    f32x2 st[RB];
#pragma unroll
    for (int q = 0; q < RB; ++q) { const hf_t* xr = Yp + (size_t)rr[q] * DM; st[q] = rst[rr[q]];
        const bf16_t* f1 = fo + (size_t)(rowb[ti[q].x] + ti[q].y) * DM; const bf16_t* f2 = fo + (size_t)(rowb[ti[q].z] + ti[q].w) * DM;
#pragma unroll
        for (int j = 0; j < 2; ++j) yh[q][j] = *(const v4u*)(xr + 8 * lane + 512 * j);
#pragma unroll
        for (int j = 0; j < 2; ++j) { fa[q][j] = *(const v4u*)(f1 + 8 * lane + 512 * j); fc[q][j] = *(const v4u*)(f2 + 8 * lane + 512 * j); } }
#pragma unroll
    for (int q = 0; q < RB; ++q) { const int r = rr[q]; const int b = r / TT, t = r - b * TT; const int cond = t < LCT ? 8 : b;
        const float* gf = modlp + (size_t)cond * NMOD + 5120;
#pragma unroll
        for (int c = 0; c < 4; ++c) { const int col = pcol(lane, c); const v4u a4 = fa[q][c >> 1], c4 = fc[q][c >> 1];
            const unsigned ax = (c & 1) ? a4.z : a4.x, ay = (c & 1) ? a4.w : a4.y, cx = (c & 1) ? c4.z : c4.x, cy = (c & 1) ? c4.w : c4.y;
            const f32x4 f = {bf_lo(ax) + bf_lo(cx), bf_hi(ax) + bf_hi(cx), bf_lo(ay) + bf_lo(cy), bf_hi(ay) + bf_hi(cy)};
            const v4u y4 = yh[q][c >> 1]; const unsigned yx = (c & 1) ? y4.z : y4.x, yy = (c & 1) ? y4.w : y4.y;
            const f32x4 yv = {hf_lo(yx), hf_hi(yx), hf_lo(yy), hf_hi(yy)};
            const f32x4 x1 = (yv - st[q].x) * st[q].y * *(const f32x4*)(mg + col) + *(const f32x4*)(mb + col);
            v[q][c] = x1 * ALPHA + *(const f32x4*)(gf + col) * f; }
        float mean, rstd; ln_row(v[q], fg, fb, lane, mean, rstd); }
#pragma unroll
    for (int q = 0; q < RB; ++q) { const int r = rr[q]; const int b = r / TT, t = r - b * TT; const int cond = t < LCT ? 8 : b;
        if (layer == 0) { if (t >= LCT) { hf_t* xh = r1p + ((size_t)b * NXT + (t - LCT)) * DM;
#pragma unroll
                for (int j = 0; j < 2; ++j) { const f32x4 a = v[q][2 * j], c4 = v[q][2 * j + 1]; v4u w; w.x = pkh(a[0], a[1]); w.y = pkh(a[2], a[3]); w.z = pkh(c4[0], c4[1]); w.w = pkh(c4[2], c4[3]);
                    *(v4u*)(xh + 8 * lane + 512 * j) = w; } } }
        else { float* xr = xr_ptr(outp, xrcp, r);
#pragma unroll
            for (int c = 0; c < 4; ++c) *(f32x4*)(xr + pcol(lane, c)) = v[q][c]; }
        if (layer == 0) { const float* mv = modn + (size_t)cond * NMOD; store_h_row(v[q], mv, mv + 1024, hbp + (size_t)r * DM, lane); } }
}

template <int RB>
__device__ __forceinline__ void h0_rows(int r0, const float* __restrict__ xin, const float* __restrict__ cin, const float* __restrict__ mv0, bf16_t* hb, hf_t* xh, int lane) {
    f32x4 v[RB][4];
#pragma unroll
    for (int q = 0; q < RB; ++q) { const float* src = in0_ptr(xin, cin, r0 + q);
#pragma unroll
        for (int j = 0; j < 2; ++j) { v[q][2 * j] = *(const f32x4*)(src + 8 * lane + 512 * j); v[q][2 * j + 1] = *(const f32x4*)(src + 8 * lane + 512 * j + 4); } }
#pragma unroll
    for (int q = 0; q < RB; ++q) { const int r = r0 + q; const int b = r / TT, t = r - b * TT; const int cond = t < LCT ? 8 : b;
        const float* sv = mv0 + (size_t)cond * NMOD; const float* av = sv + 1024; bf16_t* hrow = hb + (size_t)r * DM;
#pragma unroll
        for (int j = 0; j < 2; ++j) { const int col = 8 * lane + 512 * j;
            const f32x4 s0 = *(const f32x4*)(sv + col), s1 = *(const f32x4*)(sv + col + 4), a0 = *(const f32x4*)(av + col), a1 = *(const f32x4*)(av + col + 4);
            const f32x4 h0 = v[q][2 * j] * (a0 + 1.0f) + s0, h1 = v[q][2 * j + 1] * (a1 + 1.0f) + s1;
            v4u w; w.x = cvtpk(h0[0], h0[1]); w.y = cvtpk(h0[2], h0[3]); w.z = cvtpk(h1[0], h1[1]); w.w = cvtpk(h1[2], h1[3]); *(v4u*)(hrow + col) = w;
            const f32x4 x0 = v[q][2 * j], x1 = v[q][2 * j + 1];
            v4u xw; xw.x = pkh(x0[0], x0[1]); xw.y = pkh(x0[2], x0[3]); xw.z = pkh(x1[0], x1[1]); xw.w = pkh(x1[2], x1[3]); *(v4u*)(xh + (size_t)r * DM + col) = xw; } }
}

__global__ void __launch_bounds__(512, 2) fwd_megakernel(Args args) {
    extern __shared__ __attribute__((aligned(16))) unsigned char lds[];
    LAS unsigned char* ldsl = (LAS unsigned char*)lds;
    volatile LAS unsigned* MISC = (volatile LAS unsigned*)(ldsl + MISC_OFF);
    const int G0 = gridDim.x; const int bx0 = blockIdx.x;
    const int vcu0 = (G0 % 8 == 0) ? (bx0 % 8) * (G0 / 8) + bx0 / 8 : bx0;
    const int wv = __builtin_amdgcn_readfirstlane(threadIdx.x >> 6);
#define PHASE_IDS() int G = G0, bx = bx0, vcu = vcu0; asm volatile("" : "+s"(G), "+s"(bx), "+s"(vcu)); const int NGW = G * 8; (void)NGW; (void)bx; int wave = wv; asm volatile("" : "+s"(wave)); const int tid = ltid(wave); (void)tid; const int lane = tid & 63; const int gw = vcu * 8 + wave; (void)gw; (void)lane
#define AIN(i) ldptr(ldsl, (i))
#define WSB ((unsigned char*)ldptr(ldsl, 29))
#define ctl ((gu32*)(WSB + WS_CTL))
#define modv ((float*)(WSB + WS_MOD))
#define tab64 ((f32x2*)(WSB + WS_TAB64))
#define tab128 ((f32x2*)(WSB + WS_TAB128))
#define wrt ((float*)(WSB + WS_WRT))
#define wrs ((bf16_t*)(WSB + WS_WRS))
#define tokinfo ((int4*)(WSB + WS_TOKINFO))
#define tokof ((int*)(WSB + WS_TOKOF))
#define rstats ((f32x2*)(WSB + WS_STATS))
#define gwof ((float*)(WSB + WS_GWOF))
#define ACTB ((bf16_t*)(WSB + WS_QKV))
#define XRC ((float*)(WSB + WS_XRC))
#define wqkv0 ((bf16_t*)(WSB + WS_WQKV0))
#define wo0 ((bf16_t*)(WSB + WS_WO0))
#define wqkv1 ((bf16_t*)(WSB + WS_WQKV1))
#define wo1 ((bf16_t*)(WSB + WS_WO1))
#define wgu ((bf16_t*)(WSB + WS_WGU))
#define wd ((bf16_t*)(WSB + WS_WD))
#define HB ((bf16_t*)(WSB + WS_HBUF))
#define QKV ((bf16_t*)(WSB + WS_QKV))
#define HS QKV
#define Y ((hf_t*)(WSB + WS_YOFF))
#define rowst ((f32x2*)(WSB + WS_ROWST))
#define FO ((bf16_t*)(WSB + WS_Y))
#define out ((float*)ldptr(ldsl, 28))
    for (int u = threadIdx.x; u < (LDS_BYTES - MISC_OFF) / 4; u += 512) ((LAS unsigned*)(ldsl + MISC_OFF))[u] = 0u;
    __syncthreads();
    if (threadIdx.x == 0) { LAS unsigned long long* pt = (LAS unsigned long long*)(ldsl + PTR_OFF);
#pragma unroll
        for (int i = 0; i < 28; ++i) pt[i] = (unsigned long long)args.in[i];
        pt[28] = (unsigned long long)args.o_; pt[29] = (unsigned long long)args.w_; }
    __syncthreads();
    xcd_barrier_post((unsigned*)(ctl + CW_BAR));
#define GRID_BAR() xcd_barrier((unsigned*)(ctl + CW_BAR), MISC + 8, ltid(wv) == 0)

        for (int rep_ = 0; rep_ < ((REPMASK >> 0) & 1) * REPN + 1; ++rep_) {
    if (PHMASK & (1 << 0)) {
        PHASE_IDS();
        for (int it = bx; it < 192; it += G) {
            const int layer = it / 96, col0 = (it % 96) * 64;
            const float* Wm = AIN(I_WMOD) + (size_t)layer * DM * NMOD;
            LAS float* sl = (LAS float*)(ldsl + wave * 8192);
            const int k0 = wave * 128;
            for (int idx = lane; idx < 9 * 128; idx += 64) { const int cond = idx >> 7, kk = idx & 127;
                const float v = cond < 8 ? AIN(I_C)[cond * DM + k0 + kk] : AIN(I_CCTX)[k0 + kk];
                sl[idx] = v / (1.f + expf(-v)); }
            LDS_WAIT(); asm volatile("" ::: "memory");
            const int rg = lane >> 4, c4 = (lane & 15) * 4;
            f32x4 acc[9];
#pragma unroll
            for (int c = 0; c < 9; ++c) acc[c] = (f32x4){0.f, 0.f, 0.f, 0.f};
            const unsigned lofs = (unsigned)(rg * NMOD + c4) * 4u;
            { f32x4 wv_[32];
#pragma unroll
                for (int i = 0; i < 32; ++i) wv_[i] = __builtin_nontemporal_load((const f32x4*)((const char*)(Wm + (size_t)(k0 + 4 * i) * NMOD + col0) + lofs));
#pragma unroll
                for (int i = 0; i < 32; ++i) {
#pragma unroll
                    for (int c = 0; c < 9; ++c) acc[c] += wv_[i] * sl[c * 128 + 4 * i + rg]; } }
            LAS float* part = (LAS float*)(ldsl + 65536);
#pragma unroll
            for (int c = 0; c < 9; ++c) *(LAS f32x4*)(part + (wave * 4 + rg) * 576 + c * 64 + c4) = acc[c];
            __syncthreads();
            for (int idx = tid; idx < 576; idx += 512) { float s = 0.f;
#pragma unroll
                for (int w = 0; w < 32; ++w) s += part[w * 576 + idx];
                const int cond = idx >> 6, col = col0 + (idx & 63);
                modv[((size_t)layer * 9 + cond) * NMOD + col] = s + AIN(I_BMOD)[layer * NMOD + col]; }
            __syncthreads();
        }
        for (int idx = bx * 512 + tid; idx < 3072 + 2 * 8 * 4 * 3 * 64; idx += G * 512) {
            if (idx < 1024) { const int pos = idx >> 4, f = idx & 15; const float inv = powf(10000.f, -(float)(2 * f) / 32.f); float s, c; sincosf((float)pos * inv, &s, &c); tab64[idx] = (f32x2){c, s}; }
            else if (idx < 3072) { const int i2 = idx - 1024, pos = i2 >> 5, f = i2 & 31; const float inv = powf(10000.f, -(float)(2 * f) / 64.f); float s, c; sincosf((float)pos * inv, &s, &c); tab128[i2] = (f32x2){c, s}; }
            else { const int i2 = idx - 3072, ln = i2 & 63, nb = (i2 >> 6) % 3, s = ((i2 >> 6) / 3) & 3, w = ((i2 >> 6) / 12) & 7, l = (i2 >> 6) / 96;
                const int k0 = 128 * w + 32 * s + 8 * (ln >> 4), o = nb * 16 + (ln & 15); float wv_[8];
#pragma unroll
                for (int j = 0; j < 8; ++j) wv_[j] = o < 4 ? AIN(I_WGRP)[(size_t)l * DM * 4 + (k0 + j) * 4 + o] : (o < 36 ? AIN(I_WRT)[(size_t)l * DM * 32 + (k0 + j) * 32 + (o - 4)] : 0.f);
                unsigned hi_[4], lo_[4];
#pragma unroll
                for (int j = 0; j < 4; ++j) { hi_[j] = cvtpk(wv_[2 * j], wv_[2 * j + 1]); lo_[j] = cvtpk(wv_[2 * j] - bf_lo(hi_[j]), wv_[2 * j + 1] - bf_hi(hi_[j])); }
                bf16_t* dst = wrs + ((size_t)(((l * 8 + w) * 4 + s) * 3 + nb) * 2) * 512 + ln * 8;
                *(v4u*)dst = (v4u){hi_[0], hi_[1], hi_[2], hi_[3]}; *(v4u*)(dst + 512) = (v4u){lo_[0], lo_[1], lo_[2], lo_[3]}; }
        }
        LAS float* scr = (LAS float*)(ldsl + wave * 16384);
        constexpr int S0 = 16 * 96, S1 = 16 * 32, S2 = 16 * 48, S3 = 16 * 32, S4 = NEXP * 384;
        for (int it = gw; it < S0 + S1 + S2 + S3; it += NGW) {
            int r = it;
            if (r < S0) { const int n0 = (r % 96) * 32; const bool kcol = (n0 >= 1024 && n0 < 2048);
                transpose_item(AIN(I_DWQKV), NQKV0, wqkv0, DM, kcol ? (n0 & ~255) + ((n0 >> 6) & 3) * 32 + ((n0 >> 5) & 1) * 16 : n0, (r / 96) * 64, n0, scr, lane, kcol ? 128 : 16); continue; } r -= S0;
            if (r < S1) { transpose_item(AIN(I_DWO), DM, wo0, DM, (r % 32) * 32, (r / 32) * 64, (r % 32) * 32, scr, lane); continue; } r -= S1;
            if (r < S2) { const int n0 = (r % 48) * 32; const bool kcol = (n0 >= 1024 && n0 < 1280);
                transpose_item(AIN(I_GWQKV), NQKV1, wqkv1, DM, kcol ? 1024 + ((n0 >> 5) & 1) * 128 + ((n0 >> 7) & 1) * 64 + ((n0 >> 6) & 1) * 32 : n0, (r / 48) * 64, n0, scr, lane); continue; } r -= S2;
            if (r < S3) { transpose_item(AIN(I_GWO), DM, wo1, DM, (r % 32) * 32, (r / 32) * 64, (r % 32) * 32, scr, lane); continue; }
        }
        { int it = gw; for (; it + NGW < S4; it += 2 * NGW) moe_weight_pair(ldsl, 0, it, it + NGW, wgu, wd, scr, lane);
          if (it < S4) moe_weight_item(ldsl, 0, it, wgu, wd, scr, lane); }
    }
    GRID_BAR(); }
        for (int rep_ = 0; rep_ < ((REPMASK >> 1) & 1) * REPN + 1; ++rep_) {
    if (PHMASK & (1 << 1)) { PHASE_IDS();
    { const float* xin = AIN(I_X); const float* cin = AIN(I_CTX); const float* mv0 = modv; bf16_t* hb = HB;
    const int per = (MALL + NGW - 1) / NGW; int r0 = gw * per; const int r1 = min((int)MALL, r0 + per);
    hf_t* xh = (hf_t*)(WSB + WS_Y);
    for (; r0 + 5 <= r1; r0 += 5) h0_rows<5>(r0, xin, cin, mv0, hb, xh, lane);
    for (; r0 + 4 <= r1; r0 += 4) h0_rows<4>(r0, xin, cin, mv0, hb, xh, lane);
    for (; r0 < r1; ++r0) h0_rows<1>(r0, xin, cin, mv0, hb, xh, lane);
    } }
    GRID_BAR(); }

#pragma unroll
    for (int layer = 0; layer < 2; ++layer) {
#define modl (modv + (size_t)layer * 9 * NMOD)
        const int NQ = layer == 0 ? NQKV0 : NQKV1;
        for (int rep_ = 0; rep_ < ((REPMASK >> 2) & 1) * REPN + 1; ++rep_) {
        if (PHMASK & (1 << 2))
        { PHASE_IDS();
            pg8::Gemm g{HB, layer == 0 ? wqkv0 : wqkv1, MALL, NQ, DM};
            SchedRect S; if (layer == 0) S.init(72, NQKV0, G, bx, 0, 0); else S.init(64, NQKV1, G, bx, 1, 16);
            EpiStoreBf16 E{QKV, NQ, 0xffff, layer == 0 ? tab64 : tab128, layer == 0 ? (const float*)nullptr : AIN(I_GKN), (LAS float*)(ldsl + MISC_OFF + 4096)};
            pg8::gemm_phase<EpiStoreBf16, SchedRect, true, true>(ldsl, g, S, E, wave);
        }
        GRID_BAR(); }
        for (int rep_ = 0; rep_ < ((REPMASK >> 4) & 1) * REPN + 1; ++rep_) {
        if (PHMASK & (1 << 4)) {
        if (layer == 0 && (PHMASK & (1 << 16))) { PHASE_IDS();
            float lam;
            { const float s1 = wave_sum(AIN(I_LQ1)[lane] * AIN(I_LK1)[lane]), s2 = wave_sum(AIN(I_LQ2)[lane] * AIN(I_LK2)[lane]);
              lam = expf(s1) - expf(s2) + LAMBDA_INIT0; }
            const int nH = 1024, base = nH / G, rem = nH % G;
            const int u0 = vcu * base + (vcu < rem ? vcu : rem), cnt = base + (vcu < rem ? 1 : 0);
            for (int i = 0; i < cnt; ++i) {
                const int u = u0 + i, bh = u >> 4, qb = u & 15, b = bh >> 3, h = bh & 7;
                const size_t row0 = (size_t)b * TT + LCT + qb * 128;
                const bf16_t* kb = QKV + (size_t)b * TT * NQKV0 + h * 128;
                att::attn_unit<true>(QKV + row0 * NQKV0 + h * 128, NQKV0, kb + 1024, kb + 2048, NQKV0, TT, HB + row0 * DM + h * 128, DM,
                                     true, qb * 128, tab64, nullptr, AIN(I_SUBG), lam, (char*)lds, wave);
            }
            for (int l = vcu; l < 128; l += G) {
                const int bh = l >> 1, qb = l & 1, b = bh >> 3, h = bh & 7;
                const size_t row0 = (size_t)b * TT + qb * 128;
                const bf16_t* kb = QKV + (size_t)b * TT * NQKV0 + h * 128;
                att::attn_unit<true>(QKV + row0 * NQKV0 + h * 128, NQKV0, kb + 1024, kb + 2048, NQKV0, LCT, HB + row0 * DM + h * 128, DM,
                                     false, 0, tab64, nullptr, AIN(I_SUBG), lam, (char*)lds, wave);
            }
        } else if (PHMASK & (1 << 17)) { PHASE_IDS();
            const int nU = 512, base = nU / G, rem = nU % G;
            const int u0 = vcu * base + (vcu < rem ? vcu : rem), cnt = base + (vcu < rem ? 1 : 0);
            for (int i = 0; i < cnt; ++i) {
                const int u = u0 + i, bh = u >> 3, qb = u & 7, b = bh >> 3, h = bh & 7;
                const size_t row0 = (size_t)b * TT + LCT + qb * 256;
                const bf16_t* kb = QKV + (size_t)b * TT * NQKV1 + (h >> 2) * 128;
                att::attn_unit<false>(QKV + row0 * NQKV1 + h * 128, NQKV1, kb + 1024, kb + 1280, NQKV1, TT, HB + row0 * DM + h * 128, DM,
                                      true, qb * 256, tab128, AIN(I_GQN), nullptr, 0.f, (char*)lds, wave);
            }
        } }
        GRID_BAR(); }
        for (int rep_ = 0; rep_ < ((REPMASK >> 5) & 1) * REPN + 1; ++rep_) {
        if (PHMASK & (1 << 5))
        { PHASE_IDS();
            pg8::Gemm g{HB, layer == 0 ? wo0 : wo1, MALL, DM, DM};
            SchedRect S; if (layer == 0) S.init(72, DM, G, bx, 0, 0); else S.init(64, DM, G, bx, 1, 0);
            if (layer == 0) { EpiResid<2> E{Y, (const float*)(WSB + WS_Y), (const float*)nullptr, modl, rstats}; pg8::gemm_phase<EpiResid<2>, SchedRect, true, true>(ldsl, g, S, E, wave); }
            else { EpiResid<1> E{Y, (const float*)(WSB + WS_R1), (const float*)nullptr, modl, rstats}; pg8::gemm_phase<EpiResid<1>, SchedRect, true, true>(ldsl, g, S, E, wave); }
        }
        GRID_BAR(); }
        if (PHMASK & (1 << 6))
        { PHASE_IDS();
            const int TR = layer == 0 ? 72 : 64;
            const f32x2* stq = rstats; const hf_t* Yq = Y; float* outq = out; float* xrcq = XRC; const float* modq = modl; bf16_t* hbq = HB;
            const float* lg = AIN(I_LNMG) + layer * DM; const float* lb = AIN(I_LNMB) + layer * DM;
            const bf16_t* wrs_l = wrs + (size_t)layer * 8 * 4 * 3 * 2 * 512;
            LAS float* red = (LAS float*)ldsl;
            LAS float* logits = (LAS float*)(ldsl + 116736);
            LAS float* stats = (LAS float*)(ldsl + 127232);
            LAS int* lcnt = (LAS int*)(ldsl + 127232 + 576);
            LAS int* lbase = lcnt + 32;
            for (int it = bx; it < 256; it += G) {
                LAS float* mods = (LAS float*)(ldsl + 82944);
                LAS float* lnv = mods + 4096;
                { const int b0i = row_of(layer, 0, TR, it, 0) / TT;
                  for (int i = tid; i < 1536; i += 512) { f32x4 v;
                      if (i < 1024) { const int slot = i >> 9, w = (i >> 8) & 1, c = (i & 255) * 4; v = *(const f32x4*)(modq + (size_t)(slot ? 8 : b0i) * NMOD + (w ? 4096 : 3072) + c); }
                      else { const int w = (i - 1024) >> 8, c = ((i - 1024) & 255) * 4; v = *(const f32x4*)((w ? lb : lg) + c); }
                      *(LAS f32x4*)(mods + i * 4) = v; } }
                v4u ypre[5];
                { const int l15p = lane & 15, kgp = lane >> 4; const hf_t* Yp_ = Y;
#pragma unroll
                  for (int mt = 0; mt < 5; ++mt) { const int j = mt * 16 + l15p; const int r = row_of(layer, 0, TR, it, j < TR ? j : 0); ypre[mt] = *(const v4u*)(Yp_ + (size_t)r * DM + 128 * wave + 8 * kgp); } }
                if (tid < 32) lcnt[tid] = 0;
                if (tid < TR) { const int r = row_of(layer, 0, TR, it, tid); const f32x2* sp = stq + (size_t)r * 16; float S = 0.f, Q = 0.f;
#pragma unroll
                    for (int p = 0; p < 16; ++p) { const f32x2 v = sp[p]; S += v.x; Q += v.y; }
                    const float mean = S * (1.f / DM); const float var = fmaxf(Q * (1.f / DM) - mean * mean, 0.f);
                    const float rstd = 1.0f / sqrtf(var + LN_EPS); stats[2 * tid] = mean; stats[2 * tid + 1] = rstd; rowst[r] = (f32x2){mean, rstd}; }
                __syncthreads();
                {
                    const int l15 = lane & 15, kg = lane >> 4;
                    pg8::f32x4 acc[5][3];
#pragma unroll
                    for (int mt = 0; mt < 5; ++mt)
#pragma unroll
                        for (int nb = 0; nb < 3; ++nb) acc[mt][nb] = (pg8::f32x4){0.f, 0.f, 0.f, 0.f};
                    int rrow[5]; float rmean[5], rrstd[5]; int rcond[5];
#pragma unroll
                    for (int mt = 0; mt < 5; ++mt) { const int j = mt * 16 + l15; const bool ok = j < TR; const int r = ok ? row_of(layer, 0, TR, it, j) : row_of(layer, 0, TR, it, 0);
                        const int bb = r / TT, tt = r - bb * TT; rrow[mt] = ok ? r : -1; rmean[mt] = stats[2 * (ok ? j : 0)]; rrstd[mt] = stats[2 * (ok ? j : 0) + 1];
                        rcond[mt] = tt < LCT ? 8 : bb; }
                    const int rfirst = row_of(layer, 0, TR, it, 0);
#define P4_LOADY(YB, S_) do { const int k0_ = 128 * wave + 32 * (S_) + 8 * kg; _Pragma("unroll") for (int mt = 0; mt < 5; ++mt) YB[mt] = *(const v4u*)(Yq + (size_t)(rrow[mt] >= 0 ? rrow[mt] : rfirst) * DM + k0_); } while (0)
#define P4_STEP(YB, S_) do { const int s = (S_); const int k0 = 128 * wave + 32 * s + 8 * kg; \
                        const f32x4 g0 = *(const LAS f32x4*)(lnv + k0), g1 = *(const LAS f32x4*)(lnv + k0 + 4), b0 = *(const LAS f32x4*)(lnv + 1024 + k0), b1 = *(const LAS f32x4*)(lnv + 1024 + k0 + 4); \
                        bf16x8 bh[3], bl[3]; \
                        _Pragma("unroll") for (int nb = 0; nb < 3; ++nb) { const bf16_t* bp = wrs_l + ((size_t)((wave * 4 + s) * 3 + nb) * 2) * 512 + lane * 8; bh[nb] = *(const bf16x8*)bp; bl[nb] = *(const bf16x8*)(bp + 512); } \
                        _Pragma("unroll") for (int mt = 0; mt < 5; ++mt) { \
                            int mo_ = (rcond[mt] == 8 ? 2048 : 0) + k0; asm volatile("" : "+v"(mo_)); \
                            const LAS float* mv = mods + mo_; \
                            const f32x4 s0 = *(const LAS f32x4*)(mv), s1 = *(const LAS f32x4*)(mv + 4), a0 = *(const LAS f32x4*)(mv + 1024), a1 = *(const LAS f32x4*)(mv + 1028); \
                            const v4u yh = YB[mt]; \
                            const f32x4 y0 = {hf_lo(yh.x), hf_hi(yh.x), hf_lo(yh.y), hf_hi(yh.y)}, y1 = {hf_lo(yh.z), hf_hi(yh.z), hf_lo(yh.w), hf_hi(yh.w)}; \
                            const f32x4 x0 = (y0 - rmean[mt]) * rrstd[mt] * g0 + b0, x1 = (y1 - rmean[mt]) * rrstd[mt] * g1 + b1; \
                            f32x4 h0 = x0 * (a0 + 1.0f) + s0, h1 = x1 * (a1 + 1.0f) + s1; \
                            if (rrow[mt] < 0) { h0 = (f32x4){0.f, 0.f, 0.f, 0.f}; h1 = h0; } \
                            v4u hh; hh.x = cvtpk(h0[0], h0[1]); hh.y = cvtpk(h0[2], h0[3]); hh.z = cvtpk(h1[0], h1[1]); hh.w = cvtpk(h1[2], h1[3]); \
                            v4u hl; hl.x = cvtpk(h0[0] - bf_lo(hh.x), h0[1] - bf_hi(hh.x)); hl.y = cvtpk(h0[2] - bf_lo(hh.y), h0[3] - bf_hi(hh.y)); \
                            hl.z = cvtpk(h1[0] - bf_lo(hh.z), h1[1] - bf_hi(hh.z)); hl.w = cvtpk(h1[2] - bf_lo(hh.w), h1[3] - bf_hi(hh.w)); \
                            if (rrow[mt] >= 0) *(v4u*)(hbq + (size_t)rrow[mt] * DM + k0) = hh; \
                            const bf16x8 ah = *reinterpret_cast<const bf16x8*>(&hh), al = *reinterpret_cast<const bf16x8*>(&hl); \
                            _Pragma("unroll") for (int nb = 0; nb < 3; ++nb) { \
                                acc[mt][nb] = __builtin_amdgcn_mfma_f32_16x16x32_bf16(ah, bh[nb], acc[mt][nb], 0, 0, 0); \
                                acc[mt][nb] = __builtin_amdgcn_mfma_f32_16x16x32_bf16(ah, bl[nb], acc[mt][nb], 0, 0, 0); \
                                acc[mt][nb] = __builtin_amdgcn_mfma_f32_16x16x32_bf16(al, bh[nb], acc[mt][nb], 0, 0, 0); } } } while (0)
                    { v4u ya[5], yb[5];
#pragma unroll
                      for (int mt = 0; mt < 5; ++mt) ya[mt] = ypre[mt];
#pragma unroll 1
                      for (int s2 = 0; s2 < 4; s2 += 2) {
                          P4_LOADY(yb, s2 + 1); __builtin_amdgcn_sched_barrier(0);
                          P4_STEP(ya, s2); __builtin_amdgcn_sched_barrier(0);
                          P4_LOADY(ya, (s2 + 2) & 3); __builtin_amdgcn_sched_barrier(0);
                          P4_STEP(yb, s2 + 1); __builtin_amdgcn_sched_barrier(0); } }
#undef P4_LOADY
#undef P4_STEP
                    const int ln2 = ltid(wave) & 63; const int l15b = ln2 & 15, kgb = ln2 >> 4;
#pragma unroll
                    for (int mt = 0; mt < 5; ++mt)
#pragma unroll
                        for (int nb = 0; nb < 3; ++nb)
#pragma unroll
                            for (int q = 0; q < 4; ++q) { const int row = mt * 16 + kgb * 4 + q, col = nb * 16 + l15b; if (row < 72 && col < 36) red[wave * 2592 + row * 36 + col] = acc[mt][nb][q]; }
                }
                const int tidc = ltid(wave);
                __syncthreads();
                for (int idx = tidc; idx < 2592; idx += 512) { const int o = idx % 36;
                    float s = o < 4 ? AIN(I_BGRP)[layer * 4 + o] : AIN(I_BRT)[layer * 32 + o - 4];
#pragma unroll
                    for (int w = 0; w < 8; ++w) s += red[w * 2592 + idx];
                    logits[idx] = s; }
                __syncthreads();
                int e1 = 0, e2 = 0, rk1 = 0, rk2 = 0; float G1 = 0.f, G2 = 0.f; int rme = 0;
                if (tidc < TR) {
                    const LAS float* lgt = logits + tidc * 36;
                    int gi = 0; float gm = lgt[0];
#pragma unroll
                    for (int g = 1; g < 4; ++g) { const float v = lgt[g]; if (v > gm) { gm = v; gi = g; } }
                    float gs = 0.f;
#pragma unroll
                    for (int g = 0; g < 4; ++g) gs += expf(lgt[g] - gm);
                    const float gtop = 1.0f / gs;
                    const LAS float* el = lgt + 4 + gi * 8;
                    int i1 = 0; float v1 = el[0];
#pragma unroll
                    for (int e = 1; e < 8; ++e) { const float v = el[e]; if (v > v1) { v1 = v; i1 = e; } }
                    int i2 = -1; float v2 = -3.0e38f;
#pragma unroll
                    for (int e = 0; e < 8; ++e) { const float v = el[e]; if (e != i1 && v > v2) { v2 = v; i2 = e; } }
                    const float ex = expf(v2 - v1); const float w1 = 1.0f / (1.0f + ex), w2 = ex / (1.0f + ex);
                    e1 = gi * 8 + i1; e2 = gi * 8 + i2; G1 = gtop * w1; G2 = gtop * w2;
                    rk1 = atomicAdd((int*)(lcnt + e1), 1); rk2 = atomicAdd((int*)(lcnt + e2), 1);
                    if (layer == 0) rme = it * 72 + tidc; else { const int xi = it * 64 + tidc; rme = (xi >> 11) * TT + LCT + (xi & 2047); }
                }
                __syncthreads();
                if (tidc < 32) { const int n = lcnt[tidc]; lbase[tidc] = n ? (int)__hip_atomic_fetch_add((unsigned*)(ctl + CW_CNT + layer * 32 + tidc), (unsigned)n, RLX_AGENT) : 0; }
                __syncthreads();
                if (tidc < TR) { const int q1 = lbase[e1] + rk1, q2 = lbase[e2] + rk2; tokinfo[rme] = make_int4(e1, q1, e2, q2);
                    int* tkf = tokof; float* gwf = gwof; tkf[(size_t)e1 * ECAP + q1] = rme; tkf[(size_t)e2 * ECAP + q2] = rme; gwf[(size_t)e1 * ECAP + q1] = G1; gwf[(size_t)e2 * ECAP + q2] = G2; }
                __syncthreads();
            }
        }
        GRID_BAR();
        for (int rep_ = 0; rep_ < ((REPMASK >> 8) & 1) * REPN + 1; ++rep_) {
        if (PHMASK & (1 << 8))
        {
            PHASE_IDS();
            LAS unsigned char* tile_e = ldsl + TILEE_OFF; LAS int* rowb = (LAS int*)(ldsl + ROWB_OFF); LAS int* cntl = (LAS int*)(ldsl + ROWB_OFF + 128); LAS int* tbase = (LAS int*)(ldsl + ROWB_OFF + 256);
            if (tid == 0) { int tt = 0;
#pragma unroll 1
                for (int e = 0; e < NEXP; ++e) { const int cnt = (int)__hip_atomic_load((unsigned*)(ctl + CW_CNT + layer * 32 + e), RLX_AGENT); rowb[e] = tt * 256; tbase[e] = tt; cntl[e] = cnt; tt += (cnt + 255) >> 8; }
                tbase[NEXP] = tt; MISC[16] = (unsigned)tt; }
            __syncthreads();
            if (tid < 176) { int e = 0;
#pragma unroll 1
                for (int q = 1; q < NEXP; ++q) e += (tbase[q] <= tid) ? 1 : 0;
                tile_e[tid] = (unsigned char)e; }
            __syncthreads();
            const int ntile = (int)MISC[16];
            pg8::Gemm g{HB, wgu, SORT_ROWS, NEXP * 512, DM};
            SchedExp S{ldsl + TILEE_OFF, 2, ntile * 2, G, bx};
            EpiGateUp E{ACTB, gwof, tbase};
            pg8::GatherA GA{tokof, tbase, cntl, 2, ECAP};
            pg8::gemm_phase<EpiGateUp, SchedExp, true, true, true, pg8::GatherA>(ldsl, g, S, E, wave, GA);
        }
        GRID_BAR(); }
        for (int rep_ = 0; rep_ < ((REPMASK >> 9) & 1) * REPN + 1; ++rep_) {
        if (PHMASK & (1 << 9))
        { PHASE_IDS();
            const int ntile = (int)MISC[16];
            int kdn = FH; asm volatile("" : "+s"(kdn));
            pg8::Gemm g{ACTB, wd, SORT_ROWS, NEXP * 1024, kdn};
            SchedExp S{ldsl + TILEE_OFF, 4, ntile * 4, G, bx};
            EpiStoreBf16 E{FO, DM, 3, (const f32x2*)nullptr, (const float*)nullptr, (LAS float*)nullptr};
            pg8::gemm_phase<EpiStoreBf16, SchedExp, true, true>(ldsl, g, S, E, wave);
        }
        GRID_BAR(); }
        if (PHMASK & (1 << 10))
        { PHASE_IDS();
            const float* fg = AIN(I_LNFG) + layer * DM; const float* fb = AIN(I_LNFB) + layer * DM;
            const int nrows = layer == 0 ? MALL : MXR;
            { const hf_t* Yq = Y; const f32x2* rsq = rowst; const float* mg = AIN(I_LNMG) + layer * DM; const float* mb = AIN(I_LNMB) + layer * DM; const int4* tinfo = tokinfo; const LAS int* rowb = (const LAS int*)(ldsl + ROWB_OFF); const bf16_t* fo = FO; float* outq = out; float* xrcq = XRC; const float* modq = modl; const float* modn = modv + (size_t)9 * NMOD; bf16_t* hbq = HB;
              if (layer == 0) {
                  const int per = (nrows + NGW - 1) / NGW; int idx0 = gw * per; const int i1 = min(nrows, idx0 + per);
                  for (; idx0 + 3 <= i1; idx0 += 3) p8_rows<3>(idx0, layer, tinfo, rowb, fo, Yq, rsq, mg, mb, outq, xrcq, modq, modn, fg, fb, hbq, (hf_t*)(WSB + WS_R1), lane);
                  for (; idx0 < i1; ++idx0) p8_rows<1>(idx0, layer, tinfo, rowb, fo, Yq, rsq, mg, mb, outq, xrcq, modq, modn, fg, fb, hbq, (hf_t*)(WSB + WS_R1), lane);
              } else
              for (int idx0 = gw * 4; idx0 < nrows; idx0 += NGW * 4) p8_rows<4>(idx0, layer, tinfo, rowb, fo, Yq, rsq, mg, mb, outq, xrcq, modq, modn, fg, fb, hbq, (hf_t*)(WSB + WS_R1), lane); }
            if (layer == 0) {
                LAS float* scr = (LAS float*)(ldsl + wave * 16384);
                { int it = gw; for (; it + NGW < NEXP * 384; it += 2 * NGW) moe_weight_pair(ldsl, 1, it, it + NGW, wgu, wd, scr, lane);
                  if (it < NEXP * 384) moe_weight_item(ldsl, 1, it, wgu, wd, scr, lane); }
                GRID_BAR();
            }
        }
    }
}

#undef out
#undef Y
#undef HS
#undef QKV
#undef HB
#undef ctl
extern "C" void kernel_launch(void* const* d_in, const int* in_sizes, int n_in, void* d_out, int out_size, void* d_ws, size_t ws_size, hipStream_t stream) {
    static int grid = 0;
    if (grid == 0) {
        if (n_in != 28 || in_sizes[0] != MXR * DM || out_size != MXR * DM || ws_size < WS_END) {
            fprintf(stderr, "kernel_launch: unexpected shapes: n_in %d in0 %d out %d ws %zu (need %zu)\n", n_in, n_in > 0 ? in_sizes[0] : -1, out_size, ws_size, (size_t)WS_END); grid = -1; return; }
        int dev = 0, cus = 0, per_cu = 0;
        if (hipGetDevice(&dev) != hipSuccess || hipDeviceGetAttribute(&cus, hipDeviceAttributeMultiprocessorCount, dev) != hipSuccess) { grid = -1; return; }
        if (hipFuncSetAttribute((const void*)fwd_megakernel, hipFuncAttributeMaxDynamicSharedMemorySize, LDS_BYTES) != hipSuccess) { fprintf(stderr, "kernel_launch: hipFuncSetAttribute failed\n"); grid = -1; return; }
        if (hipOccupancyMaxActiveBlocksPerMultiprocessor(&per_cu, (const void*)fwd_megakernel, 512, LDS_BYTES) != hipSuccess || per_cu < 1) { fprintf(stderr, "kernel_launch: occupancy query reports %d\n", per_cu); (void)hipGetLastError(); per_cu = 1; }
        grid = cus;
        if (grid > 256) grid = 256;
    }
    if (grid < 0) return;
    if (hipMemsetAsync((char*)d_ws + WS_CTL, 0, CTL_ZERO_BYTES, stream) != hipSuccess) { fprintf(stderr, "kernel_launch: memset failed\n"); return; }
    Args a{};
    for (int i = 0; i < 28; ++i) a.in[i] = (const float*)d_in[i];
    a.o_ = (float*)d_out; a.w_ = (unsigned char*)d_ws;
    hipLaunchKernelGGL(fwd_megakernel, dim3(grid), dim3(512), LDS_BYTES, stream, a);
    const hipError_t le = hipPeekAtLastError();
    if (le != hipSuccess) fprintf(stderr, "kernel_launch: launch failed: %s\n", hipGetErrorName(le));
}
```
